# Optimizing an MI355X kernel written in HIP

```python
import jax, jax.numpy as jnp
from jax import lax
import numpy as np

D_MODEL = 2048
BATCH = 2
SEQ = 8192
DEPTH = 1

CHUNK = 64
M_HEADS = 4
M_HEAD_DIM = 256
M_WIDTH = M_HEADS * M_HEAD_DIM
CONV_WIDTH = 4
FORGET_BIAS_LO = 3.0
FORGET_BIAS_HI = 6.0
A_HEADS = 8
A_HEAD_DIM = 128
A_WIDTH = A_HEADS * A_HEAD_DIM
LEFT_CHUNKS = 8
BAND = (LEFT_CHUNKS + 1) * CHUNK
MAX_REL = 128
N_REL = MAX_REL + CHUNK
N_BRANCH = 2
IN_COLS = 5 * M_WIDTH + 2 * M_HEADS + 4 * A_WIDTH + N_BRANCH * D_MODEL
EPS = 1e-6

kernel_name = "hybrid_mlstm_chunkattn_gated_block"


def rmsnorm(x, g):
    xf = x.astype(jnp.float32)
    y = xf * lax.rsqrt(jnp.mean(xf * xf, axis=-1, keepdims=True) + EPS)
    return (y * g).astype(x.dtype)


def to_heads(t, n_heads):
    b, s, _ = t.shape
    return t.reshape(b, s, n_heads, -1).transpose(0, 2, 1, 3)


def from_heads(t):
    b, h, s, dh = t.shape
    return t.transpose(0, 2, 1, 3).reshape(b, s, h * dh)


def split_columns(proj):
    sizes = [M_WIDTH] * 5 + [M_HEADS] * 2 + [A_WIDTH] * 4 + [D_MODEL] * N_BRANCH
    idx = [int(v) for v in np.cumsum(sizes)[:-1]]
    return jnp.split(proj, idx, axis=-1)


def causal_depthwise_conv(u, w, b):
    s = u.shape[1]
    up = jnp.pad(u, ((0, 0), (CONV_WIDTH - 1, 0), (0, 0)))
    out = b
    for tap in range(CONV_WIDTH):
        out = out + up[:, tap:tap + s] * w[tap]
    return out


def mlstm_cell(q, k, v, ig, lf):
    b_, h_, s_, dh = q.shape
    nc = s_ // CHUNK

    def chunks(t):
        return jnp.moveaxis(t.reshape(b_, h_, nc, CHUNK, *t.shape[3:]), 2, 0)

    tril = jnp.tril(jnp.ones((CHUNK, CHUNK), dtype=bool))

    def step(carry, inp):
        C, n, m = carry
        qc, kc, vc, ic, fc = inp
        bcum = jnp.cumsum(fc, axis=-1)
        d = jnp.where(tril, bcum[..., :, None] - bcum[..., None, :] + ic[..., None, :], -jnp.inf)
        inter = bcum + m[..., None]
        m_comb = jnp.maximum(jnp.max(d, axis=-1), inter)
        w_intra = jnp.exp(d - m_comb[..., None])
        w_inter = jnp.exp(inter - m_comb)
        s = jnp.einsum('bhtd,bhsd->bhts', qc, kc) * w_intra
        num = (jnp.einsum('bhts,bhsd->bhtd', s, vc)
               + w_inter[..., None] * jnp.einsum('bhvk,bhtk->bhtv', C, qc))
        den = jnp.sum(s, axis=-1) + w_inter * jnp.einsum('bhk,bhtk->bht', n, qc)
        h = num / jnp.maximum(jnp.abs(den), jnp.exp(-m_comb))[..., None]
        b_last = bcum[..., -1]
        g = b_last[..., None] - bcum + ic
        m_new = jnp.maximum(b_last + m, jnp.max(g, axis=-1))
        w_k = jnp.exp(g - m_new[..., None])
        w_c = jnp.exp(b_last + m - m_new)
        C_new = w_c[..., None, None] * C + jnp.einsum('bhs,bhsv,bhsk->bhvk', w_k, vc, kc)
        n_new = w_c[..., None] * n + jnp.einsum('bhs,bhsk->bhk', w_k, kc)
        return (C_new, n_new, m_new), h

    init = (jnp.zeros((b_, h_, dh, dh), jnp.float32),
            jnp.zeros((b_, h_, dh), jnp.float32),
            jnp.zeros((b_, h_), jnp.float32))
    _, hs = lax.scan(step, init, (chunks(q), chunks(k), chunks(v), chunks(ig), chunks(lf)))
    return jnp.moveaxis(hs, 0, 2).reshape(b_, h_, s_, dh)


def mlstm_branch(mq, mk, mv, mo, mz, mi, mf, b_if, conv_w, conv_b, mh_norm_g):
    dt = mv.dtype
    qk = jax.nn.silu(causal_depthwise_conv(jnp.concatenate([mq, mk], axis=-1), conv_w, conv_b))
    q_in, k_in = jnp.split(qk, 2, axis=-1)
    q = to_heads(q_in, M_HEADS).astype(jnp.float32)
    k = to_heads(k_in, M_HEADS).astype(jnp.float32) * (M_HEAD_DIM ** -0.5)
    v = to_heads(mv, M_HEADS).astype(jnp.float32)
    ig = (mi + b_if[:M_HEADS]).astype(jnp.float32).transpose(0, 2, 1)
    lf = jax.nn.log_sigmoid((mf + b_if[M_HEADS:]).astype(jnp.float32)).transpose(0, 2, 1)
    h = mlstm_cell(q, k, v, ig, lf)
    h = h * lax.rsqrt(jnp.mean(h * h, axis=-1, keepdims=True) + EPS)
    h = from_heads(h) * mh_norm_g
    h = h * jax.nn.sigmoid(mo.astype(jnp.float32))
    return (h * jax.nn.silu(mz.astype(jnp.float32))).astype(dt)


def chunk_attention_branch(aq, ak, av, az, rel_bias):
    b_, s_, _ = aq.shape
    nc = s_ // CHUNK
    q = to_heads(aq, A_HEADS) * (A_HEAD_DIM ** -0.5)
    k = to_heads(ak, A_HEADS)
    v = to_heads(av, A_HEADS)
    pad = ((0, 0), (0, 0), (LEFT_CHUNKS * CHUNK, 0), (0, 0))
    k_pad = jnp.pad(k, pad)
    v_pad = jnp.pad(v, pad)
    qi = jnp.arange(CHUNK)[:, None]
    kj = jnp.arange(BAND)[None, :]
    rel = jnp.clip(qi + LEFT_CHUNKS * CHUNK - kj, -(CHUNK - 1), MAX_REL) + (CHUNK - 1)
    bias = rel_bias[:, rel].astype(jnp.float32)

    def attend(j):
        qj = lax.dynamic_slice_in_dim(q, j * CHUNK, CHUNK, axis=2)
        kb = lax.dynamic_slice_in_dim(k_pad, j * CHUNK, BAND, axis=2)
        vb = lax.dynamic_slice_in_dim(v_pad, j * CHUNK, BAND, axis=2)
        valid = ((j - LEFT_CHUNKS) * CHUNK + jnp.arange(BAND)) >= 0
        s = jnp.einsum('bhqd,bhkd->bhqk', qj, kb).astype(jnp.float32) + bias
        s = jnp.where(valid, s, -jnp.inf)
        p = jax.nn.softmax(s, axis=-1)
        return jnp.einsum('bhqk,bhkd->bhqd', p.astype(vb.dtype), vb)

    out = lax.map(attend, jnp.arange(nc))
    out = out.transpose(1, 2, 0, 3, 4).reshape(b_, A_HEADS, s_, A_HEAD_DIM)
    return from_heads(out) * jax.nn.silu(az)


def hybrid_layer(x, c, w_ada, b_ada, norm_g, w_in, b_if, conv_w, conv_b, mh_norm_g,
                 rel_bias, w_proj_m, w_proj_a, w_out):
    mod = jax.nn.silu(c) @ w_ada + b_ada
    shift, scale, gate = jnp.split(mod, 3, axis=-1)
    h = rmsnorm(x, norm_g) * (1.0 + scale[:, None]) + shift[:, None]
    proj = h @ w_in
    (mq, mk, mv, mo, mz, mi, mf, aq, ak, av, az, g_m, g_a) = split_columns(proj)
    y_m = mlstm_branch(mq, mk, mv, mo, mz, mi, mf, b_if, conv_w, conv_b, mh_norm_g)
    y_a = chunk_attention_branch(aq, ak, av, az, rel_bias)
    merged = jax.nn.sigmoid(g_m) * (y_m @ w_proj_m) + jax.nn.sigmoid(g_a) * (y_a @ w_proj_a)
    return x + gate[:, None] * (merged @ w_out)


def setup_inputs(seed: int = 0) -> dict:
    key = jax.random.key(seed)
    ks = jax.random.split(key, 16)
    f32 = jnp.float32
    nrm = lambda k, shape: jax.random.normal(k, shape, f32)
    forget_b = jnp.linspace(FORGET_BIAS_LO, FORGET_BIAS_HI, M_HEADS).astype(f32)
    b_if = jnp.concatenate([0.1 * nrm(ks[6], (DEPTH, M_HEADS)),
                            forget_b[None] + 0.1 * nrm(ks[7], (DEPTH, M_HEADS))], axis=-1)
    return {
        "x": nrm(ks[0], (BATCH, SEQ, D_MODEL)),
        "c": nrm(ks[1], (BATCH, D_MODEL)),
        "w_ada": 0.5 * D_MODEL ** -0.5 * nrm(ks[2], (DEPTH, D_MODEL, 3 * D_MODEL)),
        "b_ada": 0.02 * nrm(ks[3], (DEPTH, 3 * D_MODEL)),
        "norm_g": 1.0 + 0.02 * nrm(ks[4], (DEPTH, D_MODEL)),
        "w_in": D_MODEL ** -0.5 * nrm(ks[5], (DEPTH, D_MODEL, IN_COLS)),
        "b_if": b_if,
        "conv_w": CONV_WIDTH ** -0.5 * nrm(ks[8], (DEPTH, CONV_WIDTH, 2 * M_WIDTH)),
        "conv_b": 0.02 * nrm(ks[9], (DEPTH, 2 * M_WIDTH)),
        "mh_norm_g": 1.0 + 0.02 * nrm(ks[10], (DEPTH, M_WIDTH)),
        "rel_bias": 0.1 * nrm(ks[11], (DEPTH, A_HEADS, N_REL)),
        "w_proj_m": M_WIDTH ** -0.5 * nrm(ks[12], (DEPTH, M_WIDTH, D_MODEL)),
        "w_proj_a": A_WIDTH ** -0.5 * nrm(ks[13], (DEPTH, A_WIDTH, D_MODEL)),
        "w_out": D_MODEL ** -0.5 * nrm(ks[14], (DEPTH, D_MODEL, D_MODEL)),
        "final_norm_g": 1.0 + 0.02 * nrm(ks[15], (D_MODEL,)),
    }


def reference(x, c, w_ada, b_ada, norm_g, w_in, b_if, conv_w, conv_b, mh_norm_g,
              rel_bias, w_proj_m, w_proj_a, w_out, final_norm_g):
    for layer in range(DEPTH):
        x = hybrid_layer(x, c, w_ada[layer], b_ada[layer], norm_g[layer], w_in[layer],
                         b_if[layer], conv_w[layer], conv_b[layer], mh_norm_g[layer],
                         rel_bias[layer], w_proj_m[layer], w_proj_a[layer], w_out[layer])
    return rmsnorm(x, final_norm_g)
```

```cpp
#include <hip/hip_runtime.h>
#include <cstdio>
#include <cstdint>

typedef unsigned short bf16;
constexpr int D = 2048, NB = 2, S = 8192, M = NB * S;
constexpr int INC = 13320, NP = 13312;
constexpr int C_MQ = 0, C_MK = 1024, C_MV = 2048, C_MO = 3072, C_MZ = 4096, C_AQ = 5120, C_AK = 6144, C_AV = 7168, C_AZ = 8192, C_GM = 9216, C_GA = 11264;
constexpr float EPS = 1e-6f;

__device__ __forceinline__ bf16 f2bf(float f) { unsigned u = __builtin_bit_cast(unsigned, f); return (bf16)((u + 0x7fffu + ((u >> 16) & 1u)) >> 16); }
__device__ __forceinline__ float bf2f(bf16 h) { return __builtin_bit_cast(float, (unsigned)h << 16); }
__device__ __forceinline__ float wave_sum(float v) {
#pragma unroll
    for (int o = 1; o < 64; o <<= 1) v += __shfl_xor(v, o);
    return v;
}
__device__ __forceinline__ float wave_max(float v) {
#pragma unroll
    for (int o = 1; o < 64; o <<= 1) v = fmaxf(v, __shfl_xor(v, o));
    return v;
}
__device__ __forceinline__ float sigmoidf_(float x) { return 1.f / (1.f + __expf(-x)); }
__device__ __forceinline__ float siluf_(float x) { return x / (1.f + __expf(-x)); }

__global__ void __launch_bounds__(256) k_ada(const float* __restrict__ c, const float* __restrict__ w_ada, const float* __restrict__ b_ada, float* __restrict__ mod) {
    __shared__ float sc[2][D];
    for (int i = threadIdx.x; i < 2 * D; i += 256) { float v = c[i]; sc[i / D][i % D] = v / (1.f + expf(-v)); }
    __syncthreads();
    const int n = blockIdx.x * 256 + threadIdx.x;
    float a0 = 0.f, a1 = 0.f;
    for (int k = 0; k < D; ++k) { const float w = w_ada[(size_t)k * (3 * D) + n]; a0 += sc[0][k] * w; a1 += sc[1][k] * w; }
    mod[n] = a0 + b_ada[n]; mod[3 * D + n] = a1 + b_ada[n];
}

__global__ void __launch_bounds__(256) k_norm(const float* __restrict__ x, const float* __restrict__ norm_g, const float* __restrict__ mod, const float* __restrict__ w_in,
                                              const float* __restrict__ b_if, bf16* __restrict__ H, float* __restrict__ gates) {
    const int row = blockIdx.x * 4 + (threadIdx.x >> 6), lane = threadIdx.x & 63, b = row / S;
    const float4* xr = (const float4*)(x + (size_t)row * D);
    float4 v[8]; float ss = 0.f;
#pragma unroll
    for (int j = 0; j < 8; ++j) { v[j] = xr[lane + 64 * j]; ss += v[j].x * v[j].x + v[j].y * v[j].y + v[j].z * v[j].z + v[j].w * v[j].w; }
    ss = wave_sum(ss);
    const float rstd = 1.0f / sqrtf(ss * (1.f / D) + EPS);
    float acc[8];
#pragma unroll
    for (int i = 0; i < 8; ++i) acc[i] = 0.f;
    const float* shift = mod + b * 3 * D; const float* scale = shift + D;
#pragma unroll
    for (int j = 0; j < 8; ++j) {
        const int k0 = (lane + 64 * j) * 4;
        const float xv[4] = {v[j].x, v[j].y, v[j].z, v[j].w};
        float hv[4];
#pragma unroll
        for (int e = 0; e < 4; ++e) {
            const int k = k0 + e;
            hv[e] = xv[e] * rstd * norm_g[k] * (1.f + scale[k]) + shift[k];
            const float4* wr = (const float4*)(w_in + (size_t)k * INC + 5120);
            const float4 w0 = wr[0], w1 = wr[1];
            acc[0] += hv[e] * w0.x; acc[1] += hv[e] * w0.y; acc[2] += hv[e] * w0.z; acc[3] += hv[e] * w0.w;
            acc[4] += hv[e] * w1.x; acc[5] += hv[e] * w1.y; acc[6] += hv[e] * w1.z; acc[7] += hv[e] * w1.w;
        }
        ushort4 o; o.x = f2bf(hv[0]); o.y = f2bf(hv[1]); o.z = f2bf(hv[2]); o.w = f2bf(hv[3]);
        *(ushort4*)(H + (size_t)row * D + k0) = o;
    }
#pragma unroll
    for (int i = 0; i < 8; ++i) acc[i] = wave_sum(acc[i]);
    if (lane == 0) {
#pragma unroll
        for (int i = 0; i < 4; ++i) gates[(size_t)row * 8 + i] = acc[i] + b_if[i];
#pragma unroll
        for (int i = 4; i < 8; ++i) { const float z = acc[i] + b_if[i]; gates[(size_t)row * 8 + i] = fminf(z, 0.f) - log1pf(expf(-fabsf(z))); }
    }
}

struct GemmArgs { const bf16* A; const bf16* A2; const float* B; const float* B2; int lda, ldb, K; bf16* Ob; int ldo; float* Of; const bf16* proj; const float* x; const float* mod; };
template <int MODE> __global__ void __launch_bounds__(256) k_gemm(GemmArgs g) {
    __shared__ float As[16][68]; __shared__ float Bs[16][68];
    const int tid = threadIdx.x, tx = tid & 15, ty = tid >> 4;
    const int m0 = blockIdx.y * 64, n0 = blockIdx.x * 64;
    float acc[4][4], acc2[4][4];
#pragma unroll
    for (int i = 0; i < 4; ++i)
#pragma unroll
        for (int j = 0; j < 4; ++j) { acc[i][j] = 0.f; acc2[i][j] = 0.f; }
    const int nseg = (MODE == 1) ? 2 : 1;
    for (int seg = 0; seg < nseg; ++seg) {
        const bf16* A = seg ? g.A2 : g.A; const float* Bm = seg ? g.B2 : g.B;
        const int ncol = (MODE == 0) ? (n0 + (n0 >= 5120 ? 8 : 0)) : n0;
        for (int k0 = 0; k0 < g.K; k0 += 16) {
            { const int r = tid >> 2, kq = (tid & 3) * 4; const ushort4 a = *(const ushort4*)(A + (size_t)(m0 + r) * g.lda + k0 + kq);
              As[kq + 0][r] = bf2f(a.x); As[kq + 1][r] = bf2f(a.y); As[kq + 2][r] = bf2f(a.z); As[kq + 3][r] = bf2f(a.w); }
            { const int k = tid >> 4, n4 = (tid & 15) * 4; const float4 bv = *(const float4*)(Bm + (size_t)(k0 + k) * g.ldb + ncol + n4);
              Bs[k][n4 + 0] = bv.x; Bs[k][n4 + 1] = bv.y; Bs[k][n4 + 2] = bv.z; Bs[k][n4 + 3] = bv.w; }
            __syncthreads();
#pragma unroll
            for (int k = 0; k < 16; ++k) {
                const float4 a = *(const float4*)&As[k][ty * 4]; const float4 bq = *(const float4*)&Bs[k][tx * 4];
                const float av[4] = {a.x, a.y, a.z, a.w}, bv[4] = {bq.x, bq.y, bq.z, bq.w};
                if (seg == 0) {
#pragma unroll
                    for (int i = 0; i < 4; ++i)
#pragma unroll
                        for (int j = 0; j < 4; ++j) acc[i][j] += av[i] * bv[j];
                } else {
#pragma unroll
                    for (int i = 0; i < 4; ++i)
#pragma unroll
                        for (int j = 0; j < 4; ++j) acc2[i][j] += av[i] * bv[j];
                }
            }
            __syncthreads();
        }
    }
#pragma unroll
    for (int i = 0; i < 4; ++i) {
        const int row = m0 + ty * 4 + i;
#pragma unroll
        for (int j = 0; j < 4; ++j) {
            const int col = n0 + tx * 4 + j;
            if (MODE == 0) g.Ob[(size_t)row * g.ldo + col] = f2bf(acc[i][j]);
            else if (MODE == 1) {
                const float gm = bf2f(g.proj[(size_t)row * NP + C_GM + col]), ga = bf2f(g.proj[(size_t)row * NP + C_GA + col]);
                g.Ob[(size_t)row * g.ldo + col] = f2bf(sigmoidf_(gm) * acc[i][j] + sigmoidf_(ga) * acc2[i][j]);
            } else {
                const int b = row / S;
                g.Of[(size_t)row * D + col] = g.x[(size_t)row * D + col] + g.mod[b * 3 * D + 2 * D + col] * acc[i][j];
            }
        }
    }
}

__global__ void __launch_bounds__(256) k_conv(const bf16* __restrict__ proj, const float* __restrict__ conv_w, const float* __restrict__ conv_b, bf16* __restrict__ qc, bf16* __restrict__ kc) {
    const size_t idx = (size_t)blockIdx.x * 256 + threadIdx.x;
    const int c = (int)(idx % 2048); const int row = (int)(idx / 2048); const int t = row % S;
    float o = conv_b[c];
#pragma unroll
    for (int tap = 0; tap < 4; ++tap) { const int tt = t - 3 + tap; if (tt >= 0) o += bf2f(proj[(size_t)(row - 3 + tap) * NP + c]) * conv_w[tap * 2048 + c]; }
    o = siluf_(o);
    if (c < 1024) qc[(size_t)row * 1024 + c] = f2bf(o); else kc[(size_t)row * 1024 + c - 1024] = f2bf(o * 0.0625f);
}

__global__ void __launch_bounds__(256) k_mlstm(const bf16* __restrict__ qc, const bf16* __restrict__ kc, const bf16* __restrict__ proj, const float* __restrict__ gates, float* __restrict__ hbuf) {
    const int w = blockIdx.x * 4 + (threadIdx.x >> 6), lane = threadIdx.x & 63;
    const int v = w & 255, h = (w >> 8) & 3, b = w >> 10;
    float C[4] = {0.f, 0.f, 0.f, 0.f}, n[4] = {0.f, 0.f, 0.f, 0.f};
    for (int t = 0; t < S; ++t) {
        const size_t row = (size_t)b * S + t;
        const ushort4 q4 = *(const ushort4*)(qc + row * 1024 + h * 256 + lane * 4);
        const ushort4 k4 = *(const ushort4*)(kc + row * 1024 + h * 256 + lane * 4);
        const float vv = bf2f(proj[row * NP + C_MV + h * 256 + v]);
        const float ig = gates[row * 8 + h], lf = gates[row * 8 + 4 + h];
        const float f = expf(lf), iv = expf(ig);
        const float kf[4] = {bf2f(k4.x), bf2f(k4.y), bf2f(k4.z), bf2f(k4.w)}, qf[4] = {bf2f(q4.x), bf2f(q4.y), bf2f(q4.z), bf2f(q4.w)};
        float num = 0.f, den = 0.f;
#pragma unroll
        for (int e = 0; e < 4; ++e) { n[e] = f * n[e] + iv * kf[e]; C[e] = f * C[e] + (iv * vv) * kf[e]; num += C[e] * qf[e]; den += n[e] * qf[e]; }
        num = wave_sum(num); den = wave_sum(den);
        if (lane == 0) hbuf[row * 1024 + h * 256 + v] = num / fmaxf(fabsf(den), 1.f);
    }
}
__global__ void __launch_bounds__(256) k_mpost(const float* __restrict__ hbuf, const bf16* __restrict__ proj, const float* __restrict__ mh_norm_g, bf16* __restrict__ ym) {
    const int w = blockIdx.x * 4 + (threadIdx.x >> 6), lane = threadIdx.x & 63;
    const int h = w & 3; const size_t row = w >> 2;
    const float4 hv = *(const float4*)(hbuf + row * 1024 + h * 256 + lane * 4);
    float ss = hv.x * hv.x + hv.y * hv.y + hv.z * hv.z + hv.w * hv.w;
    ss = wave_sum(ss);
    const float r = 1.0f / sqrtf(ss * (1.f / 256.f) + EPS);
    const float hh[4] = {hv.x, hv.y, hv.z, hv.w};
    ushort4 o; bf16 ov[4];
#pragma unroll
    for (int e = 0; e < 4; ++e) {
        const int c = h * 256 + lane * 4 + e;
        const float mo = bf2f(proj[row * NP + C_MO + c]), mz = bf2f(proj[row * NP + C_MZ + c]);
        ov[e] = f2bf(hh[e] * r * mh_norm_g[c] * sigmoidf_(mo) * siluf_(mz));
    }
    o.x = ov[0]; o.y = ov[1]; o.z = ov[2]; o.w = ov[3];
    *(ushort4*)(ym + row * 1024 + h * 256 + lane * 4) = o;
}

__global__ void __launch_bounds__(256) k_attn(const bf16* __restrict__ proj, const float* __restrict__ rel_bias, bf16* __restrict__ ya) {
    __shared__ float sq[4][128];
    const int wid = threadIdx.x >> 6, lane = threadIdx.x & 63;
    const int w = blockIdx.x * 4 + wid; const int hh = w & 7; const int row = w >> 3; const int b = row / S, t = row % S, j = t >> 6;
    { const unsigned qq = *(const unsigned*)(proj + (size_t)row * NP + C_AQ + hh * 128 + 2 * lane);
      sq[wid][2 * lane] = bf2f((bf16)(qq & 0xffff)) * 0.08838834764831845f; sq[wid][2 * lane + 1] = bf2f((bf16)(qq >> 16)) * 0.08838834764831845f; }
    __syncthreads();
    const int jlo = j > 8 ? j - 8 : 0; const int kstart = jlo * 64; const int nt = j - jlo + 1;
    float sc[9];
#pragma unroll
    for (int i = 0; i < 9; ++i) {
        sc[i] = -INFINITY;
        if (i < nt) {
            const int kpos = kstart + i * 64 + lane; const bf16* kr = proj + (size_t)(b * S + kpos) * NP + C_AK + hh * 128;
            float s = 0.f;
#pragma unroll
            for (int d8 = 0; d8 < 16; ++d8) { const uint4 kk = *(const uint4*)(kr + d8 * 8); const unsigned kw[4] = {kk.x, kk.y, kk.z, kk.w};
#pragma unroll
                for (int e = 0; e < 4; ++e) { s += sq[wid][d8 * 8 + 2 * e] * bf2f((bf16)(kw[e] & 0xffff)) + sq[wid][d8 * 8 + 2 * e + 1] * bf2f((bf16)(kw[e] >> 16)); } }
            int dist = t - kpos; dist = dist < -63 ? -63 : (dist > 128 ? 128 : dist);
            sc[i] = s + rel_bias[hh * 192 + dist + 63];
        }
    }
    float mx = sc[0];
#pragma unroll
    for (int i = 1; i < 9; ++i) mx = fmaxf(mx, sc[i]);
    mx = wave_max(mx);
    float l = 0.f;
#pragma unroll
    for (int i = 0; i < 9; ++i) { sc[i] = (i < nt) ? __expf(sc[i] - mx) : 0.f; l += sc[i]; }
    l = wave_sum(l);
    float o0 = 0.f, o1 = 0.f;
#pragma unroll
    for (int i = 0; i < 9; ++i) {
        if (i < nt) {
            const bf16* vr = proj + (size_t)(b * S + kstart + i * 64) * NP + C_AV + hh * 128 + 2 * lane;
            for (int kk = 0; kk < 64; ++kk) { const float p = __shfl(sc[i], kk); const unsigned vv = *(const unsigned*)(vr + (size_t)kk * NP);
                o0 += p * bf2f((bf16)(vv & 0xffff)); o1 += p * bf2f((bf16)(vv >> 16)); }
        }
    }
    const float inv = 1.f / l;
    const unsigned zz = *(const unsigned*)(proj + (size_t)row * NP + C_AZ + hh * 128 + 2 * lane);
    const float z0 = bf2f((bf16)(zz & 0xffff)), z1 = bf2f((bf16)(zz >> 16));
    const unsigned r = (unsigned)f2bf(o0 * inv * siluf_(z0)) | ((unsigned)f2bf(o1 * inv * siluf_(z1)) << 16);
    *(unsigned*)(ya + (size_t)row * 1024 + hh * 128 + 2 * lane) = r;
}

__global__ void __launch_bounds__(256) k_final(float* __restrict__ out, const float* __restrict__ g) {
    const int row = blockIdx.x * 4 + (threadIdx.x >> 6), lane = threadIdx.x & 63;
    float4* xr = (float4*)(out + (size_t)row * D);
    float4 v[8]; float ss = 0.f;
#pragma unroll
    for (int j = 0; j < 8; ++j) { v[j] = xr[lane + 64 * j]; ss += v[j].x * v[j].x + v[j].y * v[j].y + v[j].z * v[j].z + v[j].w * v[j].w; }
    ss = wave_sum(ss);
    const float r = 1.0f / sqrtf(ss * (1.f / D) + EPS);
#pragma unroll
    for (int j = 0; j < 8; ++j) { const float4 gg = ((const float4*)g)[lane + 64 * j]; float4 o; o.x = v[j].x * r * gg.x; o.y = v[j].y * r * gg.y; o.z = v[j].z * r * gg.z; o.w = v[j].w * r * gg.w; xr[lane + 64 * j] = o; }
}

extern "C" void kernel_launch(void* const* d_in, const int* in_sizes, int n_in, void* d_out, int out_size, void* d_ws, size_t ws_size, hipStream_t stream) {
    const float* x = (const float*)d_in[0]; const float* c = (const float*)d_in[1]; const float* w_ada = (const float*)d_in[2]; const float* b_ada = (const float*)d_in[3];
    const float* norm_g = (const float*)d_in[4]; const float* w_in = (const float*)d_in[5]; const float* b_if = (const float*)d_in[6]; const float* conv_w = (const float*)d_in[7];
    const float* conv_b = (const float*)d_in[8]; const float* mh_norm_g = (const float*)d_in[9]; const float* rel_bias = (const float*)d_in[10]; const float* w_proj_m = (const float*)d_in[11];
    const float* w_proj_a = (const float*)d_in[12]; const float* w_out = (const float*)d_in[13]; const float* final_g = (const float*)d_in[14];
    constexpr size_t MiB = 1u << 20;
    const size_t need = 482 * MiB;
    if (n_in != 15 || in_sizes[0] != M * D || out_size != M * D || ws_size < need) { fprintf(stderr, "kernel_launch: unexpected shapes / workspace (%zu < %zu)\n", ws_size, need); return; }
    unsigned char* ws = (unsigned char*)d_ws;
    bf16* proj = (bf16*)ws;
    bf16* ym = (bf16*)(ws + 416 * MiB);
    bf16* ya = (bf16*)(ws + 448 * MiB);
    float* mod = (float*)(ws + 480 * MiB);
    float* gates = (float*)(ws + 481 * MiB);
    unsigned char* ob = (unsigned char*)d_out;
    bf16* H = (bf16*)ob;
    bf16* qc = (bf16*)ob;
    bf16* kc = (bf16*)(ob + 32 * MiB);
    float* hbuf = (float*)(ob + 64 * MiB);
    bf16* merged = proj;

    k_ada<<<3 * D / 256, 256, 0, stream>>>(c, w_ada, b_ada, mod);
    k_norm<<<M / 4, 256, 0, stream>>>(x, norm_g, mod, w_in, b_if, H, gates);
    { GemmArgs g{}; g.A = H; g.B = w_in; g.lda = D; g.ldb = INC; g.K = D; g.Ob = proj; g.ldo = NP; k_gemm<0><<<dim3(NP / 64, M / 64), 256, 0, stream>>>(g); }
    k_conv<<<(unsigned)((size_t)M * 2048 / 256), 256, 0, stream>>>(proj, conv_w, conv_b, qc, kc);
    k_mlstm<<<NB * 4 * 256 / 4, 256, 0, stream>>>(qc, kc, proj, gates, hbuf);
    k_mpost<<<M * 4 / 4, 256, 0, stream>>>(hbuf, proj, mh_norm_g, ym);
    k_attn<<<M * 8 / 4, 256, 0, stream>>>(proj, rel_bias, ya);
    { GemmArgs g{}; g.A = ym; g.A2 = ya; g.B = w_proj_m; g.B2 = w_proj_a; g.lda = 1024; g.ldb = D; g.K = 1024; g.Ob = merged; g.ldo = NP; g.proj = proj; k_gemm<1><<<dim3(D / 64, M / 64), 256, 0, stream>>>(g); }
    { GemmArgs g{}; g.A = merged; g.B = w_out; g.lda = NP; g.ldb = D; g.K = D; g.Of = (float*)d_out; g.x = x; g.mod = mod; k_gemm<2><<<dim3(D / 64, M / 64), 256, 0, stream>>>(g); }
    k_final<<<M / 4, 256, 0, stream>>>((float*)d_out, final_g);
}
```

```cpp
#include <hip/hip_runtime.h>
#include <cstdio>
#include <cstdint>
#include <hip/hip_cooperative_groups.h>
namespace cg = cooperative_groups;

typedef unsigned short bf16;
constexpr int D = 2048, NB = 2, S = 8192, M = NB * S;
constexpr int INC = 13320, NP = 13312;
constexpr int C_MQ = 0, C_MK = 1024, C_MV = 2048, C_MO = 3072, C_MZ = 4096, C_AQ = 5120, C_AK = 6144, C_AV = 7168, C_AZ = 8192, C_GM = 9216, C_GA = 11264;
constexpr float EPS = 1e-6f;

__device__ __forceinline__ bf16 f2bf(float f) { unsigned u = __builtin_bit_cast(unsigned, f); return (bf16)((u + 0x7fffu + ((u >> 16) & 1u)) >> 16); }
__device__ __forceinline__ float bf2f(bf16 h) { return __builtin_bit_cast(float, (unsigned)h << 16); }
__device__ __forceinline__ float wave_sum(float v) {
#pragma unroll
    for (int o = 1; o < 64; o <<= 1) v += __shfl_xor(v, o);
    return v;
}
__device__ __forceinline__ float wave_max(float v) {
#pragma unroll
    for (int o = 1; o < 64; o <<= 1) v = fmaxf(v, __shfl_xor(v, o));
    return v;
}
__device__ __forceinline__ float sigmoidf_(float x) { return 1.f / (1.f + __expf(-x)); }
__device__ __forceinline__ float siluf_(float x) { return x / (1.f + __expf(-x)); }

__global__ void __launch_bounds__(256) k_ada(const float* __restrict__ c, const float* __restrict__ w_ada, const float* __restrict__ b_ada, float* __restrict__ mod) {
    __shared__ float sc[2][D];
    for (int i = threadIdx.x; i < 2 * D; i += 256) { float v = c[i]; sc[i / D][i % D] = v / (1.f + expf(-v)); }
    __syncthreads();
    const int n = blockIdx.x * 256 + threadIdx.x;
    float a0 = 0.f, a1 = 0.f;
    for (int k = 0; k < D; ++k) { const float w = w_ada[(size_t)k * (3 * D) + n]; a0 += sc[0][k] * w; a1 += sc[1][k] * w; }
    mod[n] = a0 + b_ada[n]; mod[3 * D + n] = a1 + b_ada[n];
}

__global__ void __launch_bounds__(256) k_norm(const float* __restrict__ x, const float* __restrict__ norm_g, const float* __restrict__ mod, const float* __restrict__ w_in,
                                              const float* __restrict__ b_if, bf16* __restrict__ H, float* __restrict__ gates) {
    const int row = blockIdx.x * 4 + (threadIdx.x >> 6), lane = threadIdx.x & 63, b = row / S;
    const float4* xr = (const float4*)(x + (size_t)row * D);
    float4 v[8]; float ss = 0.f;
#pragma unroll
    for (int j = 0; j < 8; ++j) { v[j] = xr[lane + 64 * j]; ss += v[j].x * v[j].x + v[j].y * v[j].y + v[j].z * v[j].z + v[j].w * v[j].w; }
    ss = wave_sum(ss);
    const float rstd = 1.0f / sqrtf(ss * (1.f / D) + EPS);
    float acc[8];
#pragma unroll
    for (int i = 0; i < 8; ++i) acc[i] = 0.f;
    const float* shift = mod + b * 3 * D; const float* scale = shift + D;
#pragma unroll
    for (int j = 0; j < 8; ++j) {
        const int k0 = (lane + 64 * j) * 4;
        const float xv[4] = {v[j].x, v[j].y, v[j].z, v[j].w};
        float hv[4];
#pragma unroll
        for (int e = 0; e < 4; ++e) {
            const int k = k0 + e;
            hv[e] = xv[e] * rstd * norm_g[k] * (1.f + scale[k]) + shift[k];
            const float4* wr = (const float4*)(w_in + (size_t)k * INC + 5120);
            const float4 w0 = wr[0], w1 = wr[1];
            acc[0] += hv[e] * w0.x; acc[1] += hv[e] * w0.y; acc[2] += hv[e] * w0.z; acc[3] += hv[e] * w0.w;
            acc[4] += hv[e] * w1.x; acc[5] += hv[e] * w1.y; acc[6] += hv[e] * w1.z; acc[7] += hv[e] * w1.w;
        }
        ushort4 o; o.x = f2bf(hv[0]); o.y = f2bf(hv[1]); o.z = f2bf(hv[2]); o.w = f2bf(hv[3]);
        *(ushort4*)(H + (size_t)row * D + k0) = o;
    }
#pragma unroll
    for (int i = 0; i < 8; ++i) acc[i] = wave_sum(acc[i]);
    if (lane == 0) {
#pragma unroll
        for (int i = 0; i < 4; ++i) gates[(size_t)row * 8 + i] = acc[i] + b_if[i];
#pragma unroll
        for (int i = 4; i < 8; ++i) { const float z = acc[i] + b_if[i]; gates[(size_t)row * 8 + i] = fminf(z, 0.f) - log1pf(expf(-fabsf(z))); }
    }
}

struct GemmArgs { const bf16* A; const bf16* A2; const float* B; const float* B2; int lda, ldb, K; bf16* Ob; int ldo; float* Of; const bf16* proj; const float* x; const float* mod; };
template <int MODE> __global__ void __launch_bounds__(256) k_gemm(GemmArgs g) {
    __shared__ float As[16][68]; __shared__ float Bs[16][68];
    const int tid = threadIdx.x, tx = tid & 15, ty = tid >> 4;
    const int m0 = blockIdx.y * 64, n0 = blockIdx.x * 64;
    float acc[4][4], acc2[4][4];
#pragma unroll
    for (int i = 0; i < 4; ++i)
#pragma unroll
        for (int j = 0; j < 4; ++j) { acc[i][j] = 0.f; acc2[i][j] = 0.f; }
    const int nseg = (MODE == 1) ? 2 : 1;
    for (int seg = 0; seg < nseg; ++seg) {
        const bf16* A = seg ? g.A2 : g.A; const float* Bm = seg ? g.B2 : g.B;
        const int ncol = (MODE == 0) ? (n0 + (n0 >= 5120 ? 8 : 0)) : n0;
        for (int k0 = 0; k0 < g.K; k0 += 16) {
            { const int r = tid >> 2, kq = (tid & 3) * 4; const ushort4 a = *(const ushort4*)(A + (size_t)(m0 + r) * g.lda + k0 + kq);
              As[kq + 0][r] = bf2f(a.x); As[kq + 1][r] = bf2f(a.y); As[kq + 2][r] = bf2f(a.z); As[kq + 3][r] = bf2f(a.w); }
            { const int k = tid >> 4, n4 = (tid & 15) * 4; const float4 bv = *(const float4*)(Bm + (size_t)(k0 + k) * g.ldb + ncol + n4);
              Bs[k][n4 + 0] = bv.x; Bs[k][n4 + 1] = bv.y; Bs[k][n4 + 2] = bv.z; Bs[k][n4 + 3] = bv.w; }
            __syncthreads();
#pragma unroll
            for (int k = 0; k < 16; ++k) {
                const float4 a = *(const float4*)&As[k][ty * 4]; const float4 bq = *(const float4*)&Bs[k][tx * 4];
                const float av[4] = {a.x, a.y, a.z, a.w}, bv[4] = {bq.x, bq.y, bq.z, bq.w};
                if (seg == 0) {
#pragma unroll
                    for (int i = 0; i < 4; ++i)
#pragma unroll
                        for (int j = 0; j < 4; ++j) acc[i][j] += av[i] * bv[j];
                } else {
#pragma unroll
                    for (int i = 0; i < 4; ++i)
#pragma unroll
                        for (int j = 0; j < 4; ++j) acc2[i][j] += av[i] * bv[j];
                }
            }
            __syncthreads();
        }
    }
#pragma unroll
    for (int i = 0; i < 4; ++i) {
        const int row = m0 + ty * 4 + i;
#pragma unroll
        for (int j = 0; j < 4; ++j) {
            const int col = n0 + tx * 4 + j;
            if (MODE == 0) g.Ob[(size_t)row * g.ldo + col] = f2bf(acc[i][j]);
            else if (MODE == 1) {
                const float gm = bf2f(g.proj[(size_t)row * NP + C_GM + col]), ga = bf2f(g.proj[(size_t)row * NP + C_GA + col]);
                g.Ob[(size_t)row * g.ldo + col] = f2bf(sigmoidf_(gm) * acc[i][j] + sigmoidf_(ga) * acc2[i][j]);
            } else {
                const int b = row / S;
                g.Of[(size_t)row * D + col] = g.x[(size_t)row * D + col] + g.mod[b * 3 * D + 2 * D + col] * acc[i][j];
            }
        }
    }
}

__global__ void __launch_bounds__(256) k_conv(const bf16* __restrict__ proj, const float* __restrict__ conv_w, const float* __restrict__ conv_b, bf16* __restrict__ qc, bf16* __restrict__ kc) {
    const size_t idx = (size_t)blockIdx.x * 256 + threadIdx.x;
    const int c = (int)(idx % 2048); const int row = (int)(idx / 2048); const int t = row % S;
    float o = conv_b[c];
#pragma unroll
    for (int tap = 0; tap < 4; ++tap) { const int tt = t - 3 + tap; if (tt >= 0) o += bf2f(proj[(size_t)(row - 3 + tap) * NP + c]) * conv_w[tap * 2048 + c]; }
    o = siluf_(o);
    if (c < 1024) qc[(size_t)row * 1024 + c] = f2bf(o); else kc[(size_t)row * 1024 + c - 1024] = f2bf(o * 0.0625f);
}

__global__ void __launch_bounds__(256) k_mlstm(const bf16* __restrict__ qc, const bf16* __restrict__ kc, const bf16* __restrict__ proj, const float* __restrict__ gates, float* __restrict__ hbuf) {
    const int w = blockIdx.x * 4 + (threadIdx.x >> 6), lane = threadIdx.x & 63;
    const int v = w & 255, h = (w >> 8) & 3, b = w >> 10;
    float C[4] = {0.f, 0.f, 0.f, 0.f}, n[4] = {0.f, 0.f, 0.f, 0.f};
    for (int t = 0; t < S; ++t) {
        const size_t row = (size_t)b * S + t;
        const ushort4 q4 = *(const ushort4*)(qc + row * 1024 + h * 256 + lane * 4);
        const ushort4 k4 = *(const ushort4*)(kc + row * 1024 + h * 256 + lane * 4);
        const float vv = bf2f(proj[row * NP + C_MV + h * 256 + v]);
        const float ig = gates[row * 8 + h], lf = gates[row * 8 + 4 + h];
        const float f = expf(lf), iv = expf(ig);
        const float kf[4] = {bf2f(k4.x), bf2f(k4.y), bf2f(k4.z), bf2f(k4.w)}, qf[4] = {bf2f(q4.x), bf2f(q4.y), bf2f(q4.z), bf2f(q4.w)};
        float num = 0.f, den = 0.f;
#pragma unroll
        for (int e = 0; e < 4; ++e) { n[e] = f * n[e] + iv * kf[e]; C[e] = f * C[e] + (iv * vv) * kf[e]; num += C[e] * qf[e]; den += n[e] * qf[e]; }
        num = wave_sum(num); den = wave_sum(den);
        if (lane == 0) hbuf[row * 1024 + h * 256 + v] = num / fmaxf(fabsf(den), 1.f);
    }
}
__global__ void __launch_bounds__(256) k_mpost(const float* __restrict__ hbuf, const bf16* __restrict__ proj, const float* __restrict__ mh_norm_g, bf16* __restrict__ ym) {
    const int w = blockIdx.x * 4 + (threadIdx.x >> 6), lane = threadIdx.x & 63;
    const int h = w & 3; const size_t row = w >> 2;
    const float4 hv = *(const float4*)(hbuf + row * 1024 + h * 256 + lane * 4);
    float ss = hv.x * hv.x + hv.y * hv.y + hv.z * hv.z + hv.w * hv.w;
    ss = wave_sum(ss);
    const float r = 1.0f / sqrtf(ss * (1.f / 256.f) + EPS);
    const float hh[4] = {hv.x, hv.y, hv.z, hv.w};
    ushort4 o; bf16 ov[4];
#pragma unroll
    for (int e = 0; e < 4; ++e) {
        const int c = h * 256 + lane * 4 + e;
        const float mo = bf2f(proj[row * NP + C_MO + c]), mz = bf2f(proj[row * NP + C_MZ + c]);
        ov[e] = f2bf(hh[e] * r * mh_norm_g[c] * sigmoidf_(mo) * siluf_(mz));
    }
    o.x = ov[0]; o.y = ov[1]; o.z = ov[2]; o.w = ov[3];
    *(ushort4*)(ym + row * 1024 + h * 256 + lane * 4) = o;
}

__global__ void __launch_bounds__(256) k_attn(const bf16* __restrict__ proj, const float* __restrict__ rel_bias, bf16* __restrict__ ya) {
    __shared__ float sq[4][128];
    const int wid = threadIdx.x >> 6, lane = threadIdx.x & 63;
    const int w = blockIdx.x * 4 + wid; const int hh = w & 7; const int row = w >> 3; const int b = row / S, t = row % S, j = t >> 6;
    { const unsigned qq = *(const unsigned*)(proj + (size_t)row * NP + C_AQ + hh * 128 + 2 * lane);
      sq[wid][2 * lane] = bf2f((bf16)(qq & 0xffff)) * 0.08838834764831845f; sq[wid][2 * lane + 1] = bf2f((bf16)(qq >> 16)) * 0.08838834764831845f; }
    __syncthreads();
    const int jlo = j > 8 ? j - 8 : 0; const int kstart = jlo * 64; const int nt = j - jlo + 1;
    float sc[9];
#pragma unroll
    for (int i = 0; i < 9; ++i) {
        sc[i] = -INFINITY;
        if (i < nt) {
            const int kpos = kstart + i * 64 + lane; const bf16* kr = proj + (size_t)(b * S + kpos) * NP + C_AK + hh * 128;
            float s = 0.f;
#pragma unroll
            for (int d8 = 0; d8 < 16; ++d8) { const uint4 kk = *(const uint4*)(kr + d8 * 8); const unsigned kw[4] = {kk.x, kk.y, kk.z, kk.w};
#pragma unroll
                for (int e = 0; e < 4; ++e) { s += sq[wid][d8 * 8 + 2 * e] * bf2f((bf16)(kw[e] & 0xffff)) + sq[wid][d8 * 8 + 2 * e + 1] * bf2f((bf16)(kw[e] >> 16)); } }
            int dist = t - kpos; dist = dist < -63 ? -63 : (dist > 128 ? 128 : dist);
            sc[i] = s + rel_bias[hh * 192 + dist + 63];
        }
    }
    float mx = sc[0];
#pragma unroll
    for (int i = 1; i < 9; ++i) mx = fmaxf(mx, sc[i]);
    mx = wave_max(mx);
    float l = 0.f;
#pragma unroll
    for (int i = 0; i < 9; ++i) { sc[i] = (i < nt) ? __expf(sc[i] - mx) : 0.f; l += sc[i]; }
    l = wave_sum(l);
    float o0 = 0.f, o1 = 0.f;
#pragma unroll
    for (int i = 0; i < 9; ++i) {
        if (i < nt) {
            const bf16* vr = proj + (size_t)(b * S + kstart + i * 64) * NP + C_AV + hh * 128 + 2 * lane;
            for (int kk = 0; kk < 64; ++kk) { const float p = __shfl(sc[i], kk); const unsigned vv = *(const unsigned*)(vr + (size_t)kk * NP);
                o0 += p * bf2f((bf16)(vv & 0xffff)); o1 += p * bf2f((bf16)(vv >> 16)); }
        }
    }
    const float inv = 1.f / l;
    const unsigned zz = *(const unsigned*)(proj + (size_t)row * NP + C_AZ + hh * 128 + 2 * lane);
    const float z0 = bf2f((bf16)(zz & 0xffff)), z1 = bf2f((bf16)(zz >> 16));
    const unsigned r = (unsigned)f2bf(o0 * inv * siluf_(z0)) | ((unsigned)f2bf(o1 * inv * siluf_(z1)) << 16);
    *(unsigned*)(ya + (size_t)row * 1024 + hh * 128 + 2 * lane) = r;
}

__global__ void __launch_bounds__(256) k_final(float* __restrict__ out, const float* __restrict__ g) {
    const int row = blockIdx.x * 4 + (threadIdx.x >> 6), lane = threadIdx.x & 63;
    float4* xr = (float4*)(out + (size_t)row * D);
    float4 v[8]; float ss = 0.f;
#pragma unroll
    for (int j = 0; j < 8; ++j) { v[j] = xr[lane + 64 * j]; ss += v[j].x * v[j].x + v[j].y * v[j].y + v[j].z * v[j].z + v[j].w * v[j].w; }
    ss = wave_sum(ss);
    const float r = 1.0f / sqrtf(ss * (1.f / D) + EPS);
#pragma unroll
    for (int j = 0; j < 8; ++j) { const float4 gg = ((const float4*)g)[lane + 64 * j]; float4 o; o.x = v[j].x * r * gg.x; o.y = v[j].y * r * gg.y; o.z = v[j].z * r * gg.z; o.w = v[j].w * r * gg.w; xr[lane + 64 * j] = o; }
}

namespace pg8 {
#define PG8_LAS __attribute__((address_space(3)))
typedef unsigned short bf16_t;
typedef short bf16x8 __attribute__((ext_vector_type(8)));
typedef float f32x4 __attribute__((ext_vector_type(4)));
typedef unsigned u32x4 __attribute__((ext_vector_type(4)));
constexpr int BM = 256, BK = 64, HALF = 128, HTB = HALF * BK * 2  , STAGE_BYTES = 8 * HTB, NXCD = 8, WGM = 8;

__host__ __device__ __forceinline__ int lds_byte(int r, int c) { const int st = (r >> 4) * 2 + (c >> 5), rr = r & 15, cc = c & 31, ob = rr * 64 + cc * 2; return st * 1024 + (ob ^ (((ob >> 9) & 1) << 5)); }
__host__ __device__ __forceinline__ void stage_rc(int b, int& R, int& C) { const int st = b / 1024, sb = b % 1024, swz = sb ^ (((sb >> 9) & 1) << 5); R = (st >> 1) * 16 + swz / 64; C = (st & 1) * 32 + (swz % 64) / 2; }
__host__ __device__ __forceinline__ int perm32(int rho) { const int n = rho >> 4, i = rho & 15; return 8 * (i >> 2) + 4 * n + (i & 3); }

struct Unit { int pm, pn, seg; };
struct Gemm { const bf16_t* A0; const bf16_t* A1; const bf16_t* B0; const bf16_t* B1; int lda, K; };

struct StaticOrder {
    int nM, nN, nwg, G, c;
    __host__ __device__ void init(int M, int N, int G_, int c_) { nM = M / BM; nN = N / BM; nwg = nM * nN; G = G_; c = c_; }
    __host__ __device__ bool next(int i, Unit& u) const {
        const long L = (long)i * G + c; if (L >= nwg) return false;
        int wgid = (int)L; { const int q = nwg / NXCD, r = nwg % NXCD, xcd = wgid % NXCD, off = wgid / NXCD; wgid = (xcd < r ? xcd * (q + 1) : r * (q + 1) + (xcd - r) * q) + off; }
        const int nig = WGM * nN, gid = wgid / nig, fm = gid * WGM, gsz = (nM - fm) < WGM ? (nM - fm) : WGM;
        u.pm = fm + ((wgid % nig) % gsz); u.pn = (wgid % nig) / gsz; u.seg = 0; return true;
    }
    __device__ __forceinline__ void a_ready(const Unit&) const {}
    __device__ __forceinline__ void done(const Unit&) const {}
};

__device__ __forceinline__ unsigned cvt_pk_bf16(float lo, float hi) { unsigned r; asm volatile("v_cvt_pk_bf16_f32 %0, %1, %2" : "=v"(r) : "v"(lo), "v"(hi)); return r; }
typedef float f32x2 __attribute__((ext_vector_type(2)));
template <class Epi, class Sched, bool ALIGN_EPI = false, bool SP2 = false>
__device__ __forceinline__ void gemm_phase(PG8_LAS unsigned char* lds, const Gemm g, const Sched& S, const Epi& E) {
    const int tid = threadIdx.x, wid = __builtin_amdgcn_readfirstlane(tid >> 6), lane = tid & 63, wr = wid >> 2, wc = wid & 3, fr = lane & 15, fq = lane >> 4;
    const int K = g.K, nt = K / BK;
    unsigned voffA[2], voffB[2];
#pragma unroll
    for (int i = 0; i < 2; ++i) { int R, C; stage_rc(tid * 16 + i * 8192, R, C); const int Rb = Epi::PERM ? ((R & ~31) + perm32(R & 31)) : R;
        voffA[i] = (unsigned)(R * g.lda + C) * 2u; voffB[i] = (unsigned)(Rb * K + C) * 2u; }
    const size_t kstep = (size_t)(BK * 2);
    const size_t hstepA = (size_t)HALF * g.lda * 2, hstepB = (size_t)HALF * K * 2;
    const size_t tstepA = 2 * hstepA, tstepB = 2 * hstepB;
    const unsigned ldsw = (unsigned)wid * 1024u;
    const int aoff = lds_byte(wr * 64 + fr, fq * 8), boff = lds_byte(wc * 32 + fr, fq * 8);
#define PG8_SA(b, h) (((b) * 2 + (h)) * HTB)
#define PG8_SB(b, h) ((4 + (b) * 2 + (h)) * HTB)
#define PG8_STAGE(bufoff, gbase, voff) do { _Pragma("unroll") for (int _i = 0; _i < 2; ++_i) \
        __builtin_amdgcn_global_load_lds((const unsigned*)((const char*)(gbase) + (voff)[_i]), (PG8_LAS unsigned*)(lds + (bufoff) + ldsw + _i * 8192), 16, 0, 0); } while (0)
#define PG8_LDA(dst, b, h) do { _Pragma("unroll") for (int m = 0; m < 4; ++m) _Pragma("unroll") for (int k = 0; k < 2; ++k) dst[m][k] = *(const PG8_LAS bf16x8*)(lds + PG8_SA(b, h) + aoff + m * 2048 + k * 1024); } while (0)
#define PG8_LDB(dst, b, h) do { _Pragma("unroll") for (int n = 0; n < 2; ++n) _Pragma("unroll") for (int k = 0; k < 2; ++k) dst[n][k] = *(const PG8_LAS bf16x8*)(lds + PG8_SB(b, h) + boff + n * 2048 + k * 1024); } while (0)
#define PG8_MMA(ai, bj, At, Bt) do { __builtin_amdgcn_s_setprio(1); _Pragma("unroll") for (int m = 0; m < 4; ++m) _Pragma("unroll") for (int n = 0; n < 2; ++n) _Pragma("unroll") for (int k = 0; k < 2; ++k) \
        acc[ai][bj][m][n] = __builtin_amdgcn_mfma_f32_16x16x32_bf16(Bt[n][k], At[m][k], acc[ai][bj][m][n], 0, 0, 0); __builtin_amdgcn_s_setprio(0); } while (0)
#define PG8_WAIT_V(n) asm volatile("s_waitcnt vmcnt(" #n ")" ::: "memory")
#define PG8_WAIT_L(n) asm volatile("s_waitcnt lgkmcnt(" #n ")" ::: "memory")
#define PG8_BAR __builtin_amdgcn_s_barrier()
#define PG8_SCHED __builtin_amdgcn_sched_barrier(0)
    Unit cur, nxt; int ui = 0;
    if (!S.next(0, cur)) return;
    f32x4 acc[2][2][4][2];
#pragma unroll
    for (int a = 0; a < 2; ++a)
#pragma unroll
        for (int b = 0; b < 2; ++b)
#pragma unroll
            for (int m = 0; m < 4; ++m)
#pragma unroll
                for (int n = 0; n < 2; ++n) acc[a][b][m][n] = (f32x4){0.f, 0.f, 0.f, 0.f};
    bf16x8 At[4][2], B0[2][2], B1[2][2];
    const char* cA = (const char*)(cur.seg ? g.A1 : g.A0) + (size_t)cur.pm * tstepA; const char* cB = (const char*)(cur.seg ? g.B1 : g.B0) + (size_t)cur.pn * tstepB;
    S.a_ready(cur);
    if constexpr (SP2) {
        PG8_STAGE(PG8_SB(0, 0), cB, voffB); PG8_STAGE(PG8_SB(0, 1), cB + hstepB, voffB); PG8_STAGE(PG8_SA(0, 0), cA, voffA); PG8_STAGE(PG8_SA(0, 1), cA + hstepA, voffA);
        if (wr == 1) PG8_BAR;
        PG8_WAIT_V(2); PG8_BAR;
        PG8_STAGE(PG8_SB(1, 0), cB + kstep, voffB); PG8_STAGE(PG8_SA(1, 0), cA + kstep, voffA); PG8_STAGE(PG8_SB(1, 1), cB + hstepB + kstep, voffB);
        PG8_WAIT_V(6); PG8_BAR;
    } else {
        PG8_STAGE(PG8_SB(0, 0), cB, voffB); PG8_STAGE(PG8_SA(0, 0), cA, voffA); PG8_STAGE(PG8_SB(0, 1), cB + hstepB, voffB); PG8_STAGE(PG8_SA(0, 1), cA + hstepA, voffA);
        if (wr == 1) PG8_BAR;
        PG8_WAIT_V(4); PG8_BAR;
        PG8_STAGE(PG8_SB(1, 0), cB + kstep, voffB); PG8_STAGE(PG8_SA(1, 0), cA + kstep, voffA); PG8_STAGE(PG8_SB(1, 1), cB + hstepB + kstep, voffB);
        PG8_WAIT_V(6); PG8_BAR;
    }
    for (;;) {
        const bool has_next = S.next(ui + 1, nxt);
        const char* nA = has_next ? (const char*)(nxt.seg ? g.A1 : g.A0) + (size_t)nxt.pm * tstepA : cA; const char* nB = has_next ? (const char*)(nxt.seg ? g.B1 : g.B0) + (size_t)nxt.pn * tstepB : cB;
        for (int t = 0; t < nt; t += 2) {
            const bool last = (t == nt - 2);
            const char* a1 = cA + (size_t)(t + 1) * kstep;
            const char* a2 = last ? nA : cA + (size_t)(t + 2) * kstep; const char* b2 = last ? nB : cB + (size_t)(t + 2) * kstep;
            const char* a3 = a2 + kstep; const char* b3 = b2 + kstep;
            if (last && has_next) S.a_ready(nxt);
            if constexpr (SP2) {
            PG8_LDB(B0, 0, 0); PG8_LDB(B1, 0, 1); PG8_SCHED; PG8_LDA(At, 0, 0); PG8_STAGE(PG8_SA(1, 1), a1 + hstepA, voffA);
            PG8_WAIT_V(8); PG8_WAIT_L(0); PG8_BAR; PG8_MMA(0, 0, At, B0); PG8_MMA(0, 1, At, B1); PG8_BAR; PG8_SCHED;
            PG8_LDA(At, 0, 1); PG8_STAGE(PG8_SB(0, 0), b2, voffB); PG8_STAGE(PG8_SB(0, 1), b2 + hstepB, voffB); PG8_STAGE(PG8_SA(0, 0), a2, voffA);
            PG8_WAIT_V(8); PG8_WAIT_L(0); PG8_BAR; PG8_MMA(1, 0, At, B0); PG8_MMA(1, 1, At, B1); PG8_BAR; PG8_SCHED;
            PG8_LDB(B0, 1, 0); PG8_LDB(B1, 1, 1); PG8_SCHED; PG8_LDA(At, 1, 0); PG8_STAGE(PG8_SA(0, 1), a2 + hstepA, voffA);
            PG8_WAIT_V(8); PG8_WAIT_L(0); PG8_BAR; PG8_MMA(0, 0, At, B0); PG8_MMA(0, 1, At, B1); PG8_BAR; PG8_SCHED;
            PG8_LDA(At, 1, 1); PG8_STAGE(PG8_SB(1, 0), b3, voffB); PG8_STAGE(PG8_SB(1, 1), b3 + hstepB, voffB); PG8_STAGE(PG8_SA(1, 0), a3, voffA);
            PG8_WAIT_V(8); PG8_WAIT_L(0); PG8_BAR; PG8_MMA(1, 0, At, B0); PG8_MMA(1, 1, At, B1); PG8_BAR; PG8_SCHED;
            } else {
            PG8_LDB(B0, 0, 0); PG8_SCHED; PG8_LDA(At, 0, 0); PG8_STAGE(PG8_SA(1, 1), a1 + hstepA, voffA);
            PG8_WAIT_L(8); PG8_BAR; PG8_WAIT_L(0); PG8_MMA(0, 0, At, B0); PG8_BAR; PG8_SCHED;
            PG8_LDB(B1, 0, 1); PG8_STAGE(PG8_SB(0, 0), b2, voffB);
            PG8_BAR; PG8_WAIT_L(0); PG8_MMA(0, 1, At, B1); PG8_BAR;
            PG8_LDA(At, 0, 1); PG8_STAGE(PG8_SA(0, 0), a2, voffA);
            PG8_BAR; PG8_WAIT_L(0); PG8_MMA(1, 0, At, B0); PG8_BAR; PG8_SCHED;
            PG8_STAGE(PG8_SB(0, 1), b2 + hstepB, voffB);
            PG8_WAIT_V(6); PG8_BAR; PG8_MMA(1, 1, At, B1); PG8_BAR;
            PG8_LDB(B0, 1, 0); PG8_SCHED; PG8_LDA(At, 1, 0); PG8_STAGE(PG8_SA(0, 1), a2 + hstepA, voffA);
            PG8_WAIT_L(8); PG8_BAR; PG8_WAIT_L(0); PG8_MMA(0, 0, At, B0); PG8_BAR; PG8_SCHED;
            PG8_LDB(B1, 1, 1); PG8_STAGE(PG8_SB(1, 0), b3, voffB);
            PG8_BAR; PG8_WAIT_L(0); PG8_MMA(0, 1, At, B1); PG8_BAR;
            PG8_LDA(At, 1, 1); PG8_STAGE(PG8_SA(1, 0), a3, voffA);
            PG8_BAR; PG8_WAIT_L(0); PG8_MMA(1, 0, At, B0); PG8_BAR; PG8_SCHED;
            PG8_STAGE(PG8_SB(1, 1), b3 + hstepB, voffB);
            PG8_WAIT_V(6); PG8_BAR; PG8_MMA(1, 1, At, B1); PG8_BAR;
            }
        }
        if constexpr (ALIGN_EPI) { if (wr == 0) PG8_BAR; }
        if constexpr (!Epi::AFTER_DRAIN) { E(acc, cur, wr, wc, fr, fq); S.done(cur); }
        if (!has_next) break;
        if (E.zero_after(cur)) {
#pragma unroll
        for (int a = 0; a < 2; ++a)
#pragma unroll
            for (int b = 0; b < 2; ++b)
#pragma unroll
                for (int m = 0; m < 4; ++m)
#pragma unroll
                    for (int n = 0; n < 2; ++n) acc[a][b][m][n] = (f32x4){0.f, 0.f, 0.f, 0.f};
        }
        cur = nxt; cA = nA; cB = nB; ++ui;
        if constexpr (ALIGN_EPI) { if (wr == 1) PG8_BAR; }
    }
    PG8_WAIT_V(0);
    if constexpr (!ALIGN_EPI) { if (wr == 0) PG8_BAR; }
    PG8_BAR;
    if constexpr (Epi::AFTER_DRAIN) { E.fused(acc, cur, wr, wc, fr, fq, lds, wid, lane); S.done(cur); }
#undef PG8_SA
#undef PG8_SB
#undef PG8_STAGE
#undef PG8_LDA
#undef PG8_LDB
#undef PG8_MMA
#undef PG8_WAIT_V
#undef PG8_WAIT_L
#undef PG8_BAR
#undef PG8_SCHED
}
}

namespace pg8 {
typedef unsigned u32x4_ __attribute__((ext_vector_type(4)));
struct EpiProj {
    static constexpr bool PERM = true, AFTER_DRAIN = false;
    bf16_t* O; int ldc;
    __device__ __forceinline__ bool zero_after(const Unit&) const { return true; }
    __device__ __forceinline__ void operator()(f32x4 (&acc)[2][2][4][2], const Unit& u, int wr, int wc, int fr, int fq) const {
        const int row0 = u.pm * BM + wr * 64 + fr, col0 = u.pn * BM + wc * 32 + 8 * fq;
#pragma unroll
        for (int ai = 0; ai < 2; ++ai)
#pragma unroll
            for (int m = 0; m < 4; ++m) { bf16_t* rowp = O + (size_t)(row0 + ai * HALF + m * 16) * ldc + col0;
#pragma unroll
                for (int bj = 0; bj < 2; ++bj) { const f32x4 v0 = acc[ai][bj][m][0], v1 = acc[ai][bj][m][1];
                    u32x4 w; w.x = cvt_pk_bf16(v0[0], v0[1]); w.y = cvt_pk_bf16(v0[2], v0[3]); w.z = cvt_pk_bf16(v1[0], v1[1]); w.w = cvt_pk_bf16(v1[2], v1[3]);
                    *(u32x4*)(rowp + bj * HALF) = w; } }
    }
};
}

#define LAS __attribute__((address_space(3)))
typedef unsigned v4u __attribute__((ext_vector_type(4)));
typedef float f4 __attribute__((ext_vector_type(4)));
constexpr size_t MiB = 1u << 20;
constexpr size_t WS_PROJ = 0;
constexpr size_t WS_YM = 416 * MiB;
constexpr size_t WS_YA = 448 * MiB;
constexpr size_t WS_WPM = 480 * MiB;
constexpr size_t WS_WPA = 484 * MiB;
constexpr size_t WS_WOUT = 488 * MiB;
constexpr size_t WS_MODP = 496 * MiB;
constexpr size_t WS_MOD = 497 * MiB;
constexpr size_t WS_GATES = 498 * MiB;
constexpr size_t WS_END = 500 * MiB;
constexpr size_t OB_H = 0;
constexpr size_t OB_WIN = 64 * MiB;
constexpr int NWAVES = 8, LDS_BYTES = 147456;

struct MArgs { const float* in[15]; float* out; unsigned char* ws; int ph_lo, ph_hi; };

__device__ __forceinline__ unsigned pk2(float lo, float hi) { return (unsigned)f2bf(lo) | ((unsigned)f2bf(hi) << 16); }
#define LDS_WAIT() asm volatile("s_waitcnt lgkmcnt(0)" ::: "memory")

__device__ __forceinline__ void transpose_item(const float* __restrict__ W, int ldw, int ncol_src0, bf16* __restrict__ WT, int K, int nrow_dst0, int k0, LAS float* scr, int lane) {
#pragma unroll 8
    for (int i = 0; i < 32; ++i) { const int kk = 2 * i + (lane >> 5); scr[kk * 33 + (lane & 31)] = W[(size_t)(k0 + kk) * ldw + ncol_src0 + (lane & 31)]; }
    LDS_WAIT();
    const int c = lane & 7;
#pragma unroll
    for (int j = 0; j < 4; ++j) { const int n = (lane >> 3) + 8 * j; const LAS float* s = scr + (8 * c) * 33 + n;
        v4u o; o.x = pk2(s[0 * 33], s[1 * 33]); o.y = pk2(s[2 * 33], s[3 * 33]); o.z = pk2(s[4 * 33], s[5 * 33]); o.w = pk2(s[6 * 33], s[7 * 33]);
        *(v4u*)(WT + (size_t)(nrow_dst0 + n) * K + k0 + 8 * c) = o; }
    LDS_WAIT();
}

__global__ void __launch_bounds__(NWAVES * 64, 2) mega(MArgs a) {
    extern __shared__ __attribute__((aligned(16))) unsigned char lds_raw[];
    LAS unsigned char* lds = (LAS unsigned char*)lds_raw;
    cg::grid_group grid = cg::this_grid();
    const int tid = threadIdx.x, lane = tid & 63, wave = __builtin_amdgcn_readfirstlane(tid >> 6);
    const int G = gridDim.x, gw = blockIdx.x * NWAVES + wave, NGW = G * NWAVES;
    const float* x = a.in[0]; const float* cvec = a.in[1]; const float* w_ada = a.in[2]; const float* b_ada = a.in[3]; const float* norm_g = a.in[4]; const float* w_in = a.in[5];
    const float* b_if = a.in[6]; const float* w_proj_m = a.in[11]; const float* w_proj_a = a.in[12]; const float* w_out = a.in[13];
    unsigned char* ws = a.ws; unsigned char* ob = (unsigned char*)a.out;
    bf16* proj = (bf16*)(ws + WS_PROJ); bf16* Wpm_t = (bf16*)(ws + WS_WPM); bf16* Wpa_t = (bf16*)(ws + WS_WPA); bf16* Wout_t = (bf16*)(ws + WS_WOUT);
    float* modp = (float*)(ws + WS_MODP); float* mod = (float*)(ws + WS_MOD); float* gates = (float*)(ws + WS_GATES);
    bf16* H = (bf16*)(ob + OB_H); bf16* Win_t = (bf16*)(ob + OB_WIN);
    const int lo = a.ph_lo, hi = a.ph_hi;
#define IN(k) (lo <= (k) && (k) < hi)
#define BOTH(k) (IN(k) && IN((k) + 1))

    if (IN(0)) {
        LAS float* scr = (LAS float*)(lds + wave * 16384);
        constexpr int I_ADA = 16 * 24, I_IN = (D / 64) * (NP / 32), I_PM = (1024 / 64) * (D / 32), I_OUT = (D / 64) * (D / 32);
        constexpr int NITEMS = I_ADA + I_IN + 2 * I_PM + I_OUT;
        for (int it = gw; it < NITEMS; it += NGW) {
            int r = it;
            if (r < I_ADA) {
                const int ks = r / 24, cb = r % 24, n0 = cb * 256 + lane * 4;
                float4 a0 = {0.f, 0.f, 0.f, 0.f}, a1 = {0.f, 0.f, 0.f, 0.f};
                if (ks == 0) { a0 = *(const float4*)(b_ada + n0); a1 = a0; }
#pragma unroll 8
                for (int kk = 0; kk < 128; ++kk) { const int k = ks * 128 + kk; const float4 w = *(const float4*)(w_ada + (size_t)k * (3 * D) + n0);
                    const float c0 = cvec[k], c1 = cvec[D + k]; const float s0 = c0 / (1.f + __expf(-c0)), s1 = c1 / (1.f + __expf(-c1));
                    a0.x += s0 * w.x; a0.y += s0 * w.y; a0.z += s0 * w.z; a0.w += s0 * w.w; a1.x += s1 * w.x; a1.y += s1 * w.y; a1.z += s1 * w.z; a1.w += s1 * w.w; }
                *(float4*)(modp + (size_t)(ks * 2 + 0) * (3 * D) + n0) = a0; *(float4*)(modp + (size_t)(ks * 2 + 1) * (3 * D) + n0) = a1;
                continue; }
            r -= I_ADA;
            if (r < I_IN) { const int nblk = NP / 32, kb = r / nblk, nb = r % nblk, nd = 32 * nb; transpose_item(w_in, INC, nd + (nd >= 5120 ? 8 : 0), Win_t, D, nd, 64 * kb, scr, lane); continue; }
            r -= I_IN;
            if (r < I_PM) { const int nblk = D / 32, kb = r / nblk, nb = r % nblk; transpose_item(w_proj_m, D, 32 * nb, Wpm_t, 1024, 32 * nb, 64 * kb, scr, lane); continue; }
            r -= I_PM;
            if (r < I_PM) { const int nblk = D / 32, kb = r / nblk, nb = r % nblk; transpose_item(w_proj_a, D, 32 * nb, Wpa_t, 1024, 32 * nb, 64 * kb, scr, lane); continue; }
            r -= I_PM;
            { const int nblk = D / 32, kb = r / nblk, nb = r % nblk; transpose_item(w_out, D, 32 * nb, Wout_t, D, 32 * nb, 64 * kb, scr, lane); }
        }
        if (BOTH(0)) grid.sync();
    }

    if (IN(1)) {
        LAS float* smod = (LAS float*)lds;
        LAS float* gwl = (LAS float*)(lds + 49152);
        for (int i = tid; i < 2 * 3 * D; i += NWAVES * 64) { float s = 0.f;
#pragma unroll
            for (int ks = 0; ks < 16; ++ks) s += modp[(size_t)ks * (2 * 3 * D) + i];
            smod[i] = s; if (blockIdx.x == 0) mod[i] = s; }
        for (int k = tid; k < D; k += NWAVES * 64) { const float4 w0 = *(const float4*)(w_in + (size_t)k * INC + 5120), w1 = *(const float4*)(w_in + (size_t)k * INC + 5124);
            gwl[0 * D + k] = w0.x; gwl[1 * D + k] = w0.y; gwl[2 * D + k] = w0.z; gwl[3 * D + k] = w0.w; gwl[4 * D + k] = w1.x; gwl[5 * D + k] = w1.y; gwl[6 * D + k] = w1.z; gwl[7 * D + k] = w1.w; }
        __syncthreads();
        for (int row = gw; row < M; row += NGW) {
            const int b = row / S;
            const float4* xr = (const float4*)(x + (size_t)row * D);
            float4 v[8]; float ss = 0.f;
#pragma unroll
            for (int j = 0; j < 8; ++j) { v[j] = xr[lane + 64 * j]; ss += v[j].x * v[j].x + v[j].y * v[j].y + v[j].z * v[j].z + v[j].w * v[j].w; }
            ss = wave_sum(ss);
            const float rstd = 1.0f / sqrtf(ss * (1.f / D) + EPS);
            float acc[8];
#pragma unroll
            for (int i = 0; i < 8; ++i) acc[i] = 0.f;
            const LAS float* shift = smod + b * 3 * D; const LAS float* scale = shift + D;
#pragma unroll
            for (int j = 0; j < 8; ++j) {
                const int k0 = (lane + 64 * j) * 4;
                const f4 g4 = *(const f4*)(norm_g + k0); const f4 sc4 = *(const LAS f4*)(scale + k0); const f4 sh4 = *(const LAS f4*)(shift + k0);
                float4 h4; h4.x = v[j].x * rstd * g4.x * (1.f + sc4.x) + sh4.x; h4.y = v[j].y * rstd * g4.y * (1.f + sc4.y) + sh4.y; h4.z = v[j].z * rstd * g4.z * (1.f + sc4.z) + sh4.z; h4.w = v[j].w * rstd * g4.w * (1.f + sc4.w) + sh4.w;
#pragma unroll
                for (int i = 0; i < 8; ++i) { const f4 w4 = *(const LAS f4*)(gwl + i * D + k0); acc[i] += h4.x * w4.x + h4.y * w4.y + h4.z * w4.z + h4.w * w4.w; }
                uint2 o; o.x = pk2(h4.x, h4.y); o.y = pk2(h4.z, h4.w);
                *(uint2*)(H + (size_t)row * D + k0) = o;
                asm volatile("" ::: "memory");
            }
#pragma unroll
            for (int i = 0; i < 8; ++i) acc[i] = wave_sum(acc[i]);
            if (lane == 0) {
#pragma unroll
                for (int i = 0; i < 4; ++i) gates[(size_t)row * 8 + i] = acc[i] + b_if[i];
#pragma unroll
                for (int i = 4; i < 8; ++i) { const float z = acc[i] + b_if[i]; gates[(size_t)row * 8 + i] = fminf(z, 0.f) - log1pf(expf(-fabsf(z))); }
            }
        }
        __syncthreads();
        if (BOTH(1)) grid.sync();
    }

    if (IN(2)) {
        pg8::Gemm g{H, H, Win_t, Win_t, D, D}; pg8::StaticOrder So; So.init(M, NP, G, (int)blockIdx.x);
        pg8::EpiProj E{proj, NP};
        pg8::gemm_phase<pg8::EpiProj, pg8::StaticOrder, true, true>(lds, g, So, E);
        if (BOTH(2)) grid.sync();
    }
#undef IN
#undef BOTH
}

static int launch_mega(const MArgs& a, hipStream_t stream) {
    static int grid = 0;
    if (grid == 0) {
        int dev = 0, cus = 0, per_cu = 0;
        if (hipGetDevice(&dev) != hipSuccess || hipDeviceGetAttribute(&cus, hipDeviceAttributeMultiprocessorCount, dev) != hipSuccess) { fprintf(stderr, "kernel_launch: device query failed\n"); grid = -1; return -1; }
        if (hipFuncSetAttribute((const void*)mega, hipFuncAttributeMaxDynamicSharedMemorySize, LDS_BYTES) != hipSuccess) { fprintf(stderr, "kernel_launch: hipFuncSetAttribute failed\n"); grid = -1; return -1; }
        if (hipOccupancyMaxActiveBlocksPerMultiprocessor(&per_cu, (const void*)mega, NWAVES * 64, LDS_BYTES) != hipSuccess || per_cu < 1) { fprintf(stderr, "kernel_launch: occupancy query says %d blocks/CU\n", per_cu); (void)hipGetLastError(); grid = -1; return -1; }
        grid = cus * (per_cu > 1 ? 1 : per_cu);
        fprintf(stderr, "kernel_launch: %d CUs, occupancy %d blocks/CU, grid %d\n", cus, per_cu, grid);
    }
    if (grid < 0) return -1;
    MArgs arg = a; void* args[] = {(void*)&arg};
    const hipError_t e = hipLaunchCooperativeKernel((const void*)mega, dim3(grid), dim3(NWAVES * 64), args, LDS_BYTES, stream);
    if (e != hipSuccess) { fprintf(stderr, "kernel_launch: cooperative launch failed: %s (grid %d)\n", hipGetErrorString(e), grid); return -1; }
    return 0;
}

extern "C" void kernel_launch(void* const* d_in, const int* in_sizes, int n_in, void* d_out, int out_size, void* d_ws, size_t ws_size, hipStream_t stream) {
    if (n_in != 15 || in_sizes[0] != M * D || out_size != M * D || ws_size < WS_END) { fprintf(stderr, "kernel_launch: unexpected shapes / workspace (%zu < %zu)\n", ws_size, (size_t)WS_END); return; }
    const float* x = (const float*)d_in[0];
    const float* conv_w = (const float*)d_in[7]; const float* conv_b = (const float*)d_in[8]; const float* mh_norm_g = (const float*)d_in[9]; const float* rel_bias = (const float*)d_in[10];
    const float* w_proj_m = (const float*)d_in[11]; const float* w_proj_a = (const float*)d_in[12]; const float* w_out = (const float*)d_in[13]; const float* final_g = (const float*)d_in[14];
    unsigned char* ws = (unsigned char*)d_ws;
    bf16* proj = (bf16*)(ws + WS_PROJ); bf16* ym = (bf16*)(ws + WS_YM); bf16* ya = (bf16*)(ws + WS_YA); float* mod = (float*)(ws + WS_MOD); float* gates = (float*)(ws + WS_GATES);
    unsigned char* ob = (unsigned char*)d_out;
    bf16* qc = (bf16*)ob; bf16* kc = (bf16*)(ob + 32 * MiB); float* hbuf = (float*)(ob + 64 * MiB);
    bf16* merged = proj;

    MArgs a{}; for (int i = 0; i < 15; ++i) a.in[i] = (const float*)d_in[i]; a.out = (float*)d_out; a.ws = ws; a.ph_lo = 0; a.ph_hi = 3;
    if (launch_mega(a, stream) != 0) return;
    k_conv<<<(unsigned)((size_t)M * 2048 / 256), 256, 0, stream>>>(proj, conv_w, conv_b, qc, kc);
    k_mlstm<<<NB * 4 * 256 / 4, 256, 0, stream>>>(qc, kc, proj, gates, hbuf);
    k_mpost<<<M * 4 / 4, 256, 0, stream>>>(hbuf, proj, mh_norm_g, ym);
    k_attn<<<M * 8 / 4, 256, 0, stream>>>(proj, rel_bias, ya);
    { GemmArgs g{}; g.A = ym; g.A2 = ya; g.B = w_proj_m; g.B2 = w_proj_a; g.lda = 1024; g.ldb = D; g.K = 1024; g.Ob = merged; g.ldo = NP; g.proj = proj; k_gemm<1><<<dim3(D / 64, M / 64), 256, 0, stream>>>(g); }
    { GemmArgs g{}; g.A = merged; g.B = w_out; g.lda = NP; g.ldb = D; g.K = D; g.Of = (float*)d_out; g.x = x; g.mod = mod; k_gemm<2><<<dim3(D / 64, M / 64), 256, 0, stream>>>(g); }
    k_final<<<M / 4, 256, 0, stream>>>((float*)d_out, final_g);
}
```

```cpp
#include <hip/hip_runtime.h>
#include <cstdio>
#include <cstdint>
#include <hip/hip_cooperative_groups.h>
namespace cg = cooperative_groups;

typedef unsigned short bf16;
constexpr int D = 2048, NB = 2, S = 8192, M = NB * S;
constexpr int INC = 13320, NP = 13312;
constexpr int C_MQ = 0, C_MK = 1024, C_MV = 2048, C_MO = 3072, C_MZ = 4096, C_AQ = 5120, C_AK = 6144, C_AV = 7168, C_AZ = 8192, C_GM = 9216, C_GA = 11264;
constexpr float EPS = 1e-6f;

__device__ __forceinline__ bf16 f2bf(float f) { unsigned u = __builtin_bit_cast(unsigned, f); return (bf16)((u + 0x7fffu + ((u >> 16) & 1u)) >> 16); }
__device__ __forceinline__ float bf2f(bf16 h) { return __builtin_bit_cast(float, (unsigned)h << 16); }
__device__ __forceinline__ float wave_sum(float v) {
#pragma unroll
    for (int o = 1; o < 64; o <<= 1) v += __shfl_xor(v, o);
    return v;
}
__device__ __forceinline__ float wave_max(float v) {
#pragma unroll
    for (int o = 1; o < 64; o <<= 1) v = fmaxf(v, __shfl_xor(v, o));
    return v;
}
__device__ __forceinline__ float sigmoidf_(float x) { return 1.f / (1.f + __expf(-x)); }
__device__ __forceinline__ float siluf_(float x) { return x / (1.f + __expf(-x)); }

__global__ void __launch_bounds__(256) k_ada(const float* __restrict__ c, const float* __restrict__ w_ada, const float* __restrict__ b_ada, float* __restrict__ mod) {
    __shared__ float sc[2][D];
    for (int i = threadIdx.x; i < 2 * D; i += 256) { float v = c[i]; sc[i / D][i % D] = v / (1.f + expf(-v)); }
    __syncthreads();
    const int n = blockIdx.x * 256 + threadIdx.x;
    float a0 = 0.f, a1 = 0.f;
    for (int k = 0; k < D; ++k) { const float w = w_ada[(size_t)k * (3 * D) + n]; a0 += sc[0][k] * w; a1 += sc[1][k] * w; }
    mod[n] = a0 + b_ada[n]; mod[3 * D + n] = a1 + b_ada[n];
}

__global__ void __launch_bounds__(256) k_norm(const float* __restrict__ x, const float* __restrict__ norm_g, const float* __restrict__ mod, const float* __restrict__ w_in,
                                              const float* __restrict__ b_if, bf16* __restrict__ H, float* __restrict__ gates) {
    const int row = blockIdx.x * 4 + (threadIdx.x >> 6), lane = threadIdx.x & 63, b = row / S;
    const float4* xr = (const float4*)(x + (size_t)row * D);
    float4 v[8]; float ss = 0.f;
#pragma unroll
    for (int j = 0; j < 8; ++j) { v[j] = xr[lane + 64 * j]; ss += v[j].x * v[j].x + v[j].y * v[j].y + v[j].z * v[j].z + v[j].w * v[j].w; }
    ss = wave_sum(ss);
    const float rstd = 1.0f / sqrtf(ss * (1.f / D) + EPS);
    float acc[8];
#pragma unroll
    for (int i = 0; i < 8; ++i) acc[i] = 0.f;
    const float* shift = mod + b * 3 * D; const float* scale = shift + D;
#pragma unroll
    for (int j = 0; j < 8; ++j) {
        const int k0 = (lane + 64 * j) * 4;
        const float xv[4] = {v[j].x, v[j].y, v[j].z, v[j].w};
        float hv[4];
#pragma unroll
        for (int e = 0; e < 4; ++e) {
            const int k = k0 + e;
            hv[e] = xv[e] * rstd * norm_g[k] * (1.f + scale[k]) + shift[k];
            const float4* wr = (const float4*)(w_in + (size_t)k * INC + 5120);
            const float4 w0 = wr[0], w1 = wr[1];
            acc[0] += hv[e] * w0.x; acc[1] += hv[e] * w0.y; acc[2] += hv[e] * w0.z; acc[3] += hv[e] * w0.w;
            acc[4] += hv[e] * w1.x; acc[5] += hv[e] * w1.y; acc[6] += hv[e] * w1.z; acc[7] += hv[e] * w1.w;
        }
        ushort4 o; o.x = f2bf(hv[0]); o.y = f2bf(hv[1]); o.z = f2bf(hv[2]); o.w = f2bf(hv[3]);
        *(ushort4*)(H + (size_t)row * D + k0) = o;
    }
#pragma unroll
    for (int i = 0; i < 8; ++i) acc[i] = wave_sum(acc[i]);
    if (lane == 0) {
#pragma unroll
        for (int i = 0; i < 4; ++i) gates[(size_t)row * 8 + i] = acc[i] + b_if[i];
#pragma unroll
        for (int i = 4; i < 8; ++i) { const float z = acc[i] + b_if[i]; gates[(size_t)row * 8 + i] = fminf(z, 0.f) - log1pf(expf(-fabsf(z))); }
    }
}

struct GemmArgs { const bf16* A; const bf16* A2; const float* B; const float* B2; int lda, ldb, K; bf16* Ob; int ldo; float* Of; const bf16* proj; const float* x; const float* mod; };
template <int MODE> __global__ void __launch_bounds__(256) k_gemm(GemmArgs g) {
    __shared__ float As[16][68]; __shared__ float Bs[16][68];
    const int tid = threadIdx.x, tx = tid & 15, ty = tid >> 4;
    const int m0 = blockIdx.y * 64, n0 = blockIdx.x * 64;
    float acc[4][4], acc2[4][4];
#pragma unroll
    for (int i = 0; i < 4; ++i)
#pragma unroll
        for (int j = 0; j < 4; ++j) { acc[i][j] = 0.f; acc2[i][j] = 0.f; }
    const int nseg = (MODE == 1) ? 2 : 1;
    for (int seg = 0; seg < nseg; ++seg) {
        const bf16* A = seg ? g.A2 : g.A; const float* Bm = seg ? g.B2 : g.B;
        const int ncol = (MODE == 0) ? (n0 + (n0 >= 5120 ? 8 : 0)) : n0;
        for (int k0 = 0; k0 < g.K; k0 += 16) {
            { const int r = tid >> 2, kq = (tid & 3) * 4; const ushort4 a = *(const ushort4*)(A + (size_t)(m0 + r) * g.lda + k0 + kq);
              As[kq + 0][r] = bf2f(a.x); As[kq + 1][r] = bf2f(a.y); As[kq + 2][r] = bf2f(a.z); As[kq + 3][r] = bf2f(a.w); }
            { const int k = tid >> 4, n4 = (tid & 15) * 4; const float4 bv = *(const float4*)(Bm + (size_t)(k0 + k) * g.ldb + ncol + n4);
              Bs[k][n4 + 0] = bv.x; Bs[k][n4 + 1] = bv.y; Bs[k][n4 + 2] = bv.z; Bs[k][n4 + 3] = bv.w; }
            __syncthreads();
#pragma unroll
            for (int k = 0; k < 16; ++k) {
                const float4 a = *(const float4*)&As[k][ty * 4]; const float4 bq = *(const float4*)&Bs[k][tx * 4];
                const float av[4] = {a.x, a.y, a.z, a.w}, bv[4] = {bq.x, bq.y, bq.z, bq.w};
                if (seg == 0) {
#pragma unroll
                    for (int i = 0; i < 4; ++i)
#pragma unroll
                        for (int j = 0; j < 4; ++j) acc[i][j] += av[i] * bv[j];
                } else {
#pragma unroll
                    for (int i = 0; i < 4; ++i)
#pragma unroll
                        for (int j = 0; j < 4; ++j) acc2[i][j] += av[i] * bv[j];
                }
            }
            __syncthreads();
        }
    }
#pragma unroll
    for (int i = 0; i < 4; ++i) {
        const int row = m0 + ty * 4 + i;
#pragma unroll
        for (int j = 0; j < 4; ++j) {
            const int col = n0 + tx * 4 + j;
            if (MODE == 0) g.Ob[(size_t)row * g.ldo + col] = f2bf(acc[i][j]);
            else if (MODE == 1) {
                const float gm = bf2f(g.proj[(size_t)row * NP + C_GM + col]), ga = bf2f(g.proj[(size_t)row * NP + C_GA + col]);
                g.Ob[(size_t)row * g.ldo + col] = f2bf(sigmoidf_(gm) * acc[i][j] + sigmoidf_(ga) * acc2[i][j]);
            } else {
                const int b = row / S;
                g.Of[(size_t)row * D + col] = g.x[(size_t)row * D + col] + g.mod[b * 3 * D + 2 * D + col] * acc[i][j];
            }
        }
    }
}

__global__ void __launch_bounds__(256) k_conv(const bf16* __restrict__ proj, const float* __restrict__ conv_w, const float* __restrict__ conv_b, bf16* __restrict__ qc, bf16* __restrict__ kc) {
    const size_t idx = (size_t)blockIdx.x * 256 + threadIdx.x;
    const int c = (int)(idx % 2048); const int row = (int)(idx / 2048); const int t = row % S;
    float o = conv_b[c];
#pragma unroll
    for (int tap = 0; tap < 4; ++tap) { const int tt = t - 3 + tap; if (tt >= 0) o += bf2f(proj[(size_t)(row - 3 + tap) * NP + c]) * conv_w[tap * 2048 + c]; }
    o = siluf_(o);
    if (c < 1024) qc[(size_t)row * 1024 + c] = f2bf(o); else kc[(size_t)row * 1024 + c - 1024] = f2bf(o * 0.0625f);
}

__global__ void __launch_bounds__(256) k_mlstm(const bf16* __restrict__ qc, const bf16* __restrict__ kc, const bf16* __restrict__ proj, const float* __restrict__ gates, float* __restrict__ hbuf) {
    const int w = blockIdx.x * 4 + (threadIdx.x >> 6), lane = threadIdx.x & 63;
    const int v = w & 255, h = (w >> 8) & 3, b = w >> 10;
    float C[4] = {0.f, 0.f, 0.f, 0.f}, n[4] = {0.f, 0.f, 0.f, 0.f};
    for (int t = 0; t < S; ++t) {
        const size_t row = (size_t)b * S + t;
        const ushort4 q4 = *(const ushort4*)(qc + row * 1024 + h * 256 + lane * 4);
        const ushort4 k4 = *(const ushort4*)(kc + row * 1024 + h * 256 + lane * 4);
        const float vv = bf2f(proj[row * NP + C_MV + h * 256 + v]);
        const float ig = gates[row * 8 + h], lf = gates[row * 8 + 4 + h];
        const float f = expf(lf), iv = expf(ig);
        const float kf[4] = {bf2f(k4.x), bf2f(k4.y), bf2f(k4.z), bf2f(k4.w)}, qf[4] = {bf2f(q4.x), bf2f(q4.y), bf2f(q4.z), bf2f(q4.w)};
        float num = 0.f, den = 0.f;
#pragma unroll
        for (int e = 0; e < 4; ++e) { n[e] = f * n[e] + iv * kf[e]; C[e] = f * C[e] + (iv * vv) * kf[e]; num += C[e] * qf[e]; den += n[e] * qf[e]; }
        num = wave_sum(num); den = wave_sum(den);
        if (lane == 0) hbuf[row * 1024 + h * 256 + v] = num / fmaxf(fabsf(den), 1.f);
    }
}
__global__ void __launch_bounds__(256) k_mpost(const float* __restrict__ hbuf, const bf16* __restrict__ proj, const float* __restrict__ mh_norm_g, bf16* __restrict__ ym) {
    const int w = blockIdx.x * 4 + (threadIdx.x >> 6), lane = threadIdx.x & 63;
    const int h = w & 3; const size_t row = w >> 2;
    const float4 hv = *(const float4*)(hbuf + row * 1024 + h * 256 + lane * 4);
    float ss = hv.x * hv.x + hv.y * hv.y + hv.z * hv.z + hv.w * hv.w;
    ss = wave_sum(ss);
    const float r = 1.0f / sqrtf(ss * (1.f / 256.f) + EPS);
    const float hh[4] = {hv.x, hv.y, hv.z, hv.w};
    ushort4 o; bf16 ov[4];
#pragma unroll
    for (int e = 0; e < 4; ++e) {
        const int c = h * 256 + lane * 4 + e;
        const float mo = bf2f(proj[row * NP + C_MO + c]), mz = bf2f(proj[row * NP + C_MZ + c]);
        ov[e] = f2bf(hh[e] * r * mh_norm_g[c] * sigmoidf_(mo) * siluf_(mz));
    }
    o.x = ov[0]; o.y = ov[1]; o.z = ov[2]; o.w = ov[3];
    *(ushort4*)(ym + row * 1024 + h * 256 + lane * 4) = o;
}

__global__ void __launch_bounds__(256) k_attn(const bf16* __restrict__ proj, const float* __restrict__ rel_bias, bf16* __restrict__ ya) {
    __shared__ float sq[4][128];
    const int wid = threadIdx.x >> 6, lane = threadIdx.x & 63;
    const int w = blockIdx.x * 4 + wid; const int hh = w & 7; const int row = w >> 3; const int b = row / S, t = row % S, j = t >> 6;
    { const unsigned qq = *(const unsigned*)(proj + (size_t)row * NP + C_AQ + hh * 128 + 2 * lane);
      sq[wid][2 * lane] = bf2f((bf16)(qq & 0xffff)) * 0.08838834764831845f; sq[wid][2 * lane + 1] = bf2f((bf16)(qq >> 16)) * 0.08838834764831845f; }
    __syncthreads();
    const int jlo = j > 8 ? j - 8 : 0; const int kstart = jlo * 64; const int nt = j - jlo + 1;
    float sc[9];
#pragma unroll
    for (int i = 0; i < 9; ++i) {
        sc[i] = -INFINITY;
        if (i < nt) {
            const int kpos = kstart + i * 64 + lane; const bf16* kr = proj + (size_t)(b * S + kpos) * NP + C_AK + hh * 128;
            float s = 0.f;
#pragma unroll
            for (int d8 = 0; d8 < 16; ++d8) { const uint4 kk = *(const uint4*)(kr + d8 * 8); const unsigned kw[4] = {kk.x, kk.y, kk.z, kk.w};
#pragma unroll
                for (int e = 0; e < 4; ++e) { s += sq[wid][d8 * 8 + 2 * e] * bf2f((bf16)(kw[e] & 0xffff)) + sq[wid][d8 * 8 + 2 * e + 1] * bf2f((bf16)(kw[e] >> 16)); } }
            int dist = t - kpos; dist = dist < -63 ? -63 : (dist > 128 ? 128 : dist);
            sc[i] = s + rel_bias[hh * 192 + dist + 63];
        }
    }
    float mx = sc[0];
#pragma unroll
    for (int i = 1; i < 9; ++i) mx = fmaxf(mx, sc[i]);
    mx = wave_max(mx);
    float l = 0.f;
#pragma unroll
    for (int i = 0; i < 9; ++i) { sc[i] = (i < nt) ? __expf(sc[i] - mx) : 0.f; l += sc[i]; }
    l = wave_sum(l);
    float o0 = 0.f, o1 = 0.f;
#pragma unroll
    for (int i = 0; i < 9; ++i) {
        if (i < nt) {
            const bf16* vr = proj + (size_t)(b * S + kstart + i * 64) * NP + C_AV + hh * 128 + 2 * lane;
            for (int kk = 0; kk < 64; ++kk) { const float p = __shfl(sc[i], kk); const unsigned vv = *(const unsigned*)(vr + (size_t)kk * NP);
                o0 += p * bf2f((bf16)(vv & 0xffff)); o1 += p * bf2f((bf16)(vv >> 16)); }
        }
    }
    const float inv = 1.f / l;
    const unsigned zz = *(const unsigned*)(proj + (size_t)row * NP + C_AZ + hh * 128 + 2 * lane);
    const float z0 = bf2f((bf16)(zz & 0xffff)), z1 = bf2f((bf16)(zz >> 16));
    const unsigned r = (unsigned)f2bf(o0 * inv * siluf_(z0)) | ((unsigned)f2bf(o1 * inv * siluf_(z1)) << 16);
    *(unsigned*)(ya + (size_t)row * 1024 + hh * 128 + 2 * lane) = r;
}

__global__ void __launch_bounds__(256) k_final(float* __restrict__ out, const float* __restrict__ g) {
    const int row = blockIdx.x * 4 + (threadIdx.x >> 6), lane = threadIdx.x & 63;
    float4* xr = (float4*)(out + (size_t)row * D);
    float4 v[8]; float ss = 0.f;
#pragma unroll
    for (int j = 0; j < 8; ++j) { v[j] = xr[lane + 64 * j]; ss += v[j].x * v[j].x + v[j].y * v[j].y + v[j].z * v[j].z + v[j].w * v[j].w; }
    ss = wave_sum(ss);
    const float r = 1.0f / sqrtf(ss * (1.f / D) + EPS);
#pragma unroll
    for (int j = 0; j < 8; ++j) { const float4 gg = ((const float4*)g)[lane + 64 * j]; float4 o; o.x = v[j].x * r * gg.x; o.y = v[j].y * r * gg.y; o.z = v[j].z * r * gg.z; o.w = v[j].w * r * gg.w; xr[lane + 64 * j] = o; }
}

namespace pg8 {
#define PG8_LAS __attribute__((address_space(3)))
typedef unsigned short bf16_t;
typedef short bf16x8 __attribute__((ext_vector_type(8)));
typedef float f32x4 __attribute__((ext_vector_type(4)));
typedef unsigned u32x4 __attribute__((ext_vector_type(4)));
constexpr int BM = 256, BK = 64, HALF = 128, HTB = HALF * BK * 2  , STAGE_BYTES = 8 * HTB, NXCD = 8, WGM = 8;

__host__ __device__ __forceinline__ int lds_byte(int r, int c) { const int st = (r >> 4) * 2 + (c >> 5), rr = r & 15, cc = c & 31, ob = rr * 64 + cc * 2; return st * 1024 + (ob ^ (((ob >> 9) & 1) << 5)); }
__host__ __device__ __forceinline__ void stage_rc(int b, int& R, int& C) { const int st = b / 1024, sb = b % 1024, swz = sb ^ (((sb >> 9) & 1) << 5); R = (st >> 1) * 16 + swz / 64; C = (st & 1) * 32 + (swz % 64) / 2; }
__host__ __device__ __forceinline__ int perm32(int rho) { const int n = rho >> 4, i = rho & 15; return 8 * (i >> 2) + 4 * n + (i & 3); }

struct Unit { int pm, pn, seg; };
struct Gemm { const bf16_t* A0; const bf16_t* A1; const bf16_t* B0; const bf16_t* B1; int lda, K; };

struct StaticOrder {
    int nM, nN, nwg, G, c;
    __host__ __device__ void init(int M, int N, int G_, int c_) { nM = M / BM; nN = N / BM; nwg = nM * nN; G = G_; c = c_; }
    __host__ __device__ bool next(int i, Unit& u) const {
        const long L = (long)i * G + c; if (L >= nwg) return false;
        int wgid = (int)L; { const int q = nwg / NXCD, r = nwg % NXCD, xcd = wgid % NXCD, off = wgid / NXCD; wgid = (xcd < r ? xcd * (q + 1) : r * (q + 1) + (xcd - r) * q) + off; }
        const int nig = WGM * nN, gid = wgid / nig, fm = gid * WGM, gsz = (nM - fm) < WGM ? (nM - fm) : WGM;
        u.pm = fm + ((wgid % nig) % gsz); u.pn = (wgid % nig) / gsz; u.seg = 0; return true;
    }
    __device__ __forceinline__ void a_ready(const Unit&) const {}
    __device__ __forceinline__ void done(const Unit&) const {}
};

__device__ __forceinline__ unsigned cvt_pk_bf16(float lo, float hi) { unsigned r; asm volatile("v_cvt_pk_bf16_f32 %0, %1, %2" : "=v"(r) : "v"(lo), "v"(hi)); return r; }
typedef float f32x2 __attribute__((ext_vector_type(2)));
template <class Epi, class Sched, bool ALIGN_EPI = false, bool SP2 = false>
__device__ __forceinline__ void gemm_phase(PG8_LAS unsigned char* lds, const Gemm g, const Sched& S, const Epi& E) {
    const int tid = threadIdx.x, wid = __builtin_amdgcn_readfirstlane(tid >> 6), lane = tid & 63, wr = wid >> 2, wc = wid & 3, fr = lane & 15, fq = lane >> 4;
    const int K = g.K, nt = K / BK;
    unsigned voffA[2], voffB[2];
#pragma unroll
    for (int i = 0; i < 2; ++i) { int R, C; stage_rc(tid * 16 + i * 8192, R, C); const int Rb = Epi::PERM ? ((R & ~31) + perm32(R & 31)) : R;
        voffA[i] = (unsigned)(R * g.lda + C) * 2u; voffB[i] = (unsigned)(Rb * K + C) * 2u; }
    const size_t kstep = (size_t)(BK * 2);
    const size_t hstepA = (size_t)HALF * g.lda * 2, hstepB = (size_t)HALF * K * 2;
    const size_t tstepA = 2 * hstepA, tstepB = 2 * hstepB;
    const unsigned ldsw = (unsigned)wid * 1024u;
    const int aoff = lds_byte(wr * 64 + fr, fq * 8), boff = lds_byte(wc * 32 + fr, fq * 8);
#define PG8_SA(b, h) (((b) * 2 + (h)) * HTB)
#define PG8_SB(b, h) ((4 + (b) * 2 + (h)) * HTB)
#define PG8_STAGE(bufoff, gbase, voff) do { _Pragma("unroll") for (int _i = 0; _i < 2; ++_i) \
        __builtin_amdgcn_global_load_lds((const unsigned*)((const char*)(gbase) + (voff)[_i]), (PG8_LAS unsigned*)(lds + (bufoff) + ldsw + _i * 8192), 16, 0, 0); } while (0)
#define PG8_LDA(dst, b, h) do { _Pragma("unroll") for (int m = 0; m < 4; ++m) _Pragma("unroll") for (int k = 0; k < 2; ++k) dst[m][k] = *(const PG8_LAS bf16x8*)(lds + PG8_SA(b, h) + aoff + m * 2048 + k * 1024); } while (0)
#define PG8_LDB(dst, b, h) do { _Pragma("unroll") for (int n = 0; n < 2; ++n) _Pragma("unroll") for (int k = 0; k < 2; ++k) dst[n][k] = *(const PG8_LAS bf16x8*)(lds + PG8_SB(b, h) + boff + n * 2048 + k * 1024); } while (0)
#define PG8_MMA(ai, bj, At, Bt) do { __builtin_amdgcn_s_setprio(1); _Pragma("unroll") for (int m = 0; m < 4; ++m) _Pragma("unroll") for (int n = 0; n < 2; ++n) _Pragma("unroll") for (int k = 0; k < 2; ++k) \
        acc[ai][bj][m][n] = __builtin_amdgcn_mfma_f32_16x16x32_bf16(Bt[n][k], At[m][k], acc[ai][bj][m][n], 0, 0, 0); __builtin_amdgcn_s_setprio(0); } while (0)
#define PG8_WAIT_V(n) asm volatile("s_waitcnt vmcnt(" #n ")" ::: "memory")
#define PG8_WAIT_L(n) asm volatile("s_waitcnt lgkmcnt(" #n ")" ::: "memory")
#define PG8_BAR __builtin_amdgcn_s_barrier()
#define PG8_SCHED __builtin_amdgcn_sched_barrier(0)
    Unit cur, nxt; int ui = 0;
    if (!S.next(0, cur)) return;
    f32x4 acc[2][2][4][2];
#pragma unroll
    for (int a = 0; a < 2; ++a)
#pragma unroll
        for (int b = 0; b < 2; ++b)
#pragma unroll
            for (int m = 0; m < 4; ++m)
#pragma unroll
                for (int n = 0; n < 2; ++n) acc[a][b][m][n] = (f32x4){0.f, 0.f, 0.f, 0.f};
    bf16x8 At[4][2], B0[2][2], B1[2][2];
    const char* cA = (const char*)(cur.seg ? g.A1 : g.A0) + (size_t)cur.pm * tstepA; const char* cB = (const char*)(cur.seg ? g.B1 : g.B0) + (size_t)cur.pn * tstepB;
    S.a_ready(cur);
    if constexpr (SP2) {
        PG8_STAGE(PG8_SB(0, 0), cB, voffB); PG8_STAGE(PG8_SB(0, 1), cB + hstepB, voffB); PG8_STAGE(PG8_SA(0, 0), cA, voffA); PG8_STAGE(PG8_SA(0, 1), cA + hstepA, voffA);
        if (wr == 1) PG8_BAR;
        PG8_WAIT_V(2); PG8_BAR;
        PG8_STAGE(PG8_SB(1, 0), cB + kstep, voffB); PG8_STAGE(PG8_SA(1, 0), cA + kstep, voffA); PG8_STAGE(PG8_SB(1, 1), cB + hstepB + kstep, voffB);
        PG8_WAIT_V(6); PG8_BAR;
    } else {
        PG8_STAGE(PG8_SB(0, 0), cB, voffB); PG8_STAGE(PG8_SA(0, 0), cA, voffA); PG8_STAGE(PG8_SB(0, 1), cB + hstepB, voffB); PG8_STAGE(PG8_SA(0, 1), cA + hstepA, voffA);
        if (wr == 1) PG8_BAR;
        PG8_WAIT_V(4); PG8_BAR;
        PG8_STAGE(PG8_SB(1, 0), cB + kstep, voffB); PG8_STAGE(PG8_SA(1, 0), cA + kstep, voffA); PG8_STAGE(PG8_SB(1, 1), cB + hstepB + kstep, voffB);
        PG8_WAIT_V(6); PG8_BAR;
    }
    for (;;) {
        const bool has_next = S.next(ui + 1, nxt);
        const char* nA = has_next ? (const char*)(nxt.seg ? g.A1 : g.A0) + (size_t)nxt.pm * tstepA : cA; const char* nB = has_next ? (const char*)(nxt.seg ? g.B1 : g.B0) + (size_t)nxt.pn * tstepB : cB;
        for (int t = 0; t < nt; t += 2) {
            const bool last = (t == nt - 2);
            const char* a1 = cA + (size_t)(t + 1) * kstep;
            const char* a2 = last ? nA : cA + (size_t)(t + 2) * kstep; const char* b2 = last ? nB : cB + (size_t)(t + 2) * kstep;
            const char* a3 = a2 + kstep; const char* b3 = b2 + kstep;
            if (last && has_next) S.a_ready(nxt);
            if constexpr (SP2) {
            PG8_LDB(B0, 0, 0); PG8_LDB(B1, 0, 1); PG8_SCHED; PG8_LDA(At, 0, 0); PG8_STAGE(PG8_SA(1, 1), a1 + hstepA, voffA);
            PG8_WAIT_V(8); PG8_WAIT_L(0); PG8_BAR; PG8_MMA(0, 0, At, B0); PG8_MMA(0, 1, At, B1); PG8_BAR; PG8_SCHED;
            PG8_LDA(At, 0, 1); PG8_STAGE(PG8_SB(0, 0), b2, voffB); PG8_STAGE(PG8_SB(0, 1), b2 + hstepB, voffB); PG8_STAGE(PG8_SA(0, 0), a2, voffA);
            PG8_WAIT_V(8); PG8_WAIT_L(0); PG8_BAR; PG8_MMA(1, 0, At, B0); PG8_MMA(1, 1, At, B1); PG8_BAR; PG8_SCHED;
            PG8_LDB(B0, 1, 0); PG8_LDB(B1, 1, 1); PG8_SCHED; PG8_LDA(At, 1, 0); PG8_STAGE(PG8_SA(0, 1), a2 + hstepA, voffA);
            PG8_WAIT_V(8); PG8_WAIT_L(0); PG8_BAR; PG8_MMA(0, 0, At, B0); PG8_MMA(0, 1, At, B1); PG8_BAR; PG8_SCHED;
            PG8_LDA(At, 1, 1); PG8_STAGE(PG8_SB(1, 0), b3, voffB); PG8_STAGE(PG8_SB(1, 1), b3 + hstepB, voffB); PG8_STAGE(PG8_SA(1, 0), a3, voffA);
            PG8_WAIT_V(8); PG8_WAIT_L(0); PG8_BAR; PG8_MMA(1, 0, At, B0); PG8_MMA(1, 1, At, B1); PG8_BAR; PG8_SCHED;
            } else {
            PG8_LDB(B0, 0, 0); PG8_SCHED; PG8_LDA(At, 0, 0); PG8_STAGE(PG8_SA(1, 1), a1 + hstepA, voffA);
            PG8_WAIT_L(8); PG8_BAR; PG8_WAIT_L(0); PG8_MMA(0, 0, At, B0); PG8_BAR; PG8_SCHED;
            PG8_LDB(B1, 0, 1); PG8_STAGE(PG8_SB(0, 0), b2, voffB);
            PG8_BAR; PG8_WAIT_L(0); PG8_MMA(0, 1, At, B1); PG8_BAR;
            PG8_LDA(At, 0, 1); PG8_STAGE(PG8_SA(0, 0), a2, voffA);
            PG8_BAR; PG8_WAIT_L(0); PG8_MMA(1, 0, At, B0); PG8_BAR; PG8_SCHED;
            PG8_STAGE(PG8_SB(0, 1), b2 + hstepB, voffB);
            PG8_WAIT_V(6); PG8_BAR; PG8_MMA(1, 1, At, B1); PG8_BAR;
            PG8_LDB(B0, 1, 0); PG8_SCHED; PG8_LDA(At, 1, 0); PG8_STAGE(PG8_SA(0, 1), a2 + hstepA, voffA);
            PG8_WAIT_L(8); PG8_BAR; PG8_WAIT_L(0); PG8_MMA(0, 0, At, B0); PG8_BAR; PG8_SCHED;
            PG8_LDB(B1, 1, 1); PG8_STAGE(PG8_SB(1, 0), b3, voffB);
            PG8_BAR; PG8_WAIT_L(0); PG8_MMA(0, 1, At, B1); PG8_BAR;
            PG8_LDA(At, 1, 1); PG8_STAGE(PG8_SA(1, 0), a3, voffA);
            PG8_BAR; PG8_WAIT_L(0); PG8_MMA(1, 0, At, B0); PG8_BAR; PG8_SCHED;
            PG8_STAGE(PG8_SB(1, 1), b3 + hstepB, voffB);
            PG8_WAIT_V(6); PG8_BAR; PG8_MMA(1, 1, At, B1); PG8_BAR;
            }
        }
        if constexpr (ALIGN_EPI) { if (wr == 0) PG8_BAR; }
        if constexpr (!Epi::AFTER_DRAIN) { E(acc, cur, wr, wc, fr, fq); S.done(cur); }
        if (!has_next) break;
        if (E.zero_after(cur)) {
#pragma unroll
        for (int a = 0; a < 2; ++a)
#pragma unroll
            for (int b = 0; b < 2; ++b)
#pragma unroll
                for (int m = 0; m < 4; ++m)
#pragma unroll
                    for (int n = 0; n < 2; ++n) acc[a][b][m][n] = (f32x4){0.f, 0.f, 0.f, 0.f};
        }
        cur = nxt; cA = nA; cB = nB; ++ui;
        if constexpr (ALIGN_EPI) { if (wr == 1) PG8_BAR; }
    }
    PG8_WAIT_V(0);
    if constexpr (!ALIGN_EPI) { if (wr == 0) PG8_BAR; }
    PG8_BAR;
    if constexpr (Epi::AFTER_DRAIN) { E.fused(acc, cur, wr, wc, fr, fq, lds, wid, lane); S.done(cur); }
#undef PG8_SA
#undef PG8_SB
#undef PG8_STAGE
#undef PG8_LDA
#undef PG8_LDB
#undef PG8_MMA
#undef PG8_WAIT_V
#undef PG8_WAIT_L
#undef PG8_BAR
#undef PG8_SCHED
}
}

namespace pg8 {
typedef unsigned u32x4_ __attribute__((ext_vector_type(4)));
struct EpiProj {
    static constexpr bool PERM = true, AFTER_DRAIN = false;
    bf16_t* O; int ldc;
    __device__ __forceinline__ bool zero_after(const Unit&) const { return true; }
    __device__ __forceinline__ void operator()(f32x4 (&acc)[2][2][4][2], const Unit& u, int wr, int wc, int fr, int fq) const {
        const int row0 = u.pm * BM + wr * 64 + fr, col0 = u.pn * BM + wc * 32 + 8 * fq;
#pragma unroll
        for (int ai = 0; ai < 2; ++ai)
#pragma unroll
            for (int m = 0; m < 4; ++m) { bf16_t* rowp = O + (size_t)(row0 + ai * HALF + m * 16) * ldc + col0;
#pragma unroll
                for (int bj = 0; bj < 2; ++bj) { const f32x4 v0 = acc[ai][bj][m][0], v1 = acc[ai][bj][m][1];
                    u32x4 w; w.x = cvt_pk_bf16(v0[0], v0[1]); w.y = cvt_pk_bf16(v0[2], v0[3]); w.z = cvt_pk_bf16(v1[0], v1[1]); w.w = cvt_pk_bf16(v1[2], v1[3]);
                    *(u32x4*)(rowp + bj * HALF) = w; } }
    }
};
struct SegOrder {
    StaticOrder base;
    __device__ __forceinline__ bool next(int i, Unit& u) const { if (!base.next(i >> 1, u)) return false; u.seg = i & 1; return true; }
    __device__ __forceinline__ void a_ready(const Unit&) const {}
    __device__ __forceinline__ void done(const Unit&) const {}
};
__device__ __forceinline__ float bfw(unsigned w, int half) { return __builtin_bit_cast(float, half ? (w & 0xffff0000u) : (w << 16)); }
struct EpiMerge {
    static constexpr bool PERM = true, AFTER_DRAIN = false;
    const bf16_t* proj; int ldp, cgm, cga; bf16_t* O; int ldo;
    __device__ __forceinline__ bool zero_after(const Unit& u) const { return u.seg != 0; }
    __device__ __forceinline__ void operator()(f32x4 (&acc)[2][2][4][2], const Unit& u, int wr, int wc, int fr, int fq) const {
        const int row0 = u.pm * BM + wr * 64 + fr, col0 = u.pn * BM + wc * 32 + 8 * fq;
#pragma unroll
        for (int ai = 0; ai < 2; ++ai)
#pragma unroll
            for (int m = 0; m < 4; ++m) { const size_t row = (size_t)(row0 + ai * HALF + m * 16);
#pragma unroll
                for (int bj = 0; bj < 2; ++bj) {
                    const u32x4 ga4 = *(const u32x4*)(proj + row * ldp + cga + col0 + bj * HALF);
                    if (u.seg == 0) {
                        const u32x4 gm4 = *(const u32x4*)(proj + row * ldp + cgm + col0 + bj * HALF);
#pragma unroll
                        for (int e = 0; e < 8; ++e) { const float gm = bfw(gm4[e >> 1], e & 1), ga = bfw(ga4[e >> 1], e & 1);
                            acc[ai][bj][m][e >> 2][e & 3] *= (1.f + __expf(-ga)) * __builtin_amdgcn_rcpf(1.f + __expf(-gm)); }
                    } else {
                        float o[8];
#pragma unroll
                        for (int e = 0; e < 8; ++e) { const float ga = bfw(ga4[e >> 1], e & 1); o[e] = acc[ai][bj][m][e >> 2][e & 3] * __builtin_amdgcn_rcpf(1.f + __expf(-ga)); }
                        u32x4 w; w.x = cvt_pk_bf16(o[0], o[1]); w.y = cvt_pk_bf16(o[2], o[3]); w.z = cvt_pk_bf16(o[4], o[5]); w.w = cvt_pk_bf16(o[6], o[7]);
                        *(u32x4*)(O + row * ldo + col0 + bj * HALF) = w;
                    }
                }
                if (m & 1) asm volatile("" ::: "memory"); }
    }
};
struct EpiOut {
    static constexpr bool PERM = false, AFTER_DRAIN = false;
    const float* x; const float* gate; float* out; float* rowss; int ldc, rows_per_batch, gate_stride;
    __device__ __forceinline__ bool zero_after(const Unit&) const { return true; }
    __device__ __forceinline__ void operator()(f32x4 (&acc)[2][2][4][2], const Unit& u, int wr, int wc, int fr, int fq) const {
        const int row0 = u.pm * BM + wr * 64 + fr, col0 = u.pn * BM + wc * 32 + 4 * fq;
        const float* gp = gate + (size_t)((u.pm * BM) / rows_per_batch) * gate_stride + col0;
        f32x4 gt[2][2];
#pragma unroll
        for (int bj = 0; bj < 2; ++bj)
#pragma unroll
            for (int n = 0; n < 2; ++n) gt[bj][n] = *(const f32x4*)(gp + bj * HALF + n * 16);
#pragma unroll
        for (int ai = 0; ai < 2; ++ai)
#pragma unroll
            for (int m = 0; m < 4; ++m) { const int row = row0 + ai * HALF + m * 16; const size_t off = (size_t)row * ldc + col0; float ssq = 0.f;
#pragma unroll
                for (int bj = 0; bj < 2; ++bj)
#pragma unroll
                    for (int n = 0; n < 2; ++n) { const f32x4 xv = *(const f32x4*)(x + off + bj * HALF + n * 16); const f32x4 o = xv + gt[bj][n] * acc[ai][bj][m][n];
                        ssq += (o[0] * o[0] + o[1] * o[1]) + (o[2] * o[2] + o[3] * o[3]); *(f32x4*)(out + off + bj * HALF + n * 16) = o; }
                ssq += __shfl_xor(ssq, 16); ssq += __shfl_xor(ssq, 32);
                if (fq == 0) atomicAdd(rowss + row, ssq);
                if (m & 1) asm volatile("" ::: "memory"); }
    }
};
}

#define LAS __attribute__((address_space(3)))
typedef unsigned v4u __attribute__((ext_vector_type(4)));
typedef float f4 __attribute__((ext_vector_type(4)));
constexpr size_t MiB = 1u << 20;
constexpr size_t WS_PROJ = 0;
constexpr size_t WS_YM = 416 * MiB;
constexpr size_t WS_YA = 448 * MiB;
constexpr size_t WS_WPM = 480 * MiB;
constexpr size_t WS_WPA = 484 * MiB;
constexpr size_t WS_WOUT = 488 * MiB;
constexpr size_t WS_MODP = 496 * MiB;
constexpr size_t WS_MOD = 497 * MiB;
constexpr size_t WS_GATES = 498 * MiB;
constexpr size_t WS_ROWSS = 499 * MiB;
constexpr size_t WS_END = 500 * MiB;
constexpr size_t OB_H = 0;
constexpr size_t OB_WIN = 64 * MiB;
constexpr int NWAVES = 8, LDS_BYTES = 147456;

struct MArgs { const float* in[15]; float* out; unsigned char* ws; int ph_lo, ph_hi; };

__device__ __forceinline__ unsigned pk2(float lo, float hi) { return (unsigned)f2bf(lo) | ((unsigned)f2bf(hi) << 16); }
#define LDS_WAIT() asm volatile("s_waitcnt lgkmcnt(0)" ::: "memory")

__device__ __forceinline__ void transpose_item(const float* __restrict__ W, int ldw, int ncol_src0, bf16* __restrict__ WT, int K, int nrow_dst0, int k0, LAS float* scr, int lane) {
#pragma unroll 8
    for (int i = 0; i < 32; ++i) { const int kk = 2 * i + (lane >> 5); scr[kk * 33 + (lane & 31)] = W[(size_t)(k0 + kk) * ldw + ncol_src0 + (lane & 31)]; }
    LDS_WAIT();
    const int c = lane & 7;
#pragma unroll
    for (int j = 0; j < 4; ++j) { const int n = (lane >> 3) + 8 * j; const LAS float* s = scr + (8 * c) * 33 + n;
        v4u o; o.x = pk2(s[0 * 33], s[1 * 33]); o.y = pk2(s[2 * 33], s[3 * 33]); o.z = pk2(s[4 * 33], s[5 * 33]); o.w = pk2(s[6 * 33], s[7 * 33]);
        *(v4u*)(WT + (size_t)(nrow_dst0 + n) * K + k0 + 8 * c) = o; }
    LDS_WAIT();
}

__global__ void __launch_bounds__(NWAVES * 64, 2) mega(MArgs a) {
    extern __shared__ __attribute__((aligned(16))) unsigned char lds_raw[];
    LAS unsigned char* lds = (LAS unsigned char*)lds_raw;
    cg::grid_group grid = cg::this_grid();
    const int tid = threadIdx.x, lane = tid & 63, wave = __builtin_amdgcn_readfirstlane(tid >> 6);
    const int G = gridDim.x, gw = blockIdx.x * NWAVES + wave, NGW = G * NWAVES;
    const float* x = a.in[0]; const float* cvec = a.in[1]; const float* w_ada = a.in[2]; const float* b_ada = a.in[3]; const float* norm_g = a.in[4]; const float* w_in = a.in[5];
    const float* b_if = a.in[6]; const float* final_g = a.in[14]; const float* w_proj_m = a.in[11]; const float* w_proj_a = a.in[12]; const float* w_out = a.in[13];
    unsigned char* ws = a.ws; unsigned char* ob = (unsigned char*)a.out;
    bf16* proj = (bf16*)(ws + WS_PROJ); bf16* Wpm_t = (bf16*)(ws + WS_WPM); bf16* Wpa_t = (bf16*)(ws + WS_WPA); bf16* Wout_t = (bf16*)(ws + WS_WOUT);
    float* modp = (float*)(ws + WS_MODP); float* mod = (float*)(ws + WS_MOD); float* gates = (float*)(ws + WS_GATES); float* rowss = (float*)(ws + WS_ROWSS);
    bf16* ym = (bf16*)(ws + WS_YM); bf16* ya = (bf16*)(ws + WS_YA); bf16* merged = proj;
    bf16* H = (bf16*)(ob + OB_H); bf16* Win_t = (bf16*)(ob + OB_WIN);
    const int lo = a.ph_lo, hi = a.ph_hi;
#define IN(k) (lo <= (k) && (k) < hi)
#define BOTH(k) (IN(k) && IN((k) + 1))

    if (IN(0)) {
        LAS float* scr = (LAS float*)(lds + wave * 16384);
        constexpr int I_ADA = 16 * 24, I_IN = (D / 64) * (NP / 32), I_PM = (1024 / 64) * (D / 32), I_OUT = (D / 64) * (D / 32);
        constexpr int NITEMS = I_ADA + I_IN + 2 * I_PM + I_OUT;
        for (int it = gw; it < NITEMS; it += NGW) {
            int r = it;
            if (r < I_ADA) {
                const int ks = r / 24, cb = r % 24, n0 = cb * 256 + lane * 4;
                float4 a0 = {0.f, 0.f, 0.f, 0.f}, a1 = {0.f, 0.f, 0.f, 0.f};
                if (ks == 0) { a0 = *(const float4*)(b_ada + n0); a1 = a0; }
#pragma unroll 8
                for (int kk = 0; kk < 128; ++kk) { const int k = ks * 128 + kk; const float4 w = *(const float4*)(w_ada + (size_t)k * (3 * D) + n0);
                    const float c0 = cvec[k], c1 = cvec[D + k]; const float s0 = c0 / (1.f + __expf(-c0)), s1 = c1 / (1.f + __expf(-c1));
                    a0.x += s0 * w.x; a0.y += s0 * w.y; a0.z += s0 * w.z; a0.w += s0 * w.w; a1.x += s1 * w.x; a1.y += s1 * w.y; a1.z += s1 * w.z; a1.w += s1 * w.w; }
                *(float4*)(modp + (size_t)(ks * 2 + 0) * (3 * D) + n0) = a0; *(float4*)(modp + (size_t)(ks * 2 + 1) * (3 * D) + n0) = a1;
                continue; }
            r -= I_ADA;
            if (r < I_IN) { const int nblk = NP / 32, kb = r / nblk, nb = r % nblk, nd = 32 * nb; transpose_item(w_in, INC, nd + (nd >= 5120 ? 8 : 0), Win_t, D, nd, 64 * kb, scr, lane); continue; }
            r -= I_IN;
            if (r < I_PM) { const int nblk = D / 32, kb = r / nblk, nb = r % nblk; transpose_item(w_proj_m, D, 32 * nb, Wpm_t, 1024, 32 * nb, 64 * kb, scr, lane); continue; }
            r -= I_PM;
            if (r < I_PM) { const int nblk = D / 32, kb = r / nblk, nb = r % nblk; transpose_item(w_proj_a, D, 32 * nb, Wpa_t, 1024, 32 * nb, 64 * kb, scr, lane); continue; }
            r -= I_PM;
            { const int nblk = D / 32, kb = r / nblk, nb = r % nblk; transpose_item(w_out, D, 32 * nb, Wout_t, D, 32 * nb, 64 * kb, scr, lane); }
        }
        if (BOTH(0)) grid.sync();
    }

    if (IN(1)) {
        LAS float* smod = (LAS float*)lds;
        LAS float* gwl = (LAS float*)(lds + 49152);
        for (int i = tid; i < 2 * 3 * D; i += NWAVES * 64) { float s = 0.f;
#pragma unroll
            for (int ks = 0; ks < 16; ++ks) s += modp[(size_t)ks * (2 * 3 * D) + i];
            smod[i] = s; if (blockIdx.x == 0) mod[i] = s; }
        for (int k = tid; k < D; k += NWAVES * 64) { const float4 w0 = *(const float4*)(w_in + (size_t)k * INC + 5120), w1 = *(const float4*)(w_in + (size_t)k * INC + 5124);
            gwl[0 * D + k] = w0.x; gwl[1 * D + k] = w0.y; gwl[2 * D + k] = w0.z; gwl[3 * D + k] = w0.w; gwl[4 * D + k] = w1.x; gwl[5 * D + k] = w1.y; gwl[6 * D + k] = w1.z; gwl[7 * D + k] = w1.w; }
        __syncthreads();
        for (int row = gw; row < M; row += NGW) {
            const int b = row / S;
            const float4* xr = (const float4*)(x + (size_t)row * D);
            float4 v[8]; float ss = 0.f;
#pragma unroll
            for (int j = 0; j < 8; ++j) { v[j] = xr[lane + 64 * j]; ss += v[j].x * v[j].x + v[j].y * v[j].y + v[j].z * v[j].z + v[j].w * v[j].w; }
            ss = wave_sum(ss);
            const float rstd = 1.0f / sqrtf(ss * (1.f / D) + EPS);
            float acc[8];
#pragma unroll
            for (int i = 0; i < 8; ++i) acc[i] = 0.f;
            const LAS float* shift = smod + b * 3 * D; const LAS float* scale = shift + D;
#pragma unroll
            for (int j = 0; j < 8; ++j) {
                const int k0 = (lane + 64 * j) * 4;
                const f4 g4 = *(const f4*)(norm_g + k0); const f4 sc4 = *(const LAS f4*)(scale + k0); const f4 sh4 = *(const LAS f4*)(shift + k0);
                float4 h4; h4.x = v[j].x * rstd * g4.x * (1.f + sc4.x) + sh4.x; h4.y = v[j].y * rstd * g4.y * (1.f + sc4.y) + sh4.y; h4.z = v[j].z * rstd * g4.z * (1.f + sc4.z) + sh4.z; h4.w = v[j].w * rstd * g4.w * (1.f + sc4.w) + sh4.w;
#pragma unroll
                for (int i = 0; i < 8; ++i) { const f4 w4 = *(const LAS f4*)(gwl + i * D + k0); acc[i] += h4.x * w4.x + h4.y * w4.y + h4.z * w4.z + h4.w * w4.w; }
                uint2 o; o.x = pk2(h4.x, h4.y); o.y = pk2(h4.z, h4.w);
                *(uint2*)(H + (size_t)row * D + k0) = o;
                asm volatile("" ::: "memory");
            }
#pragma unroll
            for (int i = 0; i < 8; ++i) acc[i] = wave_sum(acc[i]);
            if (lane == 0) {
                rowss[row] = 0.f;
#pragma unroll
                for (int i = 0; i < 4; ++i) gates[(size_t)row * 8 + i] = acc[i] + b_if[i];
#pragma unroll
                for (int i = 4; i < 8; ++i) { const float z = acc[i] + b_if[i]; gates[(size_t)row * 8 + i] = fminf(z, 0.f) - log1pf(expf(-fabsf(z))); }
            }
        }
        __syncthreads();
        if (BOTH(1)) grid.sync();
    }

    if (IN(2)) {
        pg8::Gemm g{H, H, Win_t, Win_t, D, D}; pg8::StaticOrder So; So.init(M, NP, G, (int)blockIdx.x);
        pg8::EpiProj E{proj, NP};
        pg8::gemm_phase<pg8::EpiProj, pg8::StaticOrder, true, true>(lds, g, So, E);
        if (BOTH(2)) grid.sync();
    }
    if (IN(4)) {
        pg8::Gemm g{ym, ya, Wpm_t, Wpa_t, 1024, 1024}; pg8::SegOrder So; So.base.init(M, D, G, (int)blockIdx.x);
        pg8::EpiMerge E{proj, NP, C_GM, C_GA, merged, NP};
        pg8::gemm_phase<pg8::EpiMerge, pg8::SegOrder, true, true>(lds, g, So, E);
        if (BOTH(4)) grid.sync();
    }
    if (IN(5)) {
        pg8::Gemm g{merged, merged, Wout_t, Wout_t, NP, D}; pg8::StaticOrder So; So.init(M, D, G, (int)blockIdx.x);
        pg8::EpiOut E{x, mod + 2 * D, a.out, rowss, D, S, 3 * D};
        pg8::gemm_phase<pg8::EpiOut, pg8::StaticOrder, true, true>(lds, g, So, E);
        if (BOTH(5)) grid.sync();
    }
    if (IN(6)) {
        for (int row = gw; row < M; row += NGW) {
            const float r = 1.0f / sqrtf(rowss[row] * (1.f / D) + EPS);
            f4* xr = (f4*)(a.out + (size_t)row * D);
#pragma unroll
            for (int j = 0; j < 8; ++j) { const f4 g4 = *(const f4*)(final_g + (lane + 64 * j) * 4); xr[lane + 64 * j] = xr[lane + 64 * j] * r * g4; }
        }
    }
#undef IN
#undef BOTH
}

static int launch_mega(const MArgs& a, hipStream_t stream) {
    static int grid = 0;
    if (grid == 0) {
        int dev = 0, cus = 0, per_cu = 0;
        if (hipGetDevice(&dev) != hipSuccess || hipDeviceGetAttribute(&cus, hipDeviceAttributeMultiprocessorCount, dev) != hipSuccess) { fprintf(stderr, "kernel_launch: device query failed\n"); grid = -1; return -1; }
        if (hipFuncSetAttribute((const void*)mega, hipFuncAttributeMaxDynamicSharedMemorySize, LDS_BYTES) != hipSuccess) { fprintf(stderr, "kernel_launch: hipFuncSetAttribute failed\n"); grid = -1; return -1; }
        if (hipOccupancyMaxActiveBlocksPerMultiprocessor(&per_cu, (const void*)mega, NWAVES * 64, LDS_BYTES) != hipSuccess || per_cu < 1) { fprintf(stderr, "kernel_launch: occupancy query says %d blocks/CU\n", per_cu); (void)hipGetLastError(); grid = -1; return -1; }
        grid = cus * (per_cu > 1 ? 1 : per_cu);
        fprintf(stderr, "kernel_launch: %d CUs, occupancy %d blocks/CU, grid %d\n", cus, per_cu, grid);
    }
    if (grid < 0) return -1;
    MArgs arg = a; void* args[] = {(void*)&arg};
    const hipError_t e = hipLaunchCooperativeKernel((const void*)mega, dim3(grid), dim3(NWAVES * 64), args, LDS_BYTES, stream);
    if (e != hipSuccess) { fprintf(stderr, "kernel_launch: cooperative launch failed: %s (grid %d)\n", hipGetErrorString(e), grid); return -1; }
    return 0;
}

extern "C" void kernel_launch(void* const* d_in, const int* in_sizes, int n_in, void* d_out, int out_size, void* d_ws, size_t ws_size, hipStream_t stream) {
    if (n_in != 15 || in_sizes[0] != M * D || out_size != M * D || ws_size < WS_END) { fprintf(stderr, "kernel_launch: unexpected shapes / workspace (%zu < %zu)\n", ws_size, (size_t)WS_END); return; }
    const float* x = (const float*)d_in[0];
    const float* conv_w = (const float*)d_in[7]; const float* conv_b = (const float*)d_in[8]; const float* mh_norm_g = (const float*)d_in[9]; const float* rel_bias = (const float*)d_in[10];
    const float* w_proj_m = (const float*)d_in[11]; const float* w_proj_a = (const float*)d_in[12]; const float* w_out = (const float*)d_in[13]; const float* final_g = (const float*)d_in[14];
    unsigned char* ws = (unsigned char*)d_ws;
    bf16* proj = (bf16*)(ws + WS_PROJ); bf16* ym = (bf16*)(ws + WS_YM); bf16* ya = (bf16*)(ws + WS_YA); float* mod = (float*)(ws + WS_MOD); float* gates = (float*)(ws + WS_GATES);
    unsigned char* ob = (unsigned char*)d_out;
    bf16* qc = (bf16*)ob; bf16* kc = (bf16*)(ob + 32 * MiB); float* hbuf = (float*)(ob + 64 * MiB);
    bf16* merged = proj;

    MArgs a{}; for (int i = 0; i < 15; ++i) a.in[i] = (const float*)d_in[i]; a.out = (float*)d_out; a.ws = ws; a.ph_lo = 0; a.ph_hi = 3;
    if (launch_mega(a, stream) != 0) return;
    k_conv<<<(unsigned)((size_t)M * 2048 / 256), 256, 0, stream>>>(proj, conv_w, conv_b, qc, kc);
    k_mlstm<<<NB * 4 * 256 / 4, 256, 0, stream>>>(qc, kc, proj, gates, hbuf);
    k_mpost<<<M * 4 / 4, 256, 0, stream>>>(hbuf, proj, mh_norm_g, ym);
    k_attn<<<M * 8 / 4, 256, 0, stream>>>(proj, rel_bias, ya);
    a.ph_lo = 4; a.ph_hi = 7;
    if (launch_mega(a, stream) != 0) return;
}
```

```cpp
#include <hip/hip_runtime.h>
#include <cstdio>
#include <cstdint>
#include <hip/hip_cooperative_groups.h>
namespace cg = cooperative_groups;

typedef unsigned short bf16;
constexpr int D = 2048, NB = 2, S = 8192, M = NB * S;
constexpr int INC = 13320, NP = 13312;
constexpr int C_MQ = 0, C_MK = 1024, C_MV = 2048, C_MO = 3072, C_MZ = 4096, C_AQ = 5120, C_AK = 6144, C_AV = 7168, C_AZ = 8192, C_GM = 9216, C_GA = 11264;
constexpr float EPS = 1e-6f;

__device__ __forceinline__ bf16 f2bf(float f) { unsigned u = __builtin_bit_cast(unsigned, f); return (bf16)((u + 0x7fffu + ((u >> 16) & 1u)) >> 16); }
__device__ __forceinline__ float bf2f(bf16 h) { return __builtin_bit_cast(float, (unsigned)h << 16); }
__device__ __forceinline__ float wave_sum(float v) {
#pragma unroll
    for (int o = 1; o < 64; o <<= 1) v += __shfl_xor(v, o);
    return v;
}
__device__ __forceinline__ float wave_max(float v) {
#pragma unroll
    for (int o = 1; o < 64; o <<= 1) v = fmaxf(v, __shfl_xor(v, o));
    return v;
}
__device__ __forceinline__ float sigmoidf_(float x) { return 1.f / (1.f + __expf(-x)); }
__device__ __forceinline__ float siluf_(float x) { return x / (1.f + __expf(-x)); }

__global__ void __launch_bounds__(256) k_ada(const float* __restrict__ c, const float* __restrict__ w_ada, const float* __restrict__ b_ada, float* __restrict__ mod) {
    __shared__ float sc[2][D];
    for (int i = threadIdx.x; i < 2 * D; i += 256) { float v = c[i]; sc[i / D][i % D] = v / (1.f + expf(-v)); }
    __syncthreads();
    const int n = blockIdx.x * 256 + threadIdx.x;
    float a0 = 0.f, a1 = 0.f;
    for (int k = 0; k < D; ++k) { const float w = w_ada[(size_t)k * (3 * D) + n]; a0 += sc[0][k] * w; a1 += sc[1][k] * w; }
    mod[n] = a0 + b_ada[n]; mod[3 * D + n] = a1 + b_ada[n];
}

__global__ void __launch_bounds__(256) k_norm(const float* __restrict__ x, const float* __restrict__ norm_g, const float* __restrict__ mod, const float* __restrict__ w_in,
                                              const float* __restrict__ b_if, bf16* __restrict__ H, float* __restrict__ gates) {
    const int row = blockIdx.x * 4 + (threadIdx.x >> 6), lane = threadIdx.x & 63, b = row / S;
    const float4* xr = (const float4*)(x + (size_t)row * D);
    float4 v[8]; float ss = 0.f;
#pragma unroll
    for (int j = 0; j < 8; ++j) { v[j] = xr[lane + 64 * j]; ss += v[j].x * v[j].x + v[j].y * v[j].y + v[j].z * v[j].z + v[j].w * v[j].w; }
    ss = wave_sum(ss);
    const float rstd = 1.0f / sqrtf(ss * (1.f / D) + EPS);
    float acc[8];
#pragma unroll
    for (int i = 0; i < 8; ++i) acc[i] = 0.f;
    const float* shift = mod + b * 3 * D; const float* scale = shift + D;
#pragma unroll
    for (int j = 0; j < 8; ++j) {
        const int k0 = (lane + 64 * j) * 4;
        const float xv[4] = {v[j].x, v[j].y, v[j].z, v[j].w};
        float hv[4];
#pragma unroll
        for (int e = 0; e < 4; ++e) {
            const int k = k0 + e;
            hv[e] = xv[e] * rstd * norm_g[k] * (1.f + scale[k]) + shift[k];
            const float4* wr = (const float4*)(w_in + (size_t)k * INC + 5120);
            const float4 w0 = wr[0], w1 = wr[1];
            acc[0] += hv[e] * w0.x; acc[1] += hv[e] * w0.y; acc[2] += hv[e] * w0.z; acc[3] += hv[e] * w0.w;
            acc[4] += hv[e] * w1.x; acc[5] += hv[e] * w1.y; acc[6] += hv[e] * w1.z; acc[7] += hv[e] * w1.w;
        }
        ushort4 o; o.x = f2bf(hv[0]); o.y = f2bf(hv[1]); o.z = f2bf(hv[2]); o.w = f2bf(hv[3]);
        *(ushort4*)(H + (size_t)row * D + k0) = o;
    }
#pragma unroll
    for (int i = 0; i < 8; ++i) acc[i] = wave_sum(acc[i]);
    if (lane == 0) {
#pragma unroll
        for (int i = 0; i < 4; ++i) gates[(size_t)row * 8 + i] = acc[i] + b_if[i];
#pragma unroll
        for (int i = 4; i < 8; ++i) { const float z = acc[i] + b_if[i]; gates[(size_t)row * 8 + i] = fminf(z, 0.f) - log1pf(expf(-fabsf(z))); }
    }
}

struct GemmArgs { const bf16* A; const bf16* A2; const float* B; const float* B2; int lda, ldb, K; bf16* Ob; int ldo; float* Of; const bf16* proj; const float* x; const float* mod; };
template <int MODE> __global__ void __launch_bounds__(256) k_gemm(GemmArgs g) {
    __shared__ float As[16][68]; __shared__ float Bs[16][68];
    const int tid = threadIdx.x, tx = tid & 15, ty = tid >> 4;
    const int m0 = blockIdx.y * 64, n0 = blockIdx.x * 64;
    float acc[4][4], acc2[4][4];
#pragma unroll
    for (int i = 0; i < 4; ++i)
#pragma unroll
        for (int j = 0; j < 4; ++j) { acc[i][j] = 0.f; acc2[i][j] = 0.f; }
    const int nseg = (MODE == 1) ? 2 : 1;
    for (int seg = 0; seg < nseg; ++seg) {
        const bf16* A = seg ? g.A2 : g.A; const float* Bm = seg ? g.B2 : g.B;
        const int ncol = (MODE == 0) ? (n0 + (n0 >= 5120 ? 8 : 0)) : n0;
        for (int k0 = 0; k0 < g.K; k0 += 16) {
            { const int r = tid >> 2, kq = (tid & 3) * 4; const ushort4 a = *(const ushort4*)(A + (size_t)(m0 + r) * g.lda + k0 + kq);
              As[kq + 0][r] = bf2f(a.x); As[kq + 1][r] = bf2f(a.y); As[kq + 2][r] = bf2f(a.z); As[kq + 3][r] = bf2f(a.w); }
            { const int k = tid >> 4, n4 = (tid & 15) * 4; const float4 bv = *(const float4*)(Bm + (size_t)(k0 + k) * g.ldb + ncol + n4);
              Bs[k][n4 + 0] = bv.x; Bs[k][n4 + 1] = bv.y; Bs[k][n4 + 2] = bv.z; Bs[k][n4 + 3] = bv.w; }
            __syncthreads();
#pragma unroll
            for (int k = 0; k < 16; ++k) {
                const float4 a = *(const float4*)&As[k][ty * 4]; const float4 bq = *(const float4*)&Bs[k][tx * 4];
                const float av[4] = {a.x, a.y, a.z, a.w}, bv[4] = {bq.x, bq.y, bq.z, bq.w};
                if (seg == 0) {
#pragma unroll
                    for (int i = 0; i < 4; ++i)
#pragma unroll
                        for (int j = 0; j < 4; ++j) acc[i][j] += av[i] * bv[j];
                } else {
#pragma unroll
                    for (int i = 0; i < 4; ++i)
#pragma unroll
                        for (int j = 0; j < 4; ++j) acc2[i][j] += av[i] * bv[j];
                }
            }
            __syncthreads();
        }
    }
#pragma unroll
    for (int i = 0; i < 4; ++i) {
        const int row = m0 + ty * 4 + i;
#pragma unroll
        for (int j = 0; j < 4; ++j) {
            const int col = n0 + tx * 4 + j;
            if (MODE == 0) g.Ob[(size_t)row * g.ldo + col] = f2bf(acc[i][j]);
            else if (MODE == 1) {
                const float gm = bf2f(g.proj[(size_t)row * NP + C_GM + col]), ga = bf2f(g.proj[(size_t)row * NP + C_GA + col]);
                g.Ob[(size_t)row * g.ldo + col] = f2bf(sigmoidf_(gm) * acc[i][j] + sigmoidf_(ga) * acc2[i][j]);
            } else {
                const int b = row / S;
                g.Of[(size_t)row * D + col] = g.x[(size_t)row * D + col] + g.mod[b * 3 * D + 2 * D + col] * acc[i][j];
            }
        }
    }
}

__global__ void __launch_bounds__(256) k_conv(const bf16* __restrict__ proj, const float* __restrict__ conv_w, const float* __restrict__ conv_b, bf16* __restrict__ qc, bf16* __restrict__ kc) {
    const size_t idx = (size_t)blockIdx.x * 256 + threadIdx.x;
    const int c = (int)(idx % 2048); const int row = (int)(idx / 2048); const int t = row % S;
    float o = conv_b[c];
#pragma unroll
    for (int tap = 0; tap < 4; ++tap) { const int tt = t - 3 + tap; if (tt >= 0) o += bf2f(proj[(size_t)(row - 3 + tap) * NP + c]) * conv_w[tap * 2048 + c]; }
    o = siluf_(o);
    if (c < 1024) qc[(size_t)row * 1024 + c] = f2bf(o); else kc[(size_t)row * 1024 + c - 1024] = f2bf(o * 0.0625f);
}

__global__ void __launch_bounds__(256) k_mlstm(const bf16* __restrict__ qc, const bf16* __restrict__ kc, const bf16* __restrict__ proj, const float* __restrict__ gates, float* __restrict__ hbuf) {
    const int w = blockIdx.x * 4 + (threadIdx.x >> 6), lane = threadIdx.x & 63;
    const int v = w & 255, h = (w >> 8) & 3, b = w >> 10;
    float C[4] = {0.f, 0.f, 0.f, 0.f}, n[4] = {0.f, 0.f, 0.f, 0.f};
    for (int t = 0; t < S; ++t) {
        const size_t row = (size_t)b * S + t;
        const ushort4 q4 = *(const ushort4*)(qc + row * 1024 + h * 256 + lane * 4);
        const ushort4 k4 = *(const ushort4*)(kc + row * 1024 + h * 256 + lane * 4);
        const float vv = bf2f(proj[row * NP + C_MV + h * 256 + v]);
        const float ig = gates[row * 8 + h], lf = gates[row * 8 + 4 + h];
        const float f = expf(lf), iv = expf(ig);
        const float kf[4] = {bf2f(k4.x), bf2f(k4.y), bf2f(k4.z), bf2f(k4.w)}, qf[4] = {bf2f(q4.x), bf2f(q4.y), bf2f(q4.z), bf2f(q4.w)};
        float num = 0.f, den = 0.f;
#pragma unroll
        for (int e = 0; e < 4; ++e) { n[e] = f * n[e] + iv * kf[e]; C[e] = f * C[e] + (iv * vv) * kf[e]; num += C[e] * qf[e]; den += n[e] * qf[e]; }
        num = wave_sum(num); den = wave_sum(den);
        if (lane == 0) hbuf[row * 1024 + h * 256 + v] = num / fmaxf(fabsf(den), 1.f);
    }
}
__global__ void __launch_bounds__(256) k_mpost(const float* __restrict__ hbuf, const bf16* __restrict__ proj, const float* __restrict__ mh_norm_g, bf16* __restrict__ ym) {
    const int w = blockIdx.x * 4 + (threadIdx.x >> 6), lane = threadIdx.x & 63;
    const int h = w & 3; const size_t row = w >> 2;
    const float4 hv = *(const float4*)(hbuf + row * 1024 + h * 256 + lane * 4);
    float ss = hv.x * hv.x + hv.y * hv.y + hv.z * hv.z + hv.w * hv.w;
    ss = wave_sum(ss);
    const float r = 1.0f / sqrtf(ss * (1.f / 256.f) + EPS);
    const float hh[4] = {hv.x, hv.y, hv.z, hv.w};
    ushort4 o; bf16 ov[4];
#pragma unroll
    for (int e = 0; e < 4; ++e) {
        const int c = h * 256 + lane * 4 + e;
        const float mo = bf2f(proj[row * NP + C_MO + c]), mz = bf2f(proj[row * NP + C_MZ + c]);
        ov[e] = f2bf(hh[e] * r * mh_norm_g[c] * sigmoidf_(mo) * siluf_(mz));
    }
    o.x = ov[0]; o.y = ov[1]; o.z = ov[2]; o.w = ov[3];
    *(ushort4*)(ym + row * 1024 + h * 256 + lane * 4) = o;
}

__global__ void __launch_bounds__(256) k_attn(const bf16* __restrict__ proj, const float* __restrict__ rel_bias, bf16* __restrict__ ya) {
    __shared__ float sq[4][128];
    const int wid = threadIdx.x >> 6, lane = threadIdx.x & 63;
    const int w = blockIdx.x * 4 + wid; const int hh = w & 7; const int row = w >> 3; const int b = row / S, t = row % S, j = t >> 6;
    { const unsigned qq = *(const unsigned*)(proj + (size_t)row * NP + C_AQ + hh * 128 + 2 * lane);
      sq[wid][2 * lane] = bf2f((bf16)(qq & 0xffff)) * 0.08838834764831845f; sq[wid][2 * lane + 1] = bf2f((bf16)(qq >> 16)) * 0.08838834764831845f; }
    __syncthreads();
    const int jlo = j > 8 ? j - 8 : 0; const int kstart = jlo * 64; const int nt = j - jlo + 1;
    float sc[9];
#pragma unroll
    for (int i = 0; i < 9; ++i) {
        sc[i] = -INFINITY;
        if (i < nt) {
            const int kpos = kstart + i * 64 + lane; const bf16* kr = proj + (size_t)(b * S + kpos) * NP + C_AK + hh * 128;
            float s = 0.f;
#pragma unroll
            for (int d8 = 0; d8 < 16; ++d8) { const uint4 kk = *(const uint4*)(kr + d8 * 8); const unsigned kw[4] = {kk.x, kk.y, kk.z, kk.w};
#pragma unroll
                for (int e = 0; e < 4; ++e) { s += sq[wid][d8 * 8 + 2 * e] * bf2f((bf16)(kw[e] & 0xffff)) + sq[wid][d8 * 8 + 2 * e + 1] * bf2f((bf16)(kw[e] >> 16)); } }
            int dist = t - kpos; dist = dist < -63 ? -63 : (dist > 128 ? 128 : dist);
            sc[i] = s + rel_bias[hh * 192 + dist + 63];
        }
    }
    float mx = sc[0];
#pragma unroll
    for (int i = 1; i < 9; ++i) mx = fmaxf(mx, sc[i]);
    mx = wave_max(mx);
    float l = 0.f;
#pragma unroll
    for (int i = 0; i < 9; ++i) { sc[i] = (i < nt) ? __expf(sc[i] - mx) : 0.f; l += sc[i]; }
    l = wave_sum(l);
    float o0 = 0.f, o1 = 0.f;
#pragma unroll
    for (int i = 0; i < 9; ++i) {
        if (i < nt) {
            const bf16* vr = proj + (size_t)(b * S + kstart + i * 64) * NP + C_AV + hh * 128 + 2 * lane;
            for (int kk = 0; kk < 64; ++kk) { const float p = __shfl(sc[i], kk); const unsigned vv = *(const unsigned*)(vr + (size_t)kk * NP);
                o0 += p * bf2f((bf16)(vv & 0xffff)); o1 += p * bf2f((bf16)(vv >> 16)); }
        }
    }
    const float inv = 1.f / l;
    const unsigned zz = *(const unsigned*)(proj + (size_t)row * NP + C_AZ + hh * 128 + 2 * lane);
    const float z0 = bf2f((bf16)(zz & 0xffff)), z1 = bf2f((bf16)(zz >> 16));
    const unsigned r = (unsigned)f2bf(o0 * inv * siluf_(z0)) | ((unsigned)f2bf(o1 * inv * siluf_(z1)) << 16);
    *(unsigned*)(ya + (size_t)row * 1024 + hh * 128 + 2 * lane) = r;
}

__global__ void __launch_bounds__(256) k_final(float* __restrict__ out, const float* __restrict__ g) {
    const int row = blockIdx.x * 4 + (threadIdx.x >> 6), lane = threadIdx.x & 63;
    float4* xr = (float4*)(out + (size_t)row * D);
    float4 v[8]; float ss = 0.f;
#pragma unroll
    for (int j = 0; j < 8; ++j) { v[j] = xr[lane + 64 * j]; ss += v[j].x * v[j].x + v[j].y * v[j].y + v[j].z * v[j].z + v[j].w * v[j].w; }
    ss = wave_sum(ss);
    const float r = 1.0f / sqrtf(ss * (1.f / D) + EPS);
#pragma unroll
    for (int j = 0; j < 8; ++j) { const float4 gg = ((const float4*)g)[lane + 64 * j]; float4 o; o.x = v[j].x * r * gg.x; o.y = v[j].y * r * gg.y; o.z = v[j].z * r * gg.z; o.w = v[j].w * r * gg.w; xr[lane + 64 * j] = o; }
}

namespace pg8 {
#define PG8_LAS __attribute__((address_space(3)))
typedef unsigned short bf16_t;
typedef short bf16x8 __attribute__((ext_vector_type(8)));
typedef float f32x4 __attribute__((ext_vector_type(4)));
typedef unsigned u32x4 __attribute__((ext_vector_type(4)));
constexpr int BM = 256, BK = 64, HALF = 128, HTB = HALF * BK * 2  , STAGE_BYTES = 8 * HTB, NXCD = 8, WGM = 8;

__host__ __device__ __forceinline__ int lds_byte(int r, int c) { const int st = (r >> 4) * 2 + (c >> 5), rr = r & 15, cc = c & 31, ob = rr * 64 + cc * 2; return st * 1024 + (ob ^ (((ob >> 9) & 1) << 5)); }
__host__ __device__ __forceinline__ void stage_rc(int b, int& R, int& C) { const int st = b / 1024, sb = b % 1024, swz = sb ^ (((sb >> 9) & 1) << 5); R = (st >> 1) * 16 + swz / 64; C = (st & 1) * 32 + (swz % 64) / 2; }
__host__ __device__ __forceinline__ int perm32(int rho) { const int n = rho >> 4, i = rho & 15; return 8 * (i >> 2) + 4 * n + (i & 3); }

struct Unit { int pm, pn, seg; };
struct Gemm { const bf16_t* A0; const bf16_t* A1; const bf16_t* B0; const bf16_t* B1; int lda, K; };

struct StaticOrder {
    int nM, nN, nwg, G, c;
    __host__ __device__ void init(int M, int N, int G_, int c_) { nM = M / BM; nN = N / BM; nwg = nM * nN; G = G_; c = c_; }
    __host__ __device__ bool next(int i, Unit& u) const {
        const long L = (long)i * G + c; if (L >= nwg) return false;
        int wgid = (int)L; { const int q = nwg / NXCD, r = nwg % NXCD, xcd = wgid % NXCD, off = wgid / NXCD; wgid = (xcd < r ? xcd * (q + 1) : r * (q + 1) + (xcd - r) * q) + off; }
        const int nig = WGM * nN, gid = wgid / nig, fm = gid * WGM, gsz = (nM - fm) < WGM ? (nM - fm) : WGM;
        u.pm = fm + ((wgid % nig) % gsz); u.pn = (wgid % nig) / gsz; u.seg = 0; return true;
    }
    __device__ __forceinline__ void a_ready(const Unit&) const {}
    __device__ __forceinline__ void done(const Unit&) const {}
};

__device__ __forceinline__ unsigned cvt_pk_bf16(float lo, float hi) { unsigned r; asm volatile("v_cvt_pk_bf16_f32 %0, %1, %2" : "=v"(r) : "v"(lo), "v"(hi)); return r; }
typedef float f32x2 __attribute__((ext_vector_type(2)));
template <class Epi, class Sched, bool ALIGN_EPI = false, bool SP2 = false>
__device__ __forceinline__ void gemm_phase(PG8_LAS unsigned char* lds, const Gemm g, const Sched& S, const Epi& E) {
    const int tid = threadIdx.x, wid = __builtin_amdgcn_readfirstlane(tid >> 6), lane = tid & 63, wr = wid >> 2, wc = wid & 3, fr = lane & 15, fq = lane >> 4;
    const int K = g.K, nt = K / BK;
    unsigned voffA[2], voffB[2];
#pragma unroll
    for (int i = 0; i < 2; ++i) { int R, C; stage_rc(tid * 16 + i * 8192, R, C); const int Rb = Epi::PERM ? ((R & ~31) + perm32(R & 31)) : R;
        voffA[i] = (unsigned)(R * g.lda + C) * 2u; voffB[i] = (unsigned)(Rb * K + C) * 2u; }
    const size_t kstep = (size_t)(BK * 2);
    const size_t hstepA = (size_t)HALF * g.lda * 2, hstepB = (size_t)HALF * K * 2;
    const size_t tstepA = 2 * hstepA, tstepB = 2 * hstepB;
    const unsigned ldsw = (unsigned)wid * 1024u;
    const int aoff = lds_byte(wr * 64 + fr, fq * 8), boff = lds_byte(wc * 32 + fr, fq * 8);
#define PG8_SA(b, h) (((b) * 2 + (h)) * HTB)
#define PG8_SB(b, h) ((4 + (b) * 2 + (h)) * HTB)
#define PG8_STAGE(bufoff, gbase, voff) do { _Pragma("unroll") for (int _i = 0; _i < 2; ++_i) \
        __builtin_amdgcn_global_load_lds((const unsigned*)((const char*)(gbase) + (voff)[_i]), (PG8_LAS unsigned*)(lds + (bufoff) + ldsw + _i * 8192), 16, 0, 0); } while (0)
#define PG8_LDA(dst, b, h) do { _Pragma("unroll") for (int m = 0; m < 4; ++m) _Pragma("unroll") for (int k = 0; k < 2; ++k) dst[m][k] = *(const PG8_LAS bf16x8*)(lds + PG8_SA(b, h) + aoff + m * 2048 + k * 1024); } while (0)
#define PG8_LDB(dst, b, h) do { _Pragma("unroll") for (int n = 0; n < 2; ++n) _Pragma("unroll") for (int k = 0; k < 2; ++k) dst[n][k] = *(const PG8_LAS bf16x8*)(lds + PG8_SB(b, h) + boff + n * 2048 + k * 1024); } while (0)
#define PG8_MMA(ai, bj, At, Bt) do { __builtin_amdgcn_s_setprio(1); _Pragma("unroll") for (int m = 0; m < 4; ++m) _Pragma("unroll") for (int n = 0; n < 2; ++n) _Pragma("unroll") for (int k = 0; k < 2; ++k) \
        acc[ai][bj][m][n] = __builtin_amdgcn_mfma_f32_16x16x32_bf16(Bt[n][k], At[m][k], acc[ai][bj][m][n], 0, 0, 0); __builtin_amdgcn_s_setprio(0); } while (0)
#define PG8_WAIT_V(n) asm volatile("s_waitcnt vmcnt(" #n ")" ::: "memory")
#define PG8_WAIT_L(n) asm volatile("s_waitcnt lgkmcnt(" #n ")" ::: "memory")
#define PG8_BAR __builtin_amdgcn_s_barrier()
#define PG8_SCHED __builtin_amdgcn_sched_barrier(0)
    Unit cur, nxt; int ui = 0;
    if (!S.next(0, cur)) return;
    f32x4 acc[2][2][4][2];
#pragma unroll
    for (int a = 0; a < 2; ++a)
#pragma unroll
        for (int b = 0; b < 2; ++b)
#pragma unroll
            for (int m = 0; m < 4; ++m)
#pragma unroll
                for (int n = 0; n < 2; ++n) acc[a][b][m][n] = (f32x4){0.f, 0.f, 0.f, 0.f};
    bf16x8 At[4][2], B0[2][2], B1[2][2];
    const char* cA = (const char*)(cur.seg ? g.A1 : g.A0) + (size_t)cur.pm * tstepA; const char* cB = (const char*)(cur.seg ? g.B1 : g.B0) + (size_t)cur.pn * tstepB;
    S.a_ready(cur);
    if constexpr (SP2) {
        PG8_STAGE(PG8_SB(0, 0), cB, voffB); PG8_STAGE(PG8_SB(0, 1), cB + hstepB, voffB); PG8_STAGE(PG8_SA(0, 0), cA, voffA); PG8_STAGE(PG8_SA(0, 1), cA + hstepA, voffA);
        if (wr == 1) PG8_BAR;
        PG8_WAIT_V(2); PG8_BAR;
        PG8_STAGE(PG8_SB(1, 0), cB + kstep, voffB); PG8_STAGE(PG8_SA(1, 0), cA + kstep, voffA); PG8_STAGE(PG8_SB(1, 1), cB + hstepB + kstep, voffB);
        PG8_WAIT_V(6); PG8_BAR;
    } else {
        PG8_STAGE(PG8_SB(0, 0), cB, voffB); PG8_STAGE(PG8_SA(0, 0), cA, voffA); PG8_STAGE(PG8_SB(0, 1), cB + hstepB, voffB); PG8_STAGE(PG8_SA(0, 1), cA + hstepA, voffA);
        if (wr == 1) PG8_BAR;
        PG8_WAIT_V(4); PG8_BAR;
        PG8_STAGE(PG8_SB(1, 0), cB + kstep, voffB); PG8_STAGE(PG8_SA(1, 0), cA + kstep, voffA); PG8_STAGE(PG8_SB(1, 1), cB + hstepB + kstep, voffB);
        PG8_WAIT_V(6); PG8_BAR;
    }
    for (;;) {
        const bool has_next = S.next(ui + 1, nxt);
        const char* nA = has_next ? (const char*)(nxt.seg ? g.A1 : g.A0) + (size_t)nxt.pm * tstepA : cA; const char* nB = has_next ? (const char*)(nxt.seg ? g.B1 : g.B0) + (size_t)nxt.pn * tstepB : cB;
        for (int t = 0; t < nt; t += 2) {
            const bool last = (t == nt - 2);
            const char* a1 = cA + (size_t)(t + 1) * kstep;
            const char* a2 = last ? nA : cA + (size_t)(t + 2) * kstep; const char* b2 = last ? nB : cB + (size_t)(t + 2) * kstep;
            const char* a3 = a2 + kstep; const char* b3 = b2 + kstep;
            if (last && has_next) S.a_ready(nxt);
            if constexpr (SP2) {
            PG8_LDB(B0, 0, 0); PG8_LDB(B1, 0, 1); PG8_SCHED; PG8_LDA(At, 0, 0); PG8_STAGE(PG8_SA(1, 1), a1 + hstepA, voffA);
            PG8_WAIT_V(8); PG8_WAIT_L(0); PG8_BAR; PG8_MMA(0, 0, At, B0); PG8_MMA(0, 1, At, B1); PG8_BAR; PG8_SCHED;
            PG8_LDA(At, 0, 1); PG8_STAGE(PG8_SB(0, 0), b2, voffB); PG8_STAGE(PG8_SB(0, 1), b2 + hstepB, voffB); PG8_STAGE(PG8_SA(0, 0), a2, voffA);
            PG8_WAIT_V(8); PG8_WAIT_L(0); PG8_BAR; PG8_MMA(1, 0, At, B0); PG8_MMA(1, 1, At, B1); PG8_BAR; PG8_SCHED;
            PG8_LDB(B0, 1, 0); PG8_LDB(B1, 1, 1); PG8_SCHED; PG8_LDA(At, 1, 0); PG8_STAGE(PG8_SA(0, 1), a2 + hstepA, voffA);
            PG8_WAIT_V(8); PG8_WAIT_L(0); PG8_BAR; PG8_MMA(0, 0, At, B0); PG8_MMA(0, 1, At, B1); PG8_BAR; PG8_SCHED;
            PG8_LDA(At, 1, 1); PG8_STAGE(PG8_SB(1, 0), b3, voffB); PG8_STAGE(PG8_SB(1, 1), b3 + hstepB, voffB); PG8_STAGE(PG8_SA(1, 0), a3, voffA);
            PG8_WAIT_V(8); PG8_WAIT_L(0); PG8_BAR; PG8_MMA(1, 0, At, B0); PG8_MMA(1, 1, At, B1); PG8_BAR; PG8_SCHED;
            } else {
            PG8_LDB(B0, 0, 0); PG8_SCHED; PG8_LDA(At, 0, 0); PG8_STAGE(PG8_SA(1, 1), a1 + hstepA, voffA);
            PG8_WAIT_L(8); PG8_BAR; PG8_WAIT_L(0); PG8_MMA(0, 0, At, B0); PG8_BAR; PG8_SCHED;
            PG8_LDB(B1, 0, 1); PG8_STAGE(PG8_SB(0, 0), b2, voffB);
            PG8_BAR; PG8_WAIT_L(0); PG8_MMA(0, 1, At, B1); PG8_BAR;
            PG8_LDA(At, 0, 1); PG8_STAGE(PG8_SA(0, 0), a2, voffA);
            PG8_BAR; PG8_WAIT_L(0); PG8_MMA(1, 0, At, B0); PG8_BAR; PG8_SCHED;
            PG8_STAGE(PG8_SB(0, 1), b2 + hstepB, voffB);
            PG8_WAIT_V(6); PG8_BAR; PG8_MMA(1, 1, At, B1); PG8_BAR;
            PG8_LDB(B0, 1, 0); PG8_SCHED; PG8_LDA(At, 1, 0); PG8_STAGE(PG8_SA(0, 1), a2 + hstepA, voffA);
            PG8_WAIT_L(8); PG8_BAR; PG8_WAIT_L(0); PG8_MMA(0, 0, At, B0); PG8_BAR; PG8_SCHED;
            PG8_LDB(B1, 1, 1); PG8_STAGE(PG8_SB(1, 0), b3, voffB);
            PG8_BAR; PG8_WAIT_L(0); PG8_MMA(0, 1, At, B1); PG8_BAR;
            PG8_LDA(At, 1, 1); PG8_STAGE(PG8_SA(1, 0), a3, voffA);
            PG8_BAR; PG8_WAIT_L(0); PG8_MMA(1, 0, At, B0); PG8_BAR; PG8_SCHED;
            PG8_STAGE(PG8_SB(1, 1), b3 + hstepB, voffB);
            PG8_WAIT_V(6); PG8_BAR; PG8_MMA(1, 1, At, B1); PG8_BAR;
            }
        }
        if constexpr (ALIGN_EPI) { if (wr == 0) PG8_BAR; }
        if constexpr (!Epi::AFTER_DRAIN) { E(acc, cur, wr, wc, fr, fq); S.done(cur); }
        if (!has_next) break;
        if (E.zero_after(cur)) {
#pragma unroll
        for (int a = 0; a < 2; ++a)
#pragma unroll
            for (int b = 0; b < 2; ++b)
#pragma unroll
                for (int m = 0; m < 4; ++m)
#pragma unroll
                    for (int n = 0; n < 2; ++n) acc[a][b][m][n] = (f32x4){0.f, 0.f, 0.f, 0.f};
        }
        cur = nxt; cA = nA; cB = nB; ++ui;
        if constexpr (ALIGN_EPI) { if (wr == 1) PG8_BAR; }
    }
    PG8_WAIT_V(0);
    if constexpr (!ALIGN_EPI) { if (wr == 0) PG8_BAR; }
    PG8_BAR;
    if constexpr (Epi::AFTER_DRAIN) { E.fused(acc, cur, wr, wc, fr, fq, lds, wid, lane); S.done(cur); }
#undef PG8_SA
#undef PG8_SB
#undef PG8_STAGE
#undef PG8_LDA
#undef PG8_LDB
#undef PG8_MMA
#undef PG8_WAIT_V
#undef PG8_WAIT_L
#undef PG8_BAR
#undef PG8_SCHED
}
}

namespace pg8 {
typedef unsigned u32x4_ __attribute__((ext_vector_type(4)));
struct EpiProj {
    static constexpr bool PERM = true, AFTER_DRAIN = false;
    bf16_t* O; int ldc;
    __device__ __forceinline__ bool zero_after(const Unit&) const { return true; }
    __device__ __forceinline__ void operator()(f32x4 (&acc)[2][2][4][2], const Unit& u, int wr, int wc, int fr, int fq) const {
        const int row0 = u.pm * BM + wr * 64 + fr, col0 = u.pn * BM + wc * 32 + 8 * fq;
#pragma unroll
        for (int ai = 0; ai < 2; ++ai)
#pragma unroll
            for (int m = 0; m < 4; ++m) { bf16_t* rowp = O + (size_t)(row0 + ai * HALF + m * 16) * ldc + col0;
#pragma unroll
                for (int bj = 0; bj < 2; ++bj) { const f32x4 v0 = acc[ai][bj][m][0], v1 = acc[ai][bj][m][1];
                    u32x4 w; w.x = cvt_pk_bf16(v0[0], v0[1]); w.y = cvt_pk_bf16(v0[2], v0[3]); w.z = cvt_pk_bf16(v1[0], v1[1]); w.w = cvt_pk_bf16(v1[2], v1[3]);
                    *(u32x4*)(rowp + bj * HALF) = w; } }
    }
};
struct SegOrder {
    StaticOrder base;
    __device__ __forceinline__ bool next(int i, Unit& u) const { if (!base.next(i >> 1, u)) return false; u.seg = i & 1; return true; }
    __device__ __forceinline__ void a_ready(const Unit&) const {}
    __device__ __forceinline__ void done(const Unit&) const {}
};
__device__ __forceinline__ float bfw(unsigned w, int half) { return __builtin_bit_cast(float, half ? (w & 0xffff0000u) : (w << 16)); }
struct EpiMerge {
    static constexpr bool PERM = true, AFTER_DRAIN = false;
    const bf16_t* proj; int ldp, cgm, cga; bf16_t* O; int ldo;
    __device__ __forceinline__ bool zero_after(const Unit& u) const { return u.seg != 0; }
    __device__ __forceinline__ void operator()(f32x4 (&acc)[2][2][4][2], const Unit& u, int wr, int wc, int fr, int fq) const {
        const int row0 = u.pm * BM + wr * 64 + fr, col0 = u.pn * BM + wc * 32 + 8 * fq;
#pragma unroll
        for (int ai = 0; ai < 2; ++ai)
#pragma unroll
            for (int m = 0; m < 4; ++m) { const size_t row = (size_t)(row0 + ai * HALF + m * 16);
#pragma unroll
                for (int bj = 0; bj < 2; ++bj) {
                    const u32x4 ga4 = *(const u32x4*)(proj + row * ldp + cga + col0 + bj * HALF);
                    if (u.seg == 0) {
                        const u32x4 gm4 = *(const u32x4*)(proj + row * ldp + cgm + col0 + bj * HALF);
#pragma unroll
                        for (int e = 0; e < 8; ++e) { const float gm = bfw(gm4[e >> 1], e & 1), ga = bfw(ga4[e >> 1], e & 1);
                            acc[ai][bj][m][e >> 2][e & 3] *= (1.f + __expf(-ga)) * __builtin_amdgcn_rcpf(1.f + __expf(-gm)); }
                    } else {
                        float o[8];
#pragma unroll
                        for (int e = 0; e < 8; ++e) { const float ga = bfw(ga4[e >> 1], e & 1); o[e] = acc[ai][bj][m][e >> 2][e & 3] * __builtin_amdgcn_rcpf(1.f + __expf(-ga)); }
                        u32x4 w; w.x = cvt_pk_bf16(o[0], o[1]); w.y = cvt_pk_bf16(o[2], o[3]); w.z = cvt_pk_bf16(o[4], o[5]); w.w = cvt_pk_bf16(o[6], o[7]);
                        *(u32x4*)(O + row * ldo + col0 + bj * HALF) = w;
                    }
                }
                if (m & 1) asm volatile("" ::: "memory"); }
    }
};
struct EpiOut {
    static constexpr bool PERM = false, AFTER_DRAIN = false;
    const float* x; const float* gate; float* out; float* rowss; int ldc, rows_per_batch, gate_stride;
    __device__ __forceinline__ bool zero_after(const Unit&) const { return true; }
    __device__ __forceinline__ void operator()(f32x4 (&acc)[2][2][4][2], const Unit& u, int wr, int wc, int fr, int fq) const {
        const int row0 = u.pm * BM + wr * 64 + fr, col0 = u.pn * BM + wc * 32 + 4 * fq;
        const float* gp = gate + (size_t)((u.pm * BM) / rows_per_batch) * gate_stride + col0;
        f32x4 gt[2][2];
#pragma unroll
        for (int bj = 0; bj < 2; ++bj)
#pragma unroll
            for (int n = 0; n < 2; ++n) gt[bj][n] = *(const f32x4*)(gp + bj * HALF + n * 16);
#pragma unroll
        for (int ai = 0; ai < 2; ++ai)
#pragma unroll
            for (int m = 0; m < 4; ++m) { const int row = row0 + ai * HALF + m * 16; const size_t off = (size_t)row * ldc + col0; float ssq = 0.f;
#pragma unroll
                for (int bj = 0; bj < 2; ++bj)
#pragma unroll
                    for (int n = 0; n < 2; ++n) { const f32x4 xv = *(const f32x4*)(x + off + bj * HALF + n * 16); const f32x4 o = xv + gt[bj][n] * acc[ai][bj][m][n];
                        ssq += (o[0] * o[0] + o[1] * o[1]) + (o[2] * o[2] + o[3] * o[3]); *(f32x4*)(out + off + bj * HALF + n * 16) = o; }
                ssq += __shfl_xor(ssq, 16); ssq += __shfl_xor(ssq, 32);
                if (fq == 0) atomicAdd(rowss + row, ssq);
                if (m & 1) asm volatile("" ::: "memory"); }
    }
};
}

#define LAS __attribute__((address_space(3)))
typedef unsigned v4u __attribute__((ext_vector_type(4)));
typedef float f4 __attribute__((ext_vector_type(4)));
constexpr size_t MiB = 1u << 20;
constexpr size_t WS_PROJ = 0;
constexpr size_t WS_YM = 416 * MiB;
constexpr size_t WS_YA = 448 * MiB;
constexpr size_t WS_WPM = 480 * MiB;
constexpr size_t WS_WPA = 484 * MiB;
constexpr size_t WS_WOUT = 488 * MiB;
constexpr size_t WS_MODP = 496 * MiB;
constexpr size_t WS_MOD = 497 * MiB;
constexpr size_t WS_GATES = 498 * MiB;
constexpr size_t WS_ROWSS = 499 * MiB;
constexpr size_t WS_END = 500 * MiB;
constexpr size_t OB_H = 0;
constexpr size_t OB_WIN = 64 * MiB;
constexpr int NWAVES = 8, LDS_BYTES = 147456;

struct MArgs { const float* in[15]; float* out; unsigned char* ws; int ph_lo, ph_hi; };

__device__ __forceinline__ unsigned pk2(float lo, float hi) { return (unsigned)f2bf(lo) | ((unsigned)f2bf(hi) << 16); }
#define LDS_WAIT() asm volatile("s_waitcnt lgkmcnt(0)" ::: "memory")

__device__ __forceinline__ void transpose_item(const float* __restrict__ W, int ldw, int ncol_src0, bf16* __restrict__ WT, int K, int nrow_dst0, int k0, LAS float* scr, int lane) {
#pragma unroll 8
    for (int i = 0; i < 32; ++i) { const int kk = 2 * i + (lane >> 5); scr[kk * 33 + (lane & 31)] = W[(size_t)(k0 + kk) * ldw + ncol_src0 + (lane & 31)]; }
    LDS_WAIT();
    const int c = lane & 7;
#pragma unroll
    for (int j = 0; j < 4; ++j) { const int n = (lane >> 3) + 8 * j; const LAS float* s = scr + (8 * c) * 33 + n;
        v4u o; o.x = pk2(s[0 * 33], s[1 * 33]); o.y = pk2(s[2 * 33], s[3 * 33]); o.z = pk2(s[4 * 33], s[5 * 33]); o.w = pk2(s[6 * 33], s[7 * 33]);
        *(v4u*)(WT + (size_t)(nrow_dst0 + n) * K + k0 + 8 * c) = o; }
    LDS_WAIT();
}

typedef short bf16x8 __attribute__((ext_vector_type(8)));
typedef short s16x4 __attribute__((ext_vector_type(4)));
typedef float f32x16 __attribute__((ext_vector_type(16)));
typedef float f32x2_t __attribute__((ext_vector_type(2)));
typedef __bf16 bf16x2_t __attribute__((ext_vector_type(2)));
__device__ __forceinline__ unsigned cvtpk(float lo, float hi) { f32x2_t v = {lo, hi}; bf16x2_t b = __builtin_convertvector(v, bf16x2_t); return __builtin_bit_cast(unsigned, b); }
__device__ __forceinline__ s16x4 tr_read(const LAS unsigned char* p) { return __builtin_bit_cast(s16x4, __builtin_amdgcn_ds_read_tr16_b64_v4i16((LAS s16x4*)p)); }
constexpr int AT_KP = 272, AT_VP = 320, AT_KBUF = 64 * AT_KP, AT_VBUF = 64 * AT_VP, AT_VOFF = 2 * AT_KBUF, AT_BIAS = AT_VOFF + 2 * AT_VBUF, AT_LDS = AT_BIAS + 768;
constexpr float LOG2E = 1.4426950408889634f;

__device__ __forceinline__ void attn_unit(LAS unsigned char* lds, const bf16* __restrict__ proj, const float* __restrict__ rel_bias, bf16* __restrict__ ya, int b, int h, int g4, int tid, int lane, int wave) {
    const int j0 = 4 * g4, half = wave & 1, jq = j0 + (wave >> 1);
    const int r32 = lane & 31, hb = lane >> 5;
    const int tq = 64 * jq + 32 * half + r32;
    const size_t rowq = (size_t)b * S + tq;
    LAS float* biasL = (LAS float*)(lds + AT_BIAS);
    if (tid < 192) biasL[tid] = rel_bias[h * 192 + tid] * LOG2E;
    bf16x8 qf[8];
#pragma unroll
    for (int ks = 0; ks < 8; ++ks) qf[ks] = *(const bf16x8*)(proj + rowq * NP + C_AQ + h * 128 + 16 * ks + 8 * hb);
    f32x16 o[4];
#pragma unroll
    for (int dt = 0; dt < 4; ++dt)
#pragma unroll
        for (int r = 0; r < 16; ++r) o[dt][r] = 0.f;
    float m_run = -1e30f, l_run = 0.f;
    const int t0 = j0 > 8 ? j0 - 8 : 0, nt = j0 + 3 - t0 + 1;
    const int srow = tid >> 4, sc16 = tid & 15;
    const bf16* gsrc = proj + ((size_t)b * S + srow) * NP + h * 128 + sc16 * 8;
    v4u kr0, kr1, vr0, vr1;
#define AT_GLOAD(tc) do { const bf16* g_ = gsrc + (size_t)(64 * (tc)) * NP; kr0 = *(const v4u*)(g_ + C_AK); vr0 = *(const v4u*)(g_ + C_AV); kr1 = *(const v4u*)(g_ + (size_t)32 * NP + C_AK); vr1 = *(const v4u*)(g_ + (size_t)32 * NP + C_AV); } while (0)
#define AT_LWRITE(buf) do { LAS unsigned char* k_ = lds + (buf) * AT_KBUF + srow * AT_KP + sc16 * 16; LAS unsigned char* v_ = lds + AT_VOFF + (buf) * AT_VBUF + srow * AT_VP + sc16 * 16; \
        *(LAS v4u*)k_ = kr0; *(LAS v4u*)(k_ + 32 * AT_KP) = kr1; *(LAS v4u*)v_ = vr0; *(LAS v4u*)(v_ + 32 * AT_VP) = vr1; } while (0)
    AT_GLOAD(t0); AT_LWRITE(0);
    __syncthreads();
    const float SC = 0.08838834764831845f * LOG2E;
    for (int i = 0; i < nt; ++i) {
        const int tc = t0 + i, buf = i & 1;
        if (i + 1 < nt) AT_GLOAD(tc + 1);
        const int cdiff = jq - tc;
        if (cdiff >= 0 && cdiff <= 8) {
            const LAS unsigned char* Kb = lds + buf * AT_KBUF + r32 * AT_KP + hb * 16;
            f32x16 s0, s1;
#pragma unroll
            for (int r = 0; r < 16; ++r) { s0[r] = 0.f; s1[r] = 0.f; }
#pragma unroll
            for (int ks = 0; ks < 8; ++ks) {
                const bf16x8 k0 = *(const LAS bf16x8*)(Kb + ks * 32), k1 = *(const LAS bf16x8*)(Kb + 32 * AT_KP + ks * 32);
                s0 = __builtin_amdgcn_mfma_f32_32x32x16_bf16(k0, qf[ks], s0, 0, 0, 0);
                s1 = __builtin_amdgcn_mfma_f32_32x32x16_bf16(k1, qf[ks], s1, 0, 0, 0);
            }
            if (cdiff >= 3) { const float bc = biasL[191];
#pragma unroll
                for (int r = 0; r < 16; ++r) { s0[r] = s0[r] * SC + bc; s1[r] = s1[r] * SC + bc; }
            } else { const int base = 64 * cdiff + 32 * half + r32 + 63 - 4 * hb;
#pragma unroll
                for (int r = 0; r < 16; ++r) { const int i0 = base - ((r & 3) + 8 * (r >> 2)), i1 = i0 - 32;
                    s0[r] = s0[r] * SC + biasL[i0 > 191 ? 191 : i0]; s1[r] = s1[r] * SC + biasL[i1 > 191 ? 191 : i1]; }
            }
            float mx = fmaxf(s0[0], s1[0]);
#pragma unroll
            for (int r = 1; r < 16; ++r) mx = fmaxf(mx, fmaxf(s0[r], s1[r]));
            mx = fmaxf(mx, __shfl_xor(mx, 32));
            const float m_new = fmaxf(m_run, mx), alpha = __builtin_amdgcn_exp2f(m_run - m_new); m_run = m_new;
            float ls = 0.f;
#pragma unroll
            for (int r = 0; r < 16; ++r) { s0[r] = __builtin_amdgcn_exp2f(s0[r] - m_new); s1[r] = __builtin_amdgcn_exp2f(s1[r] - m_new); ls += s0[r] + s1[r]; }
            l_run = l_run * alpha + ls;
#pragma unroll
            for (int dt = 0; dt < 4; ++dt)
#pragma unroll
                for (int r = 0; r < 16; ++r) o[dt][r] *= alpha;
            v4u pw[4];
            pw[0] = (v4u){cvtpk(s0[0], s0[1]), cvtpk(s0[2], s0[3]), cvtpk(s0[4], s0[5]), cvtpk(s0[6], s0[7])};
            pw[1] = (v4u){cvtpk(s0[8], s0[9]), cvtpk(s0[10], s0[11]), cvtpk(s0[12], s0[13]), cvtpk(s0[14], s0[15])};
            pw[2] = (v4u){cvtpk(s1[0], s1[1]), cvtpk(s1[2], s1[3]), cvtpk(s1[4], s1[5]), cvtpk(s1[6], s1[7])};
            pw[3] = (v4u){cvtpk(s1[8], s1[9]), cvtpk(s1[10], s1[11]), cvtpk(s1[12], s1[13]), cvtpk(s1[14], s1[15])};
            const LAS unsigned char* Vb = lds + AT_VOFF + buf * AT_VBUF + (4 * hb + ((lane & 15) >> 2)) * AT_VP + (16 * ((lane >> 4) & 1) + 4 * (lane & 3)) * 2;
#pragma unroll
            for (int q = 0; q < 4; ++q) {
#pragma unroll
                for (int dt = 0; dt < 4; ++dt) {
                    const s16x4 lo = tr_read(Vb + (16 * q) * AT_VP + dt * 64), hi = tr_read(Vb + (16 * q + 8) * AT_VP + dt * 64);
                    const bf16x8 vf = (bf16x8){lo[0], lo[1], lo[2], lo[3], hi[0], hi[1], hi[2], hi[3]};
                    o[dt] = __builtin_amdgcn_mfma_f32_32x32x16_bf16(vf, __builtin_bit_cast(bf16x8, pw[q]), o[dt], 0, 0, 0);
                }
            }
        }
        if (i + 1 < nt) AT_LWRITE(buf ^ 1);
        __syncthreads();
    }
#undef AT_GLOAD
#undef AT_LWRITE
    const float linv = 1.f / (l_run + __shfl_xor(l_run, 32));
#pragma unroll
    for (int dt = 0; dt < 4; ++dt)
#pragma unroll
        for (int rq = 0; rq < 4; ++rq) {
            const int d0 = 32 * dt + 8 * rq + 4 * hb;
            const uint2 zz = *(const uint2*)(proj + rowq * NP + C_AZ + h * 128 + d0);
            const float z0 = __builtin_bit_cast(float, zz.x << 16), z1 = __builtin_bit_cast(float, zz.x & 0xffff0000u), z2 = __builtin_bit_cast(float, zz.y << 16), z3 = __builtin_bit_cast(float, zz.y & 0xffff0000u);
            uint2 w; w.x = cvtpk(o[dt][4 * rq + 0] * linv * siluf_(z0), o[dt][4 * rq + 1] * linv * siluf_(z1)); w.y = cvtpk(o[dt][4 * rq + 2] * linv * siluf_(z2), o[dt][4 * rq + 3] * linv * siluf_(z3));
            *(uint2*)(ya + rowq * 1024 + h * 128 + d0) = w;
        }
}

__global__ void __launch_bounds__(NWAVES * 64, 2) mega(MArgs a) {
    extern __shared__ __attribute__((aligned(16))) unsigned char lds_raw[];
    LAS unsigned char* lds = (LAS unsigned char*)lds_raw;
    cg::grid_group grid = cg::this_grid();
    const int tid = threadIdx.x, lane = tid & 63, wave = __builtin_amdgcn_readfirstlane(tid >> 6);
    const int G = gridDim.x, gw = blockIdx.x * NWAVES + wave, NGW = G * NWAVES;
    const float* x = a.in[0]; const float* cvec = a.in[1]; const float* w_ada = a.in[2]; const float* b_ada = a.in[3]; const float* norm_g = a.in[4]; const float* w_in = a.in[5];
    const float* b_if = a.in[6]; const float* final_g = a.in[14]; const float* w_proj_m = a.in[11]; const float* w_proj_a = a.in[12]; const float* w_out = a.in[13];
    unsigned char* ws = a.ws; unsigned char* ob = (unsigned char*)a.out;
    bf16* proj = (bf16*)(ws + WS_PROJ); bf16* Wpm_t = (bf16*)(ws + WS_WPM); bf16* Wpa_t = (bf16*)(ws + WS_WPA); bf16* Wout_t = (bf16*)(ws + WS_WOUT);
    float* modp = (float*)(ws + WS_MODP); float* mod = (float*)(ws + WS_MOD); float* gates = (float*)(ws + WS_GATES); float* rowss = (float*)(ws + WS_ROWSS);
    bf16* ym = (bf16*)(ws + WS_YM); bf16* ya = (bf16*)(ws + WS_YA); bf16* merged = proj;
    bf16* H = (bf16*)(ob + OB_H); bf16* Win_t = (bf16*)(ob + OB_WIN);
    const int lo = a.ph_lo, hi = a.ph_hi;
#define IN(k) (lo <= (k) && (k) < hi)
#define BOTH(k) (IN(k) && IN((k) + 1))

    if (IN(0)) {
        LAS float* scr = (LAS float*)(lds + wave * 16384);
        constexpr int I_ADA = 16 * 24, I_IN = (D / 64) * (NP / 32), I_PM = (1024 / 64) * (D / 32), I_OUT = (D / 64) * (D / 32);
        constexpr int NITEMS = I_ADA + I_IN + 2 * I_PM + I_OUT;
        for (int it = gw; it < NITEMS; it += NGW) {
            int r = it;
            if (r < I_ADA) {
                const int ks = r / 24, cb = r % 24, n0 = cb * 256 + lane * 4;
                float4 a0 = {0.f, 0.f, 0.f, 0.f}, a1 = {0.f, 0.f, 0.f, 0.f};
                if (ks == 0) { a0 = *(const float4*)(b_ada + n0); a1 = a0; }
#pragma unroll 8
                for (int kk = 0; kk < 128; ++kk) { const int k = ks * 128 + kk; const float4 w = *(const float4*)(w_ada + (size_t)k * (3 * D) + n0);
                    const float c0 = cvec[k], c1 = cvec[D + k]; const float s0 = c0 / (1.f + __expf(-c0)), s1 = c1 / (1.f + __expf(-c1));
                    a0.x += s0 * w.x; a0.y += s0 * w.y; a0.z += s0 * w.z; a0.w += s0 * w.w; a1.x += s1 * w.x; a1.y += s1 * w.y; a1.z += s1 * w.z; a1.w += s1 * w.w; }
                *(float4*)(modp + (size_t)(ks * 2 + 0) * (3 * D) + n0) = a0; *(float4*)(modp + (size_t)(ks * 2 + 1) * (3 * D) + n0) = a1;
                continue; }
            r -= I_ADA;
            if (r < I_IN) { const int nblk = NP / 32, kb = r / nblk, nb = r % nblk, nd = 32 * nb; transpose_item(w_in, INC, nd + (nd >= 5120 ? 8 : 0), Win_t, D, nd, 64 * kb, scr, lane); continue; }
            r -= I_IN;
            if (r < I_PM) { const int nblk = D / 32, kb = r / nblk, nb = r % nblk; transpose_item(w_proj_m, D, 32 * nb, Wpm_t, 1024, 32 * nb, 64 * kb, scr, lane); continue; }
            r -= I_PM;
            if (r < I_PM) { const int nblk = D / 32, kb = r / nblk, nb = r % nblk; transpose_item(w_proj_a, D, 32 * nb, Wpa_t, 1024, 32 * nb, 64 * kb, scr, lane); continue; }
            r -= I_PM;
            { const int nblk = D / 32, kb = r / nblk, nb = r % nblk; transpose_item(w_out, D, 32 * nb, Wout_t, D, 32 * nb, 64 * kb, scr, lane); }
        }
        if (BOTH(0)) grid.sync();
    }

    if (IN(1)) {
        LAS float* smod = (LAS float*)lds;
        LAS float* gwl = (LAS float*)(lds + 49152);
        for (int i = tid; i < 2 * 3 * D; i += NWAVES * 64) { float s = 0.f;
#pragma unroll
            for (int ks = 0; ks < 16; ++ks) s += modp[(size_t)ks * (2 * 3 * D) + i];
            smod[i] = s; if (blockIdx.x == 0) mod[i] = s; }
        for (int k = tid; k < D; k += NWAVES * 64) { const float4 w0 = *(const float4*)(w_in + (size_t)k * INC + 5120), w1 = *(const float4*)(w_in + (size_t)k * INC + 5124);
            gwl[0 * D + k] = w0.x; gwl[1 * D + k] = w0.y; gwl[2 * D + k] = w0.z; gwl[3 * D + k] = w0.w; gwl[4 * D + k] = w1.x; gwl[5 * D + k] = w1.y; gwl[6 * D + k] = w1.z; gwl[7 * D + k] = w1.w; }
        __syncthreads();
        for (int row = gw; row < M; row += NGW) {
            const int b = row / S;
            const float4* xr = (const float4*)(x + (size_t)row * D);
            float4 v[8]; float ss = 0.f;
#pragma unroll
            for (int j = 0; j < 8; ++j) { v[j] = xr[lane + 64 * j]; ss += v[j].x * v[j].x + v[j].y * v[j].y + v[j].z * v[j].z + v[j].w * v[j].w; }
            ss = wave_sum(ss);
            const float rstd = 1.0f / sqrtf(ss * (1.f / D) + EPS);
            float acc[8];
#pragma unroll
            for (int i = 0; i < 8; ++i) acc[i] = 0.f;
            const LAS float* shift = smod + b * 3 * D; const LAS float* scale = shift + D;
#pragma unroll
            for (int j = 0; j < 8; ++j) {
                const int k0 = (lane + 64 * j) * 4;
                const f4 g4 = *(const f4*)(norm_g + k0); const f4 sc4 = *(const LAS f4*)(scale + k0); const f4 sh4 = *(const LAS f4*)(shift + k0);
                float4 h4; h4.x = v[j].x * rstd * g4.x * (1.f + sc4.x) + sh4.x; h4.y = v[j].y * rstd * g4.y * (1.f + sc4.y) + sh4.y; h4.z = v[j].z * rstd * g4.z * (1.f + sc4.z) + sh4.z; h4.w = v[j].w * rstd * g4.w * (1.f + sc4.w) + sh4.w;
#pragma unroll
                for (int i = 0; i < 8; ++i) { const f4 w4 = *(const LAS f4*)(gwl + i * D + k0); acc[i] += h4.x * w4.x + h4.y * w4.y + h4.z * w4.z + h4.w * w4.w; }
                uint2 o; o.x = pk2(h4.x, h4.y); o.y = pk2(h4.z, h4.w);
                *(uint2*)(H + (size_t)row * D + k0) = o;
                asm volatile("" ::: "memory");
            }
#pragma unroll
            for (int i = 0; i < 8; ++i) acc[i] = wave_sum(acc[i]);
            if (lane == 0) {
                rowss[row] = 0.f;
#pragma unroll
                for (int i = 0; i < 4; ++i) gates[(size_t)row * 8 + i] = acc[i] + b_if[i];
#pragma unroll
                for (int i = 4; i < 8; ++i) { const float z = acc[i] + b_if[i]; gates[(size_t)row * 8 + i] = fminf(z, 0.f) - log1pf(expf(-fabsf(z))); }
            }
        }
        __syncthreads();
        if (BOTH(1)) grid.sync();
    }

    if (IN(2)) {
        pg8::Gemm g{H, H, Win_t, Win_t, D, D}; pg8::StaticOrder So; So.init(M, NP, G, (int)blockIdx.x);
        pg8::EpiProj E{proj, NP};
        pg8::gemm_phase<pg8::EpiProj, pg8::StaticOrder, true, true>(lds, g, So, E);
        if (BOTH(2)) grid.sync();
    }
    if (IN(3)) {
        for (int u = blockIdx.x; u < 512; u += G) attn_unit(lds, proj, a.in[10], ya, u >> 8, (u >> 5) & 7, u & 31, tid, lane, wave);
        if (BOTH(3)) grid.sync();
    }
    if (IN(4)) {
        pg8::Gemm g{ym, ya, Wpm_t, Wpa_t, 1024, 1024}; pg8::SegOrder So; So.base.init(M, D, G, (int)blockIdx.x);
        pg8::EpiMerge E{proj, NP, C_GM, C_GA, merged, NP};
        pg8::gemm_phase<pg8::EpiMerge, pg8::SegOrder, true, true>(lds, g, So, E);
        if (BOTH(4)) grid.sync();
    }
    if (IN(5)) {
        pg8::Gemm g{merged, merged, Wout_t, Wout_t, NP, D}; pg8::StaticOrder So; So.init(M, D, G, (int)blockIdx.x);
        pg8::EpiOut E{x, mod + 2 * D, a.out, rowss, D, S, 3 * D};
        pg8::gemm_phase<pg8::EpiOut, pg8::StaticOrder, true, true>(lds, g, So, E);
        if (BOTH(5)) grid.sync();
    }
    if (IN(6)) {
        for (int row = gw; row < M; row += NGW) {
            const float r = 1.0f / sqrtf(rowss[row] * (1.f / D) + EPS);
            f4* xr = (f4*)(a.out + (size_t)row * D);
#pragma unroll
            for (int j = 0; j < 8; ++j) { const f4 g4 = *(const f4*)(final_g + (lane + 64 * j) * 4); xr[lane + 64 * j] = xr[lane + 64 * j] * r * g4; }
        }
    }
#undef IN
#undef BOTH
}

static int launch_mega(const MArgs& a, hipStream_t stream) {
    static int grid = 0;
    if (grid == 0) {
        int dev = 0, cus = 0, per_cu = 0;
        if (hipGetDevice(&dev) != hipSuccess || hipDeviceGetAttribute(&cus, hipDeviceAttributeMultiprocessorCount, dev) != hipSuccess) { fprintf(stderr, "kernel_launch: device query failed\n"); grid = -1; return -1; }
        if (hipFuncSetAttribute((const void*)mega, hipFuncAttributeMaxDynamicSharedMemorySize, LDS_BYTES) != hipSuccess) { fprintf(stderr, "kernel_launch: hipFuncSetAttribute failed\n"); grid = -1; return -1; }
        if (hipOccupancyMaxActiveBlocksPerMultiprocessor(&per_cu, (const void*)mega, NWAVES * 64, LDS_BYTES) != hipSuccess || per_cu < 1) { fprintf(stderr, "kernel_launch: occupancy query says %d blocks/CU\n", per_cu); (void)hipGetLastError(); grid = -1; return -1; }
        grid = cus * (per_cu > 1 ? 1 : per_cu);
        fprintf(stderr, "kernel_launch: %d CUs, occupancy %d blocks/CU, grid %d\n", cus, per_cu, grid);
    }
    if (grid < 0) return -1;
    MArgs arg = a; void* args[] = {(void*)&arg};
    const hipError_t e = hipLaunchCooperativeKernel((const void*)mega, dim3(grid), dim3(NWAVES * 64), args, LDS_BYTES, stream);
    if (e != hipSuccess) { fprintf(stderr, "kernel_launch: cooperative launch failed: %s (grid %d)\n", hipGetErrorString(e), grid); return -1; }
    return 0;
}

extern "C" void kernel_launch(void* const* d_in, const int* in_sizes, int n_in, void* d_out, int out_size, void* d_ws, size_t ws_size, hipStream_t stream) {
    if (n_in != 15 || in_sizes[0] != M * D || out_size != M * D || ws_size < WS_END) { fprintf(stderr, "kernel_launch: unexpected shapes / workspace (%zu < %zu)\n", ws_size, (size_t)WS_END); return; }
    const float* x = (const float*)d_in[0];
    const float* conv_w = (const float*)d_in[7]; const float* conv_b = (const float*)d_in[8]; const float* mh_norm_g = (const float*)d_in[9]; const float* rel_bias = (const float*)d_in[10];
    const float* w_proj_m = (const float*)d_in[11]; const float* w_proj_a = (const float*)d_in[12]; const float* w_out = (const float*)d_in[13]; const float* final_g = (const float*)d_in[14];
    unsigned char* ws = (unsigned char*)d_ws;
    bf16* proj = (bf16*)(ws + WS_PROJ); bf16* ym = (bf16*)(ws + WS_YM); bf16* ya = (bf16*)(ws + WS_YA); float* mod = (float*)(ws + WS_MOD); float* gates = (float*)(ws + WS_GATES);
    unsigned char* ob = (unsigned char*)d_out;
    bf16* qc = (bf16*)ob; bf16* kc = (bf16*)(ob + 32 * MiB); float* hbuf = (float*)(ob + 64 * MiB);
    bf16* merged = proj;

    MArgs a{}; for (int i = 0; i < 15; ++i) a.in[i] = (const float*)d_in[i]; a.out = (float*)d_out; a.ws = ws; a.ph_lo = 0; a.ph_hi = 3;
    if (launch_mega(a, stream) != 0) return;
    k_conv<<<(unsigned)((size_t)M * 2048 / 256), 256, 0, stream>>>(proj, conv_w, conv_b, qc, kc);
    k_mlstm<<<NB * 4 * 256 / 4, 256, 0, stream>>>(qc, kc, proj, gates, hbuf);
    k_mpost<<<M * 4 / 4, 256, 0, stream>>>(hbuf, proj, mh_norm_g, ym);
    a.ph_lo = 3; a.ph_hi = 7;
    if (launch_mega(a, stream) != 0) return;
}
```

```cpp
#include <hip/hip_runtime.h>
#include <cstdio>
#include <cstdint>
#include <hip/hip_cooperative_groups.h>
namespace cg = cooperative_groups;

typedef unsigned short bf16;
constexpr int D = 2048, NB = 2, S = 8192, M = NB * S;
constexpr int INC = 13320, NP = 13312;
constexpr int C_MQ = 0, C_MK = 1024, C_MV = 2048, C_MO = 3072, C_MZ = 4096, C_AQ = 5120, C_AK = 6144, C_AV = 7168, C_AZ = 8192, C_GM = 9216, C_GA = 11264;
constexpr float EPS = 1e-6f;

__device__ __forceinline__ bf16 f2bf(float f) { unsigned u = __builtin_bit_cast(unsigned, f); return (bf16)((u + 0x7fffu + ((u >> 16) & 1u)) >> 16); }
__device__ __forceinline__ float bf2f(bf16 h) { return __builtin_bit_cast(float, (unsigned)h << 16); }
__device__ __forceinline__ float wave_sum(float v) {
#pragma unroll
    for (int o = 1; o < 64; o <<= 1) v += __shfl_xor(v, o);
    return v;
}
__device__ __forceinline__ float wave_max(float v) {
#pragma unroll
    for (int o = 1; o < 64; o <<= 1) v = fmaxf(v, __shfl_xor(v, o));
    return v;
}
__device__ __forceinline__ float sigmoidf_(float x) { return 1.f / (1.f + __expf(-x)); }
__device__ __forceinline__ float siluf_(float x) { return x / (1.f + __expf(-x)); }

__global__ void __launch_bounds__(256) k_ada(const float* __restrict__ c, const float* __restrict__ w_ada, const float* __restrict__ b_ada, float* __restrict__ mod) {
    __shared__ float sc[2][D];
    for (int i = threadIdx.x; i < 2 * D; i += 256) { float v = c[i]; sc[i / D][i % D] = v / (1.f + expf(-v)); }
    __syncthreads();
    const int n = blockIdx.x * 256 + threadIdx.x;
    float a0 = 0.f, a1 = 0.f;
    for (int k = 0; k < D; ++k) { const float w = w_ada[(size_t)k * (3 * D) + n]; a0 += sc[0][k] * w; a1 += sc[1][k] * w; }
    mod[n] = a0 + b_ada[n]; mod[3 * D + n] = a1 + b_ada[n];
}

__global__ void __launch_bounds__(256) k_norm(const float* __restrict__ x, const float* __restrict__ norm_g, const float* __restrict__ mod, const float* __restrict__ w_in,
                                              const float* __restrict__ b_if, bf16* __restrict__ H, float* __restrict__ gates) {
    const int row = blockIdx.x * 4 + (threadIdx.x >> 6), lane = threadIdx.x & 63, b = row / S;
    const float4* xr = (const float4*)(x + (size_t)row * D);
    float4 v[8]; float ss = 0.f;
#pragma unroll
    for (int j = 0; j < 8; ++j) { v[j] = xr[lane + 64 * j]; ss += v[j].x * v[j].x + v[j].y * v[j].y + v[j].z * v[j].z + v[j].w * v[j].w; }
    ss = wave_sum(ss);
    const float rstd = 1.0f / sqrtf(ss * (1.f / D) + EPS);
    float acc[8];
#pragma unroll
    for (int i = 0; i < 8; ++i) acc[i] = 0.f;
    const float* shift = mod + b * 3 * D; const float* scale = shift + D;
#pragma unroll
    for (int j = 0; j < 8; ++j) {
        const int k0 = (lane + 64 * j) * 4;
        const float xv[4] = {v[j].x, v[j].y, v[j].z, v[j].w};
        float hv[4];
#pragma unroll
        for (int e = 0; e < 4; ++e) {
            const int k = k0 + e;
            hv[e] = xv[e] * rstd * norm_g[k] * (1.f + scale[k]) + shift[k];
            const float4* wr = (const float4*)(w_in + (size_t)k * INC + 5120);
            const float4 w0 = wr[0], w1 = wr[1];
            acc[0] += hv[e] * w0.x; acc[1] += hv[e] * w0.y; acc[2] += hv[e] * w0.z; acc[3] += hv[e] * w0.w;
            acc[4] += hv[e] * w1.x; acc[5] += hv[e] * w1.y; acc[6] += hv[e] * w1.z; acc[7] += hv[e] * w1.w;
        }
        ushort4 o; o.x = f2bf(hv[0]); o.y = f2bf(hv[1]); o.z = f2bf(hv[2]); o.w = f2bf(hv[3]);
        *(ushort4*)(H + (size_t)row * D + k0) = o;
    }
#pragma unroll
    for (int i = 0; i < 8; ++i) acc[i] = wave_sum(acc[i]);
    if (lane == 0) {
#pragma unroll
        for (int i = 0; i < 4; ++i) gates[(size_t)row * 8 + i] = acc[i] + b_if[i];
#pragma unroll
        for (int i = 4; i < 8; ++i) { const float z = acc[i] + b_if[i]; gates[(size_t)row * 8 + i] = fminf(z, 0.f) - log1pf(expf(-fabsf(z))); }
    }
}

struct GemmArgs { const bf16* A; const bf16* A2; const float* B; const float* B2; int lda, ldb, K; bf16* Ob; int ldo; float* Of; const bf16* proj; const float* x; const float* mod; };
template <int MODE> __global__ void __launch_bounds__(256) k_gemm(GemmArgs g) {
    __shared__ float As[16][68]; __shared__ float Bs[16][68];
    const int tid = threadIdx.x, tx = tid & 15, ty = tid >> 4;
    const int m0 = blockIdx.y * 64, n0 = blockIdx.x * 64;
    float acc[4][4], acc2[4][4];
#pragma unroll
    for (int i = 0; i < 4; ++i)
#pragma unroll
        for (int j = 0; j < 4; ++j) { acc[i][j] = 0.f; acc2[i][j] = 0.f; }
    const int nseg = (MODE == 1) ? 2 : 1;
    for (int seg = 0; seg < nseg; ++seg) {
        const bf16* A = seg ? g.A2 : g.A; const float* Bm = seg ? g.B2 : g.B;
        const int ncol = (MODE == 0) ? (n0 + (n0 >= 5120 ? 8 : 0)) : n0;
        for (int k0 = 0; k0 < g.K; k0 += 16) {
            { const int r = tid >> 2, kq = (tid & 3) * 4; const ushort4 a = *(const ushort4*)(A + (size_t)(m0 + r) * g.lda + k0 + kq);
              As[kq + 0][r] = bf2f(a.x); As[kq + 1][r] = bf2f(a.y); As[kq + 2][r] = bf2f(a.z); As[kq + 3][r] = bf2f(a.w); }
            { const int k = tid >> 4, n4 = (tid & 15) * 4; const float4 bv = *(const float4*)(Bm + (size_t)(k0 + k) * g.ldb + ncol + n4);
              Bs[k][n4 + 0] = bv.x; Bs[k][n4 + 1] = bv.y; Bs[k][n4 + 2] = bv.z; Bs[k][n4 + 3] = bv.w; }
            __syncthreads();
#pragma unroll
            for (int k = 0; k < 16; ++k) {
                const float4 a = *(const float4*)&As[k][ty * 4]; const float4 bq = *(const float4*)&Bs[k][tx * 4];
                const float av[4] = {a.x, a.y, a.z, a.w}, bv[4] = {bq.x, bq.y, bq.z, bq.w};
                if (seg == 0) {
#pragma unroll
                    for (int i = 0; i < 4; ++i)
#pragma unroll
                        for (int j = 0; j < 4; ++j) acc[i][j] += av[i] * bv[j];
                } else {
#pragma unroll
                    for (int i = 0; i < 4; ++i)
#pragma unroll
                        for (int j = 0; j < 4; ++j) acc2[i][j] += av[i] * bv[j];
                }
            }
            __syncthreads();
        }
    }
#pragma unroll
    for (int i = 0; i < 4; ++i) {
        const int row = m0 + ty * 4 + i;
#pragma unroll
        for (int j = 0; j < 4; ++j) {
            const int col = n0 + tx * 4 + j;
            if (MODE == 0) g.Ob[(size_t)row * g.ldo + col] = f2bf(acc[i][j]);
            else if (MODE == 1) {
                const float gm = bf2f(g.proj[(size_t)row * NP + C_GM + col]), ga = bf2f(g.proj[(size_t)row * NP + C_GA + col]);
                g.Ob[(size_t)row * g.ldo + col] = f2bf(sigmoidf_(gm) * acc[i][j] + sigmoidf_(ga) * acc2[i][j]);
            } else {
                const int b = row / S;
                g.Of[(size_t)row * D + col] = g.x[(size_t)row * D + col] + g.mod[b * 3 * D + 2 * D + col] * acc[i][j];
            }
        }
    }
}

__global__ void __launch_bounds__(256) k_conv(const bf16* __restrict__ proj, const float* __restrict__ conv_w, const float* __restrict__ conv_b, bf16* __restrict__ qc, bf16* __restrict__ kc) {
    const size_t idx = (size_t)blockIdx.x * 256 + threadIdx.x;
    const int c = (int)(idx % 2048); const int row = (int)(idx / 2048); const int t = row % S;
    float o = conv_b[c];
#pragma unroll
    for (int tap = 0; tap < 4; ++tap) { const int tt = t - 3 + tap; if (tt >= 0) o += bf2f(proj[(size_t)(row - 3 + tap) * NP + c]) * conv_w[tap * 2048 + c]; }
    o = siluf_(o);
    if (c < 1024) qc[(size_t)row * 1024 + c] = f2bf(o); else kc[(size_t)row * 1024 + c - 1024] = f2bf(o * 0.0625f);
}

__global__ void __launch_bounds__(256) k_mlstm(const bf16* __restrict__ qc, const bf16* __restrict__ kc, const bf16* __restrict__ proj, const float* __restrict__ gates, float* __restrict__ hbuf) {
    const int w = blockIdx.x * 4 + (threadIdx.x >> 6), lane = threadIdx.x & 63;
    const int v = w & 255, h = (w >> 8) & 3, b = w >> 10;
    float C[4] = {0.f, 0.f, 0.f, 0.f}, n[4] = {0.f, 0.f, 0.f, 0.f};
    for (int t = 0; t < S; ++t) {
        const size_t row = (size_t)b * S + t;
        const ushort4 q4 = *(const ushort4*)(qc + row * 1024 + h * 256 + lane * 4);
        const ushort4 k4 = *(const ushort4*)(kc + row * 1024 + h * 256 + lane * 4);
        const float vv = bf2f(proj[row * NP + C_MV + h * 256 + v]);
        const float ig = gates[row * 8 + h], lf = gates[row * 8 + 4 + h];
        const float f = expf(lf), iv = expf(ig);
        const float kf[4] = {bf2f(k4.x), bf2f(k4.y), bf2f(k4.z), bf2f(k4.w)}, qf[4] = {bf2f(q4.x), bf2f(q4.y), bf2f(q4.z), bf2f(q4.w)};
        float num = 0.f, den = 0.f;
#pragma unroll
        for (int e = 0; e < 4; ++e) { n[e] = f * n[e] + iv * kf[e]; C[e] = f * C[e] + (iv * vv) * kf[e]; num += C[e] * qf[e]; den += n[e] * qf[e]; }
        num = wave_sum(num); den = wave_sum(den);
        if (lane == 0) hbuf[row * 1024 + h * 256 + v] = num / fmaxf(fabsf(den), 1.f);
    }
}
__global__ void __launch_bounds__(256) k_mpost(const float* __restrict__ hbuf, const bf16* __restrict__ proj, const float* __restrict__ mh_norm_g, bf16* __restrict__ ym) {
    const int w = blockIdx.x * 4 + (threadIdx.x >> 6), lane = threadIdx.x & 63;
    const int h = w & 3; const size_t row = w >> 2;
    const float4 hv = *(const float4*)(hbuf + row * 1024 + h * 256 + lane * 4);
    float ss = hv.x * hv.x + hv.y * hv.y + hv.z * hv.z + hv.w * hv.w;
    ss = wave_sum(ss);
    const float r = 1.0f / sqrtf(ss * (1.f / 256.f) + EPS);
    const float hh[4] = {hv.x, hv.y, hv.z, hv.w};
    ushort4 o; bf16 ov[4];
#pragma unroll
    for (int e = 0; e < 4; ++e) {
        const int c = h * 256 + lane * 4 + e;
        const float mo = bf2f(proj[row * NP + C_MO + c]), mz = bf2f(proj[row * NP + C_MZ + c]);
        ov[e] = f2bf(hh[e] * r * mh_norm_g[c] * sigmoidf_(mo) * siluf_(mz));
    }
    o.x = ov[0]; o.y = ov[1]; o.z = ov[2]; o.w = ov[3];
    *(ushort4*)(ym + row * 1024 + h * 256 + lane * 4) = o;
}

__global__ void __launch_bounds__(256) k_attn(const bf16* __restrict__ proj, const float* __restrict__ rel_bias, bf16* __restrict__ ya) {
    __shared__ float sq[4][128];
    const int wid = threadIdx.x >> 6, lane = threadIdx.x & 63;
    const int w = blockIdx.x * 4 + wid; const int hh = w & 7; const int row = w >> 3; const int b = row / S, t = row % S, j = t >> 6;
    { const unsigned qq = *(const unsigned*)(proj + (size_t)row * NP + C_AQ + hh * 128 + 2 * lane);
      sq[wid][2 * lane] = bf2f((bf16)(qq & 0xffff)) * 0.08838834764831845f; sq[wid][2 * lane + 1] = bf2f((bf16)(qq >> 16)) * 0.08838834764831845f; }
    __syncthreads();
    const int jlo = j > 8 ? j - 8 : 0; const int kstart = jlo * 64; const int nt = j - jlo + 1;
    float sc[9];
#pragma unroll
    for (int i = 0; i < 9; ++i) {
        sc[i] = -INFINITY;
        if (i < nt) {
            const int kpos = kstart + i * 64 + lane; const bf16* kr = proj + (size_t)(b * S + kpos) * NP + C_AK + hh * 128;
            float s = 0.f;
#pragma unroll
            for (int d8 = 0; d8 < 16; ++d8) { const uint4 kk = *(const uint4*)(kr + d8 * 8); const unsigned kw[4] = {kk.x, kk.y, kk.z, kk.w};
#pragma unroll
                for (int e = 0; e < 4; ++e) { s += sq[wid][d8 * 8 + 2 * e] * bf2f((bf16)(kw[e] & 0xffff)) + sq[wid][d8 * 8 + 2 * e + 1] * bf2f((bf16)(kw[e] >> 16)); } }
            int dist = t - kpos; dist = dist < -63 ? -63 : (dist > 128 ? 128 : dist);
            sc[i] = s + rel_bias[hh * 192 + dist + 63];
        }
    }
    float mx = sc[0];
#pragma unroll
    for (int i = 1; i < 9; ++i) mx = fmaxf(mx, sc[i]);
    mx = wave_max(mx);
    float l = 0.f;
#pragma unroll
    for (int i = 0; i < 9; ++i) { sc[i] = (i < nt) ? __expf(sc[i] - mx) : 0.f; l += sc[i]; }
    l = wave_sum(l);
    float o0 = 0.f, o1 = 0.f;
#pragma unroll
    for (int i = 0; i < 9; ++i) {
        if (i < nt) {
            const bf16* vr = proj + (size_t)(b * S + kstart + i * 64) * NP + C_AV + hh * 128 + 2 * lane;
            for (int kk = 0; kk < 64; ++kk) { const float p = __shfl(sc[i], kk); const unsigned vv = *(const unsigned*)(vr + (size_t)kk * NP);
                o0 += p * bf2f((bf16)(vv & 0xffff)); o1 += p * bf2f((bf16)(vv >> 16)); }
        }
    }
    const float inv = 1.f / l;
    const unsigned zz = *(const unsigned*)(proj + (size_t)row * NP + C_AZ + hh * 128 + 2 * lane);
    const float z0 = bf2f((bf16)(zz & 0xffff)), z1 = bf2f((bf16)(zz >> 16));
    const unsigned r = (unsigned)f2bf(o0 * inv * siluf_(z0)) | ((unsigned)f2bf(o1 * inv * siluf_(z1)) << 16);
    *(unsigned*)(ya + (size_t)row * 1024 + hh * 128 + 2 * lane) = r;
}

__global__ void __launch_bounds__(256) k_final(float* __restrict__ out, const float* __restrict__ g) {
    const int row = blockIdx.x * 4 + (threadIdx.x >> 6), lane = threadIdx.x & 63;
    float4* xr = (float4*)(out + (size_t)row * D);
    float4 v[8]; float ss = 0.f;
#pragma unroll
    for (int j = 0; j < 8; ++j) { v[j] = xr[lane + 64 * j]; ss += v[j].x * v[j].x + v[j].y * v[j].y + v[j].z * v[j].z + v[j].w * v[j].w; }
    ss = wave_sum(ss);
    const float r = 1.0f / sqrtf(ss * (1.f / D) + EPS);
#pragma unroll
    for (int j = 0; j < 8; ++j) { const float4 gg = ((const float4*)g)[lane + 64 * j]; float4 o; o.x = v[j].x * r * gg.x; o.y = v[j].y * r * gg.y; o.z = v[j].z * r * gg.z; o.w = v[j].w * r * gg.w; xr[lane + 64 * j] = o; }
}

namespace pg8 {
#define PG8_LAS __attribute__((address_space(3)))
typedef unsigned short bf16_t;
typedef short bf16x8 __attribute__((ext_vector_type(8)));
typedef float f32x4 __attribute__((ext_vector_type(4)));
typedef unsigned u32x4 __attribute__((ext_vector_type(4)));
constexpr int BM = 256, BK = 64, HALF = 128, HTB = HALF * BK * 2  , STAGE_BYTES = 8 * HTB, NXCD = 8, WGM = 8;

__host__ __device__ __forceinline__ int lds_byte(int r, int c) { const int st = (r >> 4) * 2 + (c >> 5), rr = r & 15, cc = c & 31, ob = rr * 64 + cc * 2; return st * 1024 + (ob ^ (((ob >> 9) & 1) << 5)); }
__host__ __device__ __forceinline__ void stage_rc(int b, int& R, int& C) { const int st = b / 1024, sb = b % 1024, swz = sb ^ (((sb >> 9) & 1) << 5); R = (st >> 1) * 16 + swz / 64; C = (st & 1) * 32 + (swz % 64) / 2; }
__host__ __device__ __forceinline__ int perm32(int rho) { const int n = rho >> 4, i = rho & 15; return 8 * (i >> 2) + 4 * n + (i & 3); }

struct Unit { int pm, pn, seg; };
struct Gemm { const bf16_t* A0; const bf16_t* A1; const bf16_t* B0; const bf16_t* B1; int lda, K; };

struct StaticOrder {
    int nM, nN, nwg, G, c;
    __host__ __device__ void init(int M, int N, int G_, int c_) { nM = M / BM; nN = N / BM; nwg = nM * nN; G = G_; c = c_; }
    __host__ __device__ bool next(int i, Unit& u) const {
        const long L = (long)i * G + c; if (L >= nwg) return false;
        int wgid = (int)L; { const int q = nwg / NXCD, r = nwg % NXCD, xcd = wgid % NXCD, off = wgid / NXCD; wgid = (xcd < r ? xcd * (q + 1) : r * (q + 1) + (xcd - r) * q) + off; }
        const int nig = WGM * nN, gid = wgid / nig, fm = gid * WGM, gsz = (nM - fm) < WGM ? (nM - fm) : WGM;
        u.pm = fm + ((wgid % nig) % gsz); u.pn = (wgid % nig) / gsz; u.seg = 0; return true;
    }
    __device__ __forceinline__ void a_ready(const Unit&) const {}
    __device__ __forceinline__ void done(const Unit&) const {}
};

__device__ __forceinline__ unsigned cvt_pk_bf16(float lo, float hi) { unsigned r; asm volatile("v_cvt_pk_bf16_f32 %0, %1, %2" : "=v"(r) : "v"(lo), "v"(hi)); return r; }
typedef float f32x2 __attribute__((ext_vector_type(2)));
template <class Epi, class Sched, bool ALIGN_EPI = false, bool SP2 = false>
__device__ __forceinline__ void gemm_phase(PG8_LAS unsigned char* lds, const Gemm g, const Sched& S, const Epi& E) {
    const int tid = threadIdx.x, wid = __builtin_amdgcn_readfirstlane(tid >> 6), lane = tid & 63, wr = wid >> 2, wc = wid & 3, fr = lane & 15, fq = lane >> 4;
    const int K = g.K, nt = K / BK;
    unsigned voffA[2], voffB[2];
#pragma unroll
    for (int i = 0; i < 2; ++i) { int R, C; stage_rc(tid * 16 + i * 8192, R, C); const int Rb = Epi::PERM ? ((R & ~31) + perm32(R & 31)) : R;
        voffA[i] = (unsigned)(R * g.lda + C) * 2u; voffB[i] = (unsigned)(Rb * K + C) * 2u; }
    const size_t kstep = (size_t)(BK * 2);
    const size_t hstepA = (size_t)HALF * g.lda * 2, hstepB = (size_t)HALF * K * 2;
    const size_t tstepA = 2 * hstepA, tstepB = 2 * hstepB;
    const unsigned ldsw = (unsigned)wid * 1024u;
    const int aoff = lds_byte(wr * 64 + fr, fq * 8), boff = lds_byte(wc * 32 + fr, fq * 8);
#define PG8_SA(b, h) (((b) * 2 + (h)) * HTB)
#define PG8_SB(b, h) ((4 + (b) * 2 + (h)) * HTB)
#define PG8_STAGE(bufoff, gbase, voff) do { _Pragma("unroll") for (int _i = 0; _i < 2; ++_i) \
        __builtin_amdgcn_global_load_lds((const unsigned*)((const char*)(gbase) + (voff)[_i]), (PG8_LAS unsigned*)(lds + (bufoff) + ldsw + _i * 8192), 16, 0, 0); } while (0)
#define PG8_LDA(dst, b, h) do { _Pragma("unroll") for (int m = 0; m < 4; ++m) _Pragma("unroll") for (int k = 0; k < 2; ++k) dst[m][k] = *(const PG8_LAS bf16x8*)(lds + PG8_SA(b, h) + aoff + m * 2048 + k * 1024); } while (0)
#define PG8_LDB(dst, b, h) do { _Pragma("unroll") for (int n = 0; n < 2; ++n) _Pragma("unroll") for (int k = 0; k < 2; ++k) dst[n][k] = *(const PG8_LAS bf16x8*)(lds + PG8_SB(b, h) + boff + n * 2048 + k * 1024); } while (0)
#define PG8_MMA(ai, bj, At, Bt) do { __builtin_amdgcn_s_setprio(1); _Pragma("unroll") for (int m = 0; m < 4; ++m) _Pragma("unroll") for (int n = 0; n < 2; ++n) _Pragma("unroll") for (int k = 0; k < 2; ++k) \
        acc[ai][bj][m][n] = __builtin_amdgcn_mfma_f32_16x16x32_bf16(Bt[n][k], At[m][k], acc[ai][bj][m][n], 0, 0, 0); __builtin_amdgcn_s_setprio(0); } while (0)
#define PG8_WAIT_V(n) asm volatile("s_waitcnt vmcnt(" #n ")" ::: "memory")
#define PG8_WAIT_L(n) asm volatile("s_waitcnt lgkmcnt(" #n ")" ::: "memory")
#define PG8_BAR __builtin_amdgcn_s_barrier()
#define PG8_SCHED __builtin_amdgcn_sched_barrier(0)
    Unit cur, nxt; int ui = 0;
    if (!S.next(0, cur)) return;
    f32x4 acc[2][2][4][2];
#pragma unroll
    for (int a = 0; a < 2; ++a)
#pragma unroll
        for (int b = 0; b < 2; ++b)
#pragma unroll
            for (int m = 0; m < 4; ++m)
#pragma unroll
                for (int n = 0; n < 2; ++n) acc[a][b][m][n] = (f32x4){0.f, 0.f, 0.f, 0.f};
    bf16x8 At[4][2], B0[2][2], B1[2][2];
    const char* cA = (const char*)(cur.seg ? g.A1 : g.A0) + (size_t)cur.pm * tstepA; const char* cB = (const char*)(cur.seg ? g.B1 : g.B0) + (size_t)cur.pn * tstepB;
    S.a_ready(cur);
    if constexpr (SP2) {
        PG8_STAGE(PG8_SB(0, 0), cB, voffB); PG8_STAGE(PG8_SB(0, 1), cB + hstepB, voffB); PG8_STAGE(PG8_SA(0, 0), cA, voffA); PG8_STAGE(PG8_SA(0, 1), cA + hstepA, voffA);
        if (wr == 1) PG8_BAR;
        PG8_WAIT_V(2); PG8_BAR;
        PG8_STAGE(PG8_SB(1, 0), cB + kstep, voffB); PG8_STAGE(PG8_SA(1, 0), cA + kstep, voffA); PG8_STAGE(PG8_SB(1, 1), cB + hstepB + kstep, voffB);
        PG8_WAIT_V(6); PG8_BAR;
    } else {
        PG8_STAGE(PG8_SB(0, 0), cB, voffB); PG8_STAGE(PG8_SA(0, 0), cA, voffA); PG8_STAGE(PG8_SB(0, 1), cB + hstepB, voffB); PG8_STAGE(PG8_SA(0, 1), cA + hstepA, voffA);
        if (wr == 1) PG8_BAR;
        PG8_WAIT_V(4); PG8_BAR;
        PG8_STAGE(PG8_SB(1, 0), cB + kstep, voffB); PG8_STAGE(PG8_SA(1, 0), cA + kstep, voffA); PG8_STAGE(PG8_SB(1, 1), cB + hstepB + kstep, voffB);
        PG8_WAIT_V(6); PG8_BAR;
    }
    for (;;) {
        const bool has_next = S.next(ui + 1, nxt);
        const char* nA = has_next ? (const char*)(nxt.seg ? g.A1 : g.A0) + (size_t)nxt.pm * tstepA : cA; const char* nB = has_next ? (const char*)(nxt.seg ? g.B1 : g.B0) + (size_t)nxt.pn * tstepB : cB;
        for (int t = 0; t < nt; t += 2) {
            const bool last = (t == nt - 2);
            const char* a1 = cA + (size_t)(t + 1) * kstep;
            const char* a2 = last ? nA : cA + (size_t)(t + 2) * kstep; const char* b2 = last ? nB : cB + (size_t)(t + 2) * kstep;
            const char* a3 = a2 + kstep; const char* b3 = b2 + kstep;
            if (last && has_next) S.a_ready(nxt);
            if constexpr (SP2) {
            PG8_LDB(B0, 0, 0); PG8_LDB(B1, 0, 1); PG8_SCHED; PG8_LDA(At, 0, 0); PG8_STAGE(PG8_SA(1, 1), a1 + hstepA, voffA);
            PG8_WAIT_V(8); PG8_WAIT_L(0); PG8_BAR; PG8_MMA(0, 0, At, B0); PG8_MMA(0, 1, At, B1); PG8_BAR; PG8_SCHED;
            PG8_LDA(At, 0, 1); PG8_STAGE(PG8_SB(0, 0), b2, voffB); PG8_STAGE(PG8_SB(0, 1), b2 + hstepB, voffB); PG8_STAGE(PG8_SA(0, 0), a2, voffA);
            PG8_WAIT_V(8); PG8_WAIT_L(0); PG8_BAR; PG8_MMA(1, 0, At, B0); PG8_MMA(1, 1, At, B1); PG8_BAR; PG8_SCHED;
            PG8_LDB(B0, 1, 0); PG8_LDB(B1, 1, 1); PG8_SCHED; PG8_LDA(At, 1, 0); PG8_STAGE(PG8_SA(0, 1), a2 + hstepA, voffA);
            PG8_WAIT_V(8); PG8_WAIT_L(0); PG8_BAR; PG8_MMA(0, 0, At, B0); PG8_MMA(0, 1, At, B1); PG8_BAR; PG8_SCHED;
            PG8_LDA(At, 1, 1); PG8_STAGE(PG8_SB(1, 0), b3, voffB); PG8_STAGE(PG8_SB(1, 1), b3 + hstepB, voffB); PG8_STAGE(PG8_SA(1, 0), a3, voffA);
            PG8_WAIT_V(8); PG8_WAIT_L(0); PG8_BAR; PG8_MMA(1, 0, At, B0); PG8_MMA(1, 1, At, B1); PG8_BAR; PG8_SCHED;
            } else {
            PG8_LDB(B0, 0, 0); PG8_SCHED; PG8_LDA(At, 0, 0); PG8_STAGE(PG8_SA(1, 1), a1 + hstepA, voffA);
            PG8_WAIT_L(8); PG8_BAR; PG8_WAIT_L(0); PG8_MMA(0, 0, At, B0); PG8_BAR; PG8_SCHED;
            PG8_LDB(B1, 0, 1); PG8_STAGE(PG8_SB(0, 0), b2, voffB);
            PG8_BAR; PG8_WAIT_L(0); PG8_MMA(0, 1, At, B1); PG8_BAR;
            PG8_LDA(At, 0, 1); PG8_STAGE(PG8_SA(0, 0), a2, voffA);
            PG8_BAR; PG8_WAIT_L(0); PG8_MMA(1, 0, At, B0); PG8_BAR; PG8_SCHED;
            PG8_STAGE(PG8_SB(0, 1), b2 + hstepB, voffB);
            PG8_WAIT_V(6); PG8_BAR; PG8_MMA(1, 1, At, B1); PG8_BAR;
            PG8_LDB(B0, 1, 0); PG8_SCHED; PG8_LDA(At, 1, 0); PG8_STAGE(PG8_SA(0, 1), a2 + hstepA, voffA);
            PG8_WAIT_L(8); PG8_BAR; PG8_WAIT_L(0); PG8_MMA(0, 0, At, B0); PG8_BAR; PG8_SCHED;
            PG8_LDB(B1, 1, 1); PG8_STAGE(PG8_SB(1, 0), b3, voffB);
            PG8_BAR; PG8_WAIT_L(0); PG8_MMA(0, 1, At, B1); PG8_BAR;
            PG8_LDA(At, 1, 1); PG8_STAGE(PG8_SA(1, 0), a3, voffA);
            PG8_BAR; PG8_WAIT_L(0); PG8_MMA(1, 0, At, B0); PG8_BAR; PG8_SCHED;
            PG8_STAGE(PG8_SB(1, 1), b3 + hstepB, voffB);
            PG8_WAIT_V(6); PG8_BAR; PG8_MMA(1, 1, At, B1); PG8_BAR;
            }
        }
        if constexpr (ALIGN_EPI) { if (wr == 0) PG8_BAR; }
        if constexpr (!Epi::AFTER_DRAIN) { E(acc, cur, wr, wc, fr, fq); S.done(cur); }
        if (!has_next) break;
        if (E.zero_after(cur)) {
#pragma unroll
        for (int a = 0; a < 2; ++a)
#pragma unroll
            for (int b = 0; b < 2; ++b)
#pragma unroll
                for (int m = 0; m < 4; ++m)
#pragma unroll
                    for (int n = 0; n < 2; ++n) acc[a][b][m][n] = (f32x4){0.f, 0.f, 0.f, 0.f};
        }
        cur = nxt; cA = nA; cB = nB; ++ui;
        if constexpr (ALIGN_EPI) { if (wr == 1) PG8_BAR; }
    }
    PG8_WAIT_V(0);
    if constexpr (!ALIGN_EPI) { if (wr == 0) PG8_BAR; }
    PG8_BAR;
    if constexpr (Epi::AFTER_DRAIN) { E.fused(acc, cur, wr, wc, fr, fq, lds, wid, lane); S.done(cur); }
#undef PG8_SA
#undef PG8_SB
#undef PG8_STAGE
#undef PG8_LDA
#undef PG8_LDB
#undef PG8_MMA
#undef PG8_WAIT_V
#undef PG8_WAIT_L
#undef PG8_BAR
#undef PG8_SCHED
}
}

namespace pg8 {
typedef unsigned u32x4_ __attribute__((ext_vector_type(4)));
struct EpiProj {
    static constexpr bool PERM = true, AFTER_DRAIN = false;
    bf16_t* O; int ldc;
    __device__ __forceinline__ bool zero_after(const Unit&) const { return true; }
    __device__ __forceinline__ void operator()(f32x4 (&acc)[2][2][4][2], const Unit& u, int wr, int wc, int fr, int fq) const {
        const int row0 = u.pm * BM + wr * 64 + fr, col0 = u.pn * BM + wc * 32 + 8 * fq;
#pragma unroll
        for (int ai = 0; ai < 2; ++ai)
#pragma unroll
            for (int m = 0; m < 4; ++m) { bf16_t* rowp = O + (size_t)(row0 + ai * HALF + m * 16) * ldc + col0;
#pragma unroll
                for (int bj = 0; bj < 2; ++bj) { const f32x4 v0 = acc[ai][bj][m][0], v1 = acc[ai][bj][m][1];
                    u32x4 w; w.x = cvt_pk_bf16(v0[0], v0[1]); w.y = cvt_pk_bf16(v0[2], v0[3]); w.z = cvt_pk_bf16(v1[0], v1[1]); w.w = cvt_pk_bf16(v1[2], v1[3]);
                    *(u32x4*)(rowp + bj * HALF) = w; } }
    }
};
struct SegOrder {
    StaticOrder base;
    __device__ __forceinline__ bool next(int i, Unit& u) const { if (!base.next(i >> 1, u)) return false; u.seg = i & 1; return true; }
    __device__ __forceinline__ void a_ready(const Unit&) const {}
    __device__ __forceinline__ void done(const Unit&) const {}
};
__device__ __forceinline__ float bfw(unsigned w, int half) { return __builtin_bit_cast(float, half ? (w & 0xffff0000u) : (w << 16)); }
struct EpiMerge {
    static constexpr bool PERM = true, AFTER_DRAIN = false;
    const bf16_t* proj; int ldp, cgm, cga; bf16_t* O; int ldo;
    __device__ __forceinline__ bool zero_after(const Unit& u) const { return u.seg != 0; }
    __device__ __forceinline__ void operator()(f32x4 (&acc)[2][2][4][2], const Unit& u, int wr, int wc, int fr, int fq) const {
        const int row0 = u.pm * BM + wr * 64 + fr, col0 = u.pn * BM + wc * 32 + 8 * fq;
#pragma unroll
        for (int ai = 0; ai < 2; ++ai)
#pragma unroll
            for (int m = 0; m < 4; ++m) { const size_t row = (size_t)(row0 + ai * HALF + m * 16);
#pragma unroll
                for (int bj = 0; bj < 2; ++bj) {
                    const u32x4 ga4 = *(const u32x4*)(proj + row * ldp + cga + col0 + bj * HALF);
                    if (u.seg == 0) {
                        const u32x4 gm4 = *(const u32x4*)(proj + row * ldp + cgm + col0 + bj * HALF);
#pragma unroll
                        for (int e = 0; e < 8; ++e) { const float gm = bfw(gm4[e >> 1], e & 1), ga = bfw(ga4[e >> 1], e & 1);
                            acc[ai][bj][m][e >> 2][e & 3] *= (1.f + __expf(-ga)) * __builtin_amdgcn_rcpf(1.f + __expf(-gm)); }
                    } else {
                        float o[8];
#pragma unroll
                        for (int e = 0; e < 8; ++e) { const float ga = bfw(ga4[e >> 1], e & 1); o[e] = acc[ai][bj][m][e >> 2][e & 3] * __builtin_amdgcn_rcpf(1.f + __expf(-ga)); }
                        u32x4 w; w.x = cvt_pk_bf16(o[0], o[1]); w.y = cvt_pk_bf16(o[2], o[3]); w.z = cvt_pk_bf16(o[4], o[5]); w.w = cvt_pk_bf16(o[6], o[7]);
                        *(u32x4*)(O + row * ldo + col0 + bj * HALF) = w;
                    }
                }
                if (m & 1) asm volatile("" ::: "memory"); }
    }
};
struct EpiOut {
    static constexpr bool PERM = false, AFTER_DRAIN = false;
    const float* x; const float* gate; float* out; float* rowss; int ldc, rows_per_batch, gate_stride;
    __device__ __forceinline__ bool zero_after(const Unit&) const { return true; }
    __device__ __forceinline__ void operator()(f32x4 (&acc)[2][2][4][2], const Unit& u, int wr, int wc, int fr, int fq) const {
        const int row0 = u.pm * BM + wr * 64 + fr, col0 = u.pn * BM + wc * 32 + 4 * fq;
        const float* gp = gate + (size_t)((u.pm * BM) / rows_per_batch) * gate_stride + col0;
        f32x4 gt[2][2];
#pragma unroll
        for (int bj = 0; bj < 2; ++bj)
#pragma unroll
            for (int n = 0; n < 2; ++n) gt[bj][n] = *(const f32x4*)(gp + bj * HALF + n * 16);
#pragma unroll
        for (int ai = 0; ai < 2; ++ai)
#pragma unroll
            for (int m = 0; m < 4; ++m) { const int row = row0 + ai * HALF + m * 16; const size_t off = (size_t)row * ldc + col0; float ssq = 0.f;
#pragma unroll
                for (int bj = 0; bj < 2; ++bj)
#pragma unroll
                    for (int n = 0; n < 2; ++n) { const f32x4 xv = *(const f32x4*)(x + off + bj * HALF + n * 16); const f32x4 o = xv + gt[bj][n] * acc[ai][bj][m][n];
                        ssq += (o[0] * o[0] + o[1] * o[1]) + (o[2] * o[2] + o[3] * o[3]); *(f32x4*)(out + off + bj * HALF + n * 16) = o; }
                ssq += __shfl_xor(ssq, 16); ssq += __shfl_xor(ssq, 32);
                if (fq == 0) atomicAdd(rowss + row, ssq);
                if (m & 1) asm volatile("" ::: "memory"); }
    }
};
}

#define LAS __attribute__((address_space(3)))
typedef unsigned v4u __attribute__((ext_vector_type(4)));
typedef float f4 __attribute__((ext_vector_type(4)));
constexpr size_t MiB = 1u << 20;
constexpr size_t WS_PROJ = 0;
constexpr size_t WS_YM = 416 * MiB;
constexpr size_t WS_YA = 448 * MiB;
constexpr size_t WS_WPM = 480 * MiB;
constexpr size_t WS_WPA = 484 * MiB;
constexpr size_t WS_WOUT = 488 * MiB;
constexpr size_t WS_MODP = 496 * MiB;
constexpr size_t WS_MOD = 497 * MiB;
constexpr size_t WS_GATES = 498 * MiB;
constexpr size_t WS_ROWSS = 499 * MiB;
constexpr size_t WS_SUMM = WS_ROWSS + 65536;
constexpr size_t WS_WC = WS_SUMM + 8192;
constexpr size_t WS_RSUM = WS_ROWSS + 131072;
constexpr size_t WS_WINT = WS_RSUM + 262144;
constexpr size_t WS_MCOMB = WS_WINT + 262144;
constexpr size_t WS_NINT = WS_MCOMB + 262144;
constexpr size_t WS_VONES = 500 * MiB;
constexpr size_t WS_END = 508 * MiB;
constexpr size_t OB_QC = 0, OB_KC = 32 * MiB, OB_IB = 64 * MiB, OB_NT = 96 * MiB;
constexpr size_t OB_H = 0;
constexpr size_t OB_WIN = 64 * MiB;
constexpr int NWAVES = 8, LDS_BYTES = 147456;

struct MArgs { const float* in[15]; float* out; unsigned char* ws; int ph_lo, ph_hi; };

__device__ __forceinline__ unsigned pk2(float lo, float hi) { return (unsigned)f2bf(lo) | ((unsigned)f2bf(hi) << 16); }
#define LDS_WAIT() asm volatile("s_waitcnt lgkmcnt(0)" ::: "memory")

__device__ __forceinline__ void transpose_item(const float* __restrict__ W, int ldw, int ncol_src0, bf16* __restrict__ WT, int K, int nrow_dst0, int k0, LAS float* scr, int lane) {
#pragma unroll 8
    for (int i = 0; i < 32; ++i) { const int kk = 2 * i + (lane >> 5); scr[kk * 33 + (lane & 31)] = W[(size_t)(k0 + kk) * ldw + ncol_src0 + (lane & 31)]; }
    LDS_WAIT();
    const int c = lane & 7;
#pragma unroll
    for (int j = 0; j < 4; ++j) { const int n = (lane >> 3) + 8 * j; const LAS float* s = scr + (8 * c) * 33 + n;
        v4u o; o.x = pk2(s[0 * 33], s[1 * 33]); o.y = pk2(s[2 * 33], s[3 * 33]); o.z = pk2(s[4 * 33], s[5 * 33]); o.w = pk2(s[6 * 33], s[7 * 33]);
        *(v4u*)(WT + (size_t)(nrow_dst0 + n) * K + k0 + 8 * c) = o; }
    LDS_WAIT();
}

typedef short bf16x8 __attribute__((ext_vector_type(8)));
typedef short s16x4 __attribute__((ext_vector_type(4)));
typedef float f32x16 __attribute__((ext_vector_type(16)));
typedef float f32x2_t __attribute__((ext_vector_type(2)));
typedef __bf16 bf16x2_t __attribute__((ext_vector_type(2)));
__device__ __forceinline__ unsigned cvtpk(float lo, float hi) { f32x2_t v = {lo, hi}; bf16x2_t b = __builtin_convertvector(v, bf16x2_t); return __builtin_bit_cast(unsigned, b); }
__device__ __forceinline__ s16x4 tr_read(const LAS unsigned char* p) { return __builtin_bit_cast(s16x4, __builtin_amdgcn_ds_read_tr16_b64_v4i16((LAS s16x4*)p)); }
constexpr int AT_KP = 272, AT_VP = 320, AT_KBUF = 64 * AT_KP, AT_VBUF = 64 * AT_VP, AT_VOFF = 2 * AT_KBUF, AT_BIAS = AT_VOFF + 2 * AT_VBUF, AT_LDS = AT_BIAS + 768;
constexpr float LOG2E = 1.4426950408889634f;

__device__ __forceinline__ void attn_unit(LAS unsigned char* lds, const bf16* __restrict__ proj, const float* __restrict__ rel_bias, bf16* __restrict__ ya, int b, int h, int g4, int tid, int lane, int wave) {
    const int j0 = 4 * g4, half = wave & 1, jq = j0 + (wave >> 1);
    const int r32 = lane & 31, hb = lane >> 5;
    const int tq = 64 * jq + 32 * half + r32;
    const size_t rowq = (size_t)b * S + tq;
    LAS float* biasL = (LAS float*)(lds + AT_BIAS);
    if (tid < 192) biasL[tid] = rel_bias[h * 192 + tid] * LOG2E;
    bf16x8 qf[8];
#pragma unroll
    for (int ks = 0; ks < 8; ++ks) qf[ks] = *(const bf16x8*)(proj + rowq * NP + C_AQ + h * 128 + 16 * ks + 8 * hb);
    f32x16 o[4];
#pragma unroll
    for (int dt = 0; dt < 4; ++dt)
#pragma unroll
        for (int r = 0; r < 16; ++r) o[dt][r] = 0.f;
    float m_run = -1e30f, l_run = 0.f;
    const int t0 = j0 > 8 ? j0 - 8 : 0, nt = j0 + 3 - t0 + 1;
    const int srow = tid >> 4, sc16 = tid & 15;
    const bf16* gsrc = proj + ((size_t)b * S + srow) * NP + h * 128 + sc16 * 8;
    v4u kr0, kr1, vr0, vr1;
#define AT_GLOAD(tc) do { const bf16* g_ = gsrc + (size_t)(64 * (tc)) * NP; kr0 = *(const v4u*)(g_ + C_AK); vr0 = *(const v4u*)(g_ + C_AV); kr1 = *(const v4u*)(g_ + (size_t)32 * NP + C_AK); vr1 = *(const v4u*)(g_ + (size_t)32 * NP + C_AV); } while (0)
#define AT_LWRITE(buf) do { LAS unsigned char* k_ = lds + (buf) * AT_KBUF + srow * AT_KP + sc16 * 16; LAS unsigned char* v_ = lds + AT_VOFF + (buf) * AT_VBUF + srow * AT_VP + sc16 * 16; \
        *(LAS v4u*)k_ = kr0; *(LAS v4u*)(k_ + 32 * AT_KP) = kr1; *(LAS v4u*)v_ = vr0; *(LAS v4u*)(v_ + 32 * AT_VP) = vr1; } while (0)
    AT_GLOAD(t0); AT_LWRITE(0);
    __syncthreads();
    const float SC = 0.08838834764831845f * LOG2E;
    for (int i = 0; i < nt; ++i) {
        const int tc = t0 + i, buf = i & 1;
        if (i + 1 < nt) AT_GLOAD(tc + 1);
        const int cdiff = jq - tc;
        if (cdiff >= 0 && cdiff <= 8) {
            const LAS unsigned char* Kb = lds + buf * AT_KBUF + r32 * AT_KP + hb * 16;
            f32x16 s0, s1;
#pragma unroll
            for (int r = 0; r < 16; ++r) { s0[r] = 0.f; s1[r] = 0.f; }
#pragma unroll
            for (int ks = 0; ks < 8; ++ks) {
                const bf16x8 k0 = *(const LAS bf16x8*)(Kb + ks * 32), k1 = *(const LAS bf16x8*)(Kb + 32 * AT_KP + ks * 32);
                s0 = __builtin_amdgcn_mfma_f32_32x32x16_bf16(k0, qf[ks], s0, 0, 0, 0);
                s1 = __builtin_amdgcn_mfma_f32_32x32x16_bf16(k1, qf[ks], s1, 0, 0, 0);
            }
            if (cdiff >= 3) { const float bc = biasL[191];
#pragma unroll
                for (int r = 0; r < 16; ++r) { s0[r] = s0[r] * SC + bc; s1[r] = s1[r] * SC + bc; }
            } else { const int base = 64 * cdiff + 32 * half + r32 + 63 - 4 * hb;
#pragma unroll
                for (int r = 0; r < 16; ++r) { const int i0 = base - ((r & 3) + 8 * (r >> 2)), i1 = i0 - 32;
                    s0[r] = s0[r] * SC + biasL[i0 > 191 ? 191 : i0]; s1[r] = s1[r] * SC + biasL[i1 > 191 ? 191 : i1]; }
            }
            float mx = fmaxf(s0[0], s1[0]);
#pragma unroll
            for (int r = 1; r < 16; ++r) mx = fmaxf(mx, fmaxf(s0[r], s1[r]));
            mx = fmaxf(mx, __shfl_xor(mx, 32));
            const float m_new = fmaxf(m_run, mx), alpha = __builtin_amdgcn_exp2f(m_run - m_new); m_run = m_new;
            float ls = 0.f;
#pragma unroll
            for (int r = 0; r < 16; ++r) { s0[r] = __builtin_amdgcn_exp2f(s0[r] - m_new); s1[r] = __builtin_amdgcn_exp2f(s1[r] - m_new); ls += s0[r] + s1[r]; }
            l_run = l_run * alpha + ls;
#pragma unroll
            for (int dt = 0; dt < 4; ++dt)
#pragma unroll
                for (int r = 0; r < 16; ++r) o[dt][r] *= alpha;
            v4u pw[4];
            pw[0] = (v4u){cvtpk(s0[0], s0[1]), cvtpk(s0[2], s0[3]), cvtpk(s0[4], s0[5]), cvtpk(s0[6], s0[7])};
            pw[1] = (v4u){cvtpk(s0[8], s0[9]), cvtpk(s0[10], s0[11]), cvtpk(s0[12], s0[13]), cvtpk(s0[14], s0[15])};
            pw[2] = (v4u){cvtpk(s1[0], s1[1]), cvtpk(s1[2], s1[3]), cvtpk(s1[4], s1[5]), cvtpk(s1[6], s1[7])};
            pw[3] = (v4u){cvtpk(s1[8], s1[9]), cvtpk(s1[10], s1[11]), cvtpk(s1[12], s1[13]), cvtpk(s1[14], s1[15])};
            const LAS unsigned char* Vb = lds + AT_VOFF + buf * AT_VBUF + (4 * hb + ((lane & 15) >> 2)) * AT_VP + (16 * ((lane >> 4) & 1) + 4 * (lane & 3)) * 2;
#pragma unroll
            for (int q = 0; q < 4; ++q) {
#pragma unroll
                for (int dt = 0; dt < 4; ++dt) {
                    const s16x4 lo = tr_read(Vb + (16 * q) * AT_VP + dt * 64), hi = tr_read(Vb + (16 * q + 8) * AT_VP + dt * 64);
                    const bf16x8 vf = (bf16x8){lo[0], lo[1], lo[2], lo[3], hi[0], hi[1], hi[2], hi[3]};
                    o[dt] = __builtin_amdgcn_mfma_f32_32x32x16_bf16(vf, __builtin_bit_cast(bf16x8, pw[q]), o[dt], 0, 0, 0);
                }
            }
        }
        if (i + 1 < nt) AT_LWRITE(buf ^ 1);
        __syncthreads();
    }
#undef AT_GLOAD
#undef AT_LWRITE
    const float linv = 1.f / (l_run + __shfl_xor(l_run, 32));
#pragma unroll
    for (int dt = 0; dt < 4; ++dt)
#pragma unroll
        for (int rq = 0; rq < 4; ++rq) {
            const int d0 = 32 * dt + 8 * rq + 4 * hb;
            const uint2 zz = *(const uint2*)(proj + rowq * NP + C_AZ + h * 128 + d0);
            const float z0 = __builtin_bit_cast(float, zz.x << 16), z1 = __builtin_bit_cast(float, zz.x & 0xffff0000u), z2 = __builtin_bit_cast(float, zz.y << 16), z3 = __builtin_bit_cast(float, zz.y & 0xffff0000u);
            uint2 w; w.x = cvtpk(o[dt][4 * rq + 0] * linv * siluf_(z0), o[dt][4 * rq + 1] * linv * siluf_(z1)); w.y = cvtpk(o[dt][4 * rq + 2] * linv * siluf_(z2), o[dt][4 * rq + 3] * linv * siluf_(z3));
            *(uint2*)(ya + rowq * 1024 + h * 128 + d0) = w;
        }
}

using pg8::bfw;
typedef float f32x4_ __attribute__((ext_vector_type(4)));
typedef unsigned u2v __attribute__((ext_vector_type(2)));
#define MFMA16(a, b, c) __builtin_amdgcn_mfma_f32_16x16x32_bf16((a), (b), (c), 0, 0, 0)
__device__ __forceinline__ float wave_scan_add(float x, int lane) {
#pragma unroll
    for (int o = 1; o < 64; o <<= 1) { const float t = __shfl_up(x, o); if (lane >= o) x += t; }
    return x;
}
__device__ __forceinline__ float wave_scan_max(float x, int lane) {
#pragma unroll
    for (int o = 1; o < 64; o <<= 1) { const float t = __shfl_up(x, o); if (lane >= o) x = fmaxf(x, t); }
    return x;
}
__device__ __forceinline__ void mlstm_summary(const float* __restrict__ gates, float* __restrict__ summ, int bh, int j, int lane) {
    const size_t row = (size_t)(bh >> 2) * S + 64 * j + lane; const int h = bh & 3;
    const float ig = gates[row * 8 + h], lf = gates[row * 8 + 4 + h];
    const float bc = wave_scan_add(lf, lane); const float b_last = __shfl(bc, 63);
    const float gmax = wave_max(b_last - bc + ig);
    if (lane == 0) { summ[(bh * 128 + j) * 2] = b_last; summ[(bh * 128 + j) * 2 + 1] = gmax; }
}
constexpr int U1_QP = 528, U1_VP = 576, U1_SP = 144;
constexpr int U1_QCL = 0, U1_KCL = 64 * U1_QP, U1_VL = 2 * 64 * U1_QP, U1_SWL = U1_VL + 64 * U1_VP, U1_SCAL = U1_SWL + 64 * U1_SP, U1_LDS = U1_SCAL + 3 * 256;
struct MlBufs { bf16* proj; const float* gates; const float* summ; const float* conv_w; const float* conv_b; bf16* QC; bf16* KC; bf16* IB; bf16* NT; float* rowsum; float* winter; float* mcomb; float* wc; float* ninter; bf16* vones; };

__device__ __forceinline__ void mlstm_u1_unit(LAS unsigned char* lds, const MlBufs& B, int b, int h, int j, int tid, int lane, int wave) {
    const int bh = b * 4 + h; const size_t rowb = (size_t)b * S + 64 * j;
    LAS float* sA = (LAS float*)(lds + U1_SCAL); LAS float* sC = sA + 64; LAS float* sWk = sA + 128;
    __syncthreads();
    if (wave == 0) {
        const size_t row = rowb + lane;
        const float ig = B.gates[row * 8 + h], lf = B.gates[row * 8 + 4 + h];
        const float bc = wave_scan_add(lf, lane); const float b_last = __shfl(bc, 63);
        const float a_s = ig - bc; const float pm = wave_scan_max(a_s, lane);
        const float gg = b_last - bc + ig; const float gmax = wave_max(gg);
        float m_prev = 0.f;
        if (j > 0) {
            const float bl0 = B.summ[(bh * 128 + lane) * 2], gm0 = B.summ[(bh * 128 + lane) * 2 + 1], bl1 = B.summ[(bh * 128 + 64 + lane) * 2], gm1 = B.summ[(bh * 128 + 64 + lane) * 2 + 1];
            const float P0 = wave_scan_add(bl0, lane); const float tot0 = __shfl(P0, 63); const float P1 = wave_scan_add(bl1, lane) + tot0;
            const int jm = j - 1;
            const float e0 = (lane <= jm) ? gm0 - P0 : -INFINITY, e1 = (lane + 64 <= jm) ? gm1 - P1 : -INFINITY;
            const float emax = wave_max(fmaxf(e0, e1));
            const float Bjm = (jm < 64) ? __shfl(P0, jm) : __shfl(P1, jm - 64);
            m_prev = Bjm + fmaxf(0.f, emax);
        }
        const float m_j = fmaxf(b_last + m_prev, gmax);
        const float c_t = fmaxf(pm, m_prev);
        sA[lane] = a_s; sC[lane] = c_t; sWk[lane] = __expf(gg - m_j);
        B.winter[row * 4 + h] = __expf(m_prev - c_t); B.mcomb[row * 4 + h] = bc + c_t;
        if (lane == 0) B.wc[bh * 128 + j] = __expf(b_last + m_prev - m_j);
    }
    {
        const int cg = tid & 63, tg = tid >> 6, isk = cg >> 5, c8 = (cg & 31) * 8, chan = isk * 1024 + h * 256 + c8;
        const bf16* src = B.proj + (rowb + 8 * tg - 3) * NP + (isk ? C_MK : C_MQ) + h * 256 + c8;
        float wv[4][8], bv[8];
#pragma unroll
        for (int tap = 0; tap < 4; ++tap) { const f4 w0 = *(const f4*)(B.conv_w + tap * 2048 + chan), w1 = *(const f4*)(B.conv_w + tap * 2048 + chan + 4);
            wv[tap][0] = w0[0]; wv[tap][1] = w0[1]; wv[tap][2] = w0[2]; wv[tap][3] = w0[3]; wv[tap][4] = w1[0]; wv[tap][5] = w1[1]; wv[tap][6] = w1[2]; wv[tap][7] = w1[3]; }
        { const f4 b0 = *(const f4*)(B.conv_b + chan), b1 = *(const f4*)(B.conv_b + chan + 4); bv[0] = b0[0]; bv[1] = b0[1]; bv[2] = b0[2]; bv[3] = b0[3]; bv[4] = b1[0]; bv[5] = b1[1]; bv[6] = b1[2]; bv[7] = b1[3]; }
        v4u raw[11];
#pragma unroll
        for (int i = 0; i < 11; ++i) { const int tt = 64 * j + 8 * tg - 3 + i; raw[i] = (tt >= 0) ? *(const v4u*)(src + (size_t)i * NP) : (v4u){0u, 0u, 0u, 0u}; }
        const float osc = isk ? 0.0625f : 1.f;
        LAS unsigned char* ldst = lds + (isk ? U1_KCL : U1_QCL) + (8 * tg) * U1_QP + c8 * 2;
        bf16* gdst = (isk ? B.KC : B.QC) + (rowb + 8 * tg) * 1024 + h * 256 + c8;
#pragma unroll
        for (int t8 = 0; t8 < 8; ++t8) {
            float o[8];
#pragma unroll
            for (int e = 0; e < 8; ++e) { float acc = bv[e];
#pragma unroll
                for (int tap = 0; tap < 4; ++tap) acc += wv[tap][e] * bfw(raw[t8 + tap][e >> 1], e & 1);
                o[e] = siluf_(acc) * osc; }
            const v4u w = (v4u){cvtpk(o[0], o[1]), cvtpk(o[2], o[3]), cvtpk(o[4], o[5]), cvtpk(o[6], o[7])};
            *(LAS v4u*)(ldst + t8 * U1_QP) = w; *(v4u*)(gdst + (size_t)t8 * 1024) = w;
        }
    }
    v4u vraw[4];
#pragma unroll
    for (int i = 0; i < 4; ++i) { const int ch = tid + 512 * i, row = ch >> 5, c16 = ch & 31; vraw[i] = *(const v4u*)(B.proj + (rowb + row) * NP + C_MV + h * 256 + c16 * 8);
        *(LAS v4u*)(lds + U1_VL + row * U1_VP + c16 * 16) = vraw[i]; }
    if (tid < 128) *(LAS v4u*)(lds + U1_VL + (tid >> 1) * U1_VP + 512 + (tid & 1) * 16) = (tid & 1) ? (v4u){0u, 0u, 0u, 0u} : (v4u){0x00003F80u, 0u, 0u, 0u};
    __syncthreads();
    const int fr = lane & 15, g = lane >> 4;
    {
        const int tt = wave & 3, st0 = 2 * (wave >> 2);
        f32x4_ sacc[2] = {{0.f, 0.f, 0.f, 0.f}, {0.f, 0.f, 0.f, 0.f}};
#pragma unroll
        for (int ks = 0; ks < 8; ++ks) {
            const bf16x8 bq = *(const LAS bf16x8*)(lds + U1_QCL + (16 * tt + fr) * U1_QP + (32 * ks + 8 * g) * 2);
#pragma unroll
            for (int i = 0; i < 2; ++i) { const bf16x8 ak = *(const LAS bf16x8*)(lds + U1_KCL + (16 * (st0 + i) + fr) * U1_QP + (32 * ks + 8 * g) * 2); sacc[i] = MFMA16(ak, bq, sacc[i]); }
        }
        const int t = 16 * tt + fr; const float c_t = sC[t];
#pragma unroll
        for (int i = 0; i < 2; ++i) { const int s0 = 16 * (st0 + i) + 4 * g; const f4 a4 = *(const LAS f4*)(sA + s0);
            float o[4];
#pragma unroll
            for (int r = 0; r < 4; ++r) o[r] = (s0 + r <= t) ? sacc[i][r] * __expf(a4[r] - c_t) : 0.f;
            u2v w; w.x = cvtpk(o[0], o[1]); w.y = cvtpk(o[2], o[3]);
            *(LAS u2v*)(lds + U1_SWL + t * U1_SP + s0 * 2) = w; }
    }
    __syncthreads();
    {
        const int nvt = (wave == 0) ? 3 : 2;
        for (int iv = 0; iv < nvt; ++iv) {
            const int vt = (iv == 2) ? 16 : 2 * wave + iv;
            f32x4_ ia[4] = {{0.f, 0.f, 0.f, 0.f}, {0.f, 0.f, 0.f, 0.f}, {0.f, 0.f, 0.f, 0.f}, {0.f, 0.f, 0.f, 0.f}};
#pragma unroll
            for (int ks = 0; ks < 2; ++ks) {
                const LAS unsigned char* va = lds + U1_VL + (32 * ks + 8 * g + ((lane & 15) >> 2)) * U1_VP + (16 * vt + 4 * (lane & 3)) * 2;
                const s16x4 lo = tr_read(va), hi = tr_read(va + 4 * U1_VP);
                const bf16x8 af = (bf16x8){lo[0], lo[1], lo[2], lo[3], hi[0], hi[1], hi[2], hi[3]};
#pragma unroll
                for (int tt = 0; tt < 4; ++tt) { const bf16x8 bs = *(const LAS bf16x8*)(lds + U1_SWL + (16 * tt + fr) * U1_SP + (32 * ks + 8 * g) * 2); ia[tt] = MFMA16(af, bs, ia[tt]); }
            }
#pragma unroll
            for (int tt = 0; tt < 4; ++tt) { const size_t row = rowb + 16 * tt + fr;
                if (vt < 16) { uint2 w; w.x = cvtpk(ia[tt][0], ia[tt][1]); w.y = cvtpk(ia[tt][2], ia[tt][3]); *(uint2*)(B.IB + row * 1024 + h * 256 + 16 * vt + 4 * g) = w; }
                else if (g == 0) B.rowsum[row * 4 + h] = ia[tt][0]; }
        }
    }
#pragma unroll
    for (int i = 0; i < 4; ++i) { const int ch = tid + 512 * i, row = ch >> 5, c16 = ch & 31; const float wk = sWk[row]; v4u w;
#pragma unroll
        for (int e = 0; e < 4; ++e) w[e] = cvtpk(bfw(vraw[i][e], 0) * wk, bfw(vraw[i][e], 1) * wk);
        *(v4u*)(B.proj + (rowb + row) * NP + C_MV + h * 256 + c16 * 8) = w; }
    { const int srow = tid >> 3, c = tid & 7; const unsigned w0 = (c == 0) ? (unsigned)f2bf(sWk[srow]) : 0u;
      *(v4u*)(B.vones + ((size_t)bh * S + 64 * j + srow) * 64 + c * 8) = (v4u){w0, 0u, 0u, 0u}; }
}

constexpr int W_QP = 528, W_KP = 544, W_VP = 144, W_QL = 0, W_KL = 64 * W_QP, W_VL = W_KL + 64 * W_KP, W_LDS = W_VL + 64 * W_VP;
__device__ __forceinline__ void mlstm_worker(LAS unsigned char* lds, const MlBufs& B, int b, int h, int sl, int tid, int lane, int wave) {
    const int bh = b * 4 + h; const size_t rowb = (size_t)b * S;
    const bf16* vsrc = (sl < 4) ? (B.proj + rowb * NP + C_MV + h * 256 + 64 * sl) : (B.vones + (size_t)bh * S * 64);
    const size_t vpitch = (sl < 4) ? (size_t)NP : (size_t)64;
    const int fr = lane & 15, g = lane >> 4;
    f32x4_ Ct[16];
#pragma unroll
    for (int kt = 0; kt < 16; ++kt) Ct[kt] = (f32x4_){0.f, 0.f, 0.f, 0.f};
    v4u rq[4], rk[4], rv;
#define W_GLOAD(jj) do { _Pragma("unroll") for (int i_ = 0; i_ < 4; ++i_) { const int ch_ = tid + 512 * i_, row_ = ch_ >> 5, c16_ = ch_ & 31; const size_t o_ = (rowb + 64 * (jj) + row_) * 1024 + h * 256 + c16_ * 8; \
            rq[i_] = *(const v4u*)(B.QC + o_); rk[i_] = *(const v4u*)(B.KC + o_); } \
        rv = *(const v4u*)(vsrc + (size_t)(64 * (jj) + (tid >> 3)) * vpitch + (tid & 7) * 8); } while (0)
#define W_LWRITE() do { _Pragma("unroll") for (int i_ = 0; i_ < 4; ++i_) { const int ch_ = tid + 512 * i_, row_ = ch_ >> 5, c16_ = ch_ & 31; \
            *(LAS v4u*)(lds + W_QL + row_ * W_QP + c16_ * 16) = rq[i_]; *(LAS v4u*)(lds + W_KL + row_ * W_KP + c16_ * 16) = rk[i_]; } \
        *(LAS v4u*)(lds + W_VL + (tid >> 3) * W_VP + (tid & 7) * 16) = rv; } while (0)
    W_GLOAD(0);
    for (int j = 0; j < 128; ++j) {
        __syncthreads();
        W_LWRITE();
        if (j + 1 < 128) W_GLOAD(j + 1);
        __syncthreads();
        if (wave < 4) {
            const int vq = wave;
            const float w_c = B.wc[bh * 128 + j];
            f32x4_ ia[4] = {{0.f, 0.f, 0.f, 0.f}, {0.f, 0.f, 0.f, 0.f}, {0.f, 0.f, 0.f, 0.f}, {0.f, 0.f, 0.f, 0.f}};
#pragma unroll
            for (int kk = 0; kk < 8; ++kk) {
                const v4u cw = (v4u){cvtpk(Ct[2 * kk][0], Ct[2 * kk][1]), cvtpk(Ct[2 * kk][2], Ct[2 * kk][3]), cvtpk(Ct[2 * kk + 1][0], Ct[2 * kk + 1][1]), cvtpk(Ct[2 * kk + 1][2], Ct[2 * kk + 1][3])};
#pragma unroll
                for (int tt = 0; tt < 4; ++tt) { const LAS unsigned char* qa = lds + W_QL + (16 * tt + fr) * W_QP + (32 * kk + 4 * g) * 2;
                    const u2v lo = *(const LAS u2v*)qa, hi = *(const LAS u2v*)(qa + 32);
                    ia[tt] = MFMA16(__builtin_bit_cast(bf16x8, cw), __builtin_bit_cast(bf16x8, ((v4u){lo.x, lo.y, hi.x, hi.y})), ia[tt]); }
            }
#pragma unroll
            for (int tt = 0; tt < 4; ++tt) { const size_t row = rowb + 64 * j + 16 * tt + fr;
                if (sl < 4) { uint2 w; w.x = cvtpk(ia[tt][0], ia[tt][1]); w.y = cvtpk(ia[tt][2], ia[tt][3]); *(uint2*)(B.NT + row * 1024 + h * 256 + 64 * sl + 16 * vq + 4 * g) = w; }
                else if (vq == 0 && g == 0) B.ninter[row * 4 + h] = ia[tt][0]; }
#pragma unroll
            for (int kt = 0; kt < 16; ++kt) Ct[kt] *= w_c;
#pragma unroll
            for (int ks = 0; ks < 2; ++ks) {
                const LAS unsigned char* vb = lds + W_VL + (32 * ks + 8 * g + ((lane & 15) >> 2)) * W_VP + (16 * vq + 4 * (lane & 3)) * 2;
                const s16x4 vlo = tr_read(vb), vhi = tr_read(vb + 4 * W_VP);
                const bf16x8 bvf = (bf16x8){vlo[0], vlo[1], vlo[2], vlo[3], vhi[0], vhi[1], vhi[2], vhi[3]};
                const LAS unsigned char* ka = lds + W_KL + (32 * ks + 8 * g + ((lane & 15) >> 2)) * W_KP + (4 * (lane & 3)) * 2;
#pragma unroll
                for (int kt = 0; kt < 16; ++kt) { const s16x4 klo = tr_read(ka + kt * 32), khi = tr_read(ka + kt * 32 + 4 * W_KP);
                    const bf16x8 akf = (bf16x8){klo[0], klo[1], klo[2], klo[3], khi[0], khi[1], khi[2], khi[3]};
                    Ct[kt] = MFMA16(akf, bvf, Ct[kt]); }
            }
        }
    }
    __syncthreads();
#undef W_GLOAD
#undef W_LWRITE
}
__device__ __forceinline__ void mlstm_post_item(const MlBufs& B, const float* __restrict__ mh_norm_g, bf16* __restrict__ ym, size_t row, int h, int lane) {
    const uint2 iw = *(const uint2*)(B.IB + row * 1024 + h * 256 + lane * 4), nw = *(const uint2*)(B.NT + row * 1024 + h * 256 + lane * 4);
    const float wi = B.winter[row * 4 + h], den = B.rowsum[row * 4 + h] + wi * B.ninter[row * 4 + h];
    const float dinv = 1.f / fmaxf(fabsf(den), __expf(-B.mcomb[row * 4 + h]));
    float hv[4];
    hv[0] = (bfw(iw.x, 0) + wi * bfw(nw.x, 0)) * dinv; hv[1] = (bfw(iw.x, 1) + wi * bfw(nw.x, 1)) * dinv; hv[2] = (bfw(iw.y, 0) + wi * bfw(nw.y, 0)) * dinv; hv[3] = (bfw(iw.y, 1) + wi * bfw(nw.y, 1)) * dinv;
    const float ss = wave_sum(hv[0] * hv[0] + hv[1] * hv[1] + hv[2] * hv[2] + hv[3] * hv[3]);
    const float r = 1.0f / sqrtf(ss * (1.f / 256.f) + EPS);
    const int c = h * 256 + lane * 4;
    const uint2 mo = *(const uint2*)(B.proj + row * NP + C_MO + c), mz = *(const uint2*)(B.proj + row * NP + C_MZ + c);
    const f4 gn = *(const f4*)(mh_norm_g + c);
    uint2 w;
    w.x = cvtpk(hv[0] * r * gn[0] * sigmoidf_(bfw(mo.x, 0)) * siluf_(bfw(mz.x, 0)), hv[1] * r * gn[1] * sigmoidf_(bfw(mo.x, 1)) * siluf_(bfw(mz.x, 1)));
    w.y = cvtpk(hv[2] * r * gn[2] * sigmoidf_(bfw(mo.y, 0)) * siluf_(bfw(mz.y, 0)), hv[3] * r * gn[3] * sigmoidf_(bfw(mo.y, 1)) * siluf_(bfw(mz.y, 1)));
    *(uint2*)(ym + row * 1024 + h * 256 + lane * 4) = w;
}

__global__ void __launch_bounds__(NWAVES * 64, 2) mega(MArgs a) {
    extern __shared__ __attribute__((aligned(16))) unsigned char lds_raw[];
    LAS unsigned char* lds = (LAS unsigned char*)lds_raw;
    cg::grid_group grid = cg::this_grid();
    const int tid = threadIdx.x, lane = tid & 63, wave = __builtin_amdgcn_readfirstlane(tid >> 6);
    const int G = gridDim.x, gw = blockIdx.x * NWAVES + wave, NGW = G * NWAVES;
    const float* x = a.in[0]; const float* cvec = a.in[1]; const float* w_ada = a.in[2]; const float* b_ada = a.in[3]; const float* norm_g = a.in[4]; const float* w_in = a.in[5];
    const float* b_if = a.in[6]; const float* final_g = a.in[14]; const float* w_proj_m = a.in[11]; const float* w_proj_a = a.in[12]; const float* w_out = a.in[13];
    unsigned char* ws = a.ws; unsigned char* ob = (unsigned char*)a.out;
    bf16* proj = (bf16*)(ws + WS_PROJ); bf16* Wpm_t = (bf16*)(ws + WS_WPM); bf16* Wpa_t = (bf16*)(ws + WS_WPA); bf16* Wout_t = (bf16*)(ws + WS_WOUT);
    float* modp = (float*)(ws + WS_MODP); float* mod = (float*)(ws + WS_MOD); float* gates = (float*)(ws + WS_GATES); float* rowss = (float*)(ws + WS_ROWSS);
    bf16* ym = (bf16*)(ws + WS_YM); bf16* ya = (bf16*)(ws + WS_YA); bf16* merged = proj;
    bf16* H = (bf16*)(ob + OB_H); bf16* Win_t = (bf16*)(ob + OB_WIN);
    const int lo = a.ph_lo, hi = a.ph_hi;
#define IN(k) (lo <= (k) && (k) < hi)
#define BOTH(k) (IN(k) && IN((k) + 1))

    if (IN(0)) {
        LAS float* scr = (LAS float*)(lds + wave * 16384);
        constexpr int I_ADA = 16 * 24, I_IN = (D / 64) * (NP / 32), I_PM = (1024 / 64) * (D / 32), I_OUT = (D / 64) * (D / 32);
        constexpr int NITEMS = I_ADA + I_IN + 2 * I_PM + I_OUT;
        for (int it = gw; it < NITEMS; it += NGW) {
            int r = it;
            if (r < I_ADA) {
                const int ks = r / 24, cb = r % 24, n0 = cb * 256 + lane * 4;
                float4 a0 = {0.f, 0.f, 0.f, 0.f}, a1 = {0.f, 0.f, 0.f, 0.f};
                if (ks == 0) { a0 = *(const float4*)(b_ada + n0); a1 = a0; }
#pragma unroll 8
                for (int kk = 0; kk < 128; ++kk) { const int k = ks * 128 + kk; const float4 w = *(const float4*)(w_ada + (size_t)k * (3 * D) + n0);
                    const float c0 = cvec[k], c1 = cvec[D + k]; const float s0 = c0 / (1.f + __expf(-c0)), s1 = c1 / (1.f + __expf(-c1));
                    a0.x += s0 * w.x; a0.y += s0 * w.y; a0.z += s0 * w.z; a0.w += s0 * w.w; a1.x += s1 * w.x; a1.y += s1 * w.y; a1.z += s1 * w.z; a1.w += s1 * w.w; }
                *(float4*)(modp + (size_t)(ks * 2 + 0) * (3 * D) + n0) = a0; *(float4*)(modp + (size_t)(ks * 2 + 1) * (3 * D) + n0) = a1;
                continue; }
            r -= I_ADA;
            if (r < I_IN) { const int nblk = NP / 32, kb = r / nblk, nb = r % nblk, nd = 32 * nb; transpose_item(w_in, INC, nd + (nd >= 5120 ? 8 : 0), Win_t, D, nd, 64 * kb, scr, lane); continue; }
            r -= I_IN;
            if (r < I_PM) { const int nblk = D / 32, kb = r / nblk, nb = r % nblk; transpose_item(w_proj_m, D, 32 * nb, Wpm_t, 1024, 32 * nb, 64 * kb, scr, lane); continue; }
            r -= I_PM;
            if (r < I_PM) { const int nblk = D / 32, kb = r / nblk, nb = r % nblk; transpose_item(w_proj_a, D, 32 * nb, Wpa_t, 1024, 32 * nb, 64 * kb, scr, lane); continue; }
            r -= I_PM;
            { const int nblk = D / 32, kb = r / nblk, nb = r % nblk; transpose_item(w_out, D, 32 * nb, Wout_t, D, 32 * nb, 64 * kb, scr, lane); }
        }
        if (BOTH(0)) grid.sync();
    }

    if (IN(1)) {
        LAS float* smod = (LAS float*)lds;
        LAS float* gwl = (LAS float*)(lds + 49152);
        for (int i = tid; i < 2 * 3 * D; i += NWAVES * 64) { float s = 0.f;
#pragma unroll
            for (int ks = 0; ks < 16; ++ks) s += modp[(size_t)ks * (2 * 3 * D) + i];
            smod[i] = s; if (blockIdx.x == 0) mod[i] = s; }
        for (int k = tid; k < D; k += NWAVES * 64) { const float4 w0 = *(const float4*)(w_in + (size_t)k * INC + 5120), w1 = *(const float4*)(w_in + (size_t)k * INC + 5124);
            gwl[0 * D + k] = w0.x; gwl[1 * D + k] = w0.y; gwl[2 * D + k] = w0.z; gwl[3 * D + k] = w0.w; gwl[4 * D + k] = w1.x; gwl[5 * D + k] = w1.y; gwl[6 * D + k] = w1.z; gwl[7 * D + k] = w1.w; }
        __syncthreads();
        for (int row = gw; row < M; row += NGW) {
            const int b = row / S;
            const float4* xr = (const float4*)(x + (size_t)row * D);
            float4 v[8]; float ss = 0.f;
#pragma unroll
            for (int j = 0; j < 8; ++j) { v[j] = xr[lane + 64 * j]; ss += v[j].x * v[j].x + v[j].y * v[j].y + v[j].z * v[j].z + v[j].w * v[j].w; }
            ss = wave_sum(ss);
            const float rstd = 1.0f / sqrtf(ss * (1.f / D) + EPS);
            float acc[8];
#pragma unroll
            for (int i = 0; i < 8; ++i) acc[i] = 0.f;
            const LAS float* shift = smod + b * 3 * D; const LAS float* scale = shift + D;
#pragma unroll
            for (int j = 0; j < 8; ++j) {
                const int k0 = (lane + 64 * j) * 4;
                const f4 g4 = *(const f4*)(norm_g + k0); const f4 sc4 = *(const LAS f4*)(scale + k0); const f4 sh4 = *(const LAS f4*)(shift + k0);
                float4 h4; h4.x = v[j].x * rstd * g4.x * (1.f + sc4.x) + sh4.x; h4.y = v[j].y * rstd * g4.y * (1.f + sc4.y) + sh4.y; h4.z = v[j].z * rstd * g4.z * (1.f + sc4.z) + sh4.z; h4.w = v[j].w * rstd * g4.w * (1.f + sc4.w) + sh4.w;
#pragma unroll
                for (int i = 0; i < 8; ++i) { const f4 w4 = *(const LAS f4*)(gwl + i * D + k0); acc[i] += h4.x * w4.x + h4.y * w4.y + h4.z * w4.z + h4.w * w4.w; }
                uint2 o; o.x = pk2(h4.x, h4.y); o.y = pk2(h4.z, h4.w);
                *(uint2*)(H + (size_t)row * D + k0) = o;
                asm volatile("" ::: "memory");
            }
#pragma unroll
            for (int i = 0; i < 8; ++i) acc[i] = wave_sum(acc[i]);
            if (lane == 0) {
                rowss[row] = 0.f;
#pragma unroll
                for (int i = 0; i < 4; ++i) gates[(size_t)row * 8 + i] = acc[i] + b_if[i];
#pragma unroll
                for (int i = 4; i < 8; ++i) { const float z = acc[i] + b_if[i]; gates[(size_t)row * 8 + i] = fminf(z, 0.f) - log1pf(expf(-fabsf(z))); }
            }
        }
        __syncthreads();
        if (BOTH(1)) grid.sync();
    }

    if (IN(2)) {
        if (gw < 1024) mlstm_summary(gates, (float*)(ws + WS_SUMM), gw >> 7, gw & 127, lane);
        pg8::Gemm g{H, H, Win_t, Win_t, D, D}; pg8::StaticOrder So; So.init(M, NP, G, (int)blockIdx.x);
        pg8::EpiProj E{proj, NP};
        pg8::gemm_phase<pg8::EpiProj, pg8::StaticOrder, true, true>(lds, g, So, E);
        if (BOTH(2)) grid.sync();
    }
    if (IN(3)) {
        MlBufs mb; mb.proj = proj; mb.gates = gates; mb.summ = (const float*)(ws + WS_SUMM); mb.conv_w = a.in[7]; mb.conv_b = a.in[8];
        mb.QC = (bf16*)(ob + OB_QC); mb.KC = (bf16*)(ob + OB_KC); mb.IB = (bf16*)(ob + OB_IB); mb.NT = (bf16*)(ob + OB_NT);
        mb.rowsum = (float*)(ws + WS_RSUM); mb.winter = (float*)(ws + WS_WINT); mb.mcomb = (float*)(ws + WS_MCOMB); mb.wc = (float*)(ws + WS_WC); mb.ninter = (float*)(ws + WS_NINT); mb.vones = (bf16*)(ws + WS_VONES);
        for (int u = blockIdx.x; u < 1024; u += G) mlstm_u1_unit(lds, mb, u >> 9, (u >> 7) & 3, u & 127, tid, lane, wave);
        grid.sync();
        if (blockIdx.x < 40) mlstm_worker(lds, mb, (blockIdx.x & 7) >> 2, blockIdx.x & 3, blockIdx.x >> 3, tid, lane, wave);
        for (int u = blockIdx.x; u < 512; u += G) attn_unit(lds, proj, a.in[10], ya, u >> 8, (u >> 5) & 7, u & 31, tid, lane, wave);
        grid.sync();
        for (int it = gw; it < M * 4; it += NGW) mlstm_post_item(mb, a.in[9], ym, (size_t)(it >> 2), it & 3, lane);
        if (BOTH(3)) grid.sync();
    }
    if (IN(4)) {
        pg8::Gemm g{ym, ya, Wpm_t, Wpa_t, 1024, 1024}; pg8::SegOrder So; So.base.init(M, D, G, (int)blockIdx.x);
        pg8::EpiMerge E{proj, NP, C_GM, C_GA, merged, NP};
        pg8::gemm_phase<pg8::EpiMerge, pg8::SegOrder, true, true>(lds, g, So, E);
        if (BOTH(4)) grid.sync();
    }
    if (IN(5)) {
        pg8::Gemm g{merged, merged, Wout_t, Wout_t, NP, D}; pg8::StaticOrder So; So.init(M, D, G, (int)blockIdx.x);
        pg8::EpiOut E{x, mod + 2 * D, a.out, rowss, D, S, 3 * D};
        pg8::gemm_phase<pg8::EpiOut, pg8::StaticOrder, true, true>(lds, g, So, E);
        if (BOTH(5)) grid.sync();
    }
    if (IN(6)) {
        for (int row = gw; row < M; row += NGW) {
            const float r = 1.0f / sqrtf(rowss[row] * (1.f / D) + EPS);
            f4* xr = (f4*)(a.out + (size_t)row * D);
#pragma unroll
            for (int j = 0; j < 8; ++j) { const f4 g4 = *(const f4*)(final_g + (lane + 64 * j) * 4); xr[lane + 64 * j] = xr[lane + 64 * j] * r * g4; }
        }
    }
#undef IN
#undef BOTH
}

static int launch_mega(const MArgs& a, hipStream_t stream) {
    static int grid = 0;
    if (grid == 0) {
        int dev = 0, cus = 0, per_cu = 0;
        if (hipGetDevice(&dev) != hipSuccess || hipDeviceGetAttribute(&cus, hipDeviceAttributeMultiprocessorCount, dev) != hipSuccess) { fprintf(stderr, "kernel_launch: device query failed\n"); grid = -1; return -1; }
        if (hipFuncSetAttribute((const void*)mega, hipFuncAttributeMaxDynamicSharedMemorySize, LDS_BYTES) != hipSuccess) { fprintf(stderr, "kernel_launch: hipFuncSetAttribute failed\n"); grid = -1; return -1; }
        if (hipOccupancyMaxActiveBlocksPerMultiprocessor(&per_cu, (const void*)mega, NWAVES * 64, LDS_BYTES) != hipSuccess || per_cu < 1) { fprintf(stderr, "kernel_launch: occupancy query says %d blocks/CU\n", per_cu); (void)hipGetLastError(); grid = -1; return -1; }
        grid = cus * (per_cu > 1 ? 1 : per_cu);
        fprintf(stderr, "kernel_launch: %d CUs, occupancy %d blocks/CU, grid %d\n", cus, per_cu, grid);
    }
    if (grid < 0) return -1;
    MArgs arg = a; void* args[] = {(void*)&arg};
    const hipError_t e = hipLaunchCooperativeKernel((const void*)mega, dim3(grid), dim3(NWAVES * 64), args, LDS_BYTES, stream);
    if (e != hipSuccess) { fprintf(stderr, "kernel_launch: cooperative launch failed: %s (grid %d)\n", hipGetErrorString(e), grid); return -1; }
    return 0;
}

extern "C" void kernel_launch(void* const* d_in, const int* in_sizes, int n_in, void* d_out, int out_size, void* d_ws, size_t ws_size, hipStream_t stream) {
    if (n_in != 15 || in_sizes[0] != M * D || out_size != M * D || ws_size < WS_END) { fprintf(stderr, "kernel_launch: unexpected shapes / workspace (%zu < %zu)\n", ws_size, (size_t)WS_END); return; }
    const float* x = (const float*)d_in[0];
    const float* conv_w = (const float*)d_in[7]; const float* conv_b = (const float*)d_in[8]; const float* mh_norm_g = (const float*)d_in[9]; const float* rel_bias = (const float*)d_in[10];
    const float* w_proj_m = (const float*)d_in[11]; const float* w_proj_a = (const float*)d_in[12]; const float* w_out = (const float*)d_in[13]; const float* final_g = (const float*)d_in[14];
    unsigned char* ws = (unsigned char*)d_ws;
    bf16* proj = (bf16*)(ws + WS_PROJ); bf16* ym = (bf16*)(ws + WS_YM); bf16* ya = (bf16*)(ws + WS_YA); float* mod = (float*)(ws + WS_MOD); float* gates = (float*)(ws + WS_GATES);
    unsigned char* ob = (unsigned char*)d_out;
    bf16* qc = (bf16*)ob; bf16* kc = (bf16*)(ob + 32 * MiB); float* hbuf = (float*)(ob + 64 * MiB);
    bf16* merged = proj;

    MArgs a{}; for (int i = 0; i < 15; ++i) a.in[i] = (const float*)d_in[i]; a.out = (float*)d_out; a.ws = (unsigned char*)d_ws; a.ph_lo = 0; a.ph_hi = 7;
    launch_mega(a, stream);
}
```

```cpp
#include <hip/hip_runtime.h>
#include <cstdio>
#include <cstdint>
#include <hip/hip_cooperative_groups.h>
namespace cg = cooperative_groups;

typedef unsigned short bf16;
constexpr int D = 2048, NB = 2, S = 8192, M = NB * S;
constexpr int INC = 13320, NP = 13312;
constexpr int C_MQ = 0, C_MK = 1024, C_MV = 2048, C_MO = 3072, C_MZ = 4096, C_AQ = 5120, C_AK = 6144, C_AV = 7168, C_AZ = 8192, C_GM = 9216, C_GA = 11264;
constexpr float EPS = 1e-6f;

__device__ __forceinline__ bf16 f2bf(float f) { unsigned u = __builtin_bit_cast(unsigned, f); return (bf16)((u + 0x7fffu + ((u >> 16) & 1u)) >> 16); }
__device__ __forceinline__ float bf2f(bf16 h) { return __builtin_bit_cast(float, (unsigned)h << 16); }
__device__ __forceinline__ float wave_sum(float v) {
#pragma unroll
    for (int o = 1; o < 64; o <<= 1) v += __shfl_xor(v, o);
    return v;
}
__device__ __forceinline__ float wave_max(float v) {
#pragma unroll
    for (int o = 1; o < 64; o <<= 1) v = fmaxf(v, __shfl_xor(v, o));
    return v;
}
__device__ __forceinline__ float sigmoidf_(float x) { return 1.f / (1.f + __expf(-x)); }
__device__ __forceinline__ float siluf_(float x) { return x / (1.f + __expf(-x)); }

__global__ void __launch_bounds__(256) k_ada(const float* __restrict__ c, const float* __restrict__ w_ada, const float* __restrict__ b_ada, float* __restrict__ mod) {
    __shared__ float sc[2][D];
    for (int i = threadIdx.x; i < 2 * D; i += 256) { float v = c[i]; sc[i / D][i % D] = v / (1.f + expf(-v)); }
    __syncthreads();
    const int n = blockIdx.x * 256 + threadIdx.x;
    float a0 = 0.f, a1 = 0.f;
    for (int k = 0; k < D; ++k) { const float w = w_ada[(size_t)k * (3 * D) + n]; a0 += sc[0][k] * w; a1 += sc[1][k] * w; }
    mod[n] = a0 + b_ada[n]; mod[3 * D + n] = a1 + b_ada[n];
}

__global__ void __launch_bounds__(256) k_norm(const float* __restrict__ x, const float* __restrict__ norm_g, const float* __restrict__ mod, const float* __restrict__ w_in,
                                              const float* __restrict__ b_if, bf16* __restrict__ H, float* __restrict__ gates) {
    const int row = blockIdx.x * 4 + (threadIdx.x >> 6), lane = threadIdx.x & 63, b = row / S;
    const float4* xr = (const float4*)(x + (size_t)row * D);
    float4 v[8]; float ss = 0.f;
#pragma unroll
    for (int j = 0; j < 8; ++j) { v[j] = xr[lane + 64 * j]; ss += v[j].x * v[j].x + v[j].y * v[j].y + v[j].z * v[j].z + v[j].w * v[j].w; }
    ss = wave_sum(ss);
    const float rstd = 1.0f / sqrtf(ss * (1.f / D) + EPS);
    float acc[8];
#pragma unroll
    for (int i = 0; i < 8; ++i) acc[i] = 0.f;
    const float* shift = mod + b * 3 * D; const float* scale = shift + D;
#pragma unroll
    for (int j = 0; j < 8; ++j) {
        const int k0 = (lane + 64 * j) * 4;
        const float xv[4] = {v[j].x, v[j].y, v[j].z, v[j].w};
        float hv[4];
#pragma unroll
        for (int e = 0; e < 4; ++e) {
            const int k = k0 + e;
            hv[e] = xv[e] * rstd * norm_g[k] * (1.f + scale[k]) + shift[k];
            const float4* wr = (const float4*)(w_in + (size_t)k * INC + 5120);
            const float4 w0 = wr[0], w1 = wr[1];
            acc[0] += hv[e] * w0.x; acc[1] += hv[e] * w0.y; acc[2] += hv[e] * w0.z; acc[3] += hv[e] * w0.w;
            acc[4] += hv[e] * w1.x; acc[5] += hv[e] * w1.y; acc[6] += hv[e] * w1.z; acc[7] += hv[e] * w1.w;
        }
        ushort4 o; o.x = f2bf(hv[0]); o.y = f2bf(hv[1]); o.z = f2bf(hv[2]); o.w = f2bf(hv[3]);
        *(ushort4*)(H + (size_t)row * D + k0) = o;
    }
#pragma unroll
    for (int i = 0; i < 8; ++i) acc[i] = wave_sum(acc[i]);
    if (lane == 0) {
#pragma unroll
        for (int i = 0; i < 4; ++i) gates[(size_t)row * 8 + i] = acc[i] + b_if[i];
#pragma unroll
        for (int i = 4; i < 8; ++i) { const float z = acc[i] + b_if[i]; gates[(size_t)row * 8 + i] = fminf(z, 0.f) - log1pf(expf(-fabsf(z))); }
    }
}

struct GemmArgs { const bf16* A; const bf16* A2; const float* B; const float* B2; int lda, ldb, K; bf16* Ob; int ldo; float* Of; const bf16* proj; const float* x; const float* mod; };
template <int MODE> __global__ void __launch_bounds__(256) k_gemm(GemmArgs g) {
    __shared__ float As[16][68]; __shared__ float Bs[16][68];
    const int tid = threadIdx.x, tx = tid & 15, ty = tid >> 4;
    const int m0 = blockIdx.y * 64, n0 = blockIdx.x * 64;
    float acc[4][4], acc2[4][4];
#pragma unroll
    for (int i = 0; i < 4; ++i)
#pragma unroll
        for (int j = 0; j < 4; ++j) { acc[i][j] = 0.f; acc2[i][j] = 0.f; }
    const int nseg = (MODE == 1) ? 2 : 1;
    for (int seg = 0; seg < nseg; ++seg) {
        const bf16* A = seg ? g.A2 : g.A; const float* Bm = seg ? g.B2 : g.B;
        const int ncol = (MODE == 0) ? (n0 + (n0 >= 5120 ? 8 : 0)) : n0;
        for (int k0 = 0; k0 < g.K; k0 += 16) {
            { const int r = tid >> 2, kq = (tid & 3) * 4; const ushort4 a = *(const ushort4*)(A + (size_t)(m0 + r) * g.lda + k0 + kq);
              As[kq + 0][r] = bf2f(a.x); As[kq + 1][r] = bf2f(a.y); As[kq + 2][r] = bf2f(a.z); As[kq + 3][r] = bf2f(a.w); }
            { const int k = tid >> 4, n4 = (tid & 15) * 4; const float4 bv = *(const float4*)(Bm + (size_t)(k0 + k) * g.ldb + ncol + n4);
              Bs[k][n4 + 0] = bv.x; Bs[k][n4 + 1] = bv.y; Bs[k][n4 + 2] = bv.z; Bs[k][n4 + 3] = bv.w; }
            __syncthreads();
#pragma unroll
            for (int k = 0; k < 16; ++k) {
                const float4 a = *(const float4*)&As[k][ty * 4]; const float4 bq = *(const float4*)&Bs[k][tx * 4];
                const float av[4] = {a.x, a.y, a.z, a.w}, bv[4] = {bq.x, bq.y, bq.z, bq.w};
                if (seg == 0) {
#pragma unroll
                    for (int i = 0; i < 4; ++i)
#pragma unroll
                        for (int j = 0; j < 4; ++j) acc[i][j] += av[i] * bv[j];
                } else {
#pragma unroll
                    for (int i = 0; i < 4; ++i)
#pragma unroll
                        for (int j = 0; j < 4; ++j) acc2[i][j] += av[i] * bv[j];
                }
            }
            __syncthreads();
        }
    }
#pragma unroll
    for (int i = 0; i < 4; ++i) {
        const int row = m0 + ty * 4 + i;
#pragma unroll
        for (int j = 0; j < 4; ++j) {
            const int col = n0 + tx * 4 + j;
            if (MODE == 0) g.Ob[(size_t)row * g.ldo + col] = f2bf(acc[i][j]);
            else if (MODE == 1) {
                const float gm = bf2f(g.proj[(size_t)row * NP + C_GM + col]), ga = bf2f(g.proj[(size_t)row * NP + C_GA + col]);
                g.Ob[(size_t)row * g.ldo + col] = f2bf(sigmoidf_(gm) * acc[i][j] + sigmoidf_(ga) * acc2[i][j]);
            } else {
                const int b = row / S;
                g.Of[(size_t)row * D + col] = g.x[(size_t)row * D + col] + g.mod[b * 3 * D + 2 * D + col] * acc[i][j];
            }
        }
    }
}

__global__ void __launch_bounds__(256) k_conv(const bf16* __restrict__ proj, const float* __restrict__ conv_w, const float* __restrict__ conv_b, bf16* __restrict__ qc, bf16* __restrict__ kc) {
    const size_t idx = (size_t)blockIdx.x * 256 + threadIdx.x;
    const int c = (int)(idx % 2048); const int row = (int)(idx / 2048); const int t = row % S;
    float o = conv_b[c];
#pragma unroll
    for (int tap = 0; tap < 4; ++tap) { const int tt = t - 3 + tap; if (tt >= 0) o += bf2f(proj[(size_t)(row - 3 + tap) * NP + c]) * conv_w[tap * 2048 + c]; }
    o = siluf_(o);
    if (c < 1024) qc[(size_t)row * 1024 + c] = f2bf(o); else kc[(size_t)row * 1024 + c - 1024] = f2bf(o * 0.0625f);
}

__global__ void __launch_bounds__(256) k_mlstm(const bf16* __restrict__ qc, const bf16* __restrict__ kc, const bf16* __restrict__ proj, const float* __restrict__ gates, float* __restrict__ hbuf) {
    const int w = blockIdx.x * 4 + (threadIdx.x >> 6), lane = threadIdx.x & 63;
    const int v = w & 255, h = (w >> 8) & 3, b = w >> 10;
    float C[4] = {0.f, 0.f, 0.f, 0.f}, n[4] = {0.f, 0.f, 0.f, 0.f};
    for (int t = 0; t < S; ++t) {
        const size_t row = (size_t)b * S + t;
        const ushort4 q4 = *(const ushort4*)(qc + row * 1024 + h * 256 + lane * 4);
        const ushort4 k4 = *(const ushort4*)(kc + row * 1024 + h * 256 + lane * 4);
        const float vv = bf2f(proj[row * NP + C_MV + h * 256 + v]);
        const float ig = gates[row * 8 + h], lf = gates[row * 8 + 4 + h];
        const float f = expf(lf), iv = expf(ig);
        const float kf[4] = {bf2f(k4.x), bf2f(k4.y), bf2f(k4.z), bf2f(k4.w)}, qf[4] = {bf2f(q4.x), bf2f(q4.y), bf2f(q4.z), bf2f(q4.w)};
        float num = 0.f, den = 0.f;
#pragma unroll
        for (int e = 0; e < 4; ++e) { n[e] = f * n[e] + iv * kf[e]; C[e] = f * C[e] + (iv * vv) * kf[e]; num += C[e] * qf[e]; den += n[e] * qf[e]; }
        num = wave_sum(num); den = wave_sum(den);
        if (lane == 0) hbuf[row * 1024 + h * 256 + v] = num / fmaxf(fabsf(den), 1.f);
    }
}
__global__ void __launch_bounds__(256) k_mpost(const float* __restrict__ hbuf, const bf16* __restrict__ proj, const float* __restrict__ mh_norm_g, bf16* __restrict__ ym) {
    const int w = blockIdx.x * 4 + (threadIdx.x >> 6), lane = threadIdx.x & 63;
    const int h = w & 3; const size_t row = w >> 2;
    const float4 hv = *(const float4*)(hbuf + row * 1024 + h * 256 + lane * 4);
    float ss = hv.x * hv.x + hv.y * hv.y + hv.z * hv.z + hv.w * hv.w;
    ss = wave_sum(ss);
    const float r = 1.0f / sqrtf(ss * (1.f / 256.f) + EPS);
    const float hh[4] = {hv.x, hv.y, hv.z, hv.w};
    ushort4 o; bf16 ov[4];
#pragma unroll
    for (int e = 0; e < 4; ++e) {
        const int c = h * 256 + lane * 4 + e;
        const float mo = bf2f(proj[row * NP + C_MO + c]), mz = bf2f(proj[row * NP + C_MZ + c]);
        ov[e] = f2bf(hh[e] * r * mh_norm_g[c] * sigmoidf_(mo) * siluf_(mz));
    }
    o.x = ov[0]; o.y = ov[1]; o.z = ov[2]; o.w = ov[3];
    *(ushort4*)(ym + row * 1024 + h * 256 + lane * 4) = o;
}

__global__ void __launch_bounds__(256) k_attn(const bf16* __restrict__ proj, const float* __restrict__ rel_bias, bf16* __restrict__ ya) {
    __shared__ float sq[4][128];
    const int wid = threadIdx.x >> 6, lane = threadIdx.x & 63;
    const int w = blockIdx.x * 4 + wid; const int hh = w & 7; const int row = w >> 3; const int b = row / S, t = row % S, j = t >> 6;
    { const unsigned qq = *(const unsigned*)(proj + (size_t)row * NP + C_AQ + hh * 128 + 2 * lane);
      sq[wid][2 * lane] = bf2f((bf16)(qq & 0xffff)) * 0.08838834764831845f; sq[wid][2 * lane + 1] = bf2f((bf16)(qq >> 16)) * 0.08838834764831845f; }
    __syncthreads();
    const int jlo = j > 8 ? j - 8 : 0; const int kstart = jlo * 64; const int nt = j - jlo + 1;
    float sc[9];
#pragma unroll
    for (int i = 0; i < 9; ++i) {
        sc[i] = -INFINITY;
        if (i < nt) {
            const int kpos = kstart + i * 64 + lane; const bf16* kr = proj + (size_t)(b * S + kpos) * NP + C_AK + hh * 128;
            float s = 0.f;
#pragma unroll
            for (int d8 = 0; d8 < 16; ++d8) { const uint4 kk = *(const uint4*)(kr + d8 * 8); const unsigned kw[4] = {kk.x, kk.y, kk.z, kk.w};
#pragma unroll
                for (int e = 0; e < 4; ++e) { s += sq[wid][d8 * 8 + 2 * e] * bf2f((bf16)(kw[e] & 0xffff)) + sq[wid][d8 * 8 + 2 * e + 1] * bf2f((bf16)(kw[e] >> 16)); } }
            int dist = t - kpos; dist = dist < -63 ? -63 : (dist > 128 ? 128 : dist);
            sc[i] = s + rel_bias[hh * 192 + dist + 63];
        }
    }
    float mx = sc[0];
#pragma unroll
    for (int i = 1; i < 9; ++i) mx = fmaxf(mx, sc[i]);
    mx = wave_max(mx);
    float l = 0.f;
#pragma unroll
    for (int i = 0; i < 9; ++i) { sc[i] = (i < nt) ? __expf(sc[i] - mx) : 0.f; l += sc[i]; }
    l = wave_sum(l);
    float o0 = 0.f, o1 = 0.f;
#pragma unroll
    for (int i = 0; i < 9; ++i) {
        if (i < nt) {
            const bf16* vr = proj + (size_t)(b * S + kstart + i * 64) * NP + C_AV + hh * 128 + 2 * lane;
            for (int kk = 0; kk < 64; ++kk) { const float p = __shfl(sc[i], kk); const unsigned vv = *(const unsigned*)(vr + (size_t)kk * NP);
                o0 += p * bf2f((bf16)(vv & 0xffff)); o1 += p * bf2f((bf16)(vv >> 16)); }
        }
    }
    const float inv = 1.f / l;
    const unsigned zz = *(const unsigned*)(proj + (size_t)row * NP + C_AZ + hh * 128 + 2 * lane);
    const float z0 = bf2f((bf16)(zz & 0xffff)), z1 = bf2f((bf16)(zz >> 16));
    const unsigned r = (unsigned)f2bf(o0 * inv * siluf_(z0)) | ((unsigned)f2bf(o1 * inv * siluf_(z1)) << 16);
    *(unsigned*)(ya + (size_t)row * 1024 + hh * 128 + 2 * lane) = r;
}

__global__ void __launch_bounds__(256) k_final(float* __restrict__ out, const float* __restrict__ g) {
    const int row = blockIdx.x * 4 + (threadIdx.x >> 6), lane = threadIdx.x & 63;
    float4* xr = (float4*)(out + (size_t)row * D);
    float4 v[8]; float ss = 0.f;
#pragma unroll
    for (int j = 0; j < 8; ++j) { v[j] = xr[lane + 64 * j]; ss += v[j].x * v[j].x + v[j].y * v[j].y + v[j].z * v[j].z + v[j].w * v[j].w; }
    ss = wave_sum(ss);
    const float r = 1.0f / sqrtf(ss * (1.f / D) + EPS);
#pragma unroll
    for (int j = 0; j < 8; ++j) { const float4 gg = ((const float4*)g)[lane + 64 * j]; float4 o; o.x = v[j].x * r * gg.x; o.y = v[j].y * r * gg.y; o.z = v[j].z * r * gg.z; o.w = v[j].w * r * gg.w; xr[lane + 64 * j] = o; }
}

namespace pg8 {
#define PG8_LAS __attribute__((address_space(3)))
typedef unsigned short bf16_t;
typedef short bf16x8 __attribute__((ext_vector_type(8)));
typedef float f32x4 __attribute__((ext_vector_type(4)));
typedef unsigned u32x4 __attribute__((ext_vector_type(4)));
constexpr int BM = 256, BK = 64, HALF = 128, HTB = HALF * BK * 2  , STAGE_BYTES = 8 * HTB, NXCD = 8, WGM = 8;

__host__ __device__ __forceinline__ int lds_byte(int r, int c) { const int st = (r >> 4) * 2 + (c >> 5), rr = r & 15, cc = c & 31, ob = rr * 64 + cc * 2; return st * 1024 + (ob ^ (((ob >> 9) & 1) << 5)); }
__host__ __device__ __forceinline__ void stage_rc(int b, int& R, int& C) { const int st = b / 1024, sb = b % 1024, swz = sb ^ (((sb >> 9) & 1) << 5); R = (st >> 1) * 16 + swz / 64; C = (st & 1) * 32 + (swz % 64) / 2; }
__host__ __device__ __forceinline__ int perm32(int rho) { const int n = rho >> 4, i = rho & 15; return 8 * (i >> 2) + 4 * n + (i & 3); }

struct Unit { int pm, pn, seg; };
struct Gemm { const bf16_t* A0; const bf16_t* A1; const bf16_t* B0; const bf16_t* B1; int lda, K; };

struct StaticOrder {
    int nM, nN, nwg, G, c;
    __host__ __device__ void init(int M, int N, int G_, int c_) { nM = M / BM; nN = N / BM; nwg = nM * nN; G = G_; c = c_; }
    __host__ __device__ bool next(int i, Unit& u) const {
        const long L = (long)i * G + c; if (L >= nwg) return false;
        int wgid = (int)L; { const int q = nwg / NXCD, r = nwg % NXCD, xcd = wgid % NXCD, off = wgid / NXCD; wgid = (xcd < r ? xcd * (q + 1) : r * (q + 1) + (xcd - r) * q) + off; }
        const int nig = WGM * nN, gid = wgid / nig, fm = gid * WGM, gsz = (nM - fm) < WGM ? (nM - fm) : WGM;
        u.pm = fm + ((wgid % nig) % gsz); u.pn = (wgid % nig) / gsz; u.seg = 0; return true;
    }
    __device__ __forceinline__ void a_ready(const Unit&) const {}
    __device__ __forceinline__ void done(const Unit&) const {}
};

__device__ __forceinline__ unsigned cvt_pk_bf16(float lo, float hi) { unsigned r; asm volatile("v_cvt_pk_bf16_f32 %0, %1, %2" : "=v"(r) : "v"(lo), "v"(hi)); return r; }
typedef float f32x2 __attribute__((ext_vector_type(2)));
template <class Epi, class Sched, bool ALIGN_EPI = false, bool SP2 = false>
__device__ __forceinline__ void gemm_phase(PG8_LAS unsigned char* lds, const Gemm g, const Sched& S, const Epi& E) {
    const int tid = threadIdx.x, wid = __builtin_amdgcn_readfirstlane(tid >> 6), lane = tid & 63, wr = wid >> 2, wc = wid & 3, fr = lane & 15, fq = lane >> 4;
    const int K = g.K, nt = K / BK;
    unsigned voffA[2], voffB[2];
#pragma unroll
    for (int i = 0; i < 2; ++i) { int R, C; stage_rc(tid * 16 + i * 8192, R, C); const int Rb = Epi::PERM ? ((R & ~31) + perm32(R & 31)) : R;
        voffA[i] = (unsigned)(R * g.lda + C) * 2u; voffB[i] = (unsigned)(Rb * K + C) * 2u; }
    const size_t kstep = (size_t)(BK * 2);
    const size_t hstepA = (size_t)HALF * g.lda * 2, hstepB = (size_t)HALF * K * 2;
    const size_t tstepA = 2 * hstepA, tstepB = 2 * hstepB;
    const unsigned ldsw = (unsigned)wid * 1024u;
    const int aoff = lds_byte(wr * 64 + fr, fq * 8), boff = lds_byte(wc * 32 + fr, fq * 8);
#define PG8_SA(b, h) (((b) * 2 + (h)) * HTB)
#define PG8_SB(b, h) ((4 + (b) * 2 + (h)) * HTB)
#define PG8_STAGE(bufoff, gbase, voff) do { _Pragma("unroll") for (int _i = 0; _i < 2; ++_i) \
        __builtin_amdgcn_global_load_lds((const unsigned*)((const char*)(gbase) + (voff)[_i]), (PG8_LAS unsigned*)(lds + (bufoff) + ldsw + _i * 8192), 16, 0, 0); } while (0)
#define PG8_LDA(dst, b, h) do { _Pragma("unroll") for (int m = 0; m < 4; ++m) _Pragma("unroll") for (int k = 0; k < 2; ++k) dst[m][k] = *(const PG8_LAS bf16x8*)(lds + PG8_SA(b, h) + aoff + m * 2048 + k * 1024); } while (0)
#define PG8_LDB(dst, b, h) do { _Pragma("unroll") for (int n = 0; n < 2; ++n) _Pragma("unroll") for (int k = 0; k < 2; ++k) dst[n][k] = *(const PG8_LAS bf16x8*)(lds + PG8_SB(b, h) + boff + n * 2048 + k * 1024); } while (0)
#define PG8_MMA(ai, bj, At, Bt) do { __builtin_amdgcn_s_setprio(1); _Pragma("unroll") for (int m = 0; m < 4; ++m) _Pragma("unroll") for (int n = 0; n < 2; ++n) _Pragma("unroll") for (int k = 0; k < 2; ++k) \
        acc[ai][bj][m][n] = __builtin_amdgcn_mfma_f32_16x16x32_bf16(Bt[n][k], At[m][k], acc[ai][bj][m][n], 0, 0, 0); __builtin_amdgcn_s_setprio(0); } while (0)
#define PG8_WAIT_V(n) asm volatile("s_waitcnt vmcnt(" #n ")" ::: "memory")
#define PG8_WAIT_L(n) asm volatile("s_waitcnt lgkmcnt(" #n ")" ::: "memory")
#define PG8_BAR __builtin_amdgcn_s_barrier()
#define PG8_SCHED __builtin_amdgcn_sched_barrier(0)
    Unit cur, nxt; int ui = 0;
    if (!S.next(0, cur)) return;
    f32x4 acc[2][2][4][2];
#pragma unroll
    for (int a = 0; a < 2; ++a)
#pragma unroll
        for (int b = 0; b < 2; ++b)
#pragma unroll
            for (int m = 0; m < 4; ++m)
#pragma unroll
                for (int n = 0; n < 2; ++n) acc[a][b][m][n] = (f32x4){0.f, 0.f, 0.f, 0.f};
    bf16x8 At[4][2], B0[2][2], B1[2][2];
    const char* cA = (const char*)(cur.seg ? g.A1 : g.A0) + (size_t)cur.pm * tstepA; const char* cB = (const char*)(cur.seg ? g.B1 : g.B0) + (size_t)cur.pn * tstepB;
    S.a_ready(cur);
    if constexpr (SP2) {
        PG8_STAGE(PG8_SB(0, 0), cB, voffB); PG8_STAGE(PG8_SB(0, 1), cB + hstepB, voffB); PG8_STAGE(PG8_SA(0, 0), cA, voffA); PG8_STAGE(PG8_SA(0, 1), cA + hstepA, voffA);
        if (wr == 1) PG8_BAR;
        PG8_WAIT_V(2); PG8_BAR;
        PG8_STAGE(PG8_SB(1, 0), cB + kstep, voffB); PG8_STAGE(PG8_SA(1, 0), cA + kstep, voffA); PG8_STAGE(PG8_SB(1, 1), cB + hstepB + kstep, voffB);
        PG8_WAIT_V(6); PG8_BAR;
    } else {
        PG8_STAGE(PG8_SB(0, 0), cB, voffB); PG8_STAGE(PG8_SA(0, 0), cA, voffA); PG8_STAGE(PG8_SB(0, 1), cB + hstepB, voffB); PG8_STAGE(PG8_SA(0, 1), cA + hstepA, voffA);
        if (wr == 1) PG8_BAR;
        PG8_WAIT_V(4); PG8_BAR;
        PG8_STAGE(PG8_SB(1, 0), cB + kstep, voffB); PG8_STAGE(PG8_SA(1, 0), cA + kstep, voffA); PG8_STAGE(PG8_SB(1, 1), cB + hstepB + kstep, voffB);
        PG8_WAIT_V(6); PG8_BAR;
    }
    for (;;) {
        const bool has_next = S.next(ui + 1, nxt);
        const char* nA = has_next ? (const char*)(nxt.seg ? g.A1 : g.A0) + (size_t)nxt.pm * tstepA : cA; const char* nB = has_next ? (const char*)(nxt.seg ? g.B1 : g.B0) + (size_t)nxt.pn * tstepB : cB;
        for (int t = 0; t < nt; t += 2) {
            const bool last = (t == nt - 2);
            const char* a1 = cA + (size_t)(t + 1) * kstep;
            const char* a2 = last ? nA : cA + (size_t)(t + 2) * kstep; const char* b2 = last ? nB : cB + (size_t)(t + 2) * kstep;
            const char* a3 = a2 + kstep; const char* b3 = b2 + kstep;
            if (last && has_next) S.a_ready(nxt);
            if constexpr (SP2) {
            PG8_LDB(B0, 0, 0); PG8_LDB(B1, 0, 1); PG8_SCHED; PG8_LDA(At, 0, 0); PG8_STAGE(PG8_SA(1, 1), a1 + hstepA, voffA);
            PG8_WAIT_V(8); PG8_WAIT_L(0); PG8_BAR; PG8_MMA(0, 0, At, B0); PG8_MMA(0, 1, At, B1); PG8_BAR; PG8_SCHED;
            PG8_LDA(At, 0, 1); PG8_STAGE(PG8_SB(0, 0), b2, voffB); PG8_STAGE(PG8_SB(0, 1), b2 + hstepB, voffB); PG8_STAGE(PG8_SA(0, 0), a2, voffA);
            PG8_WAIT_V(8); PG8_WAIT_L(0); PG8_BAR; PG8_MMA(1, 0, At, B0); PG8_MMA(1, 1, At, B1); PG8_BAR; PG8_SCHED;
            PG8_LDB(B0, 1, 0); PG8_LDB(B1, 1, 1); PG8_SCHED; PG8_LDA(At, 1, 0); PG8_STAGE(PG8_SA(0, 1), a2 + hstepA, voffA);
            PG8_WAIT_V(8); PG8_WAIT_L(0); PG8_BAR; PG8_MMA(0, 0, At, B0); PG8_MMA(0, 1, At, B1); PG8_BAR; PG8_SCHED;
            PG8_LDA(At, 1, 1); PG8_STAGE(PG8_SB(1, 0), b3, voffB); PG8_STAGE(PG8_SB(1, 1), b3 + hstepB, voffB); PG8_STAGE(PG8_SA(1, 0), a3, voffA);
            PG8_WAIT_V(8); PG8_WAIT_L(0); PG8_BAR; PG8_MMA(1, 0, At, B0); PG8_MMA(1, 1, At, B1); PG8_BAR; PG8_SCHED;
            } else {
            PG8_LDB(B0, 0, 0); PG8_SCHED; PG8_LDA(At, 0, 0); PG8_STAGE(PG8_SA(1, 1), a1 + hstepA, voffA);
            PG8_WAIT_L(8); PG8_BAR; PG8_WAIT_L(0); PG8_MMA(0, 0, At, B0); PG8_BAR; PG8_SCHED;
            PG8_LDB(B1, 0, 1); PG8_STAGE(PG8_SB(0, 0), b2, voffB);
            PG8_BAR; PG8_WAIT_L(0); PG8_MMA(0, 1, At, B1); PG8_BAR;
            PG8_LDA(At, 0, 1); PG8_STAGE(PG8_SA(0, 0), a2, voffA);
            PG8_BAR; PG8_WAIT_L(0); PG8_MMA(1, 0, At, B0); PG8_BAR; PG8_SCHED;
            PG8_STAGE(PG8_SB(0, 1), b2 + hstepB, voffB);
            PG8_WAIT_V(6); PG8_BAR; PG8_MMA(1, 1, At, B1); PG8_BAR;
            PG8_LDB(B0, 1, 0); PG8_SCHED; PG8_LDA(At, 1, 0); PG8_STAGE(PG8_SA(0, 1), a2 + hstepA, voffA);
            PG8_WAIT_L(8); PG8_BAR; PG8_WAIT_L(0); PG8_MMA(0, 0, At, B0); PG8_BAR; PG8_SCHED;
            PG8_LDB(B1, 1, 1); PG8_STAGE(PG8_SB(1, 0), b3, voffB);
            PG8_BAR; PG8_WAIT_L(0); PG8_MMA(0, 1, At, B1); PG8_BAR;
            PG8_LDA(At, 1, 1); PG8_STAGE(PG8_SA(1, 0), a3, voffA);
            PG8_BAR; PG8_WAIT_L(0); PG8_MMA(1, 0, At, B0); PG8_BAR; PG8_SCHED;
            PG8_STAGE(PG8_SB(1, 1), b3 + hstepB, voffB);
            PG8_WAIT_V(6); PG8_BAR; PG8_MMA(1, 1, At, B1); PG8_BAR;
            }
        }
        if constexpr (ALIGN_EPI) { if (wr == 0) PG8_BAR; }
        if constexpr (!Epi::AFTER_DRAIN) { E(acc, cur, wr, wc, fr, fq); S.done(cur); }
        if (!has_next) break;
        if (E.zero_after(cur)) {
#pragma unroll
        for (int a = 0; a < 2; ++a)
#pragma unroll
            for (int b = 0; b < 2; ++b)
#pragma unroll
                for (int m = 0; m < 4; ++m)
#pragma unroll
                    for (int n = 0; n < 2; ++n) acc[a][b][m][n] = (f32x4){0.f, 0.f, 0.f, 0.f};
        }
        cur = nxt; cA = nA; cB = nB; ++ui;
        if constexpr (ALIGN_EPI) { if (wr == 1) PG8_BAR; }
    }
    PG8_WAIT_V(0);
    if constexpr (!ALIGN_EPI) { if (wr == 0) PG8_BAR; }
    PG8_BAR;
    if constexpr (Epi::AFTER_DRAIN) { E.fused(acc, cur, wr, wc, fr, fq, lds, wid, lane); S.done(cur); }
#undef PG8_SA
#undef PG8_SB
#undef PG8_STAGE
#undef PG8_LDA
#undef PG8_LDB
#undef PG8_MMA
#undef PG8_WAIT_V
#undef PG8_WAIT_L
#undef PG8_BAR
#undef PG8_SCHED
}
}

namespace pg8 {
typedef unsigned u32x4_ __attribute__((ext_vector_type(4)));
struct EpiProj {
    static constexpr bool PERM = true, AFTER_DRAIN = false;
    bf16_t* O; int ldc;
    __device__ __forceinline__ bool zero_after(const Unit&) const { return true; }
    __device__ __forceinline__ void operator()(f32x4 (&acc)[2][2][4][2], const Unit& u, int wr, int wc, int fr, int fq) const {
        const int row0 = u.pm * BM + wr * 64 + fr, col0 = u.pn * BM + wc * 32 + 8 * fq;
#pragma unroll
        for (int ai = 0; ai < 2; ++ai)
#pragma unroll
            for (int m = 0; m < 4; ++m) { bf16_t* rowp = O + (size_t)(row0 + ai * HALF + m * 16) * ldc + col0;
#pragma unroll
                for (int bj = 0; bj < 2; ++bj) { const f32x4 v0 = acc[ai][bj][m][0], v1 = acc[ai][bj][m][1];
                    u32x4 w; w.x = cvt_pk_bf16(v0[0], v0[1]); w.y = cvt_pk_bf16(v0[2], v0[3]); w.z = cvt_pk_bf16(v1[0], v1[1]); w.w = cvt_pk_bf16(v1[2], v1[3]);
                    *(u32x4*)(rowp + bj * HALF) = w; } }
    }
};
struct SegOrder {
    StaticOrder base;
    __device__ __forceinline__ bool next(int i, Unit& u) const { if (!base.next(i >> 1, u)) return false; u.seg = i & 1; return true; }
    __device__ __forceinline__ void a_ready(const Unit&) const {}
    __device__ __forceinline__ void done(const Unit&) const {}
};
__device__ __forceinline__ float bfw(unsigned w, int half) { return __builtin_bit_cast(float, half ? (w & 0xffff0000u) : (w << 16)); }
struct EpiMerge {
    static constexpr bool PERM = true, AFTER_DRAIN = false;
    const bf16_t* proj; int ldp, cgm, cga; bf16_t* O; int ldo;
    __device__ __forceinline__ bool zero_after(const Unit& u) const { return u.seg != 0; }
    __device__ __forceinline__ void operator()(f32x4 (&acc)[2][2][4][2], const Unit& u, int wr, int wc, int fr, int fq) const {
        const int row0 = u.pm * BM + wr * 64 + fr, col0 = u.pn * BM + wc * 32 + 8 * fq;
#pragma unroll
        for (int ai = 0; ai < 2; ++ai)
#pragma unroll
            for (int m = 0; m < 4; ++m) { const size_t row = (size_t)(row0 + ai * HALF + m * 16);
#pragma unroll
                for (int bj = 0; bj < 2; ++bj) {
                    const u32x4 ga4 = *(const u32x4*)(proj + row * ldp + cga + col0 + bj * HALF);
                    if (u.seg == 0) {
                        const u32x4 gm4 = *(const u32x4*)(proj + row * ldp + cgm + col0 + bj * HALF);
#pragma unroll
                        for (int e = 0; e < 8; ++e) { const float gm = bfw(gm4[e >> 1], e & 1), ga = bfw(ga4[e >> 1], e & 1);
                            acc[ai][bj][m][e >> 2][e & 3] *= (1.f + __expf(-ga)) * __builtin_amdgcn_rcpf(1.f + __expf(-gm)); }
                    } else {
                        float o[8];
#pragma unroll
                        for (int e = 0; e < 8; ++e) { const float ga = bfw(ga4[e >> 1], e & 1); o[e] = acc[ai][bj][m][e >> 2][e & 3] * __builtin_amdgcn_rcpf(1.f + __expf(-ga)); }
                        u32x4 w; w.x = cvt_pk_bf16(o[0], o[1]); w.y = cvt_pk_bf16(o[2], o[3]); w.z = cvt_pk_bf16(o[4], o[5]); w.w = cvt_pk_bf16(o[6], o[7]);
                        *(u32x4*)(O + row * ldo + col0 + bj * HALF) = w;
                    }
                }
                if (m & 1) asm volatile("" ::: "memory"); }
    }
};
struct EpiOut {
    static constexpr bool PERM = false, AFTER_DRAIN = false;
    const float* x; const float* gate; float* out; float* rowss; int ldc, rows_per_batch, gate_stride;
    __device__ __forceinline__ bool zero_after(const Unit&) const { return true; }
    __device__ __forceinline__ void operator()(f32x4 (&acc)[2][2][4][2], const Unit& u, int wr, int wc, int fr, int fq) const {
        const int row0 = u.pm * BM + wr * 64 + fr, col0 = u.pn * BM + wc * 32 + 4 * fq;
        const float* gp = gate + (size_t)((u.pm * BM) / rows_per_batch) * gate_stride + col0;
        f32x4 gt[2][2];
#pragma unroll
        for (int bj = 0; bj < 2; ++bj)
#pragma unroll
            for (int n = 0; n < 2; ++n) gt[bj][n] = *(const f32x4*)(gp + bj * HALF + n * 16);
#pragma unroll
        for (int ai = 0; ai < 2; ++ai)
#pragma unroll
            for (int m = 0; m < 4; ++m) { const int row = row0 + ai * HALF + m * 16; const size_t off = (size_t)row * ldc + col0; float ssq = 0.f;
#pragma unroll
                for (int bj = 0; bj < 2; ++bj)
#pragma unroll
                    for (int n = 0; n < 2; ++n) { const f32x4 xv = *(const f32x4*)(x + off + bj * HALF + n * 16); const f32x4 o = xv + gt[bj][n] * acc[ai][bj][m][n];
                        ssq += (o[0] * o[0] + o[1] * o[1]) + (o[2] * o[2] + o[3] * o[3]); *(f32x4*)(out + off + bj * HALF + n * 16) = o; }
                ssq += __shfl_xor(ssq, 16); ssq += __shfl_xor(ssq, 32);
                if (fq == 0) atomicAdd(rowss + row, ssq);
                if (m & 1) asm volatile("" ::: "memory"); }
    }
};
}

#define REP_P0 1
#define REP_P1 1
#define REP_P2 1
#define REP_U1X 1
#define REP_WRK 1
#define REP_ATT 1
#define REP_POST 1
#define REP_P4 1
#define LAS __attribute__((address_space(3)))
typedef unsigned v4u __attribute__((ext_vector_type(4)));
typedef float f4 __attribute__((ext_vector_type(4)));
constexpr size_t MiB = 1u << 20;
constexpr size_t WS_PROJ = 0;
constexpr size_t WS_YM = 416 * MiB;
constexpr size_t WS_YA = 448 * MiB;
constexpr size_t WS_WPM = 480 * MiB;
constexpr size_t WS_WPA = 484 * MiB;
constexpr size_t WS_WOUT = 488 * MiB;
constexpr size_t WS_MODP = 496 * MiB;
constexpr size_t WS_MOD = 497 * MiB;
constexpr size_t WS_GATES = 498 * MiB;
constexpr size_t WS_ROWSS = 499 * MiB;
constexpr size_t WS_SUMM = WS_ROWSS + 65536;
constexpr size_t WS_WC = WS_SUMM + 8192;
constexpr size_t WS_RSUM = WS_ROWSS + 131072;
constexpr size_t WS_WINT = WS_RSUM + 262144;
constexpr size_t WS_MCOMB = WS_WINT + 262144;
constexpr size_t WS_NINT = WS_MCOMB + 262144;
constexpr size_t WS_VONES = 501 * MiB;
constexpr size_t WS_END = 510 * MiB;
static_assert(WS_NINT + 262144 <= WS_VONES && WS_VONES + (size_t)8 * 8192 * 64 * 2 <= WS_END, "d_ws map");
constexpr size_t OB_QC = 0, OB_KC = 32 * MiB, OB_IB = 64 * MiB, OB_NT = 96 * MiB;
constexpr size_t OB_H = 0;
constexpr size_t OB_WIN = 64 * MiB;
constexpr int NWAVES = 8, LDS_BYTES = 147456;

struct MArgs { const float* in[15]; float* out; unsigned char* ws; int ph_lo, ph_hi; };

__device__ __forceinline__ unsigned pk2(float lo, float hi) { return (unsigned)f2bf(lo) | ((unsigned)f2bf(hi) << 16); }
#define LDS_WAIT() asm volatile("s_waitcnt lgkmcnt(0)" ::: "memory")

__device__ __forceinline__ void transpose_item(const float* __restrict__ W, int ldw, int ncol_src0, bf16* __restrict__ WT, int K, int nrow_dst0, int k0, LAS float* scr, int lane) {
#pragma unroll 8
    for (int i = 0; i < 32; ++i) { const int kk = 2 * i + (lane >> 5); scr[kk * 33 + (lane & 31)] = W[(size_t)(k0 + kk) * ldw + ncol_src0 + (lane & 31)]; }
    LDS_WAIT();
    const int c = lane & 7;
#pragma unroll
    for (int j = 0; j < 4; ++j) { const int n = (lane >> 3) + 8 * j; const LAS float* s = scr + (8 * c) * 33 + n;
        v4u o; o.x = pk2(s[0 * 33], s[1 * 33]); o.y = pk2(s[2 * 33], s[3 * 33]); o.z = pk2(s[4 * 33], s[5 * 33]); o.w = pk2(s[6 * 33], s[7 * 33]);
        *(v4u*)(WT + (size_t)(nrow_dst0 + n) * K + k0 + 8 * c) = o; }
    LDS_WAIT();
}

typedef short bf16x8 __attribute__((ext_vector_type(8)));
typedef short s16x4 __attribute__((ext_vector_type(4)));
typedef float f32x16 __attribute__((ext_vector_type(16)));
typedef float f32x2_t __attribute__((ext_vector_type(2)));
typedef __bf16 bf16x2_t __attribute__((ext_vector_type(2)));
__device__ __forceinline__ unsigned cvtpk(float lo, float hi) { f32x2_t v = {lo, hi}; bf16x2_t b = __builtin_convertvector(v, bf16x2_t); return __builtin_bit_cast(unsigned, b); }
__device__ __forceinline__ s16x4 tr_read(const LAS unsigned char* p) { return __builtin_bit_cast(s16x4, __builtin_amdgcn_ds_read_tr16_b64_v4i16((LAS s16x4*)p)); }
constexpr int AT_KP = 272, AT_VP = 320, AT_KBUF = 64 * AT_KP, AT_VBUF = 64 * AT_VP, AT_VOFF = 2 * AT_KBUF, AT_BIAS = AT_VOFF + 2 * AT_VBUF, AT_LDS = AT_BIAS + 768;
constexpr float LOG2E = 1.4426950408889634f;

__device__ __forceinline__ void attn_unit(LAS unsigned char* lds, const bf16* __restrict__ proj, const float* __restrict__ rel_bias, bf16* __restrict__ ya, int b, int h, int g4, int tid, int lane, int wave) {
    const int j0 = 4 * g4, half = wave & 1, jq = j0 + (wave >> 1);
    const int r32 = lane & 31, hb = lane >> 5;
    const int tq = 64 * jq + 32 * half + r32;
    const size_t rowq = (size_t)b * S + tq;
    LAS float* biasL = (LAS float*)(lds + AT_BIAS);
    if (tid < 192) biasL[tid] = rel_bias[h * 192 + tid] * LOG2E;
    bf16x8 qf[8];
#pragma unroll
    for (int ks = 0; ks < 8; ++ks) qf[ks] = *(const bf16x8*)(proj + rowq * NP + C_AQ + h * 128 + 16 * ks + 8 * hb);
    f32x16 o[4];
#pragma unroll
    for (int dt = 0; dt < 4; ++dt)
#pragma unroll
        for (int r = 0; r < 16; ++r) o[dt][r] = 0.f;
    float m_run = -1e30f, l_run = 0.f;
    const int t0 = j0 > 8 ? j0 - 8 : 0, nt = j0 + 3 - t0 + 1;
    const int srow = tid >> 4, sc16 = tid & 15;
    const bf16* gsrc = proj + ((size_t)b * S + srow) * NP + h * 128 + sc16 * 8;
    v4u kr0, kr1, vr0, vr1;
#define AT_GLOAD(tc) do { const bf16* g_ = gsrc + (size_t)(64 * (tc)) * NP; kr0 = *(const v4u*)(g_ + C_AK); vr0 = *(const v4u*)(g_ + C_AV); kr1 = *(const v4u*)(g_ + (size_t)32 * NP + C_AK); vr1 = *(const v4u*)(g_ + (size_t)32 * NP + C_AV); } while (0)
#define AT_LWRITE(buf) do { LAS unsigned char* k_ = lds + (buf) * AT_KBUF + srow * AT_KP + sc16 * 16; LAS unsigned char* v_ = lds + AT_VOFF + (buf) * AT_VBUF + srow * AT_VP + sc16 * 16; \
        *(LAS v4u*)k_ = kr0; *(LAS v4u*)(k_ + 32 * AT_KP) = kr1; *(LAS v4u*)v_ = vr0; *(LAS v4u*)(v_ + 32 * AT_VP) = vr1; } while (0)
    AT_GLOAD(t0); AT_LWRITE(0);
    __syncthreads();
    const float SC = 0.08838834764831845f * LOG2E;
    for (int i = 0; i < nt; ++i) {
        const int tc = t0 + i, buf = i & 1;
        if (i + 1 < nt) AT_GLOAD(tc + 1);
        const int cdiff = jq - tc;
        if (cdiff >= 0 && cdiff <= 8) {
            const LAS unsigned char* Kb = lds + buf * AT_KBUF + r32 * AT_KP + hb * 16;
            f32x16 s0, s1;
#pragma unroll
            for (int r = 0; r < 16; ++r) { s0[r] = 0.f; s1[r] = 0.f; }
#pragma unroll
            for (int ks = 0; ks < 8; ++ks) {
                const bf16x8 k0 = *(const LAS bf16x8*)(Kb + ks * 32), k1 = *(const LAS bf16x8*)(Kb + 32 * AT_KP + ks * 32);
                s0 = __builtin_amdgcn_mfma_f32_32x32x16_bf16(k0, qf[ks], s0, 0, 0, 0);
                s1 = __builtin_amdgcn_mfma_f32_32x32x16_bf16(k1, qf[ks], s1, 0, 0, 0);
            }
            if (cdiff >= 3) { const float bc = biasL[191];
#pragma unroll
                for (int r = 0; r < 16; ++r) { s0[r] = s0[r] * SC + bc; s1[r] = s1[r] * SC + bc; }
            } else { const int base = 64 * cdiff + 32 * half + r32 + 63 - 4 * hb;
#pragma unroll
                for (int r = 0; r < 16; ++r) { const int i0 = base - ((r & 3) + 8 * (r >> 2)), i1 = i0 - 32;
                    s0[r] = s0[r] * SC + biasL[i0 > 191 ? 191 : i0]; s1[r] = s1[r] * SC + biasL[i1 > 191 ? 191 : i1]; }
            }
            float mx = fmaxf(s0[0], s1[0]);
#pragma unroll
            for (int r = 1; r < 16; ++r) mx = fmaxf(mx, fmaxf(s0[r], s1[r]));
            mx = fmaxf(mx, __shfl_xor(mx, 32));
            const float m_new = fmaxf(m_run, mx), alpha = __builtin_amdgcn_exp2f(m_run - m_new); m_run = m_new;
            float ls = 0.f;
#pragma unroll
            for (int r = 0; r < 16; ++r) { s0[r] = __builtin_amdgcn_exp2f(s0[r] - m_new); s1[r] = __builtin_amdgcn_exp2f(s1[r] - m_new); ls += s0[r] + s1[r]; }
            l_run = l_run * alpha + ls;
#pragma unroll
            for (int dt = 0; dt < 4; ++dt)
#pragma unroll
                for (int r = 0; r < 16; ++r) o[dt][r] *= alpha;
            v4u pw[4];
            pw[0] = (v4u){cvtpk(s0[0], s0[1]), cvtpk(s0[2], s0[3]), cvtpk(s0[4], s0[5]), cvtpk(s0[6], s0[7])};
            pw[1] = (v4u){cvtpk(s0[8], s0[9]), cvtpk(s0[10], s0[11]), cvtpk(s0[12], s0[13]), cvtpk(s0[14], s0[15])};
            pw[2] = (v4u){cvtpk(s1[0], s1[1]), cvtpk(s1[2], s1[3]), cvtpk(s1[4], s1[5]), cvtpk(s1[6], s1[7])};
            pw[3] = (v4u){cvtpk(s1[8], s1[9]), cvtpk(s1[10], s1[11]), cvtpk(s1[12], s1[13]), cvtpk(s1[14], s1[15])};
            const LAS unsigned char* Vb = lds + AT_VOFF + buf * AT_VBUF + (4 * hb + ((lane & 15) >> 2)) * AT_VP + (16 * ((lane >> 4) & 1) + 4 * (lane & 3)) * 2;
#pragma unroll
            for (int q = 0; q < 4; ++q) {
#pragma unroll
                for (int dt = 0; dt < 4; ++dt) {
                    const s16x4 lo = tr_read(Vb + (16 * q) * AT_VP + dt * 64), hi = tr_read(Vb + (16 * q + 8) * AT_VP + dt * 64);
                    const bf16x8 vf = (bf16x8){lo[0], lo[1], lo[2], lo[3], hi[0], hi[1], hi[2], hi[3]};
                    o[dt] = __builtin_amdgcn_mfma_f32_32x32x16_bf16(vf, __builtin_bit_cast(bf16x8, pw[q]), o[dt], 0, 0, 0);
                }
            }
        }
        if (i + 1 < nt) AT_LWRITE(buf ^ 1);
        __syncthreads();
    }
#undef AT_GLOAD
#undef AT_LWRITE
    const float linv = 1.f / (l_run + __shfl_xor(l_run, 32));
#pragma unroll
    for (int dt = 0; dt < 4; ++dt)
#pragma unroll
        for (int rq = 0; rq < 4; ++rq) {
            const int d0 = 32 * dt + 8 * rq + 4 * hb;
            const uint2 zz = *(const uint2*)(proj + rowq * NP + C_AZ + h * 128 + d0);
            const float z0 = __builtin_bit_cast(float, zz.x << 16), z1 = __builtin_bit_cast(float, zz.x & 0xffff0000u), z2 = __builtin_bit_cast(float, zz.y << 16), z3 = __builtin_bit_cast(float, zz.y & 0xffff0000u);
            uint2 w; w.x = cvtpk(o[dt][4 * rq + 0] * linv * siluf_(z0), o[dt][4 * rq + 1] * linv * siluf_(z1)); w.y = cvtpk(o[dt][4 * rq + 2] * linv * siluf_(z2), o[dt][4 * rq + 3] * linv * siluf_(z3));
            *(uint2*)(ya + rowq * 1024 + h * 128 + d0) = w;
        }
}

using pg8::bfw;
typedef float f32x4_ __attribute__((ext_vector_type(4)));
typedef unsigned u2v __attribute__((ext_vector_type(2)));
#define MFMA16(a, b, c) __builtin_amdgcn_mfma_f32_16x16x32_bf16((a), (b), (c), 0, 0, 0)
__device__ __forceinline__ float wave_scan_add(float x, int lane) {
#pragma unroll
    for (int o = 1; o < 64; o <<= 1) { const float t = __shfl_up(x, o); if (lane >= o) x += t; }
    return x;
}
__device__ __forceinline__ float wave_scan_max(float x, int lane) {
#pragma unroll
    for (int o = 1; o < 64; o <<= 1) { const float t = __shfl_up(x, o); if (lane >= o) x = fmaxf(x, t); }
    return x;
}
__device__ __forceinline__ void mlstm_summary(const float* __restrict__ gates, float* __restrict__ summ, int bh, int j, int lane) {
    const size_t row = (size_t)(bh >> 2) * S + 64 * j + lane; const int h = bh & 3;
    const float ig = gates[row * 8 + h], lf = gates[row * 8 + 4 + h];
    const float bc = wave_scan_add(lf, lane); const float b_last = __shfl(bc, 63);
    const float gmax = wave_max(b_last - bc + ig);
    if (lane == 0) { summ[(bh * 128 + j) * 2] = b_last; summ[(bh * 128 + j) * 2 + 1] = gmax; }
}
constexpr int U1_QP = 528, U1_VP = 576, U1_SP = 144;
constexpr int U1_QCL = 0, U1_KCL = 64 * U1_QP, U1_VL = 2 * 64 * U1_QP, U1_SWL = U1_VL + 64 * U1_VP, U1_SCAL = U1_SWL + 64 * U1_SP, U1_LDS = U1_SCAL + 3 * 256;
struct MlBufs { bf16* proj; const float* gates; const float* summ; const float* conv_w; const float* conv_b; bf16* QC; bf16* KC; bf16* IB; bf16* NT; float* rowsum; float* winter; float* mcomb; float* wc; float* ninter; bf16* vones; };

__device__ __forceinline__ void mlstm_u1_unit(LAS unsigned char* lds, const MlBufs& B, int b, int h, int j, int tid, int lane, int wave) {
    const int bh = b * 4 + h; const size_t rowb = (size_t)b * S + 64 * j;
    LAS float* sA = (LAS float*)(lds + U1_SCAL); LAS float* sC = sA + 64; LAS float* sWk = sA + 128;
    __syncthreads();
    if (wave == 0) {
        const size_t row = rowb + lane;
        const float ig = B.gates[row * 8 + h], lf = B.gates[row * 8 + 4 + h];
        const float bc = wave_scan_add(lf, lane); const float b_last = __shfl(bc, 63);
        const float a_s = ig - bc; const float pm = wave_scan_max(a_s, lane);
        const float gg = b_last - bc + ig; const float gmax = wave_max(gg);
        float m_prev = 0.f;
        if (j > 0) {
            const float bl0 = B.summ[(bh * 128 + lane) * 2], gm0 = B.summ[(bh * 128 + lane) * 2 + 1], bl1 = B.summ[(bh * 128 + 64 + lane) * 2], gm1 = B.summ[(bh * 128 + 64 + lane) * 2 + 1];
            const float P0 = wave_scan_add(bl0, lane); const float tot0 = __shfl(P0, 63); const float P1 = wave_scan_add(bl1, lane) + tot0;
            const int jm = j - 1;
            const float e0 = (lane <= jm) ? gm0 - P0 : -INFINITY, e1 = (lane + 64 <= jm) ? gm1 - P1 : -INFINITY;
            const float emax = wave_max(fmaxf(e0, e1));
            const float Bjm = (jm < 64) ? __shfl(P0, jm) : __shfl(P1, jm - 64);
            m_prev = Bjm + fmaxf(0.f, emax);
        }
        const float m_j = fmaxf(b_last + m_prev, gmax);
        const float c_t = fmaxf(pm, m_prev);
        sA[lane] = a_s; sC[lane] = c_t; sWk[lane] = __expf(gg - m_j);
        B.winter[row * 4 + h] = __expf(m_prev - c_t); B.mcomb[row * 4 + h] = bc + c_t;
        if (lane == 0) B.wc[bh * 128 + j] = __expf(b_last + m_prev - m_j);
    }
    {
        const int cg = tid & 63, tg = tid >> 6, isk = cg >> 5, c8 = (cg & 31) * 8, chan = isk * 1024 + h * 256 + c8;
        const bf16* src = B.proj + (rowb + 8 * tg - 3) * NP + (isk ? C_MK : C_MQ) + h * 256 + c8;
        float wv[4][8], bv[8];
#pragma unroll
        for (int tap = 0; tap < 4; ++tap) { const f4 w0 = *(const f4*)(B.conv_w + tap * 2048 + chan), w1 = *(const f4*)(B.conv_w + tap * 2048 + chan + 4);
            wv[tap][0] = w0[0]; wv[tap][1] = w0[1]; wv[tap][2] = w0[2]; wv[tap][3] = w0[3]; wv[tap][4] = w1[0]; wv[tap][5] = w1[1]; wv[tap][6] = w1[2]; wv[tap][7] = w1[3]; }
        { const f4 b0 = *(const f4*)(B.conv_b + chan), b1 = *(const f4*)(B.conv_b + chan + 4); bv[0] = b0[0]; bv[1] = b0[1]; bv[2] = b0[2]; bv[3] = b0[3]; bv[4] = b1[0]; bv[5] = b1[1]; bv[6] = b1[2]; bv[7] = b1[3]; }
        v4u raw[11];
#pragma unroll
        for (int i = 0; i < 11; ++i) { const int tt = 64 * j + 8 * tg - 3 + i; raw[i] = (tt >= 0) ? *(const v4u*)(src + (size_t)i * NP) : (v4u){0u, 0u, 0u, 0u}; }
        const float osc = isk ? 0.0625f : 1.f;
        LAS unsigned char* ldst = lds + (isk ? U1_KCL : U1_QCL) + (8 * tg) * U1_QP + c8 * 2;
        bf16* gdst = (isk ? B.KC : B.QC) + (rowb + 8 * tg) * 1024 + h * 256 + c8;
#pragma unroll
        for (int t8 = 0; t8 < 8; ++t8) {
            float o[8];
#pragma unroll
            for (int e = 0; e < 8; ++e) { float acc = bv[e];
#pragma unroll
                for (int tap = 0; tap < 4; ++tap) acc += wv[tap][e] * bfw(raw[t8 + tap][e >> 1], e & 1);
                o[e] = siluf_(acc) * osc; }
            const v4u w = (v4u){cvtpk(o[0], o[1]), cvtpk(o[2], o[3]), cvtpk(o[4], o[5]), cvtpk(o[6], o[7])};
            *(LAS v4u*)(ldst + t8 * U1_QP) = w; *(v4u*)(gdst + (size_t)t8 * 1024) = w;
        }
    }
    v4u vraw[4];
#pragma unroll
    for (int i = 0; i < 4; ++i) { const int ch = tid + 512 * i, row = ch >> 5, c16 = ch & 31; vraw[i] = *(const v4u*)(B.proj + (rowb + row) * NP + C_MV + h * 256 + c16 * 8);
        *(LAS v4u*)(lds + U1_VL + row * U1_VP + c16 * 16) = vraw[i]; }
    if (tid < 128) *(LAS v4u*)(lds + U1_VL + (tid >> 1) * U1_VP + 512 + (tid & 1) * 16) = (tid & 1) ? (v4u){0u, 0u, 0u, 0u} : (v4u){0x00003F80u, 0u, 0u, 0u};
    __syncthreads();
    const int fr = lane & 15, g = lane >> 4;
    {
        const int tt = wave & 3, st0 = 2 * (wave >> 2);
        f32x4_ sacc[2] = {{0.f, 0.f, 0.f, 0.f}, {0.f, 0.f, 0.f, 0.f}};
#pragma unroll
        for (int ks = 0; ks < 8; ++ks) {
            const bf16x8 bq = *(const LAS bf16x8*)(lds + U1_QCL + (16 * tt + fr) * U1_QP + (32 * ks + 8 * g) * 2);
#pragma unroll
            for (int i = 0; i < 2; ++i) { const bf16x8 ak = *(const LAS bf16x8*)(lds + U1_KCL + (16 * (st0 + i) + fr) * U1_QP + (32 * ks + 8 * g) * 2); sacc[i] = MFMA16(ak, bq, sacc[i]); }
        }
        const int t = 16 * tt + fr; const float c_t = sC[t];
#pragma unroll
        for (int i = 0; i < 2; ++i) { const int s0 = 16 * (st0 + i) + 4 * g; const f4 a4 = *(const LAS f4*)(sA + s0);
            float o[4];
#pragma unroll
            for (int r = 0; r < 4; ++r) o[r] = (s0 + r <= t) ? sacc[i][r] * __expf(a4[r] - c_t) : 0.f;
            u2v w; w.x = cvtpk(o[0], o[1]); w.y = cvtpk(o[2], o[3]);
            *(LAS u2v*)(lds + U1_SWL + t * U1_SP + s0 * 2) = w; }
    }
    __syncthreads();
    {
        const int nvt = (wave == 0) ? 3 : 2;
        for (int iv = 0; iv < nvt; ++iv) {
            const int vt = (iv == 2) ? 16 : 2 * wave + iv;
            f32x4_ ia[4] = {{0.f, 0.f, 0.f, 0.f}, {0.f, 0.f, 0.f, 0.f}, {0.f, 0.f, 0.f, 0.f}, {0.f, 0.f, 0.f, 0.f}};
#pragma unroll
            for (int ks = 0; ks < 2; ++ks) {
                const LAS unsigned char* va = lds + U1_VL + (32 * ks + 8 * g + ((lane & 15) >> 2)) * U1_VP + (16 * vt + 4 * (lane & 3)) * 2;
                const s16x4 lo = tr_read(va), hi = tr_read(va + 4 * U1_VP);
                const bf16x8 af = (bf16x8){lo[0], lo[1], lo[2], lo[3], hi[0], hi[1], hi[2], hi[3]};
#pragma unroll
                for (int tt = 0; tt < 4; ++tt) { const bf16x8 bs = *(const LAS bf16x8*)(lds + U1_SWL + (16 * tt + fr) * U1_SP + (32 * ks + 8 * g) * 2); ia[tt] = MFMA16(af, bs, ia[tt]); }
            }
#pragma unroll
            for (int tt = 0; tt < 4; ++tt) { const size_t row = rowb + 16 * tt + fr;
                if (vt < 16) { uint2 w; w.x = cvtpk(ia[tt][0], ia[tt][1]); w.y = cvtpk(ia[tt][2], ia[tt][3]); *(uint2*)(B.IB + row * 1024 + h * 256 + 16 * vt + 4 * g) = w; }
                else if (g == 0) B.rowsum[row * 4 + h] = ia[tt][0]; }
        }
    }
#pragma unroll
    for (int i = 0; i < 4; ++i) { const int ch = tid + 512 * i, row = ch >> 5, c16 = ch & 31; const float wk = sWk[row]; v4u w;
#pragma unroll
        for (int e = 0; e < 4; ++e) w[e] = cvtpk(bfw(vraw[i][e], 0) * wk, bfw(vraw[i][e], 1) * wk);
        *(v4u*)(B.proj + (rowb + row) * NP + C_MV + h * 256 + c16 * 8) = w; }
    { const int srow = tid >> 3, c = tid & 7; const unsigned w0 = (c == 0) ? (unsigned)f2bf(sWk[srow]) : 0u;
      *(v4u*)(B.vones + ((size_t)bh * S + 64 * j + srow) * 64 + c * 8) = (v4u){w0, 0u, 0u, 0u}; }
}

constexpr int W_QP = 528, W_KP = 544, W_VP = 144, W_QL = 0, W_KL = 64 * W_QP, W_VL = W_KL + 64 * W_KP, W_LDS = W_VL + 64 * W_VP;
__device__ __forceinline__ void mlstm_worker(LAS unsigned char* lds, const MlBufs& B, int b, int h, int sl, int tid, int lane, int wave) {
    const int bh = b * 4 + h; const size_t rowb = (size_t)b * S;
    const bf16* vsrc = (sl < 4) ? (B.proj + rowb * NP + C_MV + h * 256 + 64 * sl) : (B.vones + (size_t)bh * S * 64);
    const size_t vpitch = (sl < 4) ? (size_t)NP : (size_t)64;
    const int fr = lane & 15, g = lane >> 4;
    f32x4_ Ct[16];
#pragma unroll
    for (int kt = 0; kt < 16; ++kt) Ct[kt] = (f32x4_){0.f, 0.f, 0.f, 0.f};
    v4u rq[4], rk[4], rv;
#define W_GLOAD(jj) do { _Pragma("unroll") for (int i_ = 0; i_ < 4; ++i_) { const int ch_ = tid + 512 * i_, row_ = ch_ >> 5, c16_ = ch_ & 31; const size_t o_ = (rowb + 64 * (jj) + row_) * 1024 + h * 256 + c16_ * 8; \
            rq[i_] = *(const v4u*)(B.QC + o_); rk[i_] = *(const v4u*)(B.KC + o_); } \
        rv = *(const v4u*)(vsrc + (size_t)(64 * (jj) + (tid >> 3)) * vpitch + (tid & 7) * 8); } while (0)
#define W_LWRITE() do { _Pragma("unroll") for (int i_ = 0; i_ < 4; ++i_) { const int ch_ = tid + 512 * i_, row_ = ch_ >> 5, c16_ = ch_ & 31; \
            *(LAS v4u*)(lds + W_QL + row_ * W_QP + c16_ * 16) = rq[i_]; *(LAS v4u*)(lds + W_KL + row_ * W_KP + c16_ * 16) = rk[i_]; } \
        *(LAS v4u*)(lds + W_VL + (tid >> 3) * W_VP + (tid & 7) * 16) = rv; } while (0)
    W_GLOAD(0);
    for (int j = 0; j < 128; ++j) {
        __syncthreads();
        W_LWRITE();
        if (j + 1 < 128) W_GLOAD(j + 1);
        __syncthreads();
        if (wave < 4) {
            const int vq = wave;
            const float w_c = B.wc[bh * 128 + j];
            f32x4_ ia[4] = {{0.f, 0.f, 0.f, 0.f}, {0.f, 0.f, 0.f, 0.f}, {0.f, 0.f, 0.f, 0.f}, {0.f, 0.f, 0.f, 0.f}};
#pragma unroll
            for (int kk = 0; kk < 8; ++kk) {
                const v4u cw = (v4u){cvtpk(Ct[2 * kk][0], Ct[2 * kk][1]), cvtpk(Ct[2 * kk][2], Ct[2 * kk][3]), cvtpk(Ct[2 * kk + 1][0], Ct[2 * kk + 1][1]), cvtpk(Ct[2 * kk + 1][2], Ct[2 * kk + 1][3])};
#pragma unroll
                for (int tt = 0; tt < 4; ++tt) { const LAS unsigned char* qa = lds + W_QL + (16 * tt + fr) * W_QP + (32 * kk + 4 * g) * 2;
                    const u2v lo = *(const LAS u2v*)qa, hi = *(const LAS u2v*)(qa + 32);
                    ia[tt] = MFMA16(__builtin_bit_cast(bf16x8, cw), __builtin_bit_cast(bf16x8, ((v4u){lo.x, lo.y, hi.x, hi.y})), ia[tt]); }
            }
#pragma unroll
            for (int tt = 0; tt < 4; ++tt) { const size_t row = rowb + 64 * j + 16 * tt + fr;
                if (sl < 4) { uint2 w; w.x = cvtpk(ia[tt][0], ia[tt][1]); w.y = cvtpk(ia[tt][2], ia[tt][3]); *(uint2*)(B.NT + row * 1024 + h * 256 + 64 * sl + 16 * vq + 4 * g) = w; }
                else if (vq == 0 && g == 0) B.ninter[row * 4 + h] = ia[tt][0]; }
#pragma unroll
            for (int kt = 0; kt < 16; ++kt) Ct[kt] *= w_c;
#pragma unroll
            for (int ks = 0; ks < 2; ++ks) {
                const LAS unsigned char* vb = lds + W_VL + (32 * ks + 8 * g + ((lane & 15) >> 2)) * W_VP + (16 * vq + 4 * (lane & 3)) * 2;
                const s16x4 vlo = tr_read(vb), vhi = tr_read(vb + 4 * W_VP);
                const bf16x8 bvf = (bf16x8){vlo[0], vlo[1], vlo[2], vlo[3], vhi[0], vhi[1], vhi[2], vhi[3]};
                const LAS unsigned char* ka = lds + W_KL + (32 * ks + 8 * g + ((lane & 15) >> 2)) * W_KP + (4 * (lane & 3)) * 2;
#pragma unroll
                for (int kt = 0; kt < 16; ++kt) { const s16x4 klo = tr_read(ka + kt * 32), khi = tr_read(ka + kt * 32 + 4 * W_KP);
                    const bf16x8 akf = (bf16x8){klo[0], klo[1], klo[2], klo[3], khi[0], khi[1], khi[2], khi[3]};
                    Ct[kt] = MFMA16(akf, bvf, Ct[kt]); }
            }
        }
    }
    __syncthreads();
#undef W_GLOAD
#undef W_LWRITE
}
__device__ __forceinline__ void mlstm_post_item(const MlBufs& B, const float* __restrict__ mh_norm_g, bf16* __restrict__ ym, size_t row, int h, int lane) {
    const uint2 iw = *(const uint2*)(B.IB + row * 1024 + h * 256 + lane * 4), nw = *(const uint2*)(B.NT + row * 1024 + h * 256 + lane * 4);
    const float wi = B.winter[row * 4 + h], den = B.rowsum[row * 4 + h] + wi * B.ninter[row * 4 + h];
    const float dinv = 1.f / fmaxf(fabsf(den), __expf(-B.mcomb[row * 4 + h]));
    float hv[4];
    hv[0] = (bfw(iw.x, 0) + wi * bfw(nw.x, 0)) * dinv; hv[1] = (bfw(iw.x, 1) + wi * bfw(nw.x, 1)) * dinv; hv[2] = (bfw(iw.y, 0) + wi * bfw(nw.y, 0)) * dinv; hv[3] = (bfw(iw.y, 1) + wi * bfw(nw.y, 1)) * dinv;
    const float ss = wave_sum(hv[0] * hv[0] + hv[1] * hv[1] + hv[2] * hv[2] + hv[3] * hv[3]);
    const float r = 1.0f / sqrtf(ss * (1.f / 256.f) + EPS);
    const int c = h * 256 + lane * 4;
    const uint2 mo = *(const uint2*)(B.proj + row * NP + C_MO + c), mz = *(const uint2*)(B.proj + row * NP + C_MZ + c);
    const f4 gn = *(const f4*)(mh_norm_g + c);
    uint2 w;
    w.x = cvtpk(hv[0] * r * gn[0] * sigmoidf_(bfw(mo.x, 0)) * siluf_(bfw(mz.x, 0)), hv[1] * r * gn[1] * sigmoidf_(bfw(mo.x, 1)) * siluf_(bfw(mz.x, 1)));
    w.y = cvtpk(hv[2] * r * gn[2] * sigmoidf_(bfw(mo.y, 0)) * siluf_(bfw(mz.y, 0)), hv[3] * r * gn[3] * sigmoidf_(bfw(mo.y, 1)) * siluf_(bfw(mz.y, 1)));
    *(uint2*)(ym + row * 1024 + h * 256 + lane * 4) = w;
}

__global__ void __launch_bounds__(NWAVES * 64, 2) mega(MArgs a) {
    extern __shared__ __attribute__((aligned(16))) unsigned char lds_raw[];
    LAS unsigned char* lds = (LAS unsigned char*)lds_raw;
    cg::grid_group grid = cg::this_grid();
    const int tid = threadIdx.x, lane = tid & 63, wave = __builtin_amdgcn_readfirstlane(tid >> 6);
    const int G = gridDim.x, gw = blockIdx.x * NWAVES + wave, NGW = G * NWAVES;
    const float* x = a.in[0]; const float* cvec = a.in[1]; const float* w_ada = a.in[2]; const float* b_ada = a.in[3]; const float* norm_g = a.in[4]; const float* w_in = a.in[5];
    const float* b_if = a.in[6]; const float* final_g = a.in[14]; const float* w_proj_m = a.in[11]; const float* w_proj_a = a.in[12]; const float* w_out = a.in[13];
    unsigned char* ws = a.ws; unsigned char* ob = (unsigned char*)a.out;
    bf16* proj = (bf16*)(ws + WS_PROJ); bf16* Wpm_t = (bf16*)(ws + WS_WPM); bf16* Wpa_t = (bf16*)(ws + WS_WPA); bf16* Wout_t = (bf16*)(ws + WS_WOUT);
    float* modp = (float*)(ws + WS_MODP); float* mod = (float*)(ws + WS_MOD); float* gates = (float*)(ws + WS_GATES); float* rowss = (float*)(ws + WS_ROWSS);
    bf16* ym = (bf16*)(ws + WS_YM); bf16* ya = (bf16*)(ws + WS_YA); bf16* merged = proj;
    bf16* H = (bf16*)(ob + OB_H); bf16* Win_t = (bf16*)(ob + OB_WIN);
    const int lo = a.ph_lo, hi = a.ph_hi;
#define IN(k) (lo <= (k) && (k) < hi)
#define BOTH(k) (IN(k) && IN((k) + 1))

    if (IN(0)) {
        LAS float* scr = (LAS float*)(lds + wave * 16384);
        constexpr int I_ADA = 16 * 24, I_IN = (D / 64) * (NP / 32), I_PM = (1024 / 64) * (D / 32), I_OUT = (D / 64) * (D / 32);
        constexpr int NITEMS = I_ADA + I_IN + 2 * I_PM + I_OUT;
        for (int rep = 0; rep < REP_P0; ++rep)
        for (int it = gw; it < NITEMS; it += NGW) {
            int r = it;
            if (r < I_ADA) {
                const int ks = r / 24, cb = r % 24, n0 = cb * 256 + lane * 4;
                float4 a0 = {0.f, 0.f, 0.f, 0.f}, a1 = {0.f, 0.f, 0.f, 0.f};
                if (ks == 0) { a0 = *(const float4*)(b_ada + n0); a1 = a0; }
#pragma unroll 8
                for (int kk = 0; kk < 128; ++kk) { const int k = ks * 128 + kk; const float4 w = *(const float4*)(w_ada + (size_t)k * (3 * D) + n0);
                    const float c0 = cvec[k], c1 = cvec[D + k]; const float s0 = c0 / (1.f + __expf(-c0)), s1 = c1 / (1.f + __expf(-c1));
                    a0.x += s0 * w.x; a0.y += s0 * w.y; a0.z += s0 * w.z; a0.w += s0 * w.w; a1.x += s1 * w.x; a1.y += s1 * w.y; a1.z += s1 * w.z; a1.w += s1 * w.w; }
                *(float4*)(modp + (size_t)(ks * 2 + 0) * (3 * D) + n0) = a0; *(float4*)(modp + (size_t)(ks * 2 + 1) * (3 * D) + n0) = a1;
                continue; }
            r -= I_ADA;
            if (r < I_IN) { const int nblk = NP / 32, kb = r / nblk, nb = r % nblk, nd = 32 * nb; transpose_item(w_in, INC, nd + (nd >= 5120 ? 8 : 0), Win_t, D, nd, 64 * kb, scr, lane); continue; }
            r -= I_IN;
            if (r < I_PM) { const int nblk = D / 32, kb = r / nblk, nb = r % nblk; transpose_item(w_proj_m, D, 32 * nb, Wpm_t, 1024, 32 * nb, 64 * kb, scr, lane); continue; }
            r -= I_PM;
            if (r < I_PM) { const int nblk = D / 32, kb = r / nblk, nb = r % nblk; transpose_item(w_proj_a, D, 32 * nb, Wpa_t, 1024, 32 * nb, 64 * kb, scr, lane); continue; }
            r -= I_PM;
            { const int nblk = D / 32, kb = r / nblk, nb = r % nblk; transpose_item(w_out, D, 32 * nb, Wout_t, D, 32 * nb, 64 * kb, scr, lane); }
        }
        if (BOTH(0)) grid.sync();
    }

    if (IN(1)) {
        LAS float* smod = (LAS float*)lds;
        LAS float* gwl = (LAS float*)(lds + 49152);
        for (int i = tid; i < 2 * 3 * D; i += NWAVES * 64) { float s = 0.f;
#pragma unroll
            for (int ks = 0; ks < 16; ++ks) s += modp[(size_t)ks * (2 * 3 * D) + i];
            smod[i] = s; if (blockIdx.x == 0) mod[i] = s; }
        for (int k = tid; k < D; k += NWAVES * 64) { const float4 w0 = *(const float4*)(w_in + (size_t)k * INC + 5120), w1 = *(const float4*)(w_in + (size_t)k * INC + 5124);
            gwl[0 * D + k] = w0.x; gwl[1 * D + k] = w0.y; gwl[2 * D + k] = w0.z; gwl[3 * D + k] = w0.w; gwl[4 * D + k] = w1.x; gwl[5 * D + k] = w1.y; gwl[6 * D + k] = w1.z; gwl[7 * D + k] = w1.w; }
        __syncthreads();
        for (int rep = 0; rep < REP_P1; ++rep)
        for (int row = gw; row < M; row += NGW) {
            const int b = row / S;
            const float4* xr = (const float4*)(x + (size_t)row * D);
            float4 v[8]; float ss = 0.f;
#pragma unroll
            for (int j = 0; j < 8; ++j) { v[j] = xr[lane + 64 * j]; ss += v[j].x * v[j].x + v[j].y * v[j].y + v[j].z * v[j].z + v[j].w * v[j].w; }
            ss = wave_sum(ss);
            const float rstd = 1.0f / sqrtf(ss * (1.f / D) + EPS);
            float acc[8];
#pragma unroll
            for (int i = 0; i < 8; ++i) acc[i] = 0.f;
            const LAS float* shift = smod + b * 3 * D; const LAS float* scale = shift + D;
#pragma unroll
            for (int j = 0; j < 8; ++j) {
                const int k0 = (lane + 64 * j) * 4;
                const f4 g4 = *(const f4*)(norm_g + k0); const f4 sc4 = *(const LAS f4*)(scale + k0); const f4 sh4 = *(const LAS f4*)(shift + k0);
                float4 h4; h4.x = v[j].x * rstd * g4.x * (1.f + sc4.x) + sh4.x; h4.y = v[j].y * rstd * g4.y * (1.f + sc4.y) + sh4.y; h4.z = v[j].z * rstd * g4.z * (1.f + sc4.z) + sh4.z; h4.w = v[j].w * rstd * g4.w * (1.f + sc4.w) + sh4.w;
#pragma unroll
                for (int i = 0; i < 8; ++i) { const f4 w4 = *(const LAS f4*)(gwl + i * D + k0); acc[i] += h4.x * w4.x + h4.y * w4.y + h4.z * w4.z + h4.w * w4.w; }
                uint2 o; o.x = pk2(h4.x, h4.y); o.y = pk2(h4.z, h4.w);
                *(uint2*)(H + (size_t)row * D + k0) = o;
                asm volatile("" ::: "memory");
            }
#pragma unroll
            for (int i = 0; i < 8; ++i) acc[i] = wave_sum(acc[i]);
            if (lane == 0) {
                rowss[row] = 0.f;
#pragma unroll
                for (int i = 0; i < 4; ++i) gates[(size_t)row * 8 + i] = acc[i] + b_if[i];
#pragma unroll
                for (int i = 4; i < 8; ++i) { const float z = acc[i] + b_if[i]; gates[(size_t)row * 8 + i] = fminf(z, 0.f) - log1pf(expf(-fabsf(z))); }
            }
        }
        __syncthreads();
        if (BOTH(1)) grid.sync();
    }

    if (IN(2)) {
        if (gw < 1024) mlstm_summary(gates, (float*)(ws + WS_SUMM), gw >> 7, gw & 127, lane);
        pg8::Gemm g{H, H, Win_t, Win_t, D, D}; pg8::StaticOrder So; So.init(M, NP, G, (int)blockIdx.x);
        pg8::EpiProj E{proj, NP};
        for (int rep = 0; rep < REP_P2; ++rep) pg8::gemm_phase<pg8::EpiProj, pg8::StaticOrder, true, true>(lds, g, So, E);
        if (BOTH(2)) grid.sync();
    }
    if (IN(3)) {
        MlBufs mb; mb.proj = proj; mb.gates = gates; mb.summ = (const float*)(ws + WS_SUMM); mb.conv_w = a.in[7]; mb.conv_b = a.in[8];
        mb.QC = (bf16*)(ob + OB_QC); mb.KC = (bf16*)(ob + OB_KC); mb.IB = (bf16*)(ob + OB_IB); mb.NT = (bf16*)(ob + OB_NT);
        mb.rowsum = (float*)(ws + WS_RSUM); mb.winter = (float*)(ws + WS_WINT); mb.mcomb = (float*)(ws + WS_MCOMB); mb.wc = (float*)(ws + WS_WC); mb.ninter = (float*)(ws + WS_NINT); mb.vones = (bf16*)(ws + WS_VONES);
        for (int u = blockIdx.x; u < 1024; u += G) mlstm_u1_unit(lds, mb, u >> 9, (u >> 7) & 3, u & 127, tid, lane, wave);
        grid.sync();
        for (int rep = 0; rep < REP_WRK; ++rep) if (blockIdx.x < 40) mlstm_worker(lds, mb, (blockIdx.x & 7) >> 2, blockIdx.x & 3, blockIdx.x >> 3, tid, lane, wave);
        for (int rep = 0; rep < REP_ATT; ++rep) for (int u = blockIdx.x; u < 512; u += G) attn_unit(lds, proj, a.in[10], ya, u >> 8, (u >> 5) & 7, u & 31, tid, lane, wave);
        grid.sync();
        for (int rep = 0; rep < REP_POST; ++rep) for (int it = gw; it < M * 4; it += NGW) mlstm_post_item(mb, a.in[9], ym, (size_t)(it >> 2), it & 3, lane);
        if (BOTH(3)) grid.sync();
    }
    if (IN(4)) {
        pg8::Gemm g{ym, ya, Wpm_t, Wpa_t, 1024, 1024}; pg8::SegOrder So; So.base.init(M, D, G, (int)blockIdx.x);
        pg8::EpiMerge E{proj, NP, C_GM, C_GA, merged, NP};
        for (int rep = 0; rep < REP_P4; ++rep) pg8::gemm_phase<pg8::EpiMerge, pg8::SegOrder, true, true>(lds, g, So, E);
        if (BOTH(4)) grid.sync();
    }
    if (IN(5)) {
        pg8::Gemm g{merged, merged, Wout_t, Wout_t, NP, D}; pg8::StaticOrder So; So.init(M, D, G, (int)blockIdx.x);
        pg8::EpiOut E{x, mod + 2 * D, a.out, rowss, D, S, 3 * D};
        pg8::gemm_phase<pg8::EpiOut, pg8::StaticOrder, true, true>(lds, g, So, E);
        if (BOTH(5)) grid.sync();
    }
    if (IN(6)) {
        for (int row = gw; row < M; row += NGW) {
            const float r = 1.0f / sqrtf(rowss[row] * (1.f / D) + EPS);
            f4* xr = (f4*)(a.out + (size_t)row * D);
#pragma unroll
            for (int j = 0; j < 8; ++j) { const f4 g4 = *(const f4*)(final_g + (lane + 64 * j) * 4); xr[lane + 64 * j] = xr[lane + 64 * j] * r * g4; }
        }
    }
#undef IN
#undef BOTH
}

static int launch_mega(const MArgs& a, hipStream_t stream) {
    static int grid = 0;
    if (grid == 0) {
        int dev = 0, cus = 0, per_cu = 0;
        if (hipGetDevice(&dev) != hipSuccess || hipDeviceGetAttribute(&cus, hipDeviceAttributeMultiprocessorCount, dev) != hipSuccess) { fprintf(stderr, "kernel_launch: device query failed\n"); grid = -1; return -1; }
        if (hipFuncSetAttribute((const void*)mega, hipFuncAttributeMaxDynamicSharedMemorySize, LDS_BYTES) != hipSuccess) { fprintf(stderr, "kernel_launch: hipFuncSetAttribute failed\n"); grid = -1; return -1; }
        if (hipOccupancyMaxActiveBlocksPerMultiprocessor(&per_cu, (const void*)mega, NWAVES * 64, LDS_BYTES) != hipSuccess || per_cu < 1) { fprintf(stderr, "kernel_launch: occupancy query says %d blocks/CU\n", per_cu); (void)hipGetLastError(); grid = -1; return -1; }
        grid = cus * (per_cu > 1 ? 1 : per_cu);
        fprintf(stderr, "kernel_launch: %d CUs, occupancy %d blocks/CU, grid %d\n", cus, per_cu, grid);
    }
    if (grid < 0) return -1;
    MArgs arg = a; void* args[] = {(void*)&arg};
    const hipError_t e = hipLaunchCooperativeKernel((const void*)mega, dim3(grid), dim3(NWAVES * 64), args, LDS_BYTES, stream);
    if (e != hipSuccess) { fprintf(stderr, "kernel_launch: cooperative launch failed: %s (grid %d)\n", hipGetErrorString(e), grid); return -1; }
    return 0;
}

extern "C" void kernel_launch(void* const* d_in, const int* in_sizes, int n_in, void* d_out, int out_size, void* d_ws, size_t ws_size, hipStream_t stream) {
    if (n_in != 15 || in_sizes[0] != M * D || out_size != M * D || ws_size < WS_END) { fprintf(stderr, "kernel_launch: unexpected shapes / workspace (%zu < %zu)\n", ws_size, (size_t)WS_END); return; }
    const float* x = (const float*)d_in[0];
    const float* conv_w = (const float*)d_in[7]; const float* conv_b = (const float*)d_in[8]; const float* mh_norm_g = (const float*)d_in[9]; const float* rel_bias = (const float*)d_in[10];
    const float* w_proj_m = (const float*)d_in[11]; const float* w_proj_a = (const float*)d_in[12]; const float* w_out = (const float*)d_in[13]; const float* final_g = (const float*)d_in[14];
    unsigned char* ws = (unsigned char*)d_ws;
    bf16* proj = (bf16*)(ws + WS_PROJ); bf16* ym = (bf16*)(ws + WS_YM); bf16* ya = (bf16*)(ws + WS_YA); float* mod = (float*)(ws + WS_MOD); float* gates = (float*)(ws + WS_GATES);
    unsigned char* ob = (unsigned char*)d_out;
    bf16* qc = (bf16*)ob; bf16* kc = (bf16*)(ob + 32 * MiB); float* hbuf = (float*)(ob + 64 * MiB);
    bf16* merged = proj;

    MArgs a{}; for (int i = 0; i < 15; ++i) a.in[i] = (const float*)d_in[i]; a.out = (float*)d_out; a.ws = (unsigned char*)d_ws; a.ph_lo = 0; a.ph_hi = 7;
    launch_mega(a, stream);
}
```

```cpp
#include <hip/hip_runtime.h>
#include <cstdio>
#include <cstdint>
#include <hip/hip_cooperative_groups.h>
namespace cg = cooperative_groups;

typedef unsigned short bf16;
constexpr int D = 2048, NB = 2, S = 8192, M = NB * S;
constexpr int INC = 13320, NP = 13312;
constexpr int C_MQ = 0, C_MK = 1024, C_MV = 2048, C_MO = 3072, C_MZ = 4096, C_AQ = 5120, C_AK = 6144, C_AV = 7168, C_AZ = 8192, C_GM = 9216, C_GA = 11264;
constexpr float EPS = 1e-6f;

__device__ __forceinline__ bf16 f2bf(float f) { unsigned u = __builtin_bit_cast(unsigned, f); return (bf16)((u + 0x7fffu + ((u >> 16) & 1u)) >> 16); }
__device__ __forceinline__ float bf2f(bf16 h) { return __builtin_bit_cast(float, (unsigned)h << 16); }
__device__ __forceinline__ float wave_sum(float v) {
#pragma unroll
    for (int o = 1; o < 64; o <<= 1) v += __shfl_xor(v, o);
    return v;
}
__device__ __forceinline__ float wave_max(float v) {
#pragma unroll
    for (int o = 1; o < 64; o <<= 1) v = fmaxf(v, __shfl_xor(v, o));
    return v;
}
__device__ __forceinline__ float sigmoidf_(float x) { return 1.f / (1.f + __expf(-x)); }
__device__ __forceinline__ float siluf_(float x) { return x / (1.f + __expf(-x)); }

__global__ void __launch_bounds__(256) k_ada(const float* __restrict__ c, const float* __restrict__ w_ada, const float* __restrict__ b_ada, float* __restrict__ mod) {
    __shared__ float sc[2][D];
    for (int i = threadIdx.x; i < 2 * D; i += 256) { float v = c[i]; sc[i / D][i % D] = v / (1.f + expf(-v)); }
    __syncthreads();
    const int n = blockIdx.x * 256 + threadIdx.x;
    float a0 = 0.f, a1 = 0.f;
    for (int k = 0; k < D; ++k) { const float w = w_ada[(size_t)k * (3 * D) + n]; a0 += sc[0][k] * w; a1 += sc[1][k] * w; }
    mod[n] = a0 + b_ada[n]; mod[3 * D + n] = a1 + b_ada[n];
}

__global__ void __launch_bounds__(256) k_norm(const float* __restrict__ x, const float* __restrict__ norm_g, const float* __restrict__ mod, const float* __restrict__ w_in,
                                              const float* __restrict__ b_if, bf16* __restrict__ H, float* __restrict__ gates) {
    const int row = blockIdx.x * 4 + (threadIdx.x >> 6), lane = threadIdx.x & 63, b = row / S;
    const float4* xr = (const float4*)(x + (size_t)row * D);
    float4 v[8]; float ss = 0.f;
#pragma unroll
    for (int j = 0; j < 8; ++j) { v[j] = xr[lane + 64 * j]; ss += v[j].x * v[j].x + v[j].y * v[j].y + v[j].z * v[j].z + v[j].w * v[j].w; }
    ss = wave_sum(ss);
    const float rstd = 1.0f / sqrtf(ss * (1.f / D) + EPS);
    float acc[8];
#pragma unroll
    for (int i = 0; i < 8; ++i) acc[i] = 0.f;
    const float* shift = mod + b * 3 * D; const float* scale = shift + D;
#pragma unroll
    for (int j = 0; j < 8; ++j) {
        const int k0 = (lane + 64 * j) * 4;
        const float xv[4] = {v[j].x, v[j].y, v[j].z, v[j].w};
        float hv[4];
#pragma unroll
        for (int e = 0; e < 4; ++e) {
            const int k = k0 + e;
            hv[e] = xv[e] * rstd * norm_g[k] * (1.f + scale[k]) + shift[k];
            const float4* wr = (const float4*)(w_in + (size_t)k * INC + 5120);
            const float4 w0 = wr[0], w1 = wr[1];
            acc[0] += hv[e] * w0.x; acc[1] += hv[e] * w0.y; acc[2] += hv[e] * w0.z; acc[3] += hv[e] * w0.w;
            acc[4] += hv[e] * w1.x; acc[5] += hv[e] * w1.y; acc[6] += hv[e] * w1.z; acc[7] += hv[e] * w1.w;
        }
        ushort4 o; o.x = f2bf(hv[0]); o.y = f2bf(hv[1]); o.z = f2bf(hv[2]); o.w = f2bf(hv[3]);
        *(ushort4*)(H + (size_t)row * D + k0) = o;
    }
#pragma unroll
    for (int i = 0; i < 8; ++i) acc[i] = wave_sum(acc[i]);
    if (lane == 0) {
#pragma unroll
        for (int i = 0; i < 4; ++i) gates[(size_t)row * 8 + i] = acc[i] + b_if[i];
#pragma unroll
        for (int i = 4; i < 8; ++i) { const float z = acc[i] + b_if[i]; gates[(size_t)row * 8 + i] = fminf(z, 0.f) - log1pf(expf(-fabsf(z))); }
    }
}

struct GemmArgs { const bf16* A; const bf16* A2; const float* B; const float* B2; int lda, ldb, K; bf16* Ob; int ldo; float* Of; const bf16* proj; const float* x; const float* mod; };
template <int MODE> __global__ void __launch_bounds__(256) k_gemm(GemmArgs g) {
    __shared__ float As[16][68]; __shared__ float Bs[16][68];
    const int tid = threadIdx.x, tx = tid & 15, ty = tid >> 4;
    const int m0 = blockIdx.y * 64, n0 = blockIdx.x * 64;
    float acc[4][4], acc2[4][4];
#pragma unroll
    for (int i = 0; i < 4; ++i)
#pragma unroll
        for (int j = 0; j < 4; ++j) { acc[i][j] = 0.f; acc2[i][j] = 0.f; }
    const int nseg = (MODE == 1) ? 2 : 1;
    for (int seg = 0; seg < nseg; ++seg) {
        const bf16* A = seg ? g.A2 : g.A; const float* Bm = seg ? g.B2 : g.B;
        const int ncol = (MODE == 0) ? (n0 + (n0 >= 5120 ? 8 : 0)) : n0;
        for (int k0 = 0; k0 < g.K; k0 += 16) {
            { const int r = tid >> 2, kq = (tid & 3) * 4; const ushort4 a = *(const ushort4*)(A + (size_t)(m0 + r) * g.lda + k0 + kq);
              As[kq + 0][r] = bf2f(a.x); As[kq + 1][r] = bf2f(a.y); As[kq + 2][r] = bf2f(a.z); As[kq + 3][r] = bf2f(a.w); }
            { const int k = tid >> 4, n4 = (tid & 15) * 4; const float4 bv = *(const float4*)(Bm + (size_t)(k0 + k) * g.ldb + ncol + n4);
              Bs[k][n4 + 0] = bv.x; Bs[k][n4 + 1] = bv.y; Bs[k][n4 + 2] = bv.z; Bs[k][n4 + 3] = bv.w; }
            __syncthreads();
#pragma unroll
            for (int k = 0; k < 16; ++k) {
                const float4 a = *(const float4*)&As[k][ty * 4]; const float4 bq = *(const float4*)&Bs[k][tx * 4];
                const float av[4] = {a.x, a.y, a.z, a.w}, bv[4] = {bq.x, bq.y, bq.z, bq.w};
                if (seg == 0) {
#pragma unroll
                    for (int i = 0; i < 4; ++i)
#pragma unroll
                        for (int j = 0; j < 4; ++j) acc[i][j] += av[i] * bv[j];
                } else {
#pragma unroll
                    for (int i = 0; i < 4; ++i)
#pragma unroll
                        for (int j = 0; j < 4; ++j) acc2[i][j] += av[i] * bv[j];
                }
            }
            __syncthreads();
        }
    }
#pragma unroll
    for (int i = 0; i < 4; ++i) {
        const int row = m0 + ty * 4 + i;
#pragma unroll
        for (int j = 0; j < 4; ++j) {
            const int col = n0 + tx * 4 + j;
            if (MODE == 0) g.Ob[(size_t)row * g.ldo + col] = f2bf(acc[i][j]);
            else if (MODE == 1) {
                const float gm = bf2f(g.proj[(size_t)row * NP + C_GM + col]), ga = bf2f(g.proj[(size_t)row * NP + C_GA + col]);
                g.Ob[(size_t)row * g.ldo + col] = f2bf(sigmoidf_(gm) * acc[i][j] + sigmoidf_(ga) * acc2[i][j]);
            } else {
                const int b = row / S;
                g.Of[(size_t)row * D + col] = g.x[(size_t)row * D + col] + g.mod[b * 3 * D + 2 * D + col] * acc[i][j];
            }
        }
    }
}

__global__ void __launch_bounds__(256) k_conv(const bf16* __restrict__ proj, const float* __restrict__ conv_w, const float* __restrict__ conv_b, bf16* __restrict__ qc, bf16* __restrict__ kc) {
    const size_t idx = (size_t)blockIdx.x * 256 + threadIdx.x;
    const int c = (int)(idx % 2048); const int row = (int)(idx / 2048); const int t = row % S;
    float o = conv_b[c];
#pragma unroll
    for (int tap = 0; tap < 4; ++tap) { const int tt = t - 3 + tap; if (tt >= 0) o += bf2f(proj[(size_t)(row - 3 + tap) * NP + c]) * conv_w[tap * 2048 + c]; }
    o = siluf_(o);
    if (c < 1024) qc[(size_t)row * 1024 + c] = f2bf(o); else kc[(size_t)row * 1024 + c - 1024] = f2bf(o * 0.0625f);
}

__global__ void __launch_bounds__(256) k_mlstm(const bf16* __restrict__ qc, const bf16* __restrict__ kc, const bf16* __restrict__ proj, const float* __restrict__ gates, float* __restrict__ hbuf) {
    const int w = blockIdx.x * 4 + (threadIdx.x >> 6), lane = threadIdx.x & 63;
    const int v = w & 255, h = (w >> 8) & 3, b = w >> 10;
    float C[4] = {0.f, 0.f, 0.f, 0.f}, n[4] = {0.f, 0.f, 0.f, 0.f};
    for (int t = 0; t < S; ++t) {
        const size_t row = (size_t)b * S + t;
        const ushort4 q4 = *(const ushort4*)(qc + row * 1024 + h * 256 + lane * 4);
        const ushort4 k4 = *(const ushort4*)(kc + row * 1024 + h * 256 + lane * 4);
        const float vv = bf2f(proj[row * NP + C_MV + h * 256 + v]);
        const float ig = gates[row * 8 + h], lf = gates[row * 8 + 4 + h];
        const float f = expf(lf), iv = expf(ig);
        const float kf[4] = {bf2f(k4.x), bf2f(k4.y), bf2f(k4.z), bf2f(k4.w)}, qf[4] = {bf2f(q4.x), bf2f(q4.y), bf2f(q4.z), bf2f(q4.w)};
        float num = 0.f, den = 0.f;
#pragma unroll
        for (int e = 0; e < 4; ++e) { n[e] = f * n[e] + iv * kf[e]; C[e] = f * C[e] + (iv * vv) * kf[e]; num += C[e] * qf[e]; den += n[e] * qf[e]; }
        num = wave_sum(num); den = wave_sum(den);
        if (lane == 0) hbuf[row * 1024 + h * 256 + v] = num / fmaxf(fabsf(den), 1.f);
    }
}
__global__ void __launch_bounds__(256) k_mpost(const float* __restrict__ hbuf, const bf16* __restrict__ proj, const float* __restrict__ mh_norm_g, bf16* __restrict__ ym) {
    const int w = blockIdx.x * 4 + (threadIdx.x >> 6), lane = threadIdx.x & 63;
    const int h = w & 3; const size_t row = w >> 2;
    const float4 hv = *(const float4*)(hbuf + row * 1024 + h * 256 + lane * 4);
    float ss = hv.x * hv.x + hv.y * hv.y + hv.z * hv.z + hv.w * hv.w;
    ss = wave_sum(ss);
    const float r = 1.0f / sqrtf(ss * (1.f / 256.f) + EPS);
    const float hh[4] = {hv.x, hv.y, hv.z, hv.w};
    ushort4 o; bf16 ov[4];
#pragma unroll
    for (int e = 0; e < 4; ++e) {
        const int c = h * 256 + lane * 4 + e;
        const float mo = bf2f(proj[row * NP + C_MO + c]), mz = bf2f(proj[row * NP + C_MZ + c]);
        ov[e] = f2bf(hh[e] * r * mh_norm_g[c] * sigmoidf_(mo) * siluf_(mz));
    }
    o.x = ov[0]; o.y = ov[1]; o.z = ov[2]; o.w = ov[3];
    *(ushort4*)(ym + row * 1024 + h * 256 + lane * 4) = o;
}

__global__ void __launch_bounds__(256) k_attn(const bf16* __restrict__ proj, const float* __restrict__ rel_bias, bf16* __restrict__ ya) {
    __shared__ float sq[4][128];
    const int wid = threadIdx.x >> 6, lane = threadIdx.x & 63;
    const int w = blockIdx.x * 4 + wid; const int hh = w & 7; const int row = w >> 3; const int b = row / S, t = row % S, j = t >> 6;
    { const unsigned qq = *(const unsigned*)(proj + (size_t)row * NP + C_AQ + hh * 128 + 2 * lane);
      sq[wid][2 * lane] = bf2f((bf16)(qq & 0xffff)) * 0.08838834764831845f; sq[wid][2 * lane + 1] = bf2f((bf16)(qq >> 16)) * 0.08838834764831845f; }
    __syncthreads();
    const int jlo = j > 8 ? j - 8 : 0; const int kstart = jlo * 64; const int nt = j - jlo + 1;
    float sc[9];
#pragma unroll
    for (int i = 0; i < 9; ++i) {
        sc[i] = -INFINITY;
        if (i < nt) {
            const int kpos = kstart + i * 64 + lane; const bf16* kr = proj + (size_t)(b * S + kpos) * NP + C_AK + hh * 128;
            float s = 0.f;
#pragma unroll
            for (int d8 = 0; d8 < 16; ++d8) { const uint4 kk = *(const uint4*)(kr + d8 * 8); const unsigned kw[4] = {kk.x, kk.y, kk.z, kk.w};
#pragma unroll
                for (int e = 0; e < 4; ++e) { s += sq[wid][d8 * 8 + 2 * e] * bf2f((bf16)(kw[e] & 0xffff)) + sq[wid][d8 * 8 + 2 * e + 1] * bf2f((bf16)(kw[e] >> 16)); } }
            int dist = t - kpos; dist = dist < -63 ? -63 : (dist > 128 ? 128 : dist);
            sc[i] = s + rel_bias[hh * 192 + dist + 63];
        }
    }
    float mx = sc[0];
#pragma unroll
    for (int i = 1; i < 9; ++i) mx = fmaxf(mx, sc[i]);
    mx = wave_max(mx);
    float l = 0.f;
#pragma unroll
    for (int i = 0; i < 9; ++i) { sc[i] = (i < nt) ? __expf(sc[i] - mx) : 0.f; l += sc[i]; }
    l = wave_sum(l);
    float o0 = 0.f, o1 = 0.f;
#pragma unroll
    for (int i = 0; i < 9; ++i) {
        if (i < nt) {
            const bf16* vr = proj + (size_t)(b * S + kstart + i * 64) * NP + C_AV + hh * 128 + 2 * lane;
            for (int kk = 0; kk < 64; ++kk) { const float p = __shfl(sc[i], kk); const unsigned vv = *(const unsigned*)(vr + (size_t)kk * NP);
                o0 += p * bf2f((bf16)(vv & 0xffff)); o1 += p * bf2f((bf16)(vv >> 16)); }
        }
    }
    const float inv = 1.f / l;
    const unsigned zz = *(const unsigned*)(proj + (size_t)row * NP + C_AZ + hh * 128 + 2 * lane);
    const float z0 = bf2f((bf16)(zz & 0xffff)), z1 = bf2f((bf16)(zz >> 16));
    const unsigned r = (unsigned)f2bf(o0 * inv * siluf_(z0)) | ((unsigned)f2bf(o1 * inv * siluf_(z1)) << 16);
    *(unsigned*)(ya + (size_t)row * 1024 + hh * 128 + 2 * lane) = r;
}

__global__ void __launch_bounds__(256) k_final(float* __restrict__ out, const float* __restrict__ g) {
    const int row = blockIdx.x * 4 + (threadIdx.x >> 6), lane = threadIdx.x & 63;
    float4* xr = (float4*)(out + (size_t)row * D);
    float4 v[8]; float ss = 0.f;
#pragma unroll
    for (int j = 0; j < 8; ++j) { v[j] = xr[lane + 64 * j]; ss += v[j].x * v[j].x + v[j].y * v[j].y + v[j].z * v[j].z + v[j].w * v[j].w; }
    ss = wave_sum(ss);
    const float r = 1.0f / sqrtf(ss * (1.f / D) + EPS);
#pragma unroll
    for (int j = 0; j < 8; ++j) { const float4 gg = ((const float4*)g)[lane + 64 * j]; float4 o; o.x = v[j].x * r * gg.x; o.y = v[j].y * r * gg.y; o.z = v[j].z * r * gg.z; o.w = v[j].w * r * gg.w; xr[lane + 64 * j] = o; }
}

namespace pg8 {
#define PG8_LAS __attribute__((address_space(3)))
typedef unsigned short bf16_t;
typedef short bf16x8 __attribute__((ext_vector_type(8)));
typedef float f32x4 __attribute__((ext_vector_type(4)));
typedef unsigned u32x4 __attribute__((ext_vector_type(4)));
constexpr int BM = 256, BK = 64, HALF = 128, HTB = HALF * BK * 2  , STAGE_BYTES = 8 * HTB, NXCD = 8, WGM = 8;

__host__ __device__ __forceinline__ int lds_byte(int r, int c) { const int st = (r >> 4) * 2 + (c >> 5), rr = r & 15, cc = c & 31, ob = rr * 64 + cc * 2; return st * 1024 + (ob ^ (((ob >> 9) & 1) << 5)); }
__host__ __device__ __forceinline__ void stage_rc(int b, int& R, int& C) { const int st = b / 1024, sb = b % 1024, swz = sb ^ (((sb >> 9) & 1) << 5); R = (st >> 1) * 16 + swz / 64; C = (st & 1) * 32 + (swz % 64) / 2; }
__host__ __device__ __forceinline__ int perm32(int rho) { const int n = rho >> 4, i = rho & 15; return 8 * (i >> 2) + 4 * n + (i & 3); }

struct Unit { int pm, pn, seg; };
struct Gemm { const bf16_t* A0; const bf16_t* A1; const bf16_t* B0; const bf16_t* B1; int lda, K; };

struct StaticOrder {
    int nM, nN, nwg, G, c;
    __host__ __device__ void init(int M, int N, int G_, int c_) { nM = M / BM; nN = N / BM; nwg = nM * nN; G = G_; c = c_; }
    __host__ __device__ bool next(int i, Unit& u) const {
        const long L = (long)i * G + c; if (L >= nwg) return false;
        int wgid = (int)L; { const int q = nwg / NXCD, r = nwg % NXCD, xcd = wgid % NXCD, off = wgid / NXCD; wgid = (xcd < r ? xcd * (q + 1) : r * (q + 1) + (xcd - r) * q) + off; }
        const int nig = WGM * nN, gid = wgid / nig, fm = gid * WGM, gsz = (nM - fm) < WGM ? (nM - fm) : WGM;
        u.pm = fm + ((wgid % nig) % gsz); u.pn = (wgid % nig) / gsz; u.seg = 0; return true;
    }
    __device__ __forceinline__ void a_ready(const Unit&) const {}
    __device__ __forceinline__ void done(const Unit&) const {}
};

__device__ __forceinline__ unsigned cvt_pk_bf16(float lo, float hi) { unsigned r; asm volatile("v_cvt_pk_bf16_f32 %0, %1, %2" : "=v"(r) : "v"(lo), "v"(hi)); return r; }
typedef float f32x2 __attribute__((ext_vector_type(2)));
template <class Epi, class Sched, bool ALIGN_EPI = false, bool SP2 = false>
__device__ __forceinline__ void gemm_phase(PG8_LAS unsigned char* lds, const Gemm g, const Sched& S, const Epi& E) {
    const int tid = threadIdx.x, wid = __builtin_amdgcn_readfirstlane(tid >> 6), lane = tid & 63, wr = wid >> 2, wc = wid & 3, fr = lane & 15, fq = lane >> 4;
    const int K = g.K, nt = K / BK;
    unsigned voffA[2], voffB[2];
#pragma unroll
    for (int i = 0; i < 2; ++i) { int R, C; stage_rc(tid * 16 + i * 8192, R, C); const int Rb = Epi::PERM ? ((R & ~31) + perm32(R & 31)) : R;
        voffA[i] = (unsigned)(R * g.lda + C) * 2u; voffB[i] = (unsigned)(Rb * K + C) * 2u; }
    const size_t kstep = (size_t)(BK * 2);
    const size_t hstepA = (size_t)HALF * g.lda * 2, hstepB = (size_t)HALF * K * 2;
    const size_t tstepA = 2 * hstepA, tstepB = 2 * hstepB;
    const unsigned ldsw = (unsigned)wid * 1024u;
    const int aoff = lds_byte(wr * 64 + fr, fq * 8), boff = lds_byte(wc * 32 + fr, fq * 8);
#define PG8_SA(b, h) (((b) * 2 + (h)) * HTB)
#define PG8_SB(b, h) ((4 + (b) * 2 + (h)) * HTB)
#define PG8_STAGE(bufoff, gbase, voff) do { _Pragma("unroll") for (int _i = 0; _i < 2; ++_i) \
        __builtin_amdgcn_global_load_lds((const unsigned*)((const char*)(gbase) + (voff)[_i]), (PG8_LAS unsigned*)(lds + (bufoff) + ldsw + _i * 8192), 16, 0, 0); } while (0)
#define PG8_LDA(dst, b, h) do { _Pragma("unroll") for (int m = 0; m < 4; ++m) _Pragma("unroll") for (int k = 0; k < 2; ++k) dst[m][k] = *(const PG8_LAS bf16x8*)(lds + PG8_SA(b, h) + aoff + m * 2048 + k * 1024); } while (0)
#define PG8_LDB(dst, b, h) do { _Pragma("unroll") for (int n = 0; n < 2; ++n) _Pragma("unroll") for (int k = 0; k < 2; ++k) dst[n][k] = *(const PG8_LAS bf16x8*)(lds + PG8_SB(b, h) + boff + n * 2048 + k * 1024); } while (0)
#define PG8_MMA(ai, bj, At, Bt) do { __builtin_amdgcn_s_setprio(1); _Pragma("unroll") for (int m = 0; m < 4; ++m) _Pragma("unroll") for (int n = 0; n < 2; ++n) _Pragma("unroll") for (int k = 0; k < 2; ++k) \
        acc[ai][bj][m][n] = __builtin_amdgcn_mfma_f32_16x16x32_bf16(Bt[n][k], At[m][k], acc[ai][bj][m][n], 0, 0, 0); __builtin_amdgcn_s_setprio(0); } while (0)
#define PG8_WAIT_V(n) asm volatile("s_waitcnt vmcnt(" #n ")" ::: "memory")
#define PG8_WAIT_L(n) asm volatile("s_waitcnt lgkmcnt(" #n ")" ::: "memory")
#define PG8_BAR __builtin_amdgcn_s_barrier()
#define PG8_SCHED __builtin_amdgcn_sched_barrier(0)
    Unit cur, nxt; int ui = 0;
    if (!S.next(0, cur)) return;
    f32x4 acc[2][2][4][2];
#pragma unroll
    for (int a = 0; a < 2; ++a)
#pragma unroll
        for (int b = 0; b < 2; ++b)
#pragma unroll
            for (int m = 0; m < 4; ++m)
#pragma unroll
                for (int n = 0; n < 2; ++n) acc[a][b][m][n] = (f32x4){0.f, 0.f, 0.f, 0.f};
    bf16x8 At[4][2], B0[2][2], B1[2][2];
    const char* cA = (const char*)(cur.seg ? g.A1 : g.A0) + (size_t)cur.pm * tstepA; const char* cB = (const char*)(cur.seg ? g.B1 : g.B0) + (size_t)cur.pn * tstepB;
    S.a_ready(cur);
    if constexpr (SP2) {
        PG8_STAGE(PG8_SB(0, 0), cB, voffB); PG8_STAGE(PG8_SB(0, 1), cB + hstepB, voffB); PG8_STAGE(PG8_SA(0, 0), cA, voffA); PG8_STAGE(PG8_SA(0, 1), cA + hstepA, voffA);
        if (wr == 1) PG8_BAR;
        PG8_WAIT_V(2); PG8_BAR;
        PG8_STAGE(PG8_SB(1, 0), cB + kstep, voffB); PG8_STAGE(PG8_SA(1, 0), cA + kstep, voffA); PG8_STAGE(PG8_SB(1, 1), cB + hstepB + kstep, voffB);
        PG8_WAIT_V(6); PG8_BAR;
    } else {
        PG8_STAGE(PG8_SB(0, 0), cB, voffB); PG8_STAGE(PG8_SA(0, 0), cA, voffA); PG8_STAGE(PG8_SB(0, 1), cB + hstepB, voffB); PG8_STAGE(PG8_SA(0, 1), cA + hstepA, voffA);
        if (wr == 1) PG8_BAR;
        PG8_WAIT_V(4); PG8_BAR;
        PG8_STAGE(PG8_SB(1, 0), cB + kstep, voffB); PG8_STAGE(PG8_SA(1, 0), cA + kstep, voffA); PG8_STAGE(PG8_SB(1, 1), cB + hstepB + kstep, voffB);
        PG8_WAIT_V(6); PG8_BAR;
    }
    for (;;) {
        const bool has_next = S.next(ui + 1, nxt);
        const char* nA = has_next ? (const char*)(nxt.seg ? g.A1 : g.A0) + (size_t)nxt.pm * tstepA : cA; const char* nB = has_next ? (const char*)(nxt.seg ? g.B1 : g.B0) + (size_t)nxt.pn * tstepB : cB;
        for (int t = 0; t < nt; t += 2) {
            const bool last = (t == nt - 2);
            const char* a1 = cA + (size_t)(t + 1) * kstep;
            const char* a2 = last ? nA : cA + (size_t)(t + 2) * kstep; const char* b2 = last ? nB : cB + (size_t)(t + 2) * kstep;
            const char* a3 = a2 + kstep; const char* b3 = b2 + kstep;
            if (last && has_next) S.a_ready(nxt);
            if constexpr (SP2) {
            PG8_LDB(B0, 0, 0); PG8_LDB(B1, 0, 1); PG8_SCHED; PG8_LDA(At, 0, 0); PG8_STAGE(PG8_SA(1, 1), a1 + hstepA, voffA);
            PG8_WAIT_V(8); PG8_WAIT_L(0); PG8_BAR; PG8_MMA(0, 0, At, B0); PG8_MMA(0, 1, At, B1); PG8_BAR; PG8_SCHED;
            PG8_LDA(At, 0, 1); PG8_STAGE(PG8_SB(0, 0), b2, voffB); PG8_STAGE(PG8_SB(0, 1), b2 + hstepB, voffB); PG8_STAGE(PG8_SA(0, 0), a2, voffA);
            PG8_WAIT_V(8); PG8_WAIT_L(0); PG8_BAR; PG8_MMA(1, 0, At, B0); PG8_MMA(1, 1, At, B1); PG8_BAR; PG8_SCHED;
            PG8_LDB(B0, 1, 0); PG8_LDB(B1, 1, 1); PG8_SCHED; PG8_LDA(At, 1, 0); PG8_STAGE(PG8_SA(0, 1), a2 + hstepA, voffA);
            PG8_WAIT_V(8); PG8_WAIT_L(0); PG8_BAR; PG8_MMA(0, 0, At, B0); PG8_MMA(0, 1, At, B1); PG8_BAR; PG8_SCHED;
            PG8_LDA(At, 1, 1); PG8_STAGE(PG8_SB(1, 0), b3, voffB); PG8_STAGE(PG8_SB(1, 1), b3 + hstepB, voffB); PG8_STAGE(PG8_SA(1, 0), a3, voffA);
            PG8_WAIT_V(8); PG8_WAIT_L(0); PG8_BAR; PG8_MMA(1, 0, At, B0); PG8_MMA(1, 1, At, B1); PG8_BAR; PG8_SCHED;
            } else {
            PG8_LDB(B0, 0, 0); PG8_SCHED; PG8_LDA(At, 0, 0); PG8_STAGE(PG8_SA(1, 1), a1 + hstepA, voffA);
            PG8_WAIT_L(8); PG8_BAR; PG8_WAIT_L(0); PG8_MMA(0, 0, At, B0); PG8_BAR; PG8_SCHED;
            PG8_LDB(B1, 0, 1); PG8_STAGE(PG8_SB(0, 0), b2, voffB);
            PG8_BAR; PG8_WAIT_L(0); PG8_MMA(0, 1, At, B1); PG8_BAR;
            PG8_LDA(At, 0, 1); PG8_STAGE(PG8_SA(0, 0), a2, voffA);
            PG8_BAR; PG8_WAIT_L(0); PG8_MMA(1, 0, At, B0); PG8_BAR; PG8_SCHED;
            PG8_STAGE(PG8_SB(0, 1), b2 + hstepB, voffB);
            PG8_WAIT_V(6); PG8_BAR; PG8_MMA(1, 1, At, B1); PG8_BAR;
            PG8_LDB(B0, 1, 0); PG8_SCHED; PG8_LDA(At, 1, 0); PG8_STAGE(PG8_SA(0, 1), a2 + hstepA, voffA);
            PG8_WAIT_L(8); PG8_BAR; PG8_WAIT_L(0); PG8_MMA(0, 0, At, B0); PG8_BAR; PG8_SCHED;
            PG8_LDB(B1, 1, 1); PG8_STAGE(PG8_SB(1, 0), b3, voffB);
            PG8_BAR; PG8_WAIT_L(0); PG8_MMA(0, 1, At, B1); PG8_BAR;
            PG8_LDA(At, 1, 1); PG8_STAGE(PG8_SA(1, 0), a3, voffA);
            PG8_BAR; PG8_WAIT_L(0); PG8_MMA(1, 0, At, B0); PG8_BAR; PG8_SCHED;
            PG8_STAGE(PG8_SB(1, 1), b3 + hstepB, voffB);
            PG8_WAIT_V(6); PG8_BAR; PG8_MMA(1, 1, At, B1); PG8_BAR;
            }
        }
        if constexpr (ALIGN_EPI) { if (wr == 0) PG8_BAR; }
        if constexpr (!Epi::AFTER_DRAIN) { E(acc, cur, wr, wc, fr, fq); S.done(cur); }
        if (!has_next) break;
        if (E.zero_after(cur)) {
#pragma unroll
        for (int a = 0; a < 2; ++a)
#pragma unroll
            for (int b = 0; b < 2; ++b)
#pragma unroll
                for (int m = 0; m < 4; ++m)
#pragma unroll
                    for (int n = 0; n < 2; ++n) acc[a][b][m][n] = (f32x4){0.f, 0.f, 0.f, 0.f};
        }
        cur = nxt; cA = nA; cB = nB; ++ui;
        if constexpr (ALIGN_EPI) { if (wr == 1) PG8_BAR; }
    }
    PG8_WAIT_V(0);
    if constexpr (!ALIGN_EPI) { if (wr == 0) PG8_BAR; }
    PG8_BAR;
    if constexpr (Epi::AFTER_DRAIN) { E.fused(acc, cur, wr, wc, fr, fq, lds, wid, lane); S.done(cur); }
#undef PG8_SA
#undef PG8_SB
#undef PG8_STAGE
#undef PG8_LDA
#undef PG8_LDB
#undef PG8_MMA
#undef PG8_WAIT_V
#undef PG8_WAIT_L
#undef PG8_BAR
#undef PG8_SCHED
}
}

namespace pg8 {
typedef unsigned u32x4_ __attribute__((ext_vector_type(4)));
struct EpiProj {
    static constexpr bool PERM = true, AFTER_DRAIN = false;
    bf16_t* O; int ldc;
    __device__ __forceinline__ bool zero_after(const Unit&) const { return true; }
    __device__ __forceinline__ void operator()(f32x4 (&acc)[2][2][4][2], const Unit& u, int wr, int wc, int fr, int fq) const {
        const int row0 = u.pm * BM + wr * 64 + fr, col0 = u.pn * BM + wc * 32 + 8 * fq;
#pragma unroll
        for (int ai = 0; ai < 2; ++ai)
#pragma unroll
            for (int m = 0; m < 4; ++m) { bf16_t* rowp = O + (size_t)(row0 + ai * HALF + m * 16) * ldc + col0;
#pragma unroll
                for (int bj = 0; bj < 2; ++bj) { const f32x4 v0 = acc[ai][bj][m][0], v1 = acc[ai][bj][m][1];
                    u32x4 w; w.x = cvt_pk_bf16(v0[0], v0[1]); w.y = cvt_pk_bf16(v0[2], v0[3]); w.z = cvt_pk_bf16(v1[0], v1[1]); w.w = cvt_pk_bf16(v1[2], v1[3]);
                    *(u32x4*)(rowp + bj * HALF) = w; } }
    }
};
struct SegOrder {
    StaticOrder base;
    __device__ __forceinline__ bool next(int i, Unit& u) const { if (!base.next(i >> 1, u)) return false; u.seg = i & 1; return true; }
    __device__ __forceinline__ void a_ready(const Unit&) const {}
    __device__ __forceinline__ void done(const Unit&) const {}
};
__device__ __forceinline__ float bfw(unsigned w, int half) { return __builtin_bit_cast(float, half ? (w & 0xffff0000u) : (w << 16)); }
struct EpiMerge {
    static constexpr bool PERM = true, AFTER_DRAIN = false;
    const bf16_t* proj; int ldp, cgm, cga; bf16_t* O; int ldo;
    __device__ __forceinline__ bool zero_after(const Unit& u) const { return u.seg != 0; }
    __device__ __forceinline__ void operator()(f32x4 (&acc)[2][2][4][2], const Unit& u, int wr, int wc, int fr, int fq) const {
        const int row0 = u.pm * BM + wr * 64 + fr, col0 = u.pn * BM + wc * 32 + 8 * fq;
#pragma unroll
        for (int ai = 0; ai < 2; ++ai)
#pragma unroll
            for (int m = 0; m < 4; ++m) { const size_t row = (size_t)(row0 + ai * HALF + m * 16);
#pragma unroll
                for (int bj = 0; bj < 2; ++bj) {
                    const u32x4 ga4 = *(const u32x4*)(proj + row * ldp + cga + col0 + bj * HALF);
                    if (u.seg == 0) {
                        const u32x4 gm4 = *(const u32x4*)(proj + row * ldp + cgm + col0 + bj * HALF);
#pragma unroll
                        for (int e = 0; e < 8; ++e) { const float gm = bfw(gm4[e >> 1], e & 1), ga = bfw(ga4[e >> 1], e & 1);
                            acc[ai][bj][m][e >> 2][e & 3] *= (1.f + __expf(-ga)) * __builtin_amdgcn_rcpf(1.f + __expf(-gm)); }
                    } else {
                        float o[8];
#pragma unroll
                        for (int e = 0; e < 8; ++e) { const float ga = bfw(ga4[e >> 1], e & 1); o[e] = acc[ai][bj][m][e >> 2][e & 3] * __builtin_amdgcn_rcpf(1.f + __expf(-ga)); }
                        u32x4 w; w.x = cvt_pk_bf16(o[0], o[1]); w.y = cvt_pk_bf16(o[2], o[3]); w.z = cvt_pk_bf16(o[4], o[5]); w.w = cvt_pk_bf16(o[6], o[7]);
                        *(u32x4*)(O + row * ldo + col0 + bj * HALF) = w;
                    }
                }
                if (m & 1) asm volatile("" ::: "memory"); }
    }
};
struct EpiOut {
    static constexpr bool PERM = false, AFTER_DRAIN = false;
    const float* x; const float* gate; float* out; float* rowss; int ldc, rows_per_batch, gate_stride;
    __device__ __forceinline__ bool zero_after(const Unit&) const { return true; }
    __device__ __forceinline__ void operator()(f32x4 (&acc)[2][2][4][2], const Unit& u, int wr, int wc, int fr, int fq) const {
        const int row0 = u.pm * BM + wr * 64 + fr, col0 = u.pn * BM + wc * 32 + 4 * fq;
        const float* gp = gate + (size_t)((u.pm * BM) / rows_per_batch) * gate_stride + col0;
        f32x4 gt[2][2];
#pragma unroll
        for (int bj = 0; bj < 2; ++bj)
#pragma unroll
            for (int n = 0; n < 2; ++n) gt[bj][n] = *(const f32x4*)(gp + bj * HALF + n * 16);
#pragma unroll
        for (int ai = 0; ai < 2; ++ai)
#pragma unroll
            for (int m = 0; m < 4; ++m) { const int row = row0 + ai * HALF + m * 16; const size_t off = (size_t)row * ldc + col0; float ssq = 0.f;
#pragma unroll
                for (int bj = 0; bj < 2; ++bj)
#pragma unroll
                    for (int n = 0; n < 2; ++n) { const f32x4 xv = *(const f32x4*)(x + off + bj * HALF + n * 16); const f32x4 o = xv + gt[bj][n] * acc[ai][bj][m][n];
                        ssq += (o[0] * o[0] + o[1] * o[1]) + (o[2] * o[2] + o[3] * o[3]); *(f32x4*)(out + off + bj * HALF + n * 16) = o; }
                ssq += __shfl_xor(ssq, 16); ssq += __shfl_xor(ssq, 32);
                if (fq == 0) atomicAdd(rowss + row, ssq);
                if (m & 1) asm volatile("" ::: "memory"); }
    }
};
}

#define REP_P0 1
#define REP_P1 1
#define REP_P2 1
#define REP_U1X 1
#define REP_WRK 1
#define REP_ATT 1
#define REP_POST 1
#define REP_P4 1
#define LAS __attribute__((address_space(3)))
typedef unsigned v4u __attribute__((ext_vector_type(4)));
typedef float f4 __attribute__((ext_vector_type(4)));
constexpr size_t MiB = 1u << 20;
constexpr size_t WS_PROJ = 0;
constexpr size_t WS_YM = 416 * MiB;
constexpr size_t WS_YA = 448 * MiB;
constexpr size_t WS_WPM = 480 * MiB;
constexpr size_t WS_WPA = 484 * MiB;
constexpr size_t WS_WOUT = 488 * MiB;
constexpr size_t WS_MODP = 496 * MiB;
constexpr size_t WS_MOD = 497 * MiB;
constexpr size_t WS_GATES = 498 * MiB;
constexpr size_t WS_ROWSS = 499 * MiB;
constexpr size_t WS_SUMM = WS_ROWSS + 65536;
constexpr size_t WS_WC = WS_SUMM + 8192;
constexpr size_t WS_QCTR = WS_WC + 4096;
constexpr size_t WS_RSUM = WS_ROWSS + 131072;
constexpr size_t WS_WINT = WS_RSUM + 262144;
constexpr size_t WS_MCOMB = WS_WINT + 262144;
constexpr size_t WS_NINT = WS_MCOMB + 262144;
constexpr size_t WS_VONES = 501 * MiB;
constexpr size_t WS_END = 510 * MiB;
static_assert(WS_NINT + 262144 <= WS_VONES && WS_VONES + (size_t)8 * 8192 * 64 * 2 <= WS_END, "d_ws map");
constexpr size_t OB_QC = 0, OB_KC = 32 * MiB, OB_IB = 64 * MiB, OB_NT = 96 * MiB;
constexpr size_t OB_H = 0;
constexpr size_t OB_WIN = 64 * MiB;
constexpr int NWAVES = 8, LDS_BYTES = 163840;

struct MArgs { const float* in[15]; float* out; unsigned char* ws; int ph_lo, ph_hi; };

__device__ __forceinline__ unsigned pk2(float lo, float hi) { return (unsigned)f2bf(lo) | ((unsigned)f2bf(hi) << 16); }
#define LDS_WAIT() asm volatile("s_waitcnt lgkmcnt(0)" ::: "memory")

__device__ __forceinline__ void transpose_item(const float* __restrict__ W, int ldw, int ncol_src0, bf16* __restrict__ WT, int K, int nrow_dst0, int k0, LAS float* scr, int lane) {
#pragma unroll 8
    for (int i = 0; i < 32; ++i) { const int kk = 2 * i + (lane >> 5); scr[kk * 33 + (lane & 31)] = W[(size_t)(k0 + kk) * ldw + ncol_src0 + (lane & 31)]; }
    LDS_WAIT();
    const int c = lane & 7;
#pragma unroll
    for (int j = 0; j < 4; ++j) { const int n = (lane >> 3) + 8 * j; const LAS float* s = scr + (8 * c) * 33 + n;
        v4u o; o.x = pk2(s[0 * 33], s[1 * 33]); o.y = pk2(s[2 * 33], s[3 * 33]); o.z = pk2(s[4 * 33], s[5 * 33]); o.w = pk2(s[6 * 33], s[7 * 33]);
        *(v4u*)(WT + (size_t)(nrow_dst0 + n) * K + k0 + 8 * c) = o; }
    LDS_WAIT();
}

typedef short bf16x8 __attribute__((ext_vector_type(8)));
typedef short s16x4 __attribute__((ext_vector_type(4)));
typedef float f32x16 __attribute__((ext_vector_type(16)));
typedef float f32x2_t __attribute__((ext_vector_type(2)));
typedef __bf16 bf16x2_t __attribute__((ext_vector_type(2)));
__device__ __forceinline__ unsigned cvtpk(float lo, float hi) { f32x2_t v = {lo, hi}; bf16x2_t b = __builtin_convertvector(v, bf16x2_t); return __builtin_bit_cast(unsigned, b); }
__device__ __forceinline__ s16x4 tr_read(const LAS unsigned char* p) { return __builtin_bit_cast(s16x4, __builtin_amdgcn_ds_read_tr16_b64_v4i16((LAS s16x4*)p)); }
constexpr int AT_KP = 272, AT_VP = 320, AT_KBUF = 64 * AT_KP, AT_VBUF = 64 * AT_VP, AT_VOFF = 2 * AT_KBUF, AT_BIAS = AT_VOFF + 2 * AT_VBUF, AT_LDS = AT_BIAS + 768;
constexpr float LOG2E = 1.4426950408889634f;

__device__ __forceinline__ void attn_unit(LAS unsigned char* lds, const bf16* __restrict__ proj, const float* __restrict__ rel_bias, bf16* __restrict__ ya, int b, int h, int g4, int tid, int lane, int wave) {
    const int j0 = 4 * g4, half = wave & 1, jq = j0 + (wave >> 1);
    const int r32 = lane & 31, hb = lane >> 5;
    const int tq = 64 * jq + 32 * half + r32;
    const size_t rowq = (size_t)b * S + tq;
    LAS float* biasL = (LAS float*)(lds + AT_BIAS);
    if (tid < 192) biasL[tid] = rel_bias[h * 192 + tid] * LOG2E;
    bf16x8 qf[8];
#pragma unroll
    for (int ks = 0; ks < 8; ++ks) qf[ks] = *(const bf16x8*)(proj + rowq * NP + C_AQ + h * 128 + 16 * ks + 8 * hb);
    f32x16 o[4];
#pragma unroll
    for (int dt = 0; dt < 4; ++dt)
#pragma unroll
        for (int r = 0; r < 16; ++r) o[dt][r] = 0.f;
    float m_run = -1e30f, l_run = 0.f;
    const int t0 = j0 > 8 ? j0 - 8 : 0, nt = j0 + 3 - t0 + 1;
    const int srow = tid >> 4, sc16 = tid & 15;
    const bf16* gsrc = proj + ((size_t)b * S + srow) * NP + h * 128 + sc16 * 8;
    v4u kr0, kr1, vr0, vr1;
#define AT_GLOAD(tc) do { const bf16* g_ = gsrc + (size_t)(64 * (tc)) * NP; kr0 = *(const v4u*)(g_ + C_AK); vr0 = *(const v4u*)(g_ + C_AV); kr1 = *(const v4u*)(g_ + (size_t)32 * NP + C_AK); vr1 = *(const v4u*)(g_ + (size_t)32 * NP + C_AV); } while (0)
#define AT_LWRITE(buf) do { LAS unsigned char* k_ = lds + (buf) * AT_KBUF + srow * AT_KP + sc16 * 16; LAS unsigned char* v_ = lds + AT_VOFF + (buf) * AT_VBUF + srow * AT_VP + sc16 * 16; \
        *(LAS v4u*)k_ = kr0; *(LAS v4u*)(k_ + 32 * AT_KP) = kr1; *(LAS v4u*)v_ = vr0; *(LAS v4u*)(v_ + 32 * AT_VP) = vr1; } while (0)
    AT_GLOAD(t0); AT_LWRITE(0);
    __syncthreads();
    const float SC = 0.08838834764831845f * LOG2E;
    for (int i = 0; i < nt; ++i) {
        const int tc = t0 + i, buf = i & 1;
        if (i + 1 < nt) AT_GLOAD(tc + 1);
        const int cdiff = jq - tc;
        if (cdiff >= 0 && cdiff <= 8) {
            const LAS unsigned char* Kb = lds + buf * AT_KBUF + r32 * AT_KP + hb * 16;
            f32x16 s0, s1;
#pragma unroll
            for (int r = 0; r < 16; ++r) { s0[r] = 0.f; s1[r] = 0.f; }
#pragma unroll
            for (int ks = 0; ks < 8; ++ks) {
                const bf16x8 k0 = *(const LAS bf16x8*)(Kb + ks * 32), k1 = *(const LAS bf16x8*)(Kb + 32 * AT_KP + ks * 32);
                s0 = __builtin_amdgcn_mfma_f32_32x32x16_bf16(k0, qf[ks], s0, 0, 0, 0);
                s1 = __builtin_amdgcn_mfma_f32_32x32x16_bf16(k1, qf[ks], s1, 0, 0, 0);
            }
            if (cdiff >= 3) { const float bc = biasL[191];
#pragma unroll
                for (int r = 0; r < 16; ++r) { s0[r] = s0[r] * SC + bc; s1[r] = s1[r] * SC + bc; }
            } else { const int base = 64 * cdiff + 32 * half + r32 + 63 - 4 * hb;
#pragma unroll
                for (int r = 0; r < 16; ++r) { const int i0 = base - ((r & 3) + 8 * (r >> 2)), i1 = i0 - 32;
                    s0[r] = s0[r] * SC + biasL[i0 > 191 ? 191 : i0]; s1[r] = s1[r] * SC + biasL[i1 > 191 ? 191 : i1]; }
            }
            float mx = fmaxf(s0[0], s1[0]);
#pragma unroll
            for (int r = 1; r < 16; ++r) mx = fmaxf(mx, fmaxf(s0[r], s1[r]));
            mx = fmaxf(mx, __shfl_xor(mx, 32));
            const float m_new = fmaxf(m_run, mx), alpha = __builtin_amdgcn_exp2f(m_run - m_new); m_run = m_new;
            float ls = 0.f;
#pragma unroll
            for (int r = 0; r < 16; ++r) { s0[r] = __builtin_amdgcn_exp2f(s0[r] - m_new); s1[r] = __builtin_amdgcn_exp2f(s1[r] - m_new); ls += s0[r] + s1[r]; }
            l_run = l_run * alpha + ls;
#pragma unroll
            for (int dt = 0; dt < 4; ++dt)
#pragma unroll
                for (int r = 0; r < 16; ++r) o[dt][r] *= alpha;
            v4u pw[4];
            pw[0] = (v4u){cvtpk(s0[0], s0[1]), cvtpk(s0[2], s0[3]), cvtpk(s0[4], s0[5]), cvtpk(s0[6], s0[7])};
            pw[1] = (v4u){cvtpk(s0[8], s0[9]), cvtpk(s0[10], s0[11]), cvtpk(s0[12], s0[13]), cvtpk(s0[14], s0[15])};
            pw[2] = (v4u){cvtpk(s1[0], s1[1]), cvtpk(s1[2], s1[3]), cvtpk(s1[4], s1[5]), cvtpk(s1[6], s1[7])};
            pw[3] = (v4u){cvtpk(s1[8], s1[9]), cvtpk(s1[10], s1[11]), cvtpk(s1[12], s1[13]), cvtpk(s1[14], s1[15])};
            const LAS unsigned char* Vb = lds + AT_VOFF + buf * AT_VBUF + (4 * hb + ((lane & 15) >> 2)) * AT_VP + (16 * ((lane >> 4) & 1) + 4 * (lane & 3)) * 2;
#pragma unroll
            for (int q = 0; q < 4; ++q) {
#pragma unroll
                for (int dt = 0; dt < 4; ++dt) {
                    const s16x4 lo = tr_read(Vb + (16 * q) * AT_VP + dt * 64), hi = tr_read(Vb + (16 * q + 8) * AT_VP + dt * 64);
                    const bf16x8 vf = (bf16x8){lo[0], lo[1], lo[2], lo[3], hi[0], hi[1], hi[2], hi[3]};
                    o[dt] = __builtin_amdgcn_mfma_f32_32x32x16_bf16(vf, __builtin_bit_cast(bf16x8, pw[q]), o[dt], 0, 0, 0);
                }
            }
        }
        if (i + 1 < nt) AT_LWRITE(buf ^ 1);
        __syncthreads();
    }
#undef AT_GLOAD
#undef AT_LWRITE
    const float linv = 1.f / (l_run + __shfl_xor(l_run, 32));
#pragma unroll
    for (int dt = 0; dt < 4; ++dt)
#pragma unroll
        for (int rq = 0; rq < 4; ++rq) {
            const int d0 = 32 * dt + 8 * rq + 4 * hb;
            const uint2 zz = *(const uint2*)(proj + rowq * NP + C_AZ + h * 128 + d0);
            const float z0 = __builtin_bit_cast(float, zz.x << 16), z1 = __builtin_bit_cast(float, zz.x & 0xffff0000u), z2 = __builtin_bit_cast(float, zz.y << 16), z3 = __builtin_bit_cast(float, zz.y & 0xffff0000u);
            uint2 w; w.x = cvtpk(o[dt][4 * rq + 0] * linv * siluf_(z0), o[dt][4 * rq + 1] * linv * siluf_(z1)); w.y = cvtpk(o[dt][4 * rq + 2] * linv * siluf_(z2), o[dt][4 * rq + 3] * linv * siluf_(z3));
            *(uint2*)(ya + rowq * 1024 + h * 128 + d0) = w;
        }
}

using pg8::bfw;
typedef float f32x4_ __attribute__((ext_vector_type(4)));
typedef unsigned u2v __attribute__((ext_vector_type(2)));
#define MFMA16(a, b, c) __builtin_amdgcn_mfma_f32_16x16x32_bf16((a), (b), (c), 0, 0, 0)
__device__ __forceinline__ float wave_scan_add(float x, int lane) {
#pragma unroll
    for (int o = 1; o < 64; o <<= 1) { const float t = __shfl_up(x, o); if (lane >= o) x += t; }
    return x;
}
__device__ __forceinline__ float wave_scan_max(float x, int lane) {
#pragma unroll
    for (int o = 1; o < 64; o <<= 1) { const float t = __shfl_up(x, o); if (lane >= o) x = fmaxf(x, t); }
    return x;
}
__device__ __forceinline__ void mlstm_summary(const float* __restrict__ gates, float* __restrict__ summ, int bh, int j, int lane) {
    const size_t row = (size_t)(bh >> 2) * S + 64 * j + lane; const int h = bh & 3;
    const float ig = gates[row * 8 + h], lf = gates[row * 8 + 4 + h];
    const float bc = wave_scan_add(lf, lane); const float b_last = __shfl(bc, 63);
    const float gmax = wave_max(b_last - bc + ig);
    if (lane == 0) { summ[(bh * 128 + j) * 2] = b_last; summ[(bh * 128 + j) * 2 + 1] = gmax; }
}
constexpr int U1_QP = 528, U1_VP = 576, U1_SP = 144;
constexpr int U1_QCL = 0, U1_KCL = 64 * U1_QP, U1_VL = 2 * 64 * U1_QP, U1_SWL = U1_VL + 64 * U1_VP, U1_SCAL = U1_SWL + 64 * U1_SP, U1_LDS = U1_SCAL + 3 * 256;
struct MlBufs { bf16* proj; const float* gates; const float* summ; const float* conv_w; const float* conv_b; bf16* QC; bf16* KC; bf16* IB; bf16* NT; float* rowsum; float* winter; float* mcomb; float* wc; float* ninter; bf16* vones; };

__device__ __forceinline__ void mlstm_u1_unit(LAS unsigned char* lds, const MlBufs& B, int b, int h, int j, int tid, int lane, int wave) {
    const int bh = b * 4 + h; const size_t rowb = (size_t)b * S + 64 * j;
    LAS float* sA = (LAS float*)(lds + U1_SCAL); LAS float* sC = sA + 64; LAS float* sWk = sA + 128;
    __syncthreads();
    if (wave == 0) {
        const size_t row = rowb + lane;
        const float ig = B.gates[row * 8 + h], lf = B.gates[row * 8 + 4 + h];
        const float bc = wave_scan_add(lf, lane); const float b_last = __shfl(bc, 63);
        const float a_s = ig - bc; const float pm = wave_scan_max(a_s, lane);
        const float gg = b_last - bc + ig; const float gmax = wave_max(gg);
        float m_prev = 0.f;
        if (j > 0) {
            const float bl0 = B.summ[(bh * 128 + lane) * 2], gm0 = B.summ[(bh * 128 + lane) * 2 + 1], bl1 = B.summ[(bh * 128 + 64 + lane) * 2], gm1 = B.summ[(bh * 128 + 64 + lane) * 2 + 1];
            const float P0 = wave_scan_add(bl0, lane); const float tot0 = __shfl(P0, 63); const float P1 = wave_scan_add(bl1, lane) + tot0;
            const int jm = j - 1;
            const float e0 = (lane <= jm) ? gm0 - P0 : -INFINITY, e1 = (lane + 64 <= jm) ? gm1 - P1 : -INFINITY;
            const float emax = wave_max(fmaxf(e0, e1));
            const float Bjm = (jm < 64) ? __shfl(P0, jm) : __shfl(P1, jm - 64);
            m_prev = Bjm + fmaxf(0.f, emax);
        }
        const float m_j = fmaxf(b_last + m_prev, gmax);
        const float c_t = fmaxf(pm, m_prev);
        sA[lane] = a_s; sC[lane] = c_t; sWk[lane] = __expf(gg - m_j);
        B.winter[row * 4 + h] = __expf(m_prev - c_t); B.mcomb[row * 4 + h] = bc + c_t;
        if (lane == 0) B.wc[bh * 128 + j] = __expf(b_last + m_prev - m_j);
    }
    {
        const int cg = tid & 63, tg = tid >> 6, isk = cg >> 5, c8 = (cg & 31) * 8, chan = isk * 1024 + h * 256 + c8;
        const bf16* src = B.proj + (rowb + 8 * tg - 3) * NP + (isk ? C_MK : C_MQ) + h * 256 + c8;
        float wv[4][8], bv[8];
#pragma unroll
        for (int tap = 0; tap < 4; ++tap) { const f4 w0 = *(const f4*)(B.conv_w + tap * 2048 + chan), w1 = *(const f4*)(B.conv_w + tap * 2048 + chan + 4);
            wv[tap][0] = w0[0]; wv[tap][1] = w0[1]; wv[tap][2] = w0[2]; wv[tap][3] = w0[3]; wv[tap][4] = w1[0]; wv[tap][5] = w1[1]; wv[tap][6] = w1[2]; wv[tap][7] = w1[3]; }
        { const f4 b0 = *(const f4*)(B.conv_b + chan), b1 = *(const f4*)(B.conv_b + chan + 4); bv[0] = b0[0]; bv[1] = b0[1]; bv[2] = b0[2]; bv[3] = b0[3]; bv[4] = b1[0]; bv[5] = b1[1]; bv[6] = b1[2]; bv[7] = b1[3]; }
        v4u raw[11];
#pragma unroll
        for (int i = 0; i < 11; ++i) { const int tt = 64 * j + 8 * tg - 3 + i; raw[i] = (tt >= 0) ? *(const v4u*)(src + (size_t)i * NP) : (v4u){0u, 0u, 0u, 0u}; }
        const float osc = isk ? 0.0625f : 1.f;
        LAS unsigned char* ldst = lds + (isk ? U1_KCL : U1_QCL) + (8 * tg) * U1_QP + c8 * 2;
        bf16* gdst = (isk ? B.KC : B.QC) + (rowb + 8 * tg) * 1024 + h * 256 + c8;
#pragma unroll
        for (int t8 = 0; t8 < 8; ++t8) {
            float o[8];
#pragma unroll
            for (int e = 0; e < 8; ++e) { float acc = bv[e];
#pragma unroll
                for (int tap = 0; tap < 4; ++tap) acc += wv[tap][e] * bfw(raw[t8 + tap][e >> 1], e & 1);
                o[e] = siluf_(acc) * osc; }
            const v4u w = (v4u){cvtpk(o[0], o[1]), cvtpk(o[2], o[3]), cvtpk(o[4], o[5]), cvtpk(o[6], o[7])};
            *(LAS v4u*)(ldst + t8 * U1_QP) = w; *(v4u*)(gdst + (size_t)t8 * 1024) = w;
        }
    }
    v4u vraw[4];
#pragma unroll
    for (int i = 0; i < 4; ++i) { const int ch = tid + 512 * i, row = ch >> 5, c16 = ch & 31; vraw[i] = *(const v4u*)(B.proj + (rowb + row) * NP + C_MV + h * 256 + c16 * 8);
        *(LAS v4u*)(lds + U1_VL + row * U1_VP + c16 * 16) = vraw[i]; }
    if (tid < 128) *(LAS v4u*)(lds + U1_VL + (tid >> 1) * U1_VP + 512 + (tid & 1) * 16) = (tid & 1) ? (v4u){0u, 0u, 0u, 0u} : (v4u){0x00003F80u, 0u, 0u, 0u};
    __syncthreads();
    const int fr = lane & 15, g = lane >> 4;
    {
        const int tt = wave & 3, st0 = 2 * (wave >> 2);
        f32x4_ sacc[2] = {{0.f, 0.f, 0.f, 0.f}, {0.f, 0.f, 0.f, 0.f}};
#pragma unroll
        for (int ks = 0; ks < 8; ++ks) {
            const bf16x8 bq = *(const LAS bf16x8*)(lds + U1_QCL + (16 * tt + fr) * U1_QP + (32 * ks + 8 * g) * 2);
#pragma unroll
            for (int i = 0; i < 2; ++i) { const bf16x8 ak = *(const LAS bf16x8*)(lds + U1_KCL + (16 * (st0 + i) + fr) * U1_QP + (32 * ks + 8 * g) * 2); sacc[i] = MFMA16(ak, bq, sacc[i]); }
        }
        const int t = 16 * tt + fr; const float c_t = sC[t];
#pragma unroll
        for (int i = 0; i < 2; ++i) { const int s0 = 16 * (st0 + i) + 4 * g; const f4 a4 = *(const LAS f4*)(sA + s0);
            float o[4];
#pragma unroll
            for (int r = 0; r < 4; ++r) o[r] = (s0 + r <= t) ? sacc[i][r] * __expf(a4[r] - c_t) : 0.f;
            u2v w; w.x = cvtpk(o[0], o[1]); w.y = cvtpk(o[2], o[3]);
            *(LAS u2v*)(lds + U1_SWL + t * U1_SP + s0 * 2) = w; }
    }
    __syncthreads();
    {
        const int nvt = (wave == 0) ? 3 : 2;
        for (int iv = 0; iv < nvt; ++iv) {
            const int vt = (iv == 2) ? 16 : 2 * wave + iv;
            f32x4_ ia[4] = {{0.f, 0.f, 0.f, 0.f}, {0.f, 0.f, 0.f, 0.f}, {0.f, 0.f, 0.f, 0.f}, {0.f, 0.f, 0.f, 0.f}};
#pragma unroll
            for (int ks = 0; ks < 2; ++ks) {
                const LAS unsigned char* va = lds + U1_VL + (32 * ks + 8 * g + ((lane & 15) >> 2)) * U1_VP + (16 * vt + 4 * (lane & 3)) * 2;
                const s16x4 lo = tr_read(va), hi = tr_read(va + 4 * U1_VP);
                const bf16x8 af = (bf16x8){lo[0], lo[1], lo[2], lo[3], hi[0], hi[1], hi[2], hi[3]};
#pragma unroll
                for (int tt = 0; tt < 4; ++tt) { const bf16x8 bs = *(const LAS bf16x8*)(lds + U1_SWL + (16 * tt + fr) * U1_SP + (32 * ks + 8 * g) * 2); ia[tt] = MFMA16(af, bs, ia[tt]); }
            }
#pragma unroll
            for (int tt = 0; tt < 4; ++tt) { const size_t row = rowb + 16 * tt + fr;
                if (vt < 16) { uint2 w; w.x = cvtpk(ia[tt][0], ia[tt][1]); w.y = cvtpk(ia[tt][2], ia[tt][3]); *(uint2*)(B.IB + row * 1024 + h * 256 + 16 * vt + 4 * g) = w; }
                else if (g == 0) B.rowsum[row * 4 + h] = ia[tt][0]; }
        }
    }
#pragma unroll
    for (int i = 0; i < 4; ++i) { const int ch = tid + 512 * i, row = ch >> 5, c16 = ch & 31; const float wk = sWk[row]; v4u w;
#pragma unroll
        for (int e = 0; e < 4; ++e) w[e] = cvtpk(bfw(vraw[i][e], 0) * wk, bfw(vraw[i][e], 1) * wk);
        *(v4u*)(B.proj + (rowb + row) * NP + C_MV + h * 256 + c16 * 8) = w; }
    { const int srow = tid >> 3, c = tid & 7; const unsigned w0 = (c == 0) ? (unsigned)f2bf(sWk[srow]) : 0u;
      *(v4u*)(B.vones + ((size_t)bh * S + 64 * j + srow) * 64 + c * 8) = (v4u){w0, 0u, 0u, 0u}; }
}

constexpr int W_QP = 528, W_KP = 544, W_VP = 144, W_QL = 0, W_KL = 64 * W_QP, W_VL = W_KL + 64 * W_KP, W_LDS = W_VL + 64 * W_VP;
__device__ __forceinline__ void mlstm_worker(LAS unsigned char* lds, const MlBufs& B, int b, int h, int sl, int tid, int lane, int wave) {
    const int bh = b * 4 + h; const size_t rowb = (size_t)b * S;
    const bf16* vsrc = (sl < 4) ? (B.proj + rowb * NP + C_MV + h * 256 + 64 * sl) : (B.vones + (size_t)bh * S * 64);
    const size_t vpitch = (sl < 4) ? (size_t)NP : (size_t)64;
    const int fr = lane & 15, g = lane >> 4;
    f32x4_ Ct[16];
#pragma unroll
    for (int kt = 0; kt < 16; ++kt) Ct[kt] = (f32x4_){0.f, 0.f, 0.f, 0.f};
    v4u rq[4], rk[4], rv;
#define W_GLOAD(jj) do { _Pragma("unroll") for (int i_ = 0; i_ < 4; ++i_) { const int ch_ = tid + 512 * i_, row_ = ch_ >> 5, c16_ = ch_ & 31; const size_t o_ = (rowb + 64 * (jj) + row_) * 1024 + h * 256 + c16_ * 8; \
            rq[i_] = *(const v4u*)(B.QC + o_); rk[i_] = *(const v4u*)(B.KC + o_); } \
        rv = *(const v4u*)(vsrc + (size_t)(64 * (jj) + (tid >> 3)) * vpitch + (tid & 7) * 8); } while (0)
#define W_LWRITE() do { _Pragma("unroll") for (int i_ = 0; i_ < 4; ++i_) { const int ch_ = tid + 512 * i_, row_ = ch_ >> 5, c16_ = ch_ & 31; \
            *(LAS v4u*)(lds + W_QL + row_ * W_QP + c16_ * 16) = rq[i_]; *(LAS v4u*)(lds + W_KL + row_ * W_KP + c16_ * 16) = rk[i_]; } \
        *(LAS v4u*)(lds + W_VL + (tid >> 3) * W_VP + (tid & 7) * 16) = rv; } while (0)
    W_GLOAD(0);
    for (int j = 0; j < 128; ++j) {
        __syncthreads();
        W_LWRITE();
        if (j + 1 < 128) W_GLOAD(j + 1);
        __syncthreads();
        if (wave < 4) {
            const int vq = wave;
            const float w_c = B.wc[bh * 128 + j];
            f32x4_ ia[4] = {{0.f, 0.f, 0.f, 0.f}, {0.f, 0.f, 0.f, 0.f}, {0.f, 0.f, 0.f, 0.f}, {0.f, 0.f, 0.f, 0.f}};
#pragma unroll
            for (int kk = 0; kk < 8; ++kk) {
                const v4u cw = (v4u){cvtpk(Ct[2 * kk][0], Ct[2 * kk][1]), cvtpk(Ct[2 * kk][2], Ct[2 * kk][3]), cvtpk(Ct[2 * kk + 1][0], Ct[2 * kk + 1][1]), cvtpk(Ct[2 * kk + 1][2], Ct[2 * kk + 1][3])};
#pragma unroll
                for (int tt = 0; tt < 4; ++tt) { const LAS unsigned char* qa = lds + W_QL + (16 * tt + fr) * W_QP + (32 * kk + 4 * g) * 2;
                    const u2v lo = *(const LAS u2v*)qa, hi = *(const LAS u2v*)(qa + 32);
                    ia[tt] = MFMA16(__builtin_bit_cast(bf16x8, cw), __builtin_bit_cast(bf16x8, ((v4u){lo.x, lo.y, hi.x, hi.y})), ia[tt]); }
            }
#pragma unroll
            for (int tt = 0; tt < 4; ++tt) { const size_t row = rowb + 64 * j + 16 * tt + fr;
                if (sl < 4) { uint2 w; w.x = cvtpk(ia[tt][0], ia[tt][1]); w.y = cvtpk(ia[tt][2], ia[tt][3]); *(uint2*)(B.NT + row * 1024 + h * 256 + 64 * sl + 16 * vq + 4 * g) = w; }
                else if (vq == 0 && g == 0) B.ninter[row * 4 + h] = ia[tt][0]; }
#pragma unroll
            for (int kt = 0; kt < 16; ++kt) Ct[kt] *= w_c;
#pragma unroll
            for (int ks = 0; ks < 2; ++ks) {
                const LAS unsigned char* vb = lds + W_VL + (32 * ks + 8 * g + ((lane & 15) >> 2)) * W_VP + (16 * vq + 4 * (lane & 3)) * 2;
                const s16x4 vlo = tr_read(vb), vhi = tr_read(vb + 4 * W_VP);
                const bf16x8 bvf = (bf16x8){vlo[0], vlo[1], vlo[2], vlo[3], vhi[0], vhi[1], vhi[2], vhi[3]};
                const LAS unsigned char* ka = lds + W_KL + (32 * ks + 8 * g + ((lane & 15) >> 2)) * W_KP + (4 * (lane & 3)) * 2;
#pragma unroll
                for (int kt = 0; kt < 16; ++kt) { const s16x4 klo = tr_read(ka + kt * 32), khi = tr_read(ka + kt * 32 + 4 * W_KP);
                    const bf16x8 akf = (bf16x8){klo[0], klo[1], klo[2], klo[3], khi[0], khi[1], khi[2], khi[3]};
                    Ct[kt] = MFMA16(akf, bvf, Ct[kt]); }
            }
        }
    }
    __syncthreads();
#undef W_GLOAD
#undef W_LWRITE
}
constexpr int W2_STAGE = W_LDS, W2_WC = 2 * W2_STAGE, W2_LDS = W2_WC + 512;
__device__ __forceinline__ void w2_compute(f32x4_ (&Ct)[16], const LAS unsigned char* st, float w_c, const MlBufs& B, size_t row0, int h, int sl, int vq, int lane) {
    const int fr = lane & 15, g = lane >> 4;
    f32x4_ ia[4] = {{0.f, 0.f, 0.f, 0.f}, {0.f, 0.f, 0.f, 0.f}, {0.f, 0.f, 0.f, 0.f}, {0.f, 0.f, 0.f, 0.f}};
    const LAS unsigned char* qbase = st + W_QL + fr * W_QP + (4 * g) * 2;
    u2v qlo[2][4], qhi[2][4];
#pragma unroll
    for (int tt = 0; tt < 4; ++tt) { qlo[0][tt] = *(const LAS u2v*)(qbase + 16 * tt * W_QP); qhi[0][tt] = *(const LAS u2v*)(qbase + 16 * tt * W_QP + 32); }
#pragma unroll
    for (int kk = 0; kk < 8; ++kk) {
        if (kk + 1 < 8) {
#pragma unroll
            for (int tt = 0; tt < 4; ++tt) { qlo[(kk + 1) & 1][tt] = *(const LAS u2v*)(qbase + 16 * tt * W_QP + 64 * (kk + 1)); qhi[(kk + 1) & 1][tt] = *(const LAS u2v*)(qbase + 16 * tt * W_QP + 64 * (kk + 1) + 32); }
        }
        const v4u cw = (v4u){cvtpk(Ct[2 * kk][0], Ct[2 * kk][1]), cvtpk(Ct[2 * kk][2], Ct[2 * kk][3]), cvtpk(Ct[2 * kk + 1][0], Ct[2 * kk + 1][1]), cvtpk(Ct[2 * kk + 1][2], Ct[2 * kk + 1][3])};
        __builtin_amdgcn_sched_barrier(0);
#pragma unroll
        for (int tt = 0; tt < 4; ++tt)
            ia[tt] = MFMA16(__builtin_bit_cast(bf16x8, cw), __builtin_bit_cast(bf16x8, ((v4u){qlo[kk & 1][tt].x, qlo[kk & 1][tt].y, qhi[kk & 1][tt].x, qhi[kk & 1][tt].y})), ia[tt]);
        __builtin_amdgcn_sched_barrier(0);
    }
#pragma unroll
    for (int tt = 0; tt < 4; ++tt) { const size_t row = row0 + 16 * tt + fr;
        if (sl < 4) { uint2 w; w.x = cvtpk(ia[tt][0], ia[tt][1]); w.y = cvtpk(ia[tt][2], ia[tt][3]); *(uint2*)(B.NT + row * 1024 + h * 256 + 64 * sl + 16 * vq + 4 * g) = w; }
        else if (vq == 0 && g == 0) B.ninter[row * 4 + h] = ia[tt][0]; }
#pragma unroll
    for (int kt = 0; kt < 16; ++kt) Ct[kt] *= w_c;
#pragma unroll
    for (int ks = 0; ks < 2; ++ks) {
        const LAS unsigned char* vb = st + W_VL + (32 * ks + 8 * g + ((lane & 15) >> 2)) * W_VP + (16 * vq + 4 * (lane & 3)) * 2;
        const s16x4 vlo = tr_read(vb), vhi = tr_read(vb + 4 * W_VP);
        const bf16x8 bvf = (bf16x8){vlo[0], vlo[1], vlo[2], vlo[3], vhi[0], vhi[1], vhi[2], vhi[3]};
        const LAS unsigned char* ka = st + W_KL + (32 * ks + 8 * g + ((lane & 15) >> 2)) * W_KP + (4 * (lane & 3)) * 2;
#pragma unroll
        for (int kt = 0; kt < 16; ++kt) { const s16x4 klo = tr_read(ka + kt * 32), khi = tr_read(ka + kt * 32 + 4 * W_KP);
            const bf16x8 akf = (bf16x8){klo[0], klo[1], klo[2], klo[3], khi[0], khi[1], khi[2], khi[3]};
            Ct[kt] = MFMA16(akf, bvf, Ct[kt]); }
    }
}
__device__ __forceinline__ void mlstm_worker2(LAS unsigned char* lds, const MlBufs& B, int b, int h, int sl, int tid, int lane, int wave) {
    const int bh = b * 4 + h; const size_t rowb = (size_t)b * S;
    const bf16* vsrc = (sl < 4) ? (B.proj + rowb * NP + C_MV + h * 256 + 64 * sl) : (B.vones + (size_t)bh * S * 64);
    const size_t vpitch = (sl < 4) ? (size_t)NP : (size_t)64;
    LAS float* wcL = (LAS float*)(lds + W2_WC);
    __syncthreads();
    if (tid < 128) wcL[tid] = B.wc[bh * 128 + tid];
    const bool loader = wave >= 4;
    const int lt = tid & 255;
    const bf16* qsrc = B.QC + (rowb + (lt >> 5)) * 1024 + h * 256 + (lt & 31) * 8;
    const bf16* ksrc = B.KC + (rowb + (lt >> 5)) * 1024 + h * 256 + (lt & 31) * 8;
    const bf16* vs2 = vsrc + (size_t)(lt >> 3) * vpitch + (lt & 7) * 8;
    const int qoff = W_QL + (lt >> 5) * W_QP + (lt & 31) * 16, koff = W_KL + (lt >> 5) * W_KP + (lt & 31) * 16, voff = W_VL + (lt >> 3) * W_VP + (lt & 7) * 16;
    v4u ra[18], rb[18];
#define L_GLOAD(R, jj) do { _Pragma("unroll") for (int i_ = 0; i_ < 8; ++i_) { R[i_] = *(const v4u*)(qsrc + (size_t)(64 * (jj) + 8 * i_) * 1024); R[8 + i_] = *(const v4u*)(ksrc + (size_t)(64 * (jj) + 8 * i_) * 1024); } \
        R[16] = *(const v4u*)(vs2 + (size_t)(64 * (jj)) * vpitch); R[17] = *(const v4u*)(vs2 + (size_t)(64 * (jj) + 32) * vpitch); } while (0)
#define L_WRITE(R, bufo) do { LAS unsigned char* s_ = lds + (bufo); _Pragma("unroll") for (int i_ = 0; i_ < 8; ++i_) { *(LAS v4u*)(s_ + qoff + 8 * i_ * W_QP) = R[i_]; *(LAS v4u*)(s_ + koff + 8 * i_ * W_KP) = R[8 + i_]; } \
        *(LAS v4u*)(s_ + voff) = R[16]; *(LAS v4u*)(s_ + voff + 32 * W_VP) = R[17]; } while (0)
    if (loader) {
        L_GLOAD(ra, 0); L_WRITE(ra, 0); L_GLOAD(ra, 1); L_GLOAD(rb, 2);
        __syncthreads();
        for (int j = 0; j < 128; j += 2) {
            L_WRITE(ra, W2_STAGE); if (j + 3 < 128) L_GLOAD(ra, j + 3);
            __syncthreads();
            if (j + 2 < 128) { L_WRITE(rb, 0); } if (j + 4 < 128) L_GLOAD(rb, j + 4);
            __syncthreads();
        }
    } else {
        f32x4_ Ct[16];
#pragma unroll
        for (int kt = 0; kt < 16; ++kt) Ct[kt] = (f32x4_){0.f, 0.f, 0.f, 0.f};
        __syncthreads();
        for (int j = 0; j < 128; j += 2) {
            w2_compute(Ct, lds, wcL[j], B, rowb + 64 * j, h, sl, wave, lane);
            __syncthreads();
            w2_compute(Ct, lds + W2_STAGE, wcL[j + 1], B, rowb + 64 * (j + 1), h, sl, wave, lane);
            __syncthreads();
        }
    }
#undef L_GLOAD
#undef L_WRITE
}
__device__ __forceinline__ void mlstm_post_item(const MlBufs& B, const float* __restrict__ mh_norm_g, bf16* __restrict__ ym, size_t row, int h, int lane) {
    const uint2 iw = *(const uint2*)(B.IB + row * 1024 + h * 256 + lane * 4), nw = *(const uint2*)(B.NT + row * 1024 + h * 256 + lane * 4);
    const float wi = B.winter[row * 4 + h], den = B.rowsum[row * 4 + h] + wi * B.ninter[row * 4 + h];
    const float dinv = 1.f / fmaxf(fabsf(den), __expf(-B.mcomb[row * 4 + h]));
    float hv[4];
    hv[0] = (bfw(iw.x, 0) + wi * bfw(nw.x, 0)) * dinv; hv[1] = (bfw(iw.x, 1) + wi * bfw(nw.x, 1)) * dinv; hv[2] = (bfw(iw.y, 0) + wi * bfw(nw.y, 0)) * dinv; hv[3] = (bfw(iw.y, 1) + wi * bfw(nw.y, 1)) * dinv;
    const float ss = wave_sum(hv[0] * hv[0] + hv[1] * hv[1] + hv[2] * hv[2] + hv[3] * hv[3]);
    const float r = 1.0f / sqrtf(ss * (1.f / 256.f) + EPS);
    const int c = h * 256 + lane * 4;
    const uint2 mo = *(const uint2*)(B.proj + row * NP + C_MO + c), mz = *(const uint2*)(B.proj + row * NP + C_MZ + c);
    const f4 gn = *(const f4*)(mh_norm_g + c);
    uint2 w;
    w.x = cvtpk(hv[0] * r * gn[0] * sigmoidf_(bfw(mo.x, 0)) * siluf_(bfw(mz.x, 0)), hv[1] * r * gn[1] * sigmoidf_(bfw(mo.x, 1)) * siluf_(bfw(mz.x, 1)));
    w.y = cvtpk(hv[2] * r * gn[2] * sigmoidf_(bfw(mo.y, 0)) * siluf_(bfw(mz.y, 0)), hv[3] * r * gn[3] * sigmoidf_(bfw(mo.y, 1)) * siluf_(bfw(mz.y, 1)));
    *(uint2*)(ym + row * 1024 + h * 256 + lane * 4) = w;
}

__global__ void __launch_bounds__(NWAVES * 64, 2) mega(MArgs a) {
    extern __shared__ __attribute__((aligned(16))) unsigned char lds_raw[];
    LAS unsigned char* lds = (LAS unsigned char*)lds_raw;
    cg::grid_group grid = cg::this_grid();
    const int tid = threadIdx.x, lane = tid & 63, wave = __builtin_amdgcn_readfirstlane(tid >> 6);
    const int G = gridDim.x, gw = blockIdx.x * NWAVES + wave, NGW = G * NWAVES;
    const float* x = a.in[0]; const float* cvec = a.in[1]; const float* w_ada = a.in[2]; const float* b_ada = a.in[3]; const float* norm_g = a.in[4]; const float* w_in = a.in[5];
    const float* b_if = a.in[6]; const float* final_g = a.in[14]; const float* w_proj_m = a.in[11]; const float* w_proj_a = a.in[12]; const float* w_out = a.in[13];
    unsigned char* ws = a.ws; unsigned char* ob = (unsigned char*)a.out;
    bf16* proj = (bf16*)(ws + WS_PROJ); bf16* Wpm_t = (bf16*)(ws + WS_WPM); bf16* Wpa_t = (bf16*)(ws + WS_WPA); bf16* Wout_t = (bf16*)(ws + WS_WOUT);
    float* modp = (float*)(ws + WS_MODP); float* mod = (float*)(ws + WS_MOD); float* gates = (float*)(ws + WS_GATES); float* rowss = (float*)(ws + WS_ROWSS);
    bf16* ym = (bf16*)(ws + WS_YM); bf16* ya = (bf16*)(ws + WS_YA); bf16* merged = proj;
    bf16* H = (bf16*)(ob + OB_H); bf16* Win_t = (bf16*)(ob + OB_WIN);
    const int lo = a.ph_lo, hi = a.ph_hi;
#define IN(k) (lo <= (k) && (k) < hi)
#define BOTH(k) (IN(k) && IN((k) + 1))

    if (IN(0)) {
        LAS float* scr = (LAS float*)(lds + wave * 16384);
        constexpr int I_ADA = 16 * 24, I_IN = (D / 64) * (NP / 32), I_PM = (1024 / 64) * (D / 32), I_OUT = (D / 64) * (D / 32);
        constexpr int NITEMS = I_ADA + I_IN + 2 * I_PM + I_OUT;
        for (int rep = 0; rep < REP_P0; ++rep)
        for (int it = gw; it < NITEMS; it += NGW) {
            int r = it;
            if (r < I_ADA) {
                const int ks = r / 24, cb = r % 24, n0 = cb * 256 + lane * 4;
                float4 a0 = {0.f, 0.f, 0.f, 0.f}, a1 = {0.f, 0.f, 0.f, 0.f};
                if (ks == 0) { a0 = *(const float4*)(b_ada + n0); a1 = a0; }
#pragma unroll 8
                for (int kk = 0; kk < 128; ++kk) { const int k = ks * 128 + kk; const float4 w = *(const float4*)(w_ada + (size_t)k * (3 * D) + n0);
                    const float c0 = cvec[k], c1 = cvec[D + k]; const float s0 = c0 / (1.f + __expf(-c0)), s1 = c1 / (1.f + __expf(-c1));
                    a0.x += s0 * w.x; a0.y += s0 * w.y; a0.z += s0 * w.z; a0.w += s0 * w.w; a1.x += s1 * w.x; a1.y += s1 * w.y; a1.z += s1 * w.z; a1.w += s1 * w.w; }
                *(float4*)(modp + (size_t)(ks * 2 + 0) * (3 * D) + n0) = a0; *(float4*)(modp + (size_t)(ks * 2 + 1) * (3 * D) + n0) = a1;
                continue; }
            r -= I_ADA;
            if (r < I_IN) { const int nblk = NP / 32, kb = r / nblk, nb = r % nblk, nd = 32 * nb; transpose_item(w_in, INC, nd + (nd >= 5120 ? 8 : 0), Win_t, D, nd, 64 * kb, scr, lane); continue; }
            r -= I_IN;
            if (r < I_PM) { const int nblk = D / 32, kb = r / nblk, nb = r % nblk; transpose_item(w_proj_m, D, 32 * nb, Wpm_t, 1024, 32 * nb, 64 * kb, scr, lane); continue; }
            r -= I_PM;
            if (r < I_PM) { const int nblk = D / 32, kb = r / nblk, nb = r % nblk; transpose_item(w_proj_a, D, 32 * nb, Wpa_t, 1024, 32 * nb, 64 * kb, scr, lane); continue; }
            r -= I_PM;
            { const int nblk = D / 32, kb = r / nblk, nb = r % nblk; transpose_item(w_out, D, 32 * nb, Wout_t, D, 32 * nb, 64 * kb, scr, lane); }
        }
        if (BOTH(0)) grid.sync();
    }

    if (IN(1)) {
        LAS float* smod = (LAS float*)lds;
        LAS float* gwl = (LAS float*)(lds + 49152);
        for (int i = tid; i < 2 * 3 * D; i += NWAVES * 64) { float s = 0.f;
#pragma unroll
            for (int ks = 0; ks < 16; ++ks) s += modp[(size_t)ks * (2 * 3 * D) + i];
            smod[i] = s; if (blockIdx.x == 0) mod[i] = s; }
        if (blockIdx.x == 0 && tid == 0) *(unsigned*)(ws + WS_QCTR) = 0u;
        for (int k = tid; k < D; k += NWAVES * 64) { const float4 w0 = *(const float4*)(w_in + (size_t)k * INC + 5120), w1 = *(const float4*)(w_in + (size_t)k * INC + 5124);
            gwl[0 * D + k] = w0.x; gwl[1 * D + k] = w0.y; gwl[2 * D + k] = w0.z; gwl[3 * D + k] = w0.w; gwl[4 * D + k] = w1.x; gwl[5 * D + k] = w1.y; gwl[6 * D + k] = w1.z; gwl[7 * D + k] = w1.w; }
        __syncthreads();
        for (int rep = 0; rep < REP_P1; ++rep)
        for (int row = gw; row < M; row += NGW) {
            const int b = row / S;
            const float4* xr = (const float4*)(x + (size_t)row * D);
            float4 v[8]; float ss = 0.f;
#pragma unroll
            for (int j = 0; j < 8; ++j) { v[j] = xr[lane + 64 * j]; ss += v[j].x * v[j].x + v[j].y * v[j].y + v[j].z * v[j].z + v[j].w * v[j].w; }
            ss = wave_sum(ss);
            const float rstd = 1.0f / sqrtf(ss * (1.f / D) + EPS);
            float acc[8];
#pragma unroll
            for (int i = 0; i < 8; ++i) acc[i] = 0.f;
            const LAS float* shift = smod + b * 3 * D; const LAS float* scale = shift + D;
#pragma unroll
            for (int j = 0; j < 8; ++j) {
                const int k0 = (lane + 64 * j) * 4;
                const f4 g4 = *(const f4*)(norm_g + k0); const f4 sc4 = *(const LAS f4*)(scale + k0); const f4 sh4 = *(const LAS f4*)(shift + k0);
                float4 h4; h4.x = v[j].x * rstd * g4.x * (1.f + sc4.x) + sh4.x; h4.y = v[j].y * rstd * g4.y * (1.f + sc4.y) + sh4.y; h4.z = v[j].z * rstd * g4.z * (1.f + sc4.z) + sh4.z; h4.w = v[j].w * rstd * g4.w * (1.f + sc4.w) + sh4.w;
#pragma unroll
                for (int i = 0; i < 8; ++i) { const f4 w4 = *(const LAS f4*)(gwl + i * D + k0); acc[i] += h4.x * w4.x + h4.y * w4.y + h4.z * w4.z + h4.w * w4.w; }
                uint2 o; o.x = pk2(h4.x, h4.y); o.y = pk2(h4.z, h4.w);
                *(uint2*)(H + (size_t)row * D + k0) = o;
                asm volatile("" ::: "memory");
            }
#pragma unroll
            for (int i = 0; i < 8; ++i) acc[i] = wave_sum(acc[i]);
            if (lane == 0) {
                rowss[row] = 0.f;
#pragma unroll
                for (int i = 0; i < 4; ++i) gates[(size_t)row * 8 + i] = acc[i] + b_if[i];
#pragma unroll
                for (int i = 4; i < 8; ++i) { const float z = acc[i] + b_if[i]; gates[(size_t)row * 8 + i] = fminf(z, 0.f) - log1pf(expf(-fabsf(z))); }
            }
        }
        __syncthreads();
        if (BOTH(1)) grid.sync();
    }

    if (IN(2)) {
        if (gw < 1024) mlstm_summary(gates, (float*)(ws + WS_SUMM), gw >> 7, gw & 127, lane);
        pg8::Gemm g{H, H, Win_t, Win_t, D, D}; pg8::StaticOrder So; So.init(M, NP, G, (int)blockIdx.x);
        pg8::EpiProj E{proj, NP};
        for (int rep = 0; rep < REP_P2; ++rep) pg8::gemm_phase<pg8::EpiProj, pg8::StaticOrder, true, true>(lds, g, So, E);
        if (BOTH(2)) grid.sync();
    }
    if (IN(3)) {
        MlBufs mb; mb.proj = proj; mb.gates = gates; mb.summ = (const float*)(ws + WS_SUMM); mb.conv_w = a.in[7]; mb.conv_b = a.in[8];
        mb.QC = (bf16*)(ob + OB_QC); mb.KC = (bf16*)(ob + OB_KC); mb.IB = (bf16*)(ob + OB_IB); mb.NT = (bf16*)(ob + OB_NT);
        mb.rowsum = (float*)(ws + WS_RSUM); mb.winter = (float*)(ws + WS_WINT); mb.mcomb = (float*)(ws + WS_MCOMB); mb.wc = (float*)(ws + WS_WC); mb.ninter = (float*)(ws + WS_NINT); mb.vones = (bf16*)(ws + WS_VONES);
        for (int u = blockIdx.x; u < 1024; u += G) mlstm_u1_unit(lds, mb, u >> 9, (u >> 7) & 3, u & 127, tid, lane, wave);
        grid.sync();
        if (blockIdx.x < 40) mlstm_worker2(lds, mb, (blockIdx.x & 7) >> 2, blockIdx.x & 3, blockIdx.x >> 3, tid, lane, wave);
        {
            unsigned* qctr = (unsigned*)(ws + WS_QCTR); volatile LAS unsigned* qslot = (volatile LAS unsigned*)(lds + 163000);
            for (;;) {
                __syncthreads();
                if (tid == 0) *qslot = atomicAdd(qctr, 1u);
                __syncthreads();
                const unsigned q = *qslot;
                if (q >= 512u) break;
                const int u = 511 - (int)q;
                attn_unit(lds, proj, a.in[10], ya, (u & 15) >> 3, u & 7, u >> 4, tid, lane, wave);
            }
        }
        grid.sync();
        for (int rep = 0; rep < REP_POST; ++rep) for (int it = gw; it < M * 4; it += NGW) mlstm_post_item(mb, a.in[9], ym, (size_t)(it >> 2), it & 3, lane);
        if (BOTH(3)) grid.sync();
    }
    if (IN(4)) {
        pg8::Gemm g{ym, ya, Wpm_t, Wpa_t, 1024, 1024}; pg8::SegOrder So; So.base.init(M, D, G, (int)blockIdx.x);
        pg8::EpiMerge E{proj, NP, C_GM, C_GA, merged, NP};
        for (int rep = 0; rep < REP_P4; ++rep) pg8::gemm_phase<pg8::EpiMerge, pg8::SegOrder, true, true>(lds, g, So, E);
        if (BOTH(4)) grid.sync();
    }
    if (IN(5)) {
        pg8::Gemm g{merged, merged, Wout_t, Wout_t, NP, D}; pg8::StaticOrder So; So.init(M, D, G, (int)blockIdx.x);
        pg8::EpiOut E{x, mod + 2 * D, a.out, rowss, D, S, 3 * D};
        pg8::gemm_phase<pg8::EpiOut, pg8::StaticOrder, true, true>(lds, g, So, E);
        if (BOTH(5)) grid.sync();
    }
    if (IN(6)) {
        for (int row = gw; row < M; row += NGW) {
            const float r = 1.0f / sqrtf(rowss[row] * (1.f / D) + EPS);
            f4* xr = (f4*)(a.out + (size_t)row * D);
#pragma unroll
            for (int j = 0; j < 8; ++j) { const f4 g4 = *(const f4*)(final_g + (lane + 64 * j) * 4); xr[lane + 64 * j] = xr[lane + 64 * j] * r * g4; }
        }
    }
#undef IN
#undef BOTH
}

static int launch_mega(const MArgs& a, hipStream_t stream) {
    static int grid = 0;
    if (grid == 0) {
        int dev = 0, cus = 0, per_cu = 0;
        if (hipGetDevice(&dev) != hipSuccess || hipDeviceGetAttribute(&cus, hipDeviceAttributeMultiprocessorCount, dev) != hipSuccess) { fprintf(stderr, "kernel_launch: device query failed\n"); grid = -1; return -1; }
        if (hipFuncSetAttribute((const void*)mega, hipFuncAttributeMaxDynamicSharedMemorySize, LDS_BYTES) != hipSuccess) { fprintf(stderr, "kernel_launch: hipFuncSetAttribute failed\n"); grid = -1; return -1; }
        if (hipOccupancyMaxActiveBlocksPerMultiprocessor(&per_cu, (const void*)mega, NWAVES * 64, LDS_BYTES) != hipSuccess || per_cu < 1) { fprintf(stderr, "kernel_launch: occupancy query says %d blocks/CU\n", per_cu); (void)hipGetLastError(); grid = -1; return -1; }
        grid = cus * (per_cu > 1 ? 1 : per_cu);
        fprintf(stderr, "kernel_launch: %d CUs, occupancy %d blocks/CU, grid %d\n", cus, per_cu, grid);
    }
    if (grid < 0) return -1;
    MArgs arg = a; void* args[] = {(void*)&arg};
    const hipError_t e = hipLaunchCooperativeKernel((const void*)mega, dim3(grid), dim3(NWAVES * 64), args, LDS_BYTES, stream);
    if (e != hipSuccess) { fprintf(stderr, "kernel_launch: cooperative launch failed: %s (grid %d)\n", hipGetErrorString(e), grid); return -1; }
    return 0;
}

extern "C" void kernel_launch(void* const* d_in, const int* in_sizes, int n_in, void* d_out, int out_size, void* d_ws, size_t ws_size, hipStream_t stream) {
    if (n_in != 15 || in_sizes[0] != M * D || out_size != M * D || ws_size < WS_END) { fprintf(stderr, "kernel_launch: unexpected shapes / workspace (%zu < %zu)\n", ws_size, (size_t)WS_END); return; }
    const float* x = (const float*)d_in[0];
    const float* conv_w = (const float*)d_in[7]; const float* conv_b = (const float*)d_in[8]; const float* mh_norm_g = (const float*)d_in[9]; const float* rel_bias = (const float*)d_in[10];
    const float* w_proj_m = (const float*)d_in[11]; const float* w_proj_a = (const float*)d_in[12]; const float* w_out = (const float*)d_in[13]; const float* final_g = (const float*)d_in[14];
    unsigned char* ws = (unsigned char*)d_ws;
    bf16* proj = (bf16*)(ws + WS_PROJ); bf16* ym = (bf16*)(ws + WS_YM); bf16* ya = (bf16*)(ws + WS_YA); float* mod = (float*)(ws + WS_MOD); float* gates = (float*)(ws + WS_GATES);
    unsigned char* ob = (unsigned char*)d_out;
    bf16* qc = (bf16*)ob; bf16* kc = (bf16*)(ob + 32 * MiB); float* hbuf = (float*)(ob + 64 * MiB);
    bf16* merged = proj;

    MArgs a{}; for (int i = 0; i < 15; ++i) a.in[i] = (const float*)d_in[i]; a.out = (float*)d_out; a.ws = (unsigned char*)d_ws; a.ph_lo = 0; a.ph_hi = 7;
    launch_mega(a, stream);
}
```

```cpp
#include <hip/hip_runtime.h>
#include <cstdio>
#include <cstdint>
#include <hip/hip_cooperative_groups.h>
namespace cg = cooperative_groups;

typedef unsigned short bf16;
constexpr int D = 2048, NB = 2, S = 8192, M = NB * S;
constexpr int INC = 13320, NPW = 13312, NP = 12288;
constexpr int C_MQ = 0, C_MK = 1024, C_MV = 2048, C_GZ = 3072, C_AQ = 4096, C_AK = 5120, C_AV = 6144, C_AZ = 7168, C_GM = 8192, C_GA = 10240;
constexpr float EPS = 1e-6f;

__device__ __forceinline__ bf16 f2bf(float f) { unsigned u = __builtin_bit_cast(unsigned, f); return (bf16)((u + 0x7fffu + ((u >> 16) & 1u)) >> 16); }
__device__ __forceinline__ float bf2f(bf16 h) { return __builtin_bit_cast(float, (unsigned)h << 16); }
__device__ __forceinline__ float wave_sum(float v) {
#pragma unroll
    for (int o = 1; o < 64; o <<= 1) v += __shfl_xor(v, o);
    return v;
}
__device__ __forceinline__ float wave_max(float v) {
#pragma unroll
    for (int o = 1; o < 64; o <<= 1) v = fmaxf(v, __shfl_xor(v, o));
    return v;
}
__device__ __forceinline__ float sigmoidf_(float x) { return 1.f / (1.f + __expf(-x)); }
__device__ __forceinline__ float siluf_(float x) { return x / (1.f + __expf(-x)); }

namespace pg8 {
#define PG8_LAS __attribute__((address_space(3)))
typedef unsigned short bf16_t;
typedef short bf16x8 __attribute__((ext_vector_type(8)));
typedef float f32x4 __attribute__((ext_vector_type(4)));
typedef unsigned u32x4 __attribute__((ext_vector_type(4)));
constexpr int BM = 256, BK = 64, HALF = 128, HTB = HALF * BK * 2  , STAGE_BYTES = 8 * HTB, NXCD = 8, WGM = 8;

__host__ __device__ __forceinline__ int lds_byte(int r, int c) { const int st = (r >> 4) * 2 + (c >> 5), rr = r & 15, cc = c & 31, ob = rr * 64 + cc * 2; return st * 1024 + (ob ^ (((ob >> 9) & 1) << 5)); }
__host__ __device__ __forceinline__ void stage_rc(int b, int& R, int& C) { const int st = b / 1024, sb = b % 1024, swz = sb ^ (((sb >> 9) & 1) << 5); R = (st >> 1) * 16 + swz / 64; C = (st & 1) * 32 + (swz % 64) / 2; }
__host__ __device__ __forceinline__ int perm32(int rho) { const int n = rho >> 4, i = rho & 15; return 8 * (i >> 2) + 4 * n + (i & 3); }

struct Unit { int pm, pn, seg; };
struct Gemm { const bf16_t* A0; const bf16_t* A1; const bf16_t* B0; const bf16_t* B1; int lda, K; };

struct StaticOrder {
    int nM, nN, nwg, G, c;
    __host__ __device__ void init(int M, int N, int G_, int c_) { nM = M / BM; nN = N / BM; nwg = nM * nN; G = G_; c = c_; }
    __host__ __device__ bool next(int i, Unit& u) const { return map((long)i * G + c, u); }
    __host__ __device__ bool map(long L, Unit& u) const {
        if (L >= nwg) return false;
        int wgid = (int)L; { const int q = nwg / NXCD, r = nwg % NXCD, xcd = wgid % NXCD, off = wgid / NXCD; wgid = (xcd < r ? xcd * (q + 1) : r * (q + 1) + (xcd - r) * q) + off; }
        const int nig = WGM * nN, gid = wgid / nig, fm = gid * WGM, gsz = (nM - fm) < WGM ? (nM - fm) : WGM;
        u.pm = fm + ((wgid % nig) % gsz); u.pn = (wgid % nig) / gsz; u.seg = 0; return true;
    }
    __device__ __forceinline__ void a_ready(const Unit&) const {}
    __device__ __forceinline__ void done(const Unit&) const {}
};

__device__ __forceinline__ unsigned cvt_pk_bf16(float lo, float hi) { unsigned r; asm volatile("v_cvt_pk_bf16_f32 %0, %1, %2" : "=v"(r) : "v"(lo), "v"(hi)); return r; }
typedef float f32x2 __attribute__((ext_vector_type(2)));
template <class Epi, class Sched, bool ALIGN_EPI = false, bool SP2 = false>
__device__ __forceinline__ void gemm_phase(PG8_LAS unsigned char* lds, const Gemm g, const Sched& S, const Epi& E) {
    const int tid = threadIdx.x, wid = __builtin_amdgcn_readfirstlane(tid >> 6), lane = tid & 63, wr = wid >> 2, wc = wid & 3, fr = lane & 15, fq = lane >> 4;
    const int K = g.K, nt = K / BK;
    unsigned voffA[2], voffB[2];
#pragma unroll
    for (int i = 0; i < 2; ++i) { int R, C; stage_rc(tid * 16 + i * 8192, R, C); const int Rb = Epi::PERM ? ((R & ~31) + perm32(R & 31)) : R;
        voffA[i] = (unsigned)(R * g.lda + C) * 2u; voffB[i] = (unsigned)(Rb * K + C) * 2u; }
    const size_t kstep = (size_t)(BK * 2);
    const size_t hstepA = (size_t)HALF * g.lda * 2, hstepB = (size_t)HALF * K * 2;
    const size_t tstepA = 2 * hstepA, tstepB = 2 * hstepB;
    const unsigned ldsw = (unsigned)wid * 1024u;
    const int aoff = lds_byte(wr * 64 + fr, fq * 8), boff = lds_byte(wc * 32 + fr, fq * 8);
#define PG8_SA(b, h) (((b) * 2 + (h)) * HTB)
#define PG8_SB(b, h) ((4 + (b) * 2 + (h)) * HTB)
#define PG8_STAGE(bufoff, gbase, voff) do { _Pragma("unroll") for (int _i = 0; _i < 2; ++_i) \
        __builtin_amdgcn_global_load_lds((const unsigned*)((const char*)(gbase) + (voff)[_i]), (PG8_LAS unsigned*)(lds + (bufoff) + ldsw + _i * 8192), 16, 0, 0); } while (0)
#define PG8_LDA(dst, b, h) do { _Pragma("unroll") for (int m = 0; m < 4; ++m) _Pragma("unroll") for (int k = 0; k < 2; ++k) dst[m][k] = *(const PG8_LAS bf16x8*)(lds + PG8_SA(b, h) + aoff + m * 2048 + k * 1024); } while (0)
#define PG8_LDB(dst, b, h) do { _Pragma("unroll") for (int n = 0; n < 2; ++n) _Pragma("unroll") for (int k = 0; k < 2; ++k) dst[n][k] = *(const PG8_LAS bf16x8*)(lds + PG8_SB(b, h) + boff + n * 2048 + k * 1024); } while (0)
#define PG8_MMA(ai, bj, At, Bt) do { __builtin_amdgcn_s_setprio(1); _Pragma("unroll") for (int m = 0; m < 4; ++m) _Pragma("unroll") for (int n = 0; n < 2; ++n) _Pragma("unroll") for (int k = 0; k < 2; ++k) \
        acc[ai][bj][m][n] = __builtin_amdgcn_mfma_f32_16x16x32_bf16(Bt[n][k], At[m][k], acc[ai][bj][m][n], 0, 0, 0); __builtin_amdgcn_s_setprio(0); } while (0)
#define PG8_WAIT_V(n) asm volatile("s_waitcnt vmcnt(" #n ")" ::: "memory")
#define PG8_WAIT_L(n) asm volatile("s_waitcnt lgkmcnt(" #n ")" ::: "memory")
#define PG8_BAR __builtin_amdgcn_s_barrier()
#define PG8_SCHED __builtin_amdgcn_sched_barrier(0)
    Unit cur, nxt; int ui = 0;
    if (!S.next(0, cur)) return;
    f32x4 acc[2][2][4][2];
#pragma unroll
    for (int a = 0; a < 2; ++a)
#pragma unroll
        for (int b = 0; b < 2; ++b)
#pragma unroll
            for (int m = 0; m < 4; ++m)
#pragma unroll
                for (int n = 0; n < 2; ++n) acc[a][b][m][n] = (f32x4){0.f, 0.f, 0.f, 0.f};
    bf16x8 At[4][2], B0[2][2], B1[2][2];
    const char* cA = (const char*)(cur.seg ? g.A1 : g.A0) + (size_t)cur.pm * tstepA; const char* cB = (const char*)(cur.seg ? g.B1 : g.B0) + (size_t)cur.pn * tstepB;
    S.a_ready(cur);
    if constexpr (SP2) {
        PG8_STAGE(PG8_SB(0, 0), cB, voffB); PG8_STAGE(PG8_SB(0, 1), cB + hstepB, voffB); PG8_STAGE(PG8_SA(0, 0), cA, voffA); PG8_STAGE(PG8_SA(0, 1), cA + hstepA, voffA);
        if (wr == 1) PG8_BAR;
        PG8_WAIT_V(2); PG8_BAR;
        PG8_STAGE(PG8_SB(1, 0), cB + kstep, voffB); PG8_STAGE(PG8_SA(1, 0), cA + kstep, voffA); PG8_STAGE(PG8_SB(1, 1), cB + hstepB + kstep, voffB);
        PG8_WAIT_V(6); PG8_BAR;
    } else {
        PG8_STAGE(PG8_SB(0, 0), cB, voffB); PG8_STAGE(PG8_SA(0, 0), cA, voffA); PG8_STAGE(PG8_SB(0, 1), cB + hstepB, voffB); PG8_STAGE(PG8_SA(0, 1), cA + hstepA, voffA);
        if (wr == 1) PG8_BAR;
        PG8_WAIT_V(4); PG8_BAR;
        PG8_STAGE(PG8_SB(1, 0), cB + kstep, voffB); PG8_STAGE(PG8_SA(1, 0), cA + kstep, voffA); PG8_STAGE(PG8_SB(1, 1), cB + hstepB + kstep, voffB);
        PG8_WAIT_V(6); PG8_BAR;
    }
    for (;;) {
        const bool has_next = S.next(ui + 1, nxt);
        const char* nA = has_next ? (const char*)(nxt.seg ? g.A1 : g.A0) + (size_t)nxt.pm * tstepA : cA; const char* nB = has_next ? (const char*)(nxt.seg ? g.B1 : g.B0) + (size_t)nxt.pn * tstepB : cB;
        for (int t = 0; t < nt; t += 2) {
            const bool last = (t == nt - 2);
            const char* a1 = cA + (size_t)(t + 1) * kstep;
            const char* a2 = last ? nA : cA + (size_t)(t + 2) * kstep; const char* b2 = last ? nB : cB + (size_t)(t + 2) * kstep;
            const char* a3 = a2 + kstep; const char* b3 = b2 + kstep;
            if (last && has_next) S.a_ready(nxt);
            if constexpr (SP2) {
            PG8_LDB(B0, 0, 0); PG8_LDB(B1, 0, 1); PG8_SCHED; PG8_LDA(At, 0, 0); PG8_STAGE(PG8_SA(1, 1), a1 + hstepA, voffA);
            PG8_WAIT_V(8); PG8_WAIT_L(0); PG8_BAR; PG8_MMA(0, 0, At, B0); PG8_MMA(0, 1, At, B1); PG8_BAR; PG8_SCHED;
            PG8_LDA(At, 0, 1); PG8_STAGE(PG8_SB(0, 0), b2, voffB); PG8_STAGE(PG8_SB(0, 1), b2 + hstepB, voffB); PG8_STAGE(PG8_SA(0, 0), a2, voffA);
            PG8_WAIT_V(8); PG8_WAIT_L(0); PG8_BAR; PG8_MMA(1, 0, At, B0); PG8_MMA(1, 1, At, B1); PG8_BAR; PG8_SCHED;
            PG8_LDB(B0, 1, 0); PG8_LDB(B1, 1, 1); PG8_SCHED; PG8_LDA(At, 1, 0); PG8_STAGE(PG8_SA(0, 1), a2 + hstepA, voffA);
            PG8_WAIT_V(8); PG8_WAIT_L(0); PG8_BAR; PG8_MMA(0, 0, At, B0); PG8_MMA(0, 1, At, B1); PG8_BAR; PG8_SCHED;
            PG8_LDA(At, 1, 1); PG8_STAGE(PG8_SB(1, 0), b3, voffB); PG8_STAGE(PG8_SB(1, 1), b3 + hstepB, voffB); PG8_STAGE(PG8_SA(1, 0), a3, voffA);
            PG8_WAIT_V(8); PG8_WAIT_L(0); PG8_BAR; PG8_MMA(1, 0, At, B0); PG8_MMA(1, 1, At, B1); PG8_BAR; PG8_SCHED;
            } else {
            PG8_LDB(B0, 0, 0); PG8_SCHED; PG8_LDA(At, 0, 0); PG8_STAGE(PG8_SA(1, 1), a1 + hstepA, voffA);
            PG8_WAIT_L(8); PG8_BAR; PG8_WAIT_L(0); PG8_MMA(0, 0, At, B0); PG8_BAR; PG8_SCHED;
            PG8_LDB(B1, 0, 1); PG8_STAGE(PG8_SB(0, 0), b2, voffB);
            PG8_BAR; PG8_WAIT_L(0); PG8_MMA(0, 1, At, B1); PG8_BAR;
            PG8_LDA(At, 0, 1); PG8_STAGE(PG8_SA(0, 0), a2, voffA);
            PG8_BAR; PG8_WAIT_L(0); PG8_MMA(1, 0, At, B0); PG8_BAR; PG8_SCHED;
            PG8_STAGE(PG8_SB(0, 1), b2 + hstepB, voffB);
            PG8_WAIT_V(6); PG8_BAR; PG8_MMA(1, 1, At, B1); PG8_BAR;
            PG8_LDB(B0, 1, 0); PG8_SCHED; PG8_LDA(At, 1, 0); PG8_STAGE(PG8_SA(0, 1), a2 + hstepA, voffA);
            PG8_WAIT_L(8); PG8_BAR; PG8_WAIT_L(0); PG8_MMA(0, 0, At, B0); PG8_BAR; PG8_SCHED;
            PG8_LDB(B1, 1, 1); PG8_STAGE(PG8_SB(1, 0), b3, voffB);
            PG8_BAR; PG8_WAIT_L(0); PG8_MMA(0, 1, At, B1); PG8_BAR;
            PG8_LDA(At, 1, 1); PG8_STAGE(PG8_SA(1, 0), a3, voffA);
            PG8_BAR; PG8_WAIT_L(0); PG8_MMA(1, 0, At, B0); PG8_BAR; PG8_SCHED;
            PG8_STAGE(PG8_SB(1, 1), b3 + hstepB, voffB);
            PG8_WAIT_V(6); PG8_BAR; PG8_MMA(1, 1, At, B1); PG8_BAR;
            }
        }
        if constexpr (ALIGN_EPI) { if (wr == 0) PG8_BAR; }
        if constexpr (!Epi::AFTER_DRAIN) { E(acc, cur, wr, wc, fr, fq); S.done(cur); }
        if (!has_next) break;
        if (E.zero_after(cur)) {
#pragma unroll
        for (int a = 0; a < 2; ++a)
#pragma unroll
            for (int b = 0; b < 2; ++b)
#pragma unroll
                for (int m = 0; m < 4; ++m)
#pragma unroll
                    for (int n = 0; n < 2; ++n) acc[a][b][m][n] = (f32x4){0.f, 0.f, 0.f, 0.f};
        }
        cur = nxt; cA = nA; cB = nB; ++ui;
        if constexpr (ALIGN_EPI) { if (wr == 1) PG8_BAR; }
    }
    PG8_WAIT_V(0);
    if constexpr (!ALIGN_EPI) { if (wr == 0) PG8_BAR; }
    PG8_BAR;
    if constexpr (Epi::AFTER_DRAIN) { E.fused(acc, cur, wr, wc, fr, fq, lds, wid, lane); S.done(cur); }
#undef PG8_SA
#undef PG8_SB
#undef PG8_STAGE
#undef PG8_LDA
#undef PG8_LDB
#undef PG8_MMA
#undef PG8_WAIT_V
#undef PG8_WAIT_L
#undef PG8_BAR
#undef PG8_SCHED
}
}

namespace pg8 {
typedef unsigned u32x4_ __attribute__((ext_vector_type(4)));
struct EpiProj {
    static constexpr bool PERM = true, AFTER_DRAIN = false;
    bf16_t* O; int ldc;
    __device__ __forceinline__ bool zero_after(const Unit&) const { return true; }
    __device__ __forceinline__ void operator()(f32x4 (&acc)[2][2][4][2], const Unit& u, int wr, int wc, int fr, int fq) const {
        const int row0 = u.pm * BM + wr * 64 + fr;
        if (u.pn >= 12 && u.pn < 20) {
            const int col0 = 3072 + 128 * (u.pn - 12) + wc * 32 + 8 * fq;
#pragma unroll
            for (int ai = 0; ai < 2; ++ai)
#pragma unroll
                for (int m = 0; m < 4; ++m) { float o[8];
#pragma unroll
                    for (int e = 0; e < 8; ++e) { const float mo = acc[ai][0][m][e >> 2][e & 3], mz = acc[ai][1][m][e >> 2][e & 3];
                        o[e] = mz * __builtin_amdgcn_rcpf((1.f + __expf(-mo)) * (1.f + __expf(-mz))); }
                    u32x4 w; w.x = cvt_pk_bf16(o[0], o[1]); w.y = cvt_pk_bf16(o[2], o[3]); w.z = cvt_pk_bf16(o[4], o[5]); w.w = cvt_pk_bf16(o[6], o[7]);
                    *(u32x4*)(O + (size_t)(row0 + ai * HALF + m * 16) * ldc + col0) = w; }
        } else {
            const int col0 = (u.pn < 12 ? u.pn * BM : 4096 + (u.pn - 20) * BM) + wc * 32 + 8 * fq;
#pragma unroll
            for (int ai = 0; ai < 2; ++ai)
#pragma unroll
                for (int m = 0; m < 4; ++m) { bf16_t* rowp = O + (size_t)(row0 + ai * HALF + m * 16) * ldc + col0;
#pragma unroll
                    for (int bj = 0; bj < 2; ++bj) { const f32x4 v0 = acc[ai][bj][m][0], v1 = acc[ai][bj][m][1];
                        u32x4 w; w.x = cvt_pk_bf16(v0[0], v0[1]); w.y = cvt_pk_bf16(v0[2], v0[3]); w.z = cvt_pk_bf16(v1[0], v1[1]); w.w = cvt_pk_bf16(v1[2], v1[3]);
                        *(u32x4*)(rowp + bj * HALF) = w; } }
        }
    }
};
struct RestOrder {
    StaticOrder base; int nwork, R, pn0;
    __device__ __forceinline__ bool next(int i, Unit& u) const {
        const int G = base.G, c = base.c, nn = G - nwork; long L;
        if (c < nwork) L = (long)R * nn + (long)i * G + c;
        else L = (i < R) ? (long)i * nn + (c - nwork) : (long)R * nn + (long)(i - R) * G + c;
        if (!base.map(L, u)) return false;
        u.pn += pn0; return true;
    }
    __device__ __forceinline__ void a_ready(const Unit&) const {}
    __device__ __forceinline__ void done(const Unit&) const {}
};
struct SegOrder {
    StaticOrder base;
    __device__ __forceinline__ bool next(int i, Unit& u) const { if (!base.next(i >> 1, u)) return false; u.seg = i & 1; return true; }
    __device__ __forceinline__ void a_ready(const Unit&) const {}
    __device__ __forceinline__ void done(const Unit&) const {}
};
__device__ __forceinline__ float bfw(unsigned w, int half) { return __builtin_bit_cast(float, half ? (w & 0xffff0000u) : (w << 16)); }
struct EpiMerge {
    static constexpr bool PERM = true, AFTER_DRAIN = false;
    const bf16_t* proj; int ldp, cgm, cga; bf16_t* O; int ldo;
    __device__ __forceinline__ bool zero_after(const Unit& u) const { return u.seg != 0; }
    __device__ __forceinline__ void operator()(f32x4 (&acc)[2][2][4][2], const Unit& u, int wr, int wc, int fr, int fq) const {
        const int row0 = u.pm * BM + wr * 64 + fr, col0 = u.pn * BM + wc * 32 + 8 * fq;
#pragma unroll
        for (int ai = 0; ai < 2; ++ai)
#pragma unroll
            for (int m = 0; m < 4; ++m) { const size_t row = (size_t)(row0 + ai * HALF + m * 16);
#pragma unroll
                for (int bj = 0; bj < 2; ++bj) {
                    const u32x4 ga4 = *(const u32x4*)(proj + row * ldp + cga + col0 + bj * HALF);
                    if (u.seg == 0) {
                        const u32x4 gm4 = *(const u32x4*)(proj + row * ldp + cgm + col0 + bj * HALF);
#pragma unroll
                        for (int e = 0; e < 8; ++e) { const float gm = bfw(gm4[e >> 1], e & 1), ga = bfw(ga4[e >> 1], e & 1);
                            acc[ai][bj][m][e >> 2][e & 3] *= (1.f + __expf(-ga)) * __builtin_amdgcn_rcpf(1.f + __expf(-gm)); }
                    } else {
                        float o[8];
#pragma unroll
                        for (int e = 0; e < 8; ++e) { const float ga = bfw(ga4[e >> 1], e & 1); o[e] = acc[ai][bj][m][e >> 2][e & 3] * __builtin_amdgcn_rcpf(1.f + __expf(-ga)); }
                        u32x4 w; w.x = cvt_pk_bf16(o[0], o[1]); w.y = cvt_pk_bf16(o[2], o[3]); w.z = cvt_pk_bf16(o[4], o[5]); w.w = cvt_pk_bf16(o[6], o[7]);
                        *(u32x4*)(O + row * ldo + col0 + bj * HALF) = w;
                    }
                }
                if (m & 1) asm volatile("" ::: "memory"); }
    }
};
struct EpiOut {
    static constexpr bool PERM = false, AFTER_DRAIN = false;
    const float* x; const float* gate; float* out; float* rowss; int ldc, rows_per_batch, gate_stride;
    __device__ __forceinline__ bool zero_after(const Unit&) const { return true; }
    __device__ __forceinline__ void operator()(f32x4 (&acc)[2][2][4][2], const Unit& u, int wr, int wc, int fr, int fq) const {
        const int row0 = u.pm * BM + wr * 64 + fr, col0 = u.pn * BM + wc * 32 + 4 * fq;
        const float* gp = gate + (size_t)((u.pm * BM) / rows_per_batch) * gate_stride + col0;
        f32x4 gt[2][2];
#pragma unroll
        for (int bj = 0; bj < 2; ++bj)
#pragma unroll
            for (int n = 0; n < 2; ++n) gt[bj][n] = *(const f32x4*)(gp + bj * HALF + n * 16);
#pragma unroll
        for (int ai = 0; ai < 2; ++ai)
#pragma unroll
            for (int m = 0; m < 4; ++m) { const int row = row0 + ai * HALF + m * 16; const size_t off = (size_t)row * ldc + col0; float ssq = 0.f;
#pragma unroll
                for (int bj = 0; bj < 2; ++bj)
#pragma unroll
                    for (int n = 0; n < 2; ++n) { const f32x4 xv = *(const f32x4*)(x + off + bj * HALF + n * 16); const f32x4 o = xv + gt[bj][n] * acc[ai][bj][m][n];
                        ssq += (o[0] * o[0] + o[1] * o[1]) + (o[2] * o[2] + o[3] * o[3]); *(f32x4*)(out + off + bj * HALF + n * 16) = o; }
                ssq += __shfl_xor(ssq, 16); ssq += __shfl_xor(ssq, 32);
                if (fq == 0) atomicAdd(rowss + row, ssq);
                if (m & 1) asm volatile("" ::: "memory"); }
    }
};
}

#define PROBE_QUANT 1
#define PROBE_SLOT (-1)
#define LAS __attribute__((address_space(3)))
typedef unsigned v4u __attribute__((ext_vector_type(4)));
typedef float f4 __attribute__((ext_vector_type(4)));
constexpr size_t MiB = 1u << 20;
constexpr size_t WS_PROJ = 0;
constexpr size_t WS_QC = 384 * MiB;
constexpr size_t WS_KC = 416 * MiB;
constexpr size_t WS_IB = 448 * MiB;
constexpr size_t WS_WPM = 480 * MiB;
constexpr size_t WS_WPA = 484 * MiB;
constexpr size_t WS_WOUT = 488 * MiB;
constexpr size_t WS_MODP = 496 * MiB;
constexpr size_t WS_MOD = 497 * MiB;
constexpr size_t WS_GATES = 498 * MiB;
constexpr size_t WS_ROWSS = 499 * MiB;
constexpr size_t WS_SUMM = WS_ROWSS + 65536;
constexpr size_t WS_WC = WS_SUMM + 8192;
constexpr size_t WS_QCTR = WS_WC + 4096;
constexpr size_t WS_TS = WS_WC + 4096 + 256;
constexpr size_t WS_RSUM = WS_ROWSS + 131072;
constexpr size_t WS_WINT = WS_RSUM + 262144;
constexpr size_t WS_MCOMB = WS_WINT + 262144;
constexpr size_t WS_VONES = 501 * MiB;
constexpr size_t WS_END = 510 * MiB;
static_assert(WS_MCOMB + 262144 <= WS_VONES && WS_VONES + (size_t)8 * 8192 * 64 * 2 <= WS_END && WS_PROJ + (size_t)M * NP * 2 <= WS_QC, "d_ws map");
constexpr size_t OB_H = 0;
constexpr size_t OB_WIN = 64 * MiB;
constexpr int NWAVES = 8, LDS_BYTES = 163840;

struct MArgs { const float* in[15]; float* out; unsigned char* ws; int ph_lo, ph_hi; };

__device__ __forceinline__ unsigned pk2(float lo, float hi) { return (unsigned)f2bf(lo) | ((unsigned)f2bf(hi) << 16); }
#define LDS_WAIT() asm volatile("s_waitcnt lgkmcnt(0)" ::: "memory")

__device__ __forceinline__ void transpose_item(const float* __restrict__ W, int ldw, int ncol_src0, bf16* __restrict__ WT, int K, int nrow_dst0, int k0, LAS float* scr, int lane) {
#pragma unroll 8
    for (int i = 0; i < 32; ++i) { const int kk = 2 * i + (lane >> 5); scr[kk * 33 + (lane & 31)] = W[(size_t)(k0 + kk) * ldw + ncol_src0 + (lane & 31)]; }
    LDS_WAIT();
    const int c = lane & 7;
#pragma unroll
    for (int j = 0; j < 4; ++j) { const int n = (lane >> 3) + 8 * j; const LAS float* s = scr + (8 * c) * 33 + n;
        v4u o; o.x = pk2(s[0 * 33], s[1 * 33]); o.y = pk2(s[2 * 33], s[3 * 33]); o.z = pk2(s[4 * 33], s[5 * 33]); o.w = pk2(s[6 * 33], s[7 * 33]);
        *(v4u*)(WT + (size_t)(nrow_dst0 + n) * K + k0 + 8 * c) = o; }
    LDS_WAIT();
}

typedef short bf16x8 __attribute__((ext_vector_type(8)));
typedef short s16x4 __attribute__((ext_vector_type(4)));
typedef float f32x16 __attribute__((ext_vector_type(16)));
typedef float f32x2_t __attribute__((ext_vector_type(2)));
typedef __bf16 bf16x2_t __attribute__((ext_vector_type(2)));
__device__ __forceinline__ unsigned cvtpk(float lo, float hi) { f32x2_t v = {lo, hi}; bf16x2_t b = __builtin_convertvector(v, bf16x2_t); return __builtin_bit_cast(unsigned, b); }
__device__ __forceinline__ s16x4 tr_read(const LAS unsigned char* p) { return __builtin_bit_cast(s16x4, __builtin_amdgcn_ds_read_tr16_b64_v4i16((LAS s16x4*)p)); }
constexpr int AT_KP = 272, AT_VP = 320, AT_KBUF = 64 * AT_KP, AT_VBUF = 64 * AT_VP, AT_VOFF = 2 * AT_KBUF, AT_BIAS = AT_VOFF + 2 * AT_VBUF, AT_LDS = AT_BIAS + 768;
constexpr float LOG2E = 1.4426950408889634f;

__device__ __forceinline__ void attn_unit(LAS unsigned char* lds, bf16* proj, const float* __restrict__ rel_bias, int b, int h, int g4, int tid, int lane, int wave) {
    const int j0 = 4 * g4, half = wave & 1, jq = j0 + (wave >> 1);
    const int r32 = lane & 31, hb = lane >> 5;
    const int tq = 64 * jq + 32 * half + r32;
    const size_t rowq = (size_t)b * S + tq;
    LAS float* biasL = (LAS float*)(lds + AT_BIAS);
    if (tid < 192) biasL[tid] = rel_bias[h * 192 + tid] * LOG2E;
    bf16x8 qf[8];
#pragma unroll
    for (int ks = 0; ks < 8; ++ks) qf[ks] = *(const bf16x8*)(proj + rowq * NP + C_AQ + h * 128 + 16 * ks + 8 * hb);
    f32x16 o[4];
#pragma unroll
    for (int dt = 0; dt < 4; ++dt)
#pragma unroll
        for (int r = 0; r < 16; ++r) o[dt][r] = 0.f;
    float m_run = -1e30f, l_run = 0.f;
    const int t0 = j0 > 8 ? j0 - 8 : 0, nt = j0 + 3 - t0 + 1;
    const int srow = tid >> 4, sc16 = tid & 15;
    const bf16* gsrc = proj + ((size_t)b * S + srow) * NP + h * 128 + sc16 * 8;
    v4u kr0, kr1, vr0, vr1;
#define AT_GLOAD(tc) do { const bf16* g_ = gsrc + (size_t)(64 * (tc)) * NP; kr0 = *(const v4u*)(g_ + C_AK); vr0 = *(const v4u*)(g_ + C_AV); kr1 = *(const v4u*)(g_ + (size_t)32 * NP + C_AK); vr1 = *(const v4u*)(g_ + (size_t)32 * NP + C_AV); } while (0)
#define AT_LWRITE(buf) do { LAS unsigned char* k_ = lds + (buf) * AT_KBUF + srow * AT_KP + sc16 * 16; LAS unsigned char* v_ = lds + AT_VOFF + (buf) * AT_VBUF + srow * AT_VP + sc16 * 16; \
        *(LAS v4u*)k_ = kr0; *(LAS v4u*)(k_ + 32 * AT_KP) = kr1; *(LAS v4u*)v_ = vr0; *(LAS v4u*)(v_ + 32 * AT_VP) = vr1; } while (0)
    AT_GLOAD(t0); AT_LWRITE(0);
    __syncthreads();
    const float SC = 0.08838834764831845f * LOG2E;
    for (int i = 0; i < nt; ++i) {
        const int tc = t0 + i, buf = i & 1;
        if (i + 1 < nt) AT_GLOAD(tc + 1);
        const int cdiff = jq - tc;
        if (cdiff >= 0 && cdiff <= 8) {
            const LAS unsigned char* Kb = lds + buf * AT_KBUF + r32 * AT_KP + hb * 16;
            f32x16 s0, s1;
#pragma unroll
            for (int r = 0; r < 16; ++r) { s0[r] = 0.f; s1[r] = 0.f; }
#pragma unroll
            for (int ks = 0; ks < 8; ++ks) {
                const bf16x8 k0 = *(const LAS bf16x8*)(Kb + ks * 32), k1 = *(const LAS bf16x8*)(Kb + 32 * AT_KP + ks * 32);
                s0 = __builtin_amdgcn_mfma_f32_32x32x16_bf16(k0, qf[ks], s0, 0, 0, 0);
                s1 = __builtin_amdgcn_mfma_f32_32x32x16_bf16(k1, qf[ks], s1, 0, 0, 0);
            }
            if (cdiff >= 3) { const float bc = biasL[191];
#pragma unroll
                for (int r = 0; r < 16; ++r) { s0[r] = s0[r] * SC + bc; s1[r] = s1[r] * SC + bc; }
            } else { const int base = 64 * cdiff + 32 * half + r32 + 63 - 4 * hb;
#pragma unroll
                for (int r = 0; r < 16; ++r) { const int i0 = base - ((r & 3) + 8 * (r >> 2)), i1 = i0 - 32;
                    s0[r] = s0[r] * SC + biasL[i0 > 191 ? 191 : i0]; s1[r] = s1[r] * SC + biasL[i1 > 191 ? 191 : i1]; }
            }
            float mx = fmaxf(s0[0], s1[0]);
#pragma unroll
            for (int r = 1; r < 16; ++r) mx = fmaxf(mx, fmaxf(s0[r], s1[r]));
            mx = fmaxf(mx, __shfl_xor(mx, 32));
            const float m_new = fmaxf(m_run, mx), alpha = __builtin_amdgcn_exp2f(m_run - m_new); m_run = m_new;
            float ls = 0.f;
#pragma unroll
            for (int r = 0; r < 16; ++r) { s0[r] = __builtin_amdgcn_exp2f(s0[r] - m_new); s1[r] = __builtin_amdgcn_exp2f(s1[r] - m_new); ls += s0[r] + s1[r]; }
            l_run = l_run * alpha + ls;
#pragma unroll
            for (int dt = 0; dt < 4; ++dt)
#pragma unroll
                for (int r = 0; r < 16; ++r) o[dt][r] *= alpha;
            v4u pw[4];
            pw[0] = (v4u){cvtpk(s0[0], s0[1]), cvtpk(s0[2], s0[3]), cvtpk(s0[4], s0[5]), cvtpk(s0[6], s0[7])};
            pw[1] = (v4u){cvtpk(s0[8], s0[9]), cvtpk(s0[10], s0[11]), cvtpk(s0[12], s0[13]), cvtpk(s0[14], s0[15])};
            pw[2] = (v4u){cvtpk(s1[0], s1[1]), cvtpk(s1[2], s1[3]), cvtpk(s1[4], s1[5]), cvtpk(s1[6], s1[7])};
            pw[3] = (v4u){cvtpk(s1[8], s1[9]), cvtpk(s1[10], s1[11]), cvtpk(s1[12], s1[13]), cvtpk(s1[14], s1[15])};
            const LAS unsigned char* Vb = lds + AT_VOFF + buf * AT_VBUF + (4 * hb + ((lane & 15) >> 2)) * AT_VP + (16 * ((lane >> 4) & 1) + 4 * (lane & 3)) * 2;
#pragma unroll
            for (int q = 0; q < 4; ++q) {
#pragma unroll
                for (int dt = 0; dt < 4; ++dt) {
                    const s16x4 lo = tr_read(Vb + (16 * q) * AT_VP + dt * 64), hi = tr_read(Vb + (16 * q + 8) * AT_VP + dt * 64);
                    const bf16x8 vf = (bf16x8){lo[0], lo[1], lo[2], lo[3], hi[0], hi[1], hi[2], hi[3]};
                    o[dt] = __builtin_amdgcn_mfma_f32_32x32x16_bf16(vf, __builtin_bit_cast(bf16x8, pw[q]), o[dt], 0, 0, 0);
                }
            }
        }
        if (i + 1 < nt) AT_LWRITE(buf ^ 1);
        __syncthreads();
    }
#undef AT_GLOAD
#undef AT_LWRITE
    const float linv = 1.f / (l_run + __shfl_xor(l_run, 32));
#pragma unroll
    for (int dt = 0; dt < 4; ++dt)
#pragma unroll
        for (int rq = 0; rq < 4; ++rq) {
            const int d0 = 32 * dt + 8 * rq + 4 * hb;
            const uint2 zz = *(const uint2*)(proj + rowq * NP + C_AZ + h * 128 + d0);
            const float z0 = __builtin_bit_cast(float, zz.x << 16), z1 = __builtin_bit_cast(float, zz.x & 0xffff0000u), z2 = __builtin_bit_cast(float, zz.y << 16), z3 = __builtin_bit_cast(float, zz.y & 0xffff0000u);
            uint2 w; w.x = cvtpk(o[dt][4 * rq + 0] * linv * siluf_(z0), o[dt][4 * rq + 1] * linv * siluf_(z1)); w.y = cvtpk(o[dt][4 * rq + 2] * linv * siluf_(z2), o[dt][4 * rq + 3] * linv * siluf_(z3));
            *(uint2*)(proj + rowq * NP + C_AQ + h * 128 + d0) = w;
        }
}

using pg8::bfw;
typedef float f32x4_ __attribute__((ext_vector_type(4)));
typedef unsigned u2v __attribute__((ext_vector_type(2)));
#define MFMA16(a, b, c) __builtin_amdgcn_mfma_f32_16x16x32_bf16((a), (b), (c), 0, 0, 0)
__device__ __forceinline__ float wave_scan_add(float x, int lane) {
#pragma unroll
    for (int o = 1; o < 64; o <<= 1) { const float t = __shfl_up(x, o); if (lane >= o) x += t; }
    return x;
}
__device__ __forceinline__ float wave_scan_max(float x, int lane) {
#pragma unroll
    for (int o = 1; o < 64; o <<= 1) { const float t = __shfl_up(x, o); if (lane >= o) x = fmaxf(x, t); }
    return x;
}
__device__ __forceinline__ void mlstm_summary(const float* __restrict__ gates, float* __restrict__ summ, int bh, int j, int lane) {
    const size_t row = (size_t)(bh >> 2) * S + 64 * j + lane; const int h = bh & 3;
    const float ig = gates[row * 8 + h], lf = gates[row * 8 + 4 + h];
    const float bc = wave_scan_add(lf, lane); const float b_last = __shfl(bc, 63);
    const float gmax = wave_max(b_last - bc + ig);
    if (lane == 0) { summ[(bh * 128 + j) * 2] = b_last; summ[(bh * 128 + j) * 2 + 1] = gmax; }
}
constexpr int U1_QP = 528, U1_VP = 576, U1_SP = 144;
constexpr int U1_QCL = 0, U1_KCL = 64 * U1_QP, U1_VL = 2 * 64 * U1_QP, U1_SWL = U1_VL + 64 * U1_VP, U1_SCAL = U1_SWL + 64 * U1_SP, U1_LDS = U1_SCAL + 3 * 256;
struct MlBufs { bf16* proj; const float* gates; const float* summ; const float* conv_w; const float* conv_b; bf16* QC; bf16* KC; bf16* IB; float* rowsum; float* winter; float* mcomb; float* wc; bf16* vones; };

__device__ __forceinline__ void mlstm_u1_unit(LAS unsigned char* lds, const MlBufs& B, int b, int h, int j, int tid, int lane, int wave) {
    const int bh = b * 4 + h; const size_t rowb = (size_t)b * S + 64 * j;
    LAS float* sA = (LAS float*)(lds + U1_SCAL); LAS float* sC = sA + 64; LAS float* sWk = sA + 128;
    __syncthreads();
    if (wave == 0) {
        const size_t row = rowb + lane;
        const float ig = B.gates[row * 8 + h], lf = B.gates[row * 8 + 4 + h];
        const float bc = wave_scan_add(lf, lane); const float b_last = __shfl(bc, 63);
        const float a_s = ig - bc; const float pm = wave_scan_max(a_s, lane);
        const float gg = b_last - bc + ig; const float gmax = wave_max(gg);
        float m_prev = 0.f;
        if (j > 0) {
            const float bl0 = B.summ[(bh * 128 + lane) * 2], gm0 = B.summ[(bh * 128 + lane) * 2 + 1], bl1 = B.summ[(bh * 128 + 64 + lane) * 2], gm1 = B.summ[(bh * 128 + 64 + lane) * 2 + 1];
            const float P0 = wave_scan_add(bl0, lane); const float tot0 = __shfl(P0, 63); const float P1 = wave_scan_add(bl1, lane) + tot0;
            const int jm = j - 1;
            const float e0 = (lane <= jm) ? gm0 - P0 : -INFINITY, e1 = (lane + 64 <= jm) ? gm1 - P1 : -INFINITY;
            const float emax = wave_max(fmaxf(e0, e1));
            const float Bjm = (jm < 64) ? __shfl(P0, jm) : __shfl(P1, jm - 64);
            m_prev = Bjm + fmaxf(0.f, emax);
        }
        const float m_j = fmaxf(b_last + m_prev, gmax);
        const float c_t = fmaxf(pm, m_prev);
        sA[lane] = a_s; sC[lane] = c_t; sWk[lane] = __expf(gg - m_j);
        B.winter[row * 4 + h] = __expf(m_prev - c_t); B.mcomb[row * 4 + h] = bc + c_t;
        if (lane == 0) B.wc[bh * 128 + j] = __expf(b_last + m_prev - m_j);
    }
    {
        const int cg = tid & 63, tg = tid >> 6, isk = cg >> 5, c8 = (cg & 31) * 8, chan = isk * 1024 + h * 256 + c8;
        const bf16* src = B.proj + (rowb + 8 * tg - 3) * NP + (isk ? C_MK : C_MQ) + h * 256 + c8;
        float wv[4][8], bv[8];
#pragma unroll
        for (int tap = 0; tap < 4; ++tap) { const f4 w0 = *(const f4*)(B.conv_w + tap * 2048 + chan), w1 = *(const f4*)(B.conv_w + tap * 2048 + chan + 4);
            wv[tap][0] = w0[0]; wv[tap][1] = w0[1]; wv[tap][2] = w0[2]; wv[tap][3] = w0[3]; wv[tap][4] = w1[0]; wv[tap][5] = w1[1]; wv[tap][6] = w1[2]; wv[tap][7] = w1[3]; }
        { const f4 b0 = *(const f4*)(B.conv_b + chan), b1 = *(const f4*)(B.conv_b + chan + 4); bv[0] = b0[0]; bv[1] = b0[1]; bv[2] = b0[2]; bv[3] = b0[3]; bv[4] = b1[0]; bv[5] = b1[1]; bv[6] = b1[2]; bv[7] = b1[3]; }
        v4u raw[11];
#pragma unroll
        for (int i = 0; i < 11; ++i) { const int tt = 64 * j + 8 * tg - 3 + i; raw[i] = (tt >= 0) ? *(const v4u*)(src + (size_t)i * NP) : (v4u){0u, 0u, 0u, 0u}; }
        const float osc = isk ? 0.0625f : 1.f;
        LAS unsigned char* ldst = lds + (isk ? U1_KCL : U1_QCL) + (8 * tg) * U1_QP + c8 * 2;
        bf16* gdst = (isk ? B.KC : B.QC) + (rowb + 8 * tg) * 1024 + h * 256 + c8;
#pragma unroll
        for (int t8 = 0; t8 < 8; ++t8) {
            float o[8];
#pragma unroll
            for (int e = 0; e < 8; ++e) { float acc = bv[e];
#pragma unroll
                for (int tap = 0; tap < 4; ++tap) acc += wv[tap][e] * bfw(raw[t8 + tap][e >> 1], e & 1);
                o[e] = siluf_(acc) * osc; }
            const v4u w = (v4u){cvtpk(o[0], o[1]), cvtpk(o[2], o[3]), cvtpk(o[4], o[5]), cvtpk(o[6], o[7])};
            *(LAS v4u*)(ldst + t8 * U1_QP) = w; *(v4u*)(gdst + (size_t)t8 * 1024) = w;
        }
    }
    v4u vraw[4];
#pragma unroll
    for (int i = 0; i < 4; ++i) { const int ch = tid + 512 * i, row = ch >> 5, c16 = ch & 31; vraw[i] = *(const v4u*)(B.proj + (rowb + row) * NP + C_MV + h * 256 + c16 * 8);
        *(LAS v4u*)(lds + U1_VL + row * U1_VP + c16 * 16) = vraw[i]; }
    if (tid < 128) *(LAS v4u*)(lds + U1_VL + (tid >> 1) * U1_VP + 512 + (tid & 1) * 16) = (tid & 1) ? (v4u){0u, 0u, 0u, 0u} : (v4u){0x00003F80u, 0u, 0u, 0u};
    __syncthreads();
    const int fr = lane & 15, g = lane >> 4;
    {
        const int tt = wave & 3, st0 = 2 * (wave >> 2);
        f32x4_ sacc[2] = {{0.f, 0.f, 0.f, 0.f}, {0.f, 0.f, 0.f, 0.f}};
#pragma unroll
        for (int ks = 0; ks < 8; ++ks) {
            const bf16x8 bq = *(const LAS bf16x8*)(lds + U1_QCL + (16 * tt + fr) * U1_QP + (32 * ks + 8 * g) * 2);
#pragma unroll
            for (int i = 0; i < 2; ++i) { const bf16x8 ak = *(const LAS bf16x8*)(lds + U1_KCL + (16 * (st0 + i) + fr) * U1_QP + (32 * ks + 8 * g) * 2); sacc[i] = MFMA16(ak, bq, sacc[i]); }
        }
        const int t = 16 * tt + fr; const float c_t = sC[t];
#pragma unroll
        for (int i = 0; i < 2; ++i) { const int s0 = 16 * (st0 + i) + 4 * g; const f4 a4 = *(const LAS f4*)(sA + s0);
            float o[4];
#pragma unroll
            for (int r = 0; r < 4; ++r) o[r] = (s0 + r <= t) ? sacc[i][r] * __expf(a4[r] - c_t) : 0.f;
            u2v w; w.x = cvtpk(o[0], o[1]); w.y = cvtpk(o[2], o[3]);
            *(LAS u2v*)(lds + U1_SWL + t * U1_SP + s0 * 2) = w; }
    }
    __syncthreads();
    {
        const int nvt = (wave == 0) ? 3 : 2;
        for (int iv = 0; iv < nvt; ++iv) {
            const int vt = (iv == 2) ? 16 : 2 * wave + iv;
            f32x4_ ia[4] = {{0.f, 0.f, 0.f, 0.f}, {0.f, 0.f, 0.f, 0.f}, {0.f, 0.f, 0.f, 0.f}, {0.f, 0.f, 0.f, 0.f}};
#pragma unroll
            for (int ks = 0; ks < 2; ++ks) {
                const LAS unsigned char* va = lds + U1_VL + (32 * ks + 8 * g + ((lane & 15) >> 2)) * U1_VP + (16 * vt + 4 * (lane & 3)) * 2;
                const s16x4 lo = tr_read(va), hi = tr_read(va + 4 * U1_VP);
                const bf16x8 af = (bf16x8){lo[0], lo[1], lo[2], lo[3], hi[0], hi[1], hi[2], hi[3]};
#pragma unroll
                for (int tt = 0; tt < 4; ++tt) { const bf16x8 bs = *(const LAS bf16x8*)(lds + U1_SWL + (16 * tt + fr) * U1_SP + (32 * ks + 8 * g) * 2); ia[tt] = MFMA16(af, bs, ia[tt]); }
            }
#pragma unroll
            for (int tt = 0; tt < 4; ++tt) { const size_t row = rowb + 16 * tt + fr;
                if (vt < 16) { uint2 w; w.x = cvtpk(ia[tt][0], ia[tt][1]); w.y = cvtpk(ia[tt][2], ia[tt][3]); *(uint2*)(B.IB + row * 1024 + h * 256 + 16 * vt + 4 * g) = w; }
                else if (g == 0) B.rowsum[row * 4 + h] = ia[tt][0]; }
        }
    }
#pragma unroll
    for (int i = 0; i < 4; ++i) { const int ch = tid + 512 * i, row = ch >> 5, c16 = ch & 31; const float wk = sWk[row]; v4u w;
#pragma unroll
        for (int e = 0; e < 4; ++e) w[e] = cvtpk(bfw(vraw[i][e], 0) * wk, bfw(vraw[i][e], 1) * wk);
        *(v4u*)(B.proj + (rowb + row) * NP + C_MV + h * 256 + c16 * 8) = w; }
    { const int srow = tid >> 3, c = tid & 7; const unsigned w0 = (c == 0) ? (unsigned)f2bf(sWk[srow]) : 0u;
      *(v4u*)(B.vones + ((size_t)bh * S + 64 * j + srow) * 64 + c * 8) = (v4u){w0, 0u, 0u, 0u}; }
}

constexpr int W_QP = 528, W_KP = 544, W_VP = 144, W_QL = 0, W_KL = 64 * W_QP, W_VL = W_KL + 64 * W_KP, W_LDS = W_VL + 64 * W_VP;
constexpr int W2_STAGE = W_LDS, W2_WC = 2 * W2_STAGE, W2_LDS = W2_WC + 512;
__device__ __forceinline__ void w2_compute(f32x4_ (&Ct)[16], const LAS unsigned char* st, float w_c, const MlBufs& B, size_t row0, int h, int sl, int vq, int lane,
                                           const uint2 (&ibn)[4], const float (&win)[4], uint2 (&ibx)[4], float (&wix)[4], bool has_next) {
    const int fr = lane & 15, g = lane >> 4;
#pragma unroll
    for (int tt = 0; tt < 4; ++tt) { const size_t rown = row0 + (has_next ? 64 : 0) + 16 * tt + fr;
        wix[tt] = B.winter[rown * 4 + h];
        if (sl < 4) ibx[tt] = *(const uint2*)(B.IB + rown * 1024 + h * 256 + 64 * sl + 16 * vq + 4 * g); else { ibx[tt].x = __float_as_uint(B.rowsum[rown * 4 + h]); ibx[tt].y = 0u; } }
    f32x4_ ia[4] = {{0.f, 0.f, 0.f, 0.f}, {0.f, 0.f, 0.f, 0.f}, {0.f, 0.f, 0.f, 0.f}, {0.f, 0.f, 0.f, 0.f}};
    const LAS unsigned char* qbase = st + W_QL + fr * W_QP + (4 * g) * 2;
    u2v qlo[2][4], qhi[2][4];
#pragma unroll
    for (int tt = 0; tt < 4; ++tt) { qlo[0][tt] = *(const LAS u2v*)(qbase + 16 * tt * W_QP); qhi[0][tt] = *(const LAS u2v*)(qbase + 16 * tt * W_QP + 32); }
#pragma unroll
    for (int kk = 0; kk < 8; ++kk) {
        if (kk + 1 < 8) {
#pragma unroll
            for (int tt = 0; tt < 4; ++tt) { qlo[(kk + 1) & 1][tt] = *(const LAS u2v*)(qbase + 16 * tt * W_QP + 64 * (kk + 1)); qhi[(kk + 1) & 1][tt] = *(const LAS u2v*)(qbase + 16 * tt * W_QP + 64 * (kk + 1) + 32); }
        }
        const v4u cw = (v4u){cvtpk(Ct[2 * kk][0], Ct[2 * kk][1]), cvtpk(Ct[2 * kk][2], Ct[2 * kk][3]), cvtpk(Ct[2 * kk + 1][0], Ct[2 * kk + 1][1]), cvtpk(Ct[2 * kk + 1][2], Ct[2 * kk + 1][3])};
        __builtin_amdgcn_sched_barrier(0);
#pragma unroll
        for (int tt = 0; tt < 4; ++tt)
            ia[tt] = MFMA16(__builtin_bit_cast(bf16x8, cw), __builtin_bit_cast(bf16x8, ((v4u){qlo[kk & 1][tt].x, qlo[kk & 1][tt].y, qhi[kk & 1][tt].x, qhi[kk & 1][tt].y})), ia[tt]);
        __builtin_amdgcn_sched_barrier(0);
    }
#pragma unroll
    for (int tt = 0; tt < 4; ++tt) { const size_t row = row0 + 16 * tt + fr; const float wi = win[tt];
        if (sl < 4) { uint2 w; w.x = cvtpk(bfw(ibn[tt].x, 0) + wi * ia[tt][0], bfw(ibn[tt].x, 1) + wi * ia[tt][1]); w.y = cvtpk(bfw(ibn[tt].y, 0) + wi * ia[tt][2], bfw(ibn[tt].y, 1) + wi * ia[tt][3]);
            *(uint2*)(B.IB + row * 1024 + h * 256 + 64 * sl + 16 * vq + 4 * g) = w; }
        else if (vq == 0 && g == 0) B.rowsum[row * 4 + h] = __uint_as_float(ibn[tt].x) + wi * ia[tt][0]; }
#pragma unroll
    for (int kt = 0; kt < 16; ++kt) Ct[kt] *= w_c;
#pragma unroll
    for (int ks = 0; ks < 2; ++ks) {
        const LAS unsigned char* vb = st + W_VL + (32 * ks + 8 * g + ((lane & 15) >> 2)) * W_VP + (16 * vq + 4 * (lane & 3)) * 2;
        const s16x4 vlo = tr_read(vb), vhi = tr_read(vb + 4 * W_VP);
        const bf16x8 bvf = (bf16x8){vlo[0], vlo[1], vlo[2], vlo[3], vhi[0], vhi[1], vhi[2], vhi[3]};
        const LAS unsigned char* ka = st + W_KL + (32 * ks + 8 * g + ((lane & 15) >> 2)) * W_KP + (4 * (lane & 3)) * 2;
#pragma unroll
        for (int kt = 0; kt < 16; ++kt) { const s16x4 klo = tr_read(ka + kt * 32), khi = tr_read(ka + kt * 32 + 4 * W_KP);
            const bf16x8 akf = (bf16x8){klo[0], klo[1], klo[2], klo[3], khi[0], khi[1], khi[2], khi[3]};
            Ct[kt] = MFMA16(akf, bvf, Ct[kt]); }
    }
}
__device__ __forceinline__ void mlstm_worker2(LAS unsigned char* lds, const MlBufs& B, int b, int h, int sl, int tid, int lane, int wave) {
    const int bh = b * 4 + h; const size_t rowb = (size_t)b * S;
    const bf16* vsrc = (sl < 4) ? (B.proj + rowb * NP + C_MV + h * 256 + 64 * sl) : (B.vones + (size_t)bh * S * 64);
    const size_t vpitch = (sl < 4) ? (size_t)NP : (size_t)64;
    LAS float* wcL = (LAS float*)(lds + W2_WC);
    __syncthreads();
    if (tid < 128) wcL[tid] = B.wc[bh * 128 + tid];
    const bool loader = wave >= 4;
    const int lt = tid & 255;
    const bf16* qsrc = B.QC + (rowb + (lt >> 5)) * 1024 + h * 256 + (lt & 31) * 8;
    const bf16* ksrc = B.KC + (rowb + (lt >> 5)) * 1024 + h * 256 + (lt & 31) * 8;
    const bf16* vs2 = vsrc + (size_t)(lt >> 3) * vpitch + (lt & 7) * 8;
    const int qoff = W_QL + (lt >> 5) * W_QP + (lt & 31) * 16, koff = W_KL + (lt >> 5) * W_KP + (lt & 31) * 16, voff = W_VL + (lt >> 3) * W_VP + (lt & 7) * 16;
    v4u ra[18], rb[18];
#define L_GLOAD(R, jj) do { _Pragma("unroll") for (int i_ = 0; i_ < 8; ++i_) { R[i_] = *(const v4u*)(qsrc + (size_t)(64 * (jj) + 8 * i_) * 1024); R[8 + i_] = *(const v4u*)(ksrc + (size_t)(64 * (jj) + 8 * i_) * 1024); } \
        R[16] = *(const v4u*)(vs2 + (size_t)(64 * (jj)) * vpitch); R[17] = *(const v4u*)(vs2 + (size_t)(64 * (jj) + 32) * vpitch); } while (0)
#define L_WRITE(R, bufo) do { LAS unsigned char* s_ = lds + (bufo); _Pragma("unroll") for (int i_ = 0; i_ < 8; ++i_) { *(LAS v4u*)(s_ + qoff + 8 * i_ * W_QP) = R[i_]; *(LAS v4u*)(s_ + koff + 8 * i_ * W_KP) = R[8 + i_]; } \
        *(LAS v4u*)(s_ + voff) = R[16]; *(LAS v4u*)(s_ + voff + 32 * W_VP) = R[17]; } while (0)
    if (loader) {
        L_GLOAD(ra, 0); L_WRITE(ra, 0); L_GLOAD(ra, 1); L_GLOAD(rb, 2);
        __syncthreads();
        for (int j = 0; j < 128; j += 2) {
            L_WRITE(ra, W2_STAGE); { const int jn = (j + 3 < 128) ? j + 3 : 127; L_GLOAD(ra, jn); }
            __syncthreads();
            L_WRITE(rb, 0); { const int jn = (j + 4 < 128) ? j + 4 : 127; L_GLOAD(rb, jn); }
            __syncthreads();
        }
    } else {
        f32x4_ Ct[16];
#pragma unroll
        for (int kt = 0; kt < 16; ++kt) Ct[kt] = (f32x4_){0.f, 0.f, 0.f, 0.f};
        uint2 iba[4], ibb[4]; float wia[4], wib[4];
        { const int fr = lane & 15, g = lane >> 4;
#pragma unroll
          for (int tt = 0; tt < 4; ++tt) { const size_t r0 = rowb + 16 * tt + fr; wia[tt] = B.winter[r0 * 4 + h];
              if (sl < 4) iba[tt] = *(const uint2*)(B.IB + r0 * 1024 + h * 256 + 64 * sl + 16 * wave + 4 * g); else { iba[tt].x = __float_as_uint(B.rowsum[r0 * 4 + h]); iba[tt].y = 0u; } } }
        __syncthreads();
        for (int j = 0; j < 128; j += 2) {
            w2_compute(Ct, lds, wcL[j], B, rowb + 64 * j, h, sl, wave, lane, iba, wia, ibb, wib, true);
            __syncthreads();
            w2_compute(Ct, lds + W2_STAGE, wcL[j + 1], B, rowb + 64 * (j + 1), h, sl, wave, lane, ibb, wib, iba, wia, j + 2 < 128);
            __syncthreads();
        }
    }
#undef L_GLOAD
#undef L_WRITE
}
__device__ __forceinline__ void mlstm_post_item(const MlBufs& B, const float* __restrict__ mh_norm_g, size_t row, int h, int lane) {
    const uint2 iw = *(const uint2*)(B.IB + row * 1024 + h * 256 + lane * 4);
    const float dinv = 1.f / fmaxf(fabsf(B.rowsum[row * 4 + h]), __expf(-B.mcomb[row * 4 + h]));
    float hv[4];
    hv[0] = bfw(iw.x, 0) * dinv; hv[1] = bfw(iw.x, 1) * dinv; hv[2] = bfw(iw.y, 0) * dinv; hv[3] = bfw(iw.y, 1) * dinv;
    const float ss = wave_sum(hv[0] * hv[0] + hv[1] * hv[1] + hv[2] * hv[2] + hv[3] * hv[3]);
    const float r = 1.0f / sqrtf(ss * (1.f / 256.f) + EPS);
    const int c = h * 256 + lane * 4;
    bf16* gp = B.proj + row * NP + C_GZ + c;
    const uint2 gz = *(const uint2*)gp;
    const f4 gn = *(const f4*)(mh_norm_g + c);
    uint2 w;
    w.x = cvtpk(hv[0] * r * gn[0] * bfw(gz.x, 0), hv[1] * r * gn[1] * bfw(gz.x, 1));
    w.y = cvtpk(hv[2] * r * gn[2] * bfw(gz.y, 0), hv[3] * r * gn[3] * bfw(gz.y, 1));
    *(uint2*)gp = w;
}
__global__ void __launch_bounds__(NWAVES * 64, 2) mega(MArgs a) {
    extern __shared__ __attribute__((aligned(16))) unsigned char lds_raw[];
    LAS unsigned char* lds = (LAS unsigned char*)lds_raw;
    cg::grid_group grid = cg::this_grid();
    const int tid = threadIdx.x, lane = tid & 63, wave = __builtin_amdgcn_readfirstlane(tid >> 6);
    const int G = gridDim.x, gw = blockIdx.x * NWAVES + wave, NGW = G * NWAVES;
    const float* x = a.in[0]; const float* cvec = a.in[1]; const float* w_ada = a.in[2]; const float* b_ada = a.in[3]; const float* norm_g = a.in[4]; const float* w_in = a.in[5];
    const float* b_if = a.in[6]; const float* final_g = a.in[14]; const float* w_proj_m = a.in[11]; const float* w_proj_a = a.in[12]; const float* w_out = a.in[13];
    unsigned char* ws = a.ws; unsigned char* ob = (unsigned char*)a.out;
    bf16* proj = (bf16*)(ws + WS_PROJ); bf16* Wpm_t = (bf16*)(ws + WS_WPM); bf16* Wpa_t = (bf16*)(ws + WS_WPA); bf16* Wout_t = (bf16*)(ws + WS_WOUT);
    float* modp = (float*)(ws + WS_MODP); float* mod = (float*)(ws + WS_MOD); float* gates = (float*)(ws + WS_GATES); float* rowss = (float*)(ws + WS_ROWSS);
    bf16* merged = proj;
    bf16* H = (bf16*)(ob + OB_H); bf16* Win_t = (bf16*)(ob + OB_WIN);
    const int lo = a.ph_lo, hi = a.ph_hi;
    unsigned long long* tsb = (unsigned long long*)(ws + WS_TS); int nst = 0;
#define STAMP() do { if (PROBE_SLOT >= 0 && blockIdx.x == 0 && tid == 0) tsb[nst] = __builtin_amdgcn_s_memrealtime(); ++nst; } while (0)
    STAMP();
#define IN(k) (lo <= (k) && (k) < hi)
#define BOTH(k) (IN(k) && IN((k) + 1))

    if (IN(0)) {
        LAS float* scr = (LAS float*)(lds + wave * 16384);
        constexpr int I_ADA = 16 * 24, I_IN = (D / 64) * (NPW / 32), I_PM = (1024 / 64) * (D / 32), I_OUT = (D / 64) * (D / 32);
        constexpr int NITEMS = I_ADA + I_IN + 2 * I_PM + I_OUT;
        for (int it = gw; it < NITEMS; it += NGW) {
            int r = it;
            if (r < I_ADA) {
                const int ks = r / 24, cb = r % 24, n0 = cb * 256 + lane * 4;
                float4 a0 = {0.f, 0.f, 0.f, 0.f}, a1 = {0.f, 0.f, 0.f, 0.f};
                if (ks == 0) { a0 = *(const float4*)(b_ada + n0); a1 = a0; }
#pragma unroll 8
                for (int kk = 0; kk < 128; ++kk) { const int k = ks * 128 + kk; const float4 w = *(const float4*)(w_ada + (size_t)k * (3 * D) + n0);
                    const float c0 = cvec[k], c1 = cvec[D + k]; const float s0 = c0 / (1.f + __expf(-c0)), s1 = c1 / (1.f + __expf(-c1));
                    a0.x += s0 * w.x; a0.y += s0 * w.y; a0.z += s0 * w.z; a0.w += s0 * w.w; a1.x += s1 * w.x; a1.y += s1 * w.y; a1.z += s1 * w.z; a1.w += s1 * w.w; }
                *(float4*)(modp + (size_t)(ks * 2 + 0) * (3 * D) + n0) = a0; *(float4*)(modp + (size_t)(ks * 2 + 1) * (3 * D) + n0) = a1;
                continue; }
            r -= I_ADA;
            if (r < I_IN) { const int nblk = NPW / 32, kb = r / nblk, nb = r % nblk, nd = 32 * nb;
                int ns = nd; if (nd >= 5120) ns = nd + 8; else if (nd >= 3072) { const int t = (nd - 3072) >> 8, rr = (nd - 3072) & 255; ns = (rr < 128) ? 3072 + 128 * t + rr : 4096 + 128 * t + (rr - 128); }
                transpose_item(w_in, INC, ns, Win_t, D, nd, 64 * kb, scr, lane); continue; }
            r -= I_IN;
            if (r < I_PM) { const int nblk = D / 32, kb = r / nblk, nb = r % nblk; transpose_item(w_proj_m, D, 32 * nb, Wpm_t, 1024, 32 * nb, 64 * kb, scr, lane); continue; }
            r -= I_PM;
            if (r < I_PM) { const int nblk = D / 32, kb = r / nblk, nb = r % nblk; transpose_item(w_proj_a, D, 32 * nb, Wpa_t, 1024, 32 * nb, 64 * kb, scr, lane); continue; }
            r -= I_PM;
            { const int nblk = D / 32, kb = r / nblk, nb = r % nblk; transpose_item(w_out, D, 32 * nb, Wout_t, D, 32 * nb, 64 * kb, scr, lane); }
        }
        if (BOTH(0)) grid.sync(); STAMP();
    }

    if (IN(1)) {
        LAS float* smod = (LAS float*)lds;
        LAS float* gwl = (LAS float*)(lds + 49152);
        for (int i = tid; i < 2 * 3 * D; i += NWAVES * 64) { float s = 0.f;
#pragma unroll
            for (int ks = 0; ks < 16; ++ks) s += modp[(size_t)ks * (2 * 3 * D) + i];
            smod[i] = s; if (blockIdx.x == 0) mod[i] = s; }
        if (blockIdx.x == 0 && tid == 0) *(unsigned*)(ws + WS_QCTR) = 0u;
        for (int k = tid; k < D; k += NWAVES * 64) { const float4 w0 = *(const float4*)(w_in + (size_t)k * INC + 5120), w1 = *(const float4*)(w_in + (size_t)k * INC + 5124);
            gwl[0 * D + k] = w0.x; gwl[1 * D + k] = w0.y; gwl[2 * D + k] = w0.z; gwl[3 * D + k] = w0.w; gwl[4 * D + k] = w1.x; gwl[5 * D + k] = w1.y; gwl[6 * D + k] = w1.z; gwl[7 * D + k] = w1.w; }
        __syncthreads();
        for (int row = gw; row < M; row += NGW) {
            const int b = row / S;
            const float4* xr = (const float4*)(x + (size_t)row * D);
            float4 v[8]; float ss = 0.f;
#pragma unroll
            for (int j = 0; j < 8; ++j) { v[j] = xr[lane + 64 * j]; ss += v[j].x * v[j].x + v[j].y * v[j].y + v[j].z * v[j].z + v[j].w * v[j].w; }
            ss = wave_sum(ss);
            const float rstd = 1.0f / sqrtf(ss * (1.f / D) + EPS);
            float acc[8];
#pragma unroll
            for (int i = 0; i < 8; ++i) acc[i] = 0.f;
            const LAS float* shift = smod + b * 3 * D; const LAS float* scale = shift + D;
#pragma unroll
            for (int j = 0; j < 8; ++j) {
                const int k0 = (lane + 64 * j) * 4;
                const f4 g4 = *(const f4*)(norm_g + k0); const f4 sc4 = *(const LAS f4*)(scale + k0); const f4 sh4 = *(const LAS f4*)(shift + k0);
                float4 h4; h4.x = v[j].x * rstd * g4.x * (1.f + sc4.x) + sh4.x; h4.y = v[j].y * rstd * g4.y * (1.f + sc4.y) + sh4.y; h4.z = v[j].z * rstd * g4.z * (1.f + sc4.z) + sh4.z; h4.w = v[j].w * rstd * g4.w * (1.f + sc4.w) + sh4.w;
#pragma unroll
                for (int i = 0; i < 8; ++i) { const f4 w4 = *(const LAS f4*)(gwl + i * D + k0); acc[i] += h4.x * w4.x + h4.y * w4.y + h4.z * w4.z + h4.w * w4.w; }
                uint2 o; o.x = pk2(h4.x, h4.y); o.y = pk2(h4.z, h4.w);
                *(uint2*)(H + (size_t)row * D + k0) = o;
                asm volatile("" ::: "memory");
            }
#pragma unroll
            for (int i = 0; i < 8; ++i) acc[i] = wave_sum(acc[i]);
            if (lane == 0) {
                rowss[row] = 0.f;
#pragma unroll
                for (int i = 0; i < 4; ++i) gates[(size_t)row * 8 + i] = acc[i] + b_if[i];
#pragma unroll
                for (int i = 4; i < 8; ++i) { const float z = acc[i] + b_if[i]; gates[(size_t)row * 8 + i] = fminf(z, 0.f) - log1pf(expf(-fabsf(z))); }
            }
        }
        __syncthreads();
        if (BOTH(1)) grid.sync(); STAMP();
    }

    constexpr int NWORK = 40, SKIP_ROUNDS = 6;
    if (IN(2)) {
        if (gw < 1024) mlstm_summary(gates, (float*)(ws + WS_SUMM), gw >> 7, gw & 127, lane);
        pg8::Gemm g{H, H, Win_t, Win_t, D, D}; pg8::StaticOrder So; So.init(M, 12 * 256, G, (int)blockIdx.x);
        pg8::EpiProj E{proj, NP};
        pg8::gemm_phase<pg8::EpiProj, pg8::StaticOrder, true, true>(lds, g, So, E);
        if (BOTH(2)) { grid.sync(); STAMP(); }
    }
    if (IN(3)) {
        MlBufs mb; mb.proj = proj; mb.gates = gates; mb.summ = (const float*)(ws + WS_SUMM); mb.conv_w = a.in[7]; mb.conv_b = a.in[8];
        mb.QC = (bf16*)(ws + WS_QC); mb.KC = (bf16*)(ws + WS_KC); mb.IB = (bf16*)(ws + WS_IB);
        mb.rowsum = (float*)(ws + WS_RSUM); mb.winter = (float*)(ws + WS_WINT); mb.mcomb = (float*)(ws + WS_MCOMB); mb.wc = (float*)(ws + WS_WC); mb.vones = (bf16*)(ws + WS_VONES);
        for (int u = blockIdx.x; u < 1024; u += G) mlstm_u1_unit(lds, mb, u >> 9, (u >> 7) & 3, u & 127, tid, lane, wave);
        grid.sync(); STAMP();
        if (blockIdx.x < NWORK) mlstm_worker2(lds, mb, (blockIdx.x & 7) >> 2, blockIdx.x & 3, blockIdx.x >> 3, tid, lane, wave);
        {
            pg8::Gemm g{H, H, Win_t, Win_t, D, D}; pg8::RestOrder So; So.base.init(M, 40 * 256, G, (int)blockIdx.x); So.nwork = NWORK; So.R = SKIP_ROUNDS; So.pn0 = 12;
            pg8::EpiProj E{proj, NP};
            pg8::gemm_phase<pg8::EpiProj, pg8::RestOrder, true, true>(lds, g, So, E);
        }
        grid.sync(); STAMP();
        for (int it = gw; it < M * 4; it += NGW) mlstm_post_item(mb, a.in[9], (size_t)(it >> 2), it & 3, lane);
        {
            unsigned* qctr = (unsigned*)(ws + WS_QCTR); volatile LAS unsigned* qslot = (volatile LAS unsigned*)(lds + 163000);
            for (;;) {
                __syncthreads();
                if (tid == 0) *qslot = atomicAdd(qctr, 1u);
                __syncthreads();
                const unsigned q = *qslot;
                if (q >= 512u) break;
                const int u = 511 - (int)q;
                attn_unit(lds, proj, a.in[10], (u & 15) >> 3, u & 7, u >> 4, tid, lane, wave);
            }
        }
        if (BOTH(3)) { grid.sync(); STAMP(); }
    }
    if (IN(4)) {
        pg8::Gemm g{proj + C_GZ, proj + C_AQ, Wpm_t, Wpa_t, NP, 1024}; pg8::SegOrder So; So.base.init(M, D, G, (int)blockIdx.x);
        pg8::EpiMerge E{proj, NP, C_GM, C_GA, merged, NP};
        pg8::gemm_phase<pg8::EpiMerge, pg8::SegOrder, true, true>(lds, g, So, E);
        if (BOTH(4)) grid.sync(); STAMP();
    }
    if (IN(5)) {
        pg8::Gemm g{merged, merged, Wout_t, Wout_t, NP, D}; pg8::StaticOrder So; So.init(M, D, G, (int)blockIdx.x);
        pg8::EpiOut E{x, mod + 2 * D, a.out, rowss, D, S, 3 * D};
        pg8::gemm_phase<pg8::EpiOut, pg8::StaticOrder, true, true>(lds, g, So, E);
        if (BOTH(5)) grid.sync(); STAMP();
    }
    if (IN(6)) {
        for (int row = gw; row < M; row += NGW) {
            const float r = 1.0f / sqrtf(rowss[row] * (1.f / D) + EPS);
            f4* xr = (f4*)(a.out + (size_t)row * D);
#pragma unroll
            for (int j = 0; j < 8; ++j) { const f4 g4 = *(const f4*)(final_g + (lane + 64 * j) * 4); xr[lane + 64 * j] = xr[lane + 64 * j] * r * g4; }
        }
    }
    if (PROBE_SLOT >= 0) {
        STAMP(); grid.sync();
        const float e = (float)(((tsb[PROBE_SLOT + 1] - tsb[PROBE_SLOT]) / PROBE_QUANT) * PROBE_QUANT) * 1e-6f;
        for (int row = gw; row < M; row += NGW) { f4* xr = (f4*)(a.out + (size_t)row * D);
#pragma unroll
            for (int j = 0; j < 8; ++j) xr[lane + 64 * j] = xr[lane + 64 * j] + e; }
    }
#undef IN
#undef BOTH
}

static int launch_mega(const MArgs& a, hipStream_t stream) {
    static int grid = 0;
    if (grid == 0) {
        int dev = 0, cus = 0, per_cu = 0;
        if (hipGetDevice(&dev) != hipSuccess || hipDeviceGetAttribute(&cus, hipDeviceAttributeMultiprocessorCount, dev) != hipSuccess) { fprintf(stderr, "kernel_launch: device query failed\n"); grid = -1; return -1; }
        if (hipFuncSetAttribute((const void*)mega, hipFuncAttributeMaxDynamicSharedMemorySize, LDS_BYTES) != hipSuccess) { fprintf(stderr, "kernel_launch: hipFuncSetAttribute failed\n"); grid = -1; return -1; }
        if (hipOccupancyMaxActiveBlocksPerMultiprocessor(&per_cu, (const void*)mega, NWAVES * 64, LDS_BYTES) != hipSuccess || per_cu < 1) { fprintf(stderr, "kernel_launch: occupancy query says %d blocks/CU\n", per_cu); (void)hipGetLastError(); grid = -1; return -1; }
        grid = cus * (per_cu > 1 ? 1 : per_cu);
        fprintf(stderr, "kernel_launch: %d CUs, occupancy %d blocks/CU, grid %d\n", cus, per_cu, grid);
    }
    if (grid < 0) return -1;
    MArgs arg = a; void* args[] = {(void*)&arg};
    const hipError_t e = hipLaunchCooperativeKernel((const void*)mega, dim3(grid), dim3(NWAVES * 64), args, LDS_BYTES, stream);
    if (e != hipSuccess) { fprintf(stderr, "kernel_launch: cooperative launch failed: %s (grid %d)\n", hipGetErrorString(e), grid); return -1; }
    return 0;
}

extern "C" void kernel_launch(void* const* d_in, const int* in_sizes, int n_in, void* d_out, int out_size, void* d_ws, size_t ws_size, hipStream_t stream) {
    if (n_in != 15 || in_sizes[0] != M * D || out_size != M * D || ws_size < WS_END) { fprintf(stderr, "kernel_launch: unexpected shapes / workspace (%zu < %zu)\n", ws_size, (size_t)WS_END); return; }
    MArgs a{}; for (int i = 0; i < 15; ++i) a.in[i] = (const float*)d_in[i]; a.out = (float*)d_out; a.ws = (unsigned char*)d_ws; a.ph_lo = 0; a.ph_hi = 7;
    launch_mega(a, stream);
}
```

```cpp
#include <hip/hip_runtime.h>
#include <cstdio>
#include <cstdint>
#include <hip/hip_cooperative_groups.h>
namespace cg = cooperative_groups;

typedef unsigned short bf16;
constexpr int D = 2048, NB = 2, S = 8192, M = NB * S;
constexpr int INC = 13320, NPW = 13312, NP = 12288 + 64;
constexpr int C_MQ = 0, C_MK = 1024, C_MV = 2048, C_GZ = 3072, C_AQ = 4096, C_AK = 5120, C_AV = 6144, C_AZ = 7168, C_GM = 8192, C_GA = 10240;
constexpr float EPS = 1e-6f;

__device__ __forceinline__ bf16 f2bf(float f) { unsigned u = __builtin_bit_cast(unsigned, f); return (bf16)((u + 0x7fffu + ((u >> 16) & 1u)) >> 16); }
__device__ __forceinline__ float bf2f(bf16 h) { return __builtin_bit_cast(float, (unsigned)h << 16); }
__device__ __forceinline__ float wave_sum(float v) {
#pragma unroll
    for (int o = 1; o < 64; o <<= 1) v += __shfl_xor(v, o);
    return v;
}
__device__ __forceinline__ float wave_max(float v) {
#pragma unroll
    for (int o = 1; o < 64; o <<= 1) v = fmaxf(v, __shfl_xor(v, o));
    return v;
}
__device__ __forceinline__ float sigmoidf_(float x) { return 1.f / (1.f + __expf(-x)); }
__device__ __forceinline__ float siluf_(float x) { return x / (1.f + __expf(-x)); }

namespace pg8 {
#define PG8_LAS __attribute__((address_space(3)))
typedef unsigned short bf16_t;
typedef short bf16x8 __attribute__((ext_vector_type(8)));
typedef float f32x4 __attribute__((ext_vector_type(4)));
typedef unsigned u32x4 __attribute__((ext_vector_type(4)));
constexpr int BM = 256, BK = 64, HALF = 128, HTB = HALF * BK * 2  , STAGE_BYTES = 8 * HTB, NXCD = 8, WGM = 8;

__host__ __device__ __forceinline__ int lds_byte(int r, int c) { const int st = (r >> 4) * 2 + (c >> 5), rr = r & 15, cc = c & 31, ob = rr * 64 + cc * 2; return st * 1024 + (ob ^ (((ob >> 9) & 1) << 5)); }
__host__ __device__ __forceinline__ void stage_rc(int b, int& R, int& C) { const int st = b / 1024, sb = b % 1024, swz = sb ^ (((sb >> 9) & 1) << 5); R = (st >> 1) * 16 + swz / 64; C = (st & 1) * 32 + (swz % 64) / 2; }
__host__ __device__ __forceinline__ int perm32(int rho) { const int n = rho >> 4, i = rho & 15; return 8 * (i >> 2) + 4 * n + (i & 3); }

struct Unit { int pm, pn, seg; };
struct Gemm { const bf16_t* A0; const bf16_t* A1; const bf16_t* B0; const bf16_t* B1; int lda, K; };

struct StaticOrder {
    int nM, nN, nwg, G, c;
    __host__ __device__ void init(int M, int N, int G_, int c_) { nM = M / BM; nN = N / BM; nwg = nM * nN; G = G_; c = c_; }
    __host__ __device__ bool next(int i, Unit& u) const { return map((long)i * G + c, u); }
    __host__ __device__ bool map(long L, Unit& u) const {
        if (L >= nwg) return false;
        int wgid = (int)L; { const int q = nwg / NXCD, r = nwg % NXCD, xcd = wgid % NXCD, off = wgid / NXCD; wgid = (xcd < r ? xcd * (q + 1) : r * (q + 1) + (xcd - r) * q) + off; }
        const int nig = WGM * nN, gid = wgid / nig, fm = gid * WGM, gsz = (nM - fm) < WGM ? (nM - fm) : WGM;
        u.pm = fm + ((wgid % nig) % gsz); u.pn = (wgid % nig) / gsz; u.seg = 0; return true;
    }
    __device__ __forceinline__ void a_ready(const Unit&) const {}
    __device__ __forceinline__ void done(const Unit&) const {}
};

__device__ __forceinline__ unsigned cvt_pk_bf16(float lo, float hi) { unsigned r; asm volatile("v_cvt_pk_bf16_f32 %0, %1, %2" : "=v"(r) : "v"(lo), "v"(hi)); return r; }
typedef float f32x2 __attribute__((ext_vector_type(2)));
template <class Epi, class Sched, bool ALIGN_EPI = false, bool SP2 = false>
__device__ __forceinline__ void gemm_phase(PG8_LAS unsigned char* lds, const Gemm g, const Sched& S, const Epi& E) {
    const int tid = threadIdx.x, wid = __builtin_amdgcn_readfirstlane(tid >> 6), lane = tid & 63, wr = wid >> 2, wc = wid & 3, fr = lane & 15, fq = lane >> 4;
    const int K = g.K, nt = K / BK;
    unsigned voffA[2], voffB[2];
#pragma unroll
    for (int i = 0; i < 2; ++i) { int R, C; stage_rc(tid * 16 + i * 8192, R, C); const int Rb = Epi::PERM ? ((R & ~31) + perm32(R & 31)) : R;
        voffA[i] = (unsigned)(R * g.lda + C) * 2u; voffB[i] = (unsigned)(Rb * K + C) * 2u; }
    const size_t kstep = (size_t)(BK * 2);
    const size_t hstepA = (size_t)HALF * g.lda * 2, hstepB = (size_t)HALF * K * 2;
    const size_t tstepA = 2 * hstepA, tstepB = 2 * hstepB;
    const unsigned ldsw = (unsigned)wid * 1024u;
    const int aoff = lds_byte(wr * 64 + fr, fq * 8), boff = lds_byte(wc * 32 + fr, fq * 8);
#define PG8_SA(b, h) (((b) * 2 + (h)) * HTB)
#define PG8_SB(b, h) ((4 + (b) * 2 + (h)) * HTB)
#define PG8_STAGE(bufoff, gbase, voff) do { _Pragma("unroll") for (int _i = 0; _i < 2; ++_i) \
        __builtin_amdgcn_global_load_lds((const unsigned*)((const char*)(gbase) + (voff)[_i]), (PG8_LAS unsigned*)(lds + (bufoff) + ldsw + _i * 8192), 16, 0, 0); } while (0)
#define PG8_LDA(dst, b, h) do { _Pragma("unroll") for (int m = 0; m < 4; ++m) _Pragma("unroll") for (int k = 0; k < 2; ++k) dst[m][k] = *(const PG8_LAS bf16x8*)(lds + PG8_SA(b, h) + aoff + m * 2048 + k * 1024); } while (0)
#define PG8_LDB(dst, b, h) do { _Pragma("unroll") for (int n = 0; n < 2; ++n) _Pragma("unroll") for (int k = 0; k < 2; ++k) dst[n][k] = *(const PG8_LAS bf16x8*)(lds + PG8_SB(b, h) + boff + n * 2048 + k * 1024); } while (0)
#define PG8_MMA(ai, bj, At, Bt) do { __builtin_amdgcn_s_setprio(1); _Pragma("unroll") for (int m = 0; m < 4; ++m) _Pragma("unroll") for (int n = 0; n < 2; ++n) _Pragma("unroll") for (int k = 0; k < 2; ++k) \
        acc[ai][bj][m][n] = __builtin_amdgcn_mfma_f32_16x16x32_bf16(Bt[n][k], At[m][k], acc[ai][bj][m][n], 0, 0, 0); __builtin_amdgcn_s_setprio(0); } while (0)
#define PG8_WAIT_V(n) asm volatile("s_waitcnt vmcnt(" #n ")" ::: "memory")
#define PG8_WAIT_L(n) asm volatile("s_waitcnt lgkmcnt(" #n ")" ::: "memory")
#define PG8_BAR __builtin_amdgcn_s_barrier()
#define PG8_SCHED __builtin_amdgcn_sched_barrier(0)
    Unit cur, nxt; int ui = 0;
    if (!S.next(0, cur)) return;
    f32x4 acc[2][2][4][2];
#pragma unroll
    for (int a = 0; a < 2; ++a)
#pragma unroll
        for (int b = 0; b < 2; ++b)
#pragma unroll
            for (int m = 0; m < 4; ++m)
#pragma unroll
                for (int n = 0; n < 2; ++n) acc[a][b][m][n] = (f32x4){0.f, 0.f, 0.f, 0.f};
    bf16x8 At[4][2], B0[2][2], B1[2][2];
    const char* cA = (const char*)(cur.seg ? g.A1 : g.A0) + (size_t)cur.pm * tstepA; const char* cB = (const char*)(cur.seg ? g.B1 : g.B0) + (size_t)cur.pn * tstepB;
    S.a_ready(cur);
    if constexpr (SP2) {
        PG8_STAGE(PG8_SB(0, 0), cB, voffB); PG8_STAGE(PG8_SB(0, 1), cB + hstepB, voffB); PG8_STAGE(PG8_SA(0, 0), cA, voffA); PG8_STAGE(PG8_SA(0, 1), cA + hstepA, voffA);
        if (wr == 1) PG8_BAR;
        PG8_WAIT_V(2); PG8_BAR;
        PG8_STAGE(PG8_SB(1, 0), cB + kstep, voffB); PG8_STAGE(PG8_SA(1, 0), cA + kstep, voffA); PG8_STAGE(PG8_SB(1, 1), cB + hstepB + kstep, voffB);
        PG8_WAIT_V(6); PG8_BAR;
    } else {
        PG8_STAGE(PG8_SB(0, 0), cB, voffB); PG8_STAGE(PG8_SA(0, 0), cA, voffA); PG8_STAGE(PG8_SB(0, 1), cB + hstepB, voffB); PG8_STAGE(PG8_SA(0, 1), cA + hstepA, voffA);
        if (wr == 1) PG8_BAR;
        PG8_WAIT_V(4); PG8_BAR;
        PG8_STAGE(PG8_SB(1, 0), cB + kstep, voffB); PG8_STAGE(PG8_SA(1, 0), cA + kstep, voffA); PG8_STAGE(PG8_SB(1, 1), cB + hstepB + kstep, voffB);
        PG8_WAIT_V(6); PG8_BAR;
    }
    for (;;) {
        const bool has_next = S.next(ui + 1, nxt);
        const char* nA = has_next ? (const char*)(nxt.seg ? g.A1 : g.A0) + (size_t)nxt.pm * tstepA : cA; const char* nB = has_next ? (const char*)(nxt.seg ? g.B1 : g.B0) + (size_t)nxt.pn * tstepB : cB;
        for (int t = 0; t < nt; t += 2) {
            const bool last = (t == nt - 2);
            const char* a1 = cA + (size_t)(t + 1) * kstep;
            const char* a2 = last ? nA : cA + (size_t)(t + 2) * kstep; const char* b2 = last ? nB : cB + (size_t)(t + 2) * kstep;
            const char* a3 = a2 + kstep; const char* b3 = b2 + kstep;
            if (last && has_next) S.a_ready(nxt);
            if constexpr (SP2) {
            PG8_LDB(B0, 0, 0); PG8_LDB(B1, 0, 1); PG8_SCHED; PG8_LDA(At, 0, 0); PG8_STAGE(PG8_SA(1, 1), a1 + hstepA, voffA);
            PG8_WAIT_V(8); PG8_WAIT_L(0); PG8_BAR; PG8_MMA(0, 0, At, B0); PG8_MMA(0, 1, At, B1); PG8_BAR; PG8_SCHED;
            PG8_LDA(At, 0, 1); PG8_STAGE(PG8_SB(0, 0), b2, voffB); PG8_STAGE(PG8_SB(0, 1), b2 + hstepB, voffB); PG8_STAGE(PG8_SA(0, 0), a2, voffA);
            PG8_WAIT_V(8); PG8_WAIT_L(0); PG8_BAR; PG8_MMA(1, 0, At, B0); PG8_MMA(1, 1, At, B1); PG8_BAR; PG8_SCHED;
            PG8_LDB(B0, 1, 0); PG8_LDB(B1, 1, 1); PG8_SCHED; PG8_LDA(At, 1, 0); PG8_STAGE(PG8_SA(0, 1), a2 + hstepA, voffA);
            PG8_WAIT_V(8); PG8_WAIT_L(0); PG8_BAR; PG8_MMA(0, 0, At, B0); PG8_MMA(0, 1, At, B1); PG8_BAR; PG8_SCHED;
            PG8_LDA(At, 1, 1); PG8_STAGE(PG8_SB(1, 0), b3, voffB); PG8_STAGE(PG8_SB(1, 1), b3 + hstepB, voffB); PG8_STAGE(PG8_SA(1, 0), a3, voffA);
            PG8_WAIT_V(8); PG8_WAIT_L(0); PG8_BAR; PG8_MMA(1, 0, At, B0); PG8_MMA(1, 1, At, B1); PG8_BAR; PG8_SCHED;
            } else {
            PG8_LDB(B0, 0, 0); PG8_SCHED; PG8_LDA(At, 0, 0); PG8_STAGE(PG8_SA(1, 1), a1 + hstepA, voffA);
            PG8_WAIT_L(8); PG8_BAR; PG8_WAIT_L(0); PG8_MMA(0, 0, At, B0); PG8_BAR; PG8_SCHED;
            PG8_LDB(B1, 0, 1); PG8_STAGE(PG8_SB(0, 0), b2, voffB);
            PG8_BAR; PG8_WAIT_L(0); PG8_MMA(0, 1, At, B1); PG8_BAR;
            PG8_LDA(At, 0, 1); PG8_STAGE(PG8_SA(0, 0), a2, voffA);
            PG8_BAR; PG8_WAIT_L(0); PG8_MMA(1, 0, At, B0); PG8_BAR; PG8_SCHED;
            PG8_STAGE(PG8_SB(0, 1), b2 + hstepB, voffB);
            PG8_WAIT_V(6); PG8_BAR; PG8_MMA(1, 1, At, B1); PG8_BAR;
            PG8_LDB(B0, 1, 0); PG8_SCHED; PG8_LDA(At, 1, 0); PG8_STAGE(PG8_SA(0, 1), a2 + hstepA, voffA);
            PG8_WAIT_L(8); PG8_BAR; PG8_WAIT_L(0); PG8_MMA(0, 0, At, B0); PG8_BAR; PG8_SCHED;
            PG8_LDB(B1, 1, 1); PG8_STAGE(PG8_SB(1, 0), b3, voffB);
            PG8_BAR; PG8_WAIT_L(0); PG8_MMA(0, 1, At, B1); PG8_BAR;
            PG8_LDA(At, 1, 1); PG8_STAGE(PG8_SA(1, 0), a3, voffA);
            PG8_BAR; PG8_WAIT_L(0); PG8_MMA(1, 0, At, B0); PG8_BAR; PG8_SCHED;
            PG8_STAGE(PG8_SB(1, 1), b3 + hstepB, voffB);
            PG8_WAIT_V(6); PG8_BAR; PG8_MMA(1, 1, At, B1); PG8_BAR;
            }
        }
        if constexpr (ALIGN_EPI) { if (wr == 0) PG8_BAR; }
        if constexpr (!Epi::AFTER_DRAIN) { E(acc, cur, wr, wc, fr, fq); S.done(cur); }
        if (!has_next) break;
        if (E.zero_after(cur)) {
#pragma unroll
        for (int a = 0; a < 2; ++a)
#pragma unroll
            for (int b = 0; b < 2; ++b)
#pragma unroll
                for (int m = 0; m < 4; ++m)
#pragma unroll
                    for (int n = 0; n < 2; ++n) acc[a][b][m][n] = (f32x4){0.f, 0.f, 0.f, 0.f};
        }
        cur = nxt; cA = nA; cB = nB; ++ui;
        if constexpr (ALIGN_EPI) { if (wr == 1) PG8_BAR; }
    }
    PG8_WAIT_V(0);
    if constexpr (!ALIGN_EPI) { if (wr == 0) PG8_BAR; }
    PG8_BAR;
    if constexpr (Epi::AFTER_DRAIN) { E.fused(acc, cur, wr, wc, fr, fq, lds, wid, lane); S.done(cur); }
#undef PG8_SA
#undef PG8_SB
#undef PG8_STAGE
#undef PG8_LDA
#undef PG8_LDB
#undef PG8_MMA
#undef PG8_WAIT_V
#undef PG8_WAIT_L
#undef PG8_BAR
#undef PG8_SCHED
}
}

namespace pg8 {
typedef unsigned u32x4_ __attribute__((ext_vector_type(4)));
struct EpiProj {
    static constexpr bool PERM = true, AFTER_DRAIN = false;
    bf16_t* O; int ldc;
    __device__ __forceinline__ bool zero_after(const Unit&) const { return true; }
    __device__ __forceinline__ void operator()(f32x4 (&acc)[2][2][4][2], const Unit& u, int wr, int wc, int fr, int fq) const {
        const int row0 = u.pm * BM + wr * 64 + fr;
        if (u.pn >= 12 && u.pn < 20) {
            const int col0 = 3072 + 128 * (u.pn - 12) + wc * 32 + 8 * fq;
#pragma unroll
            for (int ai = 0; ai < 2; ++ai)
#pragma unroll
                for (int m = 0; m < 4; ++m) { float o[8];
#pragma unroll
                    for (int e = 0; e < 8; ++e) { const float mo = acc[ai][0][m][e >> 2][e & 3], mz = acc[ai][1][m][e >> 2][e & 3];
                        o[e] = mz * __builtin_amdgcn_rcpf((1.f + __expf(-mo)) * (1.f + __expf(-mz))); }
                    u32x4 w; w.x = cvt_pk_bf16(o[0], o[1]); w.y = cvt_pk_bf16(o[2], o[3]); w.z = cvt_pk_bf16(o[4], o[5]); w.w = cvt_pk_bf16(o[6], o[7]);
                    *(u32x4*)(O + (size_t)(row0 + ai * HALF + m * 16) * ldc + col0) = w; }
        } else {
            const int col0 = (u.pn < 12 ? u.pn * BM : 4096 + (u.pn - 20) * BM) + wc * 32 + 8 * fq;
#pragma unroll
            for (int ai = 0; ai < 2; ++ai)
#pragma unroll
                for (int m = 0; m < 4; ++m) { bf16_t* rowp = O + (size_t)(row0 + ai * HALF + m * 16) * ldc + col0;
#pragma unroll
                    for (int bj = 0; bj < 2; ++bj) { const f32x4 v0 = acc[ai][bj][m][0], v1 = acc[ai][bj][m][1];
                        u32x4 w; w.x = cvt_pk_bf16(v0[0], v0[1]); w.y = cvt_pk_bf16(v0[2], v0[3]); w.z = cvt_pk_bf16(v1[0], v1[1]); w.w = cvt_pk_bf16(v1[2], v1[3]);
                        *(u32x4*)(rowp + bj * HALF) = w; } }
        }
    }
};
struct RestOrder {
    StaticOrder base; int nwork, R, pn0;
    __device__ __forceinline__ bool next(int i, Unit& u) const {
        const int G = base.G, c = base.c, nn = G - nwork; long L;
        if (c < nwork) L = (long)R * nn + (long)i * G + c;
        else L = (i < R) ? (long)i * nn + (c - nwork) : (long)R * nn + (long)(i - R) * G + c;
        if (!base.map(L, u)) return false;
        u.pn += pn0; return true;
    }
    __device__ __forceinline__ void a_ready(const Unit&) const {}
    __device__ __forceinline__ void done(const Unit&) const {}
};
struct SegOrder {
    StaticOrder base;
    __device__ __forceinline__ bool next(int i, Unit& u) const { if (!base.next(i >> 1, u)) return false; u.seg = i & 1; return true; }
    __device__ __forceinline__ void a_ready(const Unit&) const {}
    __device__ __forceinline__ void done(const Unit&) const {}
};
__device__ __forceinline__ float bfw(unsigned w, int half) { return __builtin_bit_cast(float, half ? (w & 0xffff0000u) : (w << 16)); }
struct EpiMerge {
    static constexpr bool PERM = true, AFTER_DRAIN = false;
    const bf16_t* proj; int ldp, cgm, cga; bf16_t* O; int ldo;
    __device__ __forceinline__ bool zero_after(const Unit& u) const { return u.seg != 0; }
    __device__ __forceinline__ void operator()(f32x4 (&acc)[2][2][4][2], const Unit& u, int wr, int wc, int fr, int fq) const {
        const int row0 = u.pm * BM + wr * 64 + fr, col0 = u.pn * BM + wc * 32 + 8 * fq;
#pragma unroll
        for (int ai = 0; ai < 2; ++ai)
#pragma unroll
            for (int m = 0; m < 4; ++m) { const size_t row = (size_t)(row0 + ai * HALF + m * 16);
#pragma unroll
                for (int bj = 0; bj < 2; ++bj) {
                    const u32x4 ga4 = *(const u32x4*)(proj + row * ldp + cga + col0 + bj * HALF);
                    if (u.seg == 0) {
                        const u32x4 gm4 = *(const u32x4*)(proj + row * ldp + cgm + col0 + bj * HALF);
#pragma unroll
                        for (int e = 0; e < 8; ++e) { const float gm = bfw(gm4[e >> 1], e & 1), ga = bfw(ga4[e >> 1], e & 1);
                            acc[ai][bj][m][e >> 2][e & 3] *= (1.f + __expf(-ga)) * __builtin_amdgcn_rcpf(1.f + __expf(-gm)); }
                    } else {
                        float o[8];
#pragma unroll
                        for (int e = 0; e < 8; ++e) { const float ga = bfw(ga4[e >> 1], e & 1); o[e] = acc[ai][bj][m][e >> 2][e & 3] * __builtin_amdgcn_rcpf(1.f + __expf(-ga)); }
                        u32x4 w; w.x = cvt_pk_bf16(o[0], o[1]); w.y = cvt_pk_bf16(o[2], o[3]); w.z = cvt_pk_bf16(o[4], o[5]); w.w = cvt_pk_bf16(o[6], o[7]);
                        *(u32x4*)(O + row * ldo + col0 + bj * HALF) = w;
                    }
                }
                if (m & 1) asm volatile("" ::: "memory"); }
    }
};
struct EpiOut {
    static constexpr bool PERM = false, AFTER_DRAIN = false;
    const float* x; const float* gate; float* out; float* rowss; int ldc, rows_per_batch, gate_stride;
    __device__ __forceinline__ bool zero_after(const Unit&) const { return true; }
    __device__ __forceinline__ void operator()(f32x4 (&acc)[2][2][4][2], const Unit& u, int wr, int wc, int fr, int fq) const {
        const int row0 = u.pm * BM + wr * 64 + fr, col0 = u.pn * BM + wc * 32 + 4 * fq;
        const float* gp = gate + (size_t)((u.pm * BM) / rows_per_batch) * gate_stride + col0;
        f32x4 gt[2][2];
#pragma unroll
        for (int bj = 0; bj < 2; ++bj)
#pragma unroll
            for (int n = 0; n < 2; ++n) gt[bj][n] = *(const f32x4*)(gp + bj * HALF + n * 16);
#pragma unroll
        for (int ai = 0; ai < 2; ++ai)
#pragma unroll
            for (int m = 0; m < 4; ++m) { const int row = row0 + ai * HALF + m * 16; const size_t off = (size_t)row * ldc + col0; float ssq = 0.f;
#pragma unroll
                for (int bj = 0; bj < 2; ++bj)
#pragma unroll
                    for (int n = 0; n < 2; ++n) { const f32x4 xv = *(const f32x4*)(x + off + bj * HALF + n * 16); const f32x4 o = xv + gt[bj][n] * acc[ai][bj][m][n];
                        ssq += (o[0] * o[0] + o[1] * o[1]) + (o[2] * o[2] + o[3] * o[3]); *(f32x4*)(out + off + bj * HALF + n * 16) = o; }
                ssq += __shfl_xor(ssq, 16); ssq += __shfl_xor(ssq, 32);
                if (fq == 0) atomicAdd(rowss + row, ssq);
                if (m & 1) asm volatile("" ::: "memory"); }
    }
};
}

#define PROBE_QUANT 1
#define PROBE_SLOT (-1)
#define LAS __attribute__((address_space(3)))
typedef unsigned v4u __attribute__((ext_vector_type(4)));
typedef float f4 __attribute__((ext_vector_type(4)));
constexpr size_t MiB = 1u << 20;
constexpr size_t WS_PROJ = 0;
constexpr size_t WS_QC = 386 * MiB;
constexpr size_t WS_KC = 418 * MiB;
constexpr size_t WS_IB = 450 * MiB;
constexpr size_t WS_WPM = 482 * MiB;
constexpr size_t WS_WPA = 486 * MiB;
constexpr size_t WS_WOUT = 490 * MiB;
constexpr size_t WS_MODP = 498 * MiB;
constexpr size_t WS_MOD = WS_MODP + 786432;
constexpr size_t WS_GATES = 499 * MiB;
constexpr size_t WS_ROWSS = WS_GATES + 524288;
constexpr size_t WS_SUMM = WS_ROWSS + 65536;
constexpr size_t WS_WC = WS_SUMM + 8192;
constexpr size_t WS_QCTR = WS_WC + 4096;
constexpr size_t WS_TS = WS_WC + 4096 + 256;
constexpr size_t WS_RSUM = 500 * MiB;
constexpr size_t WS_WINT = WS_RSUM + 262144;
constexpr size_t WS_MCOMB = WS_WINT + 262144;
constexpr size_t WS_VONES = 501 * MiB;
constexpr size_t WS_END = 509 * MiB;
static_assert(WS_MCOMB + 262144 <= WS_VONES && WS_VONES + (size_t)8 * 8192 * 64 * 2 <= WS_END && WS_PROJ + (size_t)M * NP * 2 <= WS_QC && WS_TS + 256 <= WS_RSUM && WS_MOD + 49152 <= WS_GATES, "d_ws map");
constexpr size_t OB_H = 0;
constexpr size_t OB_WIN = 64 * MiB;
constexpr int NWAVES = 8, LDS_BYTES = 163840;

struct MArgs { const float* in[15]; float* out; unsigned char* ws; int ph_lo, ph_hi; };

__device__ __forceinline__ unsigned pk2(float lo, float hi) { return (unsigned)f2bf(lo) | ((unsigned)f2bf(hi) << 16); }
#define LDS_WAIT() asm volatile("s_waitcnt lgkmcnt(0)" ::: "memory")

__device__ __forceinline__ void transpose_item(const float* __restrict__ W, int ldw, int ncol_src0, bf16* __restrict__ WT, int K, int nrow_dst0, int k0, LAS float* scr, int lane) {
#pragma unroll 8
    for (int i = 0; i < 32; ++i) { const int kk = 2 * i + (lane >> 5); scr[kk * 33 + (lane & 31)] = W[(size_t)(k0 + kk) * ldw + ncol_src0 + (lane & 31)]; }
    LDS_WAIT();
    const int c = lane & 7;
#pragma unroll
    for (int j = 0; j < 4; ++j) { const int n = (lane >> 3) + 8 * j; const LAS float* s = scr + (8 * c) * 33 + n;
        v4u o; o.x = pk2(s[0 * 33], s[1 * 33]); o.y = pk2(s[2 * 33], s[3 * 33]); o.z = pk2(s[4 * 33], s[5 * 33]); o.w = pk2(s[6 * 33], s[7 * 33]);
        *(v4u*)(WT + (size_t)(nrow_dst0 + n) * K + k0 + 8 * c) = o; }
    LDS_WAIT();
}

typedef short bf16x8 __attribute__((ext_vector_type(8)));
typedef short s16x4 __attribute__((ext_vector_type(4)));
typedef float f32x16 __attribute__((ext_vector_type(16)));
typedef float f32x2_t __attribute__((ext_vector_type(2)));
typedef __bf16 bf16x2_t __attribute__((ext_vector_type(2)));
__device__ __forceinline__ unsigned cvtpk(float lo, float hi) { f32x2_t v = {lo, hi}; bf16x2_t b = __builtin_convertvector(v, bf16x2_t); return __builtin_bit_cast(unsigned, b); }
__device__ __forceinline__ s16x4 tr_read(const LAS unsigned char* p) { return __builtin_bit_cast(s16x4, __builtin_amdgcn_ds_read_tr16_b64_v4i16((LAS s16x4*)p)); }
constexpr int AT_KP = 272, AT_VP = 320, AT_KBUF = 64 * AT_KP, AT_VBUF = 64 * AT_VP, AT_VOFF = 2 * AT_KBUF, AT_BIAS = AT_VOFF + 2 * AT_VBUF, AT_LDS = AT_BIAS + 768;
constexpr float LOG2E = 1.4426950408889634f;

__device__ __forceinline__ void attn_unit(LAS unsigned char* lds, bf16* proj, const float* __restrict__ rel_bias, int b, int h, int g4, int tid, int lane, int wave) {
    const int j0 = 4 * g4, half = wave & 1, jq = j0 + (wave >> 1);
    const int r32 = lane & 31, hb = lane >> 5;
    const int tq = 64 * jq + 32 * half + r32;
    const size_t rowq = (size_t)b * S + tq;
    LAS float* biasL = (LAS float*)(lds + AT_BIAS);
    if (tid < 192) biasL[tid] = rel_bias[h * 192 + tid] * LOG2E;
    bf16x8 qf[8];
#pragma unroll
    for (int ks = 0; ks < 8; ++ks) qf[ks] = *(const bf16x8*)(proj + rowq * NP + C_AQ + h * 128 + 16 * ks + 8 * hb);
    f32x16 o[4];
#pragma unroll
    for (int dt = 0; dt < 4; ++dt)
#pragma unroll
        for (int r = 0; r < 16; ++r) o[dt][r] = 0.f;
    float m_run = -1e30f, l_run = 0.f;
    const int t0 = j0 > 8 ? j0 - 8 : 0, nt = j0 + 3 - t0 + 1;
    const int srow = tid >> 4, sc16 = tid & 15;
    const bf16* gsrc = proj + ((size_t)b * S + srow) * NP + h * 128 + sc16 * 8;
    v4u kr0, kr1, vr0, vr1;
#define AT_GLOAD(tc) do { const bf16* g_ = gsrc + (size_t)(64 * (tc)) * NP; kr0 = *(const v4u*)(g_ + C_AK); vr0 = *(const v4u*)(g_ + C_AV); kr1 = *(const v4u*)(g_ + (size_t)32 * NP + C_AK); vr1 = *(const v4u*)(g_ + (size_t)32 * NP + C_AV); } while (0)
#define AT_LWRITE(buf) do { LAS unsigned char* k_ = lds + (buf) * AT_KBUF + srow * AT_KP + sc16 * 16; LAS unsigned char* v_ = lds + AT_VOFF + (buf) * AT_VBUF + srow * AT_VP + sc16 * 16; \
        *(LAS v4u*)k_ = kr0; *(LAS v4u*)(k_ + 32 * AT_KP) = kr1; *(LAS v4u*)v_ = vr0; *(LAS v4u*)(v_ + 32 * AT_VP) = vr1; } while (0)
    AT_GLOAD(t0); AT_LWRITE(0);
    __syncthreads();
    const float SC = 0.08838834764831845f * LOG2E;
    for (int i = 0; i < nt; ++i) {
        const int tc = t0 + i, buf = i & 1;
        if (i + 1 < nt) AT_GLOAD(tc + 1);
        const int cdiff = jq - tc;
        if (cdiff >= 0 && cdiff <= 8) {
            const LAS unsigned char* Kb = lds + buf * AT_KBUF + r32 * AT_KP + hb * 16;
            f32x16 s0, s1;
#pragma unroll
            for (int r = 0; r < 16; ++r) { s0[r] = 0.f; s1[r] = 0.f; }
#pragma unroll
            for (int ks = 0; ks < 8; ++ks) {
                const bf16x8 k0 = *(const LAS bf16x8*)(Kb + ks * 32), k1 = *(const LAS bf16x8*)(Kb + 32 * AT_KP + ks * 32);
                s0 = __builtin_amdgcn_mfma_f32_32x32x16_bf16(k0, qf[ks], s0, 0, 0, 0);
                s1 = __builtin_amdgcn_mfma_f32_32x32x16_bf16(k1, qf[ks], s1, 0, 0, 0);
            }
            if (cdiff >= 3) { const float bc = biasL[191];
#pragma unroll
                for (int r = 0; r < 16; ++r) { s0[r] = s0[r] * SC + bc; s1[r] = s1[r] * SC + bc; }
            } else { const int base = 64 * cdiff + 32 * half + r32 + 63 - 4 * hb;
#pragma unroll
                for (int r = 0; r < 16; ++r) { const int i0 = base - ((r & 3) + 8 * (r >> 2)), i1 = i0 - 32;
                    s0[r] = s0[r] * SC + biasL[i0 > 191 ? 191 : i0]; s1[r] = s1[r] * SC + biasL[i1 > 191 ? 191 : i1]; }
            }
            float mx = fmaxf(s0[0], s1[0]);
#pragma unroll
            for (int r = 1; r < 16; ++r) mx = fmaxf(mx, fmaxf(s0[r], s1[r]));
            mx = fmaxf(mx, __shfl_xor(mx, 32));
            const float m_new = fmaxf(m_run, mx), alpha = __builtin_amdgcn_exp2f(m_run - m_new); m_run = m_new;
            float ls = 0.f;
#pragma unroll
            for (int r = 0; r < 16; ++r) { s0[r] = __builtin_amdgcn_exp2f(s0[r] - m_new); s1[r] = __builtin_amdgcn_exp2f(s1[r] - m_new); ls += s0[r] + s1[r]; }
            l_run = l_run * alpha + ls;
#pragma unroll
            for (int dt = 0; dt < 4; ++dt)
#pragma unroll
                for (int r = 0; r < 16; ++r) o[dt][r] *= alpha;
            v4u pw[4];
            pw[0] = (v4u){cvtpk(s0[0], s0[1]), cvtpk(s0[2], s0[3]), cvtpk(s0[4], s0[5]), cvtpk(s0[6], s0[7])};
            pw[1] = (v4u){cvtpk(s0[8], s0[9]), cvtpk(s0[10], s0[11]), cvtpk(s0[12], s0[13]), cvtpk(s0[14], s0[15])};
            pw[2] = (v4u){cvtpk(s1[0], s1[1]), cvtpk(s1[2], s1[3]), cvtpk(s1[4], s1[5]), cvtpk(s1[6], s1[7])};
            pw[3] = (v4u){cvtpk(s1[8], s1[9]), cvtpk(s1[10], s1[11]), cvtpk(s1[12], s1[13]), cvtpk(s1[14], s1[15])};
            const LAS unsigned char* Vb = lds + AT_VOFF + buf * AT_VBUF + (4 * hb + ((lane & 15) >> 2)) * AT_VP + (16 * ((lane >> 4) & 1) + 4 * (lane & 3)) * 2;
#pragma unroll
            for (int q = 0; q < 4; ++q) {
#pragma unroll
                for (int dt = 0; dt < 4; ++dt) {
                    const s16x4 lo = tr_read(Vb + (16 * q) * AT_VP + dt * 64), hi = tr_read(Vb + (16 * q + 8) * AT_VP + dt * 64);
                    const bf16x8 vf = (bf16x8){lo[0], lo[1], lo[2], lo[3], hi[0], hi[1], hi[2], hi[3]};
                    o[dt] = __builtin_amdgcn_mfma_f32_32x32x16_bf16(vf, __builtin_bit_cast(bf16x8, pw[q]), o[dt], 0, 0, 0);
                }
            }
        }
        if (i + 1 < nt) AT_LWRITE(buf ^ 1);
        __syncthreads();
    }
#undef AT_GLOAD
#undef AT_LWRITE
    const float linv = 1.f / (l_run + __shfl_xor(l_run, 32));
#pragma unroll
    for (int dt = 0; dt < 4; ++dt)
#pragma unroll
        for (int rq = 0; rq < 4; ++rq) {
            const int d0 = 32 * dt + 8 * rq + 4 * hb;
            const uint2 zz = *(const uint2*)(proj + rowq * NP + C_AZ + h * 128 + d0);
            const float z0 = __builtin_bit_cast(float, zz.x << 16), z1 = __builtin_bit_cast(float, zz.x & 0xffff0000u), z2 = __builtin_bit_cast(float, zz.y << 16), z3 = __builtin_bit_cast(float, zz.y & 0xffff0000u);
            uint2 w; w.x = cvtpk(o[dt][4 * rq + 0] * linv * siluf_(z0), o[dt][4 * rq + 1] * linv * siluf_(z1)); w.y = cvtpk(o[dt][4 * rq + 2] * linv * siluf_(z2), o[dt][4 * rq + 3] * linv * siluf_(z3));
            *(uint2*)(proj + rowq * NP + C_AQ + h * 128 + d0) = w;
        }
}

using pg8::bfw;
typedef float f32x4_ __attribute__((ext_vector_type(4)));
typedef unsigned u2v __attribute__((ext_vector_type(2)));
#define MFMA16(a, b, c) __builtin_amdgcn_mfma_f32_16x16x32_bf16((a), (b), (c), 0, 0, 0)
__device__ __forceinline__ float wave_scan_add(float x, int lane) {
#pragma unroll
    for (int o = 1; o < 64; o <<= 1) { const float t = __shfl_up(x, o); if (lane >= o) x += t; }
    return x;
}
__device__ __forceinline__ float wave_scan_max(float x, int lane) {
#pragma unroll
    for (int o = 1; o < 64; o <<= 1) { const float t = __shfl_up(x, o); if (lane >= o) x = fmaxf(x, t); }
    return x;
}
__device__ __forceinline__ void mlstm_summary(const float* __restrict__ gates, float* __restrict__ summ, int bh, int j, int lane) {
    const size_t row = (size_t)(bh >> 2) * S + 64 * j + lane; const int h = bh & 3;
    const float ig = gates[row * 8 + h], lf = gates[row * 8 + 4 + h];
    const float bc = wave_scan_add(lf, lane); const float b_last = __shfl(bc, 63);
    const float gmax = wave_max(b_last - bc + ig);
    if (lane == 0) { summ[(bh * 128 + j) * 2] = b_last; summ[(bh * 128 + j) * 2 + 1] = gmax; }
}
constexpr int U1_QP = 528, U1_VP = 576, U1_SP = 144;
constexpr int U1_QCL = 0, U1_KCL = 64 * U1_QP, U1_VL = 2 * 64 * U1_QP, U1_SWL = U1_VL + 64 * U1_VP, U1_SCAL = U1_SWL + 64 * U1_SP, U1_LDS = U1_SCAL + 3 * 256;
struct MlBufs { bf16* proj; const float* gates; const float* summ; const float* conv_w; const float* conv_b; bf16* QC; bf16* KC; bf16* IB; float* rowsum; float* winter; float* mcomb; float* wc; bf16* vones; };

__device__ __forceinline__ void mlstm_u1_unit(LAS unsigned char* lds, const MlBufs& B, int b, int h, int j, int tid, int lane, int wave) {
    const int bh = b * 4 + h; const size_t rowb = (size_t)b * S + 64 * j;
    LAS float* sA = (LAS float*)(lds + U1_SCAL); LAS float* sC = sA + 64; LAS float* sWk = sA + 128;
    __syncthreads();
    if (wave == 0) {
        const size_t row = rowb + lane;
        const float ig = B.gates[row * 8 + h], lf = B.gates[row * 8 + 4 + h];
        const float bc = wave_scan_add(lf, lane); const float b_last = __shfl(bc, 63);
        const float a_s = ig - bc; const float pm = wave_scan_max(a_s, lane);
        const float gg = b_last - bc + ig; const float gmax = wave_max(gg);
        float m_prev = 0.f;
        if (j > 0) {
            const float bl0 = B.summ[(bh * 128 + lane) * 2], gm0 = B.summ[(bh * 128 + lane) * 2 + 1], bl1 = B.summ[(bh * 128 + 64 + lane) * 2], gm1 = B.summ[(bh * 128 + 64 + lane) * 2 + 1];
            const float P0 = wave_scan_add(bl0, lane); const float tot0 = __shfl(P0, 63); const float P1 = wave_scan_add(bl1, lane) + tot0;
            const int jm = j - 1;
            const float e0 = (lane <= jm) ? gm0 - P0 : -INFINITY, e1 = (lane + 64 <= jm) ? gm1 - P1 : -INFINITY;
            const float emax = wave_max(fmaxf(e0, e1));
            const float Bjm = (jm < 64) ? __shfl(P0, jm) : __shfl(P1, jm - 64);
            m_prev = Bjm + fmaxf(0.f, emax);
        }
        const float m_j = fmaxf(b_last + m_prev, gmax);
        const float c_t = fmaxf(pm, m_prev);
        sA[lane] = a_s; sC[lane] = c_t; sWk[lane] = __expf(gg - m_j);
        B.winter[row * 4 + h] = __expf(m_prev - c_t); B.mcomb[row * 4 + h] = bc + c_t;
        if (lane == 0) B.wc[bh * 128 + j] = __expf(b_last + m_prev - m_j);
    }
    {
        const int cg = tid & 63, tg = tid >> 6, isk = cg >> 5, c8 = (cg & 31) * 8, chan = isk * 1024 + h * 256 + c8;
        const bf16* src = B.proj + (rowb + 8 * tg - 3) * NP + (isk ? C_MK : C_MQ) + h * 256 + c8;
        float wv[4][8], bv[8];
#pragma unroll
        for (int tap = 0; tap < 4; ++tap) { const f4 w0 = *(const f4*)(B.conv_w + tap * 2048 + chan), w1 = *(const f4*)(B.conv_w + tap * 2048 + chan + 4);
            wv[tap][0] = w0[0]; wv[tap][1] = w0[1]; wv[tap][2] = w0[2]; wv[tap][3] = w0[3]; wv[tap][4] = w1[0]; wv[tap][5] = w1[1]; wv[tap][6] = w1[2]; wv[tap][7] = w1[3]; }
        { const f4 b0 = *(const f4*)(B.conv_b + chan), b1 = *(const f4*)(B.conv_b + chan + 4); bv[0] = b0[0]; bv[1] = b0[1]; bv[2] = b0[2]; bv[3] = b0[3]; bv[4] = b1[0]; bv[5] = b1[1]; bv[6] = b1[2]; bv[7] = b1[3]; }
        v4u raw[11];
#pragma unroll
        for (int i = 0; i < 11; ++i) { const int tt = 64 * j + 8 * tg - 3 + i; raw[i] = (tt >= 0) ? *(const v4u*)(src + (size_t)i * NP) : (v4u){0u, 0u, 0u, 0u}; }
        const float osc = isk ? 0.0625f : 1.f;
        LAS unsigned char* ldst = lds + (isk ? U1_KCL : U1_QCL) + (8 * tg) * U1_QP + c8 * 2;
        bf16* gdst = (isk ? B.KC : B.QC) + (rowb + 8 * tg) * 1024 + h * 256 + c8;
#pragma unroll
        for (int t8 = 0; t8 < 8; ++t8) {
            float o[8];
#pragma unroll
            for (int e = 0; e < 8; ++e) { float acc = bv[e];
#pragma unroll
                for (int tap = 0; tap < 4; ++tap) acc += wv[tap][e] * bfw(raw[t8 + tap][e >> 1], e & 1);
                o[e] = siluf_(acc) * osc; }
            const v4u w = (v4u){cvtpk(o[0], o[1]), cvtpk(o[2], o[3]), cvtpk(o[4], o[5]), cvtpk(o[6], o[7])};
            *(LAS v4u*)(ldst + t8 * U1_QP) = w; *(v4u*)(gdst + (size_t)t8 * 1024) = w;
        }
    }
    v4u vraw[4];
#pragma unroll
    for (int i = 0; i < 4; ++i) { const int ch = tid + 512 * i, row = ch >> 5, c16 = ch & 31; vraw[i] = *(const v4u*)(B.proj + (rowb + row) * NP + C_MV + h * 256 + c16 * 8);
        *(LAS v4u*)(lds + U1_VL + row * U1_VP + c16 * 16) = vraw[i]; }
    if (tid < 128) *(LAS v4u*)(lds + U1_VL + (tid >> 1) * U1_VP + 512 + (tid & 1) * 16) = (tid & 1) ? (v4u){0u, 0u, 0u, 0u} : (v4u){0x00003F80u, 0u, 0u, 0u};
    __syncthreads();
    const int fr = lane & 15, g = lane >> 4;
    {
        const int tt = wave & 3, st0 = 2 * (wave >> 2);
        f32x4_ sacc[2] = {{0.f, 0.f, 0.f, 0.f}, {0.f, 0.f, 0.f, 0.f}};
#pragma unroll
        for (int ks = 0; ks < 8; ++ks) {
            const bf16x8 bq = *(const LAS bf16x8*)(lds + U1_QCL + (16 * tt + fr) * U1_QP + (32 * ks + 8 * g) * 2);
#pragma unroll
            for (int i = 0; i < 2; ++i) { const bf16x8 ak = *(const LAS bf16x8*)(lds + U1_KCL + (16 * (st0 + i) + fr) * U1_QP + (32 * ks + 8 * g) * 2); sacc[i] = MFMA16(ak, bq, sacc[i]); }
        }
        const int t = 16 * tt + fr; const float c_t = sC[t];
#pragma unroll
        for (int i = 0; i < 2; ++i) { const int s0 = 16 * (st0 + i) + 4 * g; const f4 a4 = *(const LAS f4*)(sA + s0);
            float o[4];
#pragma unroll
            for (int r = 0; r < 4; ++r) o[r] = (s0 + r <= t) ? sacc[i][r] * __expf(a4[r] - c_t) : 0.f;
            u2v w; w.x = cvtpk(o[0], o[1]); w.y = cvtpk(o[2], o[3]);
            *(LAS u2v*)(lds + U1_SWL + t * U1_SP + s0 * 2) = w; }
    }
    __syncthreads();
    {
        const int nvt = (wave == 0) ? 3 : 2;
        for (int iv = 0; iv < nvt; ++iv) {
            const int vt = (iv == 2) ? 16 : 2 * wave + iv;
            f32x4_ ia[4] = {{0.f, 0.f, 0.f, 0.f}, {0.f, 0.f, 0.f, 0.f}, {0.f, 0.f, 0.f, 0.f}, {0.f, 0.f, 0.f, 0.f}};
#pragma unroll
            for (int ks = 0; ks < 2; ++ks) {
                const LAS unsigned char* va = lds + U1_VL + (32 * ks + 8 * g + ((lane & 15) >> 2)) * U1_VP + (16 * vt + 4 * (lane & 3)) * 2;
                const s16x4 lo = tr_read(va), hi = tr_read(va + 4 * U1_VP);
                const bf16x8 af = (bf16x8){lo[0], lo[1], lo[2], lo[3], hi[0], hi[1], hi[2], hi[3]};
#pragma unroll
                for (int tt = 0; tt < 4; ++tt) { const bf16x8 bs = *(const LAS bf16x8*)(lds + U1_SWL + (16 * tt + fr) * U1_SP + (32 * ks + 8 * g) * 2); ia[tt] = MFMA16(af, bs, ia[tt]); }
            }
#pragma unroll
            for (int tt = 0; tt < 4; ++tt) { const size_t row = rowb + 16 * tt + fr;
                if (vt < 16) { uint2 w; w.x = cvtpk(ia[tt][0], ia[tt][1]); w.y = cvtpk(ia[tt][2], ia[tt][3]); *(uint2*)(B.IB + row * 1024 + h * 256 + 16 * vt + 4 * g) = w; }
                else if (g == 0) B.rowsum[row * 4 + h] = ia[tt][0]; }
        }
    }
#pragma unroll
    for (int i = 0; i < 4; ++i) { const int ch = tid + 512 * i, row = ch >> 5, c16 = ch & 31; const float wk = sWk[row]; v4u w;
#pragma unroll
        for (int e = 0; e < 4; ++e) w[e] = cvtpk(bfw(vraw[i][e], 0) * wk, bfw(vraw[i][e], 1) * wk);
        *(v4u*)(B.proj + (rowb + row) * NP + C_MV + h * 256 + c16 * 8) = w; }
    { const int srow = tid >> 3, c = tid & 7; const unsigned w0 = (c == 0) ? (unsigned)f2bf(sWk[srow]) : 0u;
      *(v4u*)(B.vones + ((size_t)bh * S + 64 * j + srow) * 64 + c * 8) = (v4u){w0, 0u, 0u, 0u}; }
}

constexpr int W_QP = 528, W_KP = 544, W_VP = 144, W_QL = 0, W_KL = 64 * W_QP, W_VL = W_KL + 64 * W_KP, W_LDS = W_VL + 64 * W_VP;
constexpr int W2_STAGE = W_LDS, W2_WC = 2 * W2_STAGE, W2_LDS = W2_WC + 512;
__device__ __forceinline__ void w2_compute(f32x4_ (&Ct)[16], const LAS unsigned char* st, float w_c, const MlBufs& B, size_t row0, int h, int sl, int vq, int lane,
                                           const uint2 (&ibn)[4], const float (&win)[4], uint2 (&ibx)[4], float (&wix)[4], bool has_next) {
    const int fr = lane & 15, g = lane >> 4;
#pragma unroll
    for (int tt = 0; tt < 4; ++tt) { const size_t rown = row0 + (has_next ? 64 : 0) + 16 * tt + fr;
        wix[tt] = B.winter[rown * 4 + h];
        if (sl < 4) ibx[tt] = *(const uint2*)(B.IB + rown * 1024 + h * 256 + 64 * sl + 16 * vq + 4 * g); else { ibx[tt].x = __float_as_uint(B.rowsum[rown * 4 + h]); ibx[tt].y = 0u; } }
    f32x4_ ia[4] = {{0.f, 0.f, 0.f, 0.f}, {0.f, 0.f, 0.f, 0.f}, {0.f, 0.f, 0.f, 0.f}, {0.f, 0.f, 0.f, 0.f}};
    const LAS unsigned char* qbase = st + W_QL + fr * W_QP + (4 * g) * 2;
    u2v qlo[2][4], qhi[2][4];
#pragma unroll
    for (int tt = 0; tt < 4; ++tt) { qlo[0][tt] = *(const LAS u2v*)(qbase + 16 * tt * W_QP); qhi[0][tt] = *(const LAS u2v*)(qbase + 16 * tt * W_QP + 32); }
#pragma unroll
    for (int kk = 0; kk < 8; ++kk) {
        if (kk + 1 < 8) {
#pragma unroll
            for (int tt = 0; tt < 4; ++tt) { qlo[(kk + 1) & 1][tt] = *(const LAS u2v*)(qbase + 16 * tt * W_QP + 64 * (kk + 1)); qhi[(kk + 1) & 1][tt] = *(const LAS u2v*)(qbase + 16 * tt * W_QP + 64 * (kk + 1) + 32); }
        }
        const v4u cw = (v4u){cvtpk(Ct[2 * kk][0], Ct[2 * kk][1]), cvtpk(Ct[2 * kk][2], Ct[2 * kk][3]), cvtpk(Ct[2 * kk + 1][0], Ct[2 * kk + 1][1]), cvtpk(Ct[2 * kk + 1][2], Ct[2 * kk + 1][3])};
        __builtin_amdgcn_sched_barrier(0);
#pragma unroll
        for (int tt = 0; tt < 4; ++tt)
            ia[tt] = MFMA16(__builtin_bit_cast(bf16x8, cw), __builtin_bit_cast(bf16x8, ((v4u){qlo[kk & 1][tt].x, qlo[kk & 1][tt].y, qhi[kk & 1][tt].x, qhi[kk & 1][tt].y})), ia[tt]);
        __builtin_amdgcn_sched_barrier(0);
    }
#pragma unroll
    for (int tt = 0; tt < 4; ++tt) { const size_t row = row0 + 16 * tt + fr; const float wi = win[tt];
        if (sl < 4) { uint2 w; w.x = cvtpk(bfw(ibn[tt].x, 0) + wi * ia[tt][0], bfw(ibn[tt].x, 1) + wi * ia[tt][1]); w.y = cvtpk(bfw(ibn[tt].y, 0) + wi * ia[tt][2], bfw(ibn[tt].y, 1) + wi * ia[tt][3]);
            *(uint2*)(B.IB + row * 1024 + h * 256 + 64 * sl + 16 * vq + 4 * g) = w; }
        else if (vq == 0 && g == 0) B.rowsum[row * 4 + h] = __uint_as_float(ibn[tt].x) + wi * ia[tt][0]; }
#pragma unroll
    for (int kt = 0; kt < 16; ++kt) Ct[kt] *= w_c;
#pragma unroll
    for (int ks = 0; ks < 2; ++ks) {
        const LAS unsigned char* vb = st + W_VL + (32 * ks + 8 * g + ((lane & 15) >> 2)) * W_VP + (16 * vq + 4 * (lane & 3)) * 2;
        const s16x4 vlo = tr_read(vb), vhi = tr_read(vb + 4 * W_VP);
        const bf16x8 bvf = (bf16x8){vlo[0], vlo[1], vlo[2], vlo[3], vhi[0], vhi[1], vhi[2], vhi[3]};
        const LAS unsigned char* ka = st + W_KL + (32 * ks + 8 * g + ((lane & 15) >> 2)) * W_KP + (4 * (lane & 3)) * 2;
#pragma unroll
        for (int kt = 0; kt < 16; ++kt) { const s16x4 klo = tr_read(ka + kt * 32), khi = tr_read(ka + kt * 32 + 4 * W_KP);
            const bf16x8 akf = (bf16x8){klo[0], klo[1], klo[2], klo[3], khi[0], khi[1], khi[2], khi[3]};
            Ct[kt] = MFMA16(akf, bvf, Ct[kt]); }
    }
}
__device__ __forceinline__ void mlstm_worker2(LAS unsigned char* lds, const MlBufs& B, int b, int h, int sl, int tid, int lane, int wave) {
    const int bh = b * 4 + h; const size_t rowb = (size_t)b * S;
    const bf16* vsrc = (sl < 4) ? (B.proj + rowb * NP + C_MV + h * 256 + 64 * sl) : (B.vones + (size_t)bh * S * 64);
    const size_t vpitch = (sl < 4) ? (size_t)NP : (size_t)64;
    LAS float* wcL = (LAS float*)(lds + W2_WC);
    __syncthreads();
    if (tid < 128) wcL[tid] = B.wc[bh * 128 + tid];
    const bool loader = wave >= 4;
    const int lt = tid & 255;
    const bf16* qsrc = B.QC + (rowb + (lt >> 5)) * 1024 + h * 256 + (lt & 31) * 8;
    const bf16* ksrc = B.KC + (rowb + (lt >> 5)) * 1024 + h * 256 + (lt & 31) * 8;
    const bf16* vs2 = vsrc + (size_t)(lt >> 3) * vpitch + (lt & 7) * 8;
    const int qoff = W_QL + (lt >> 5) * W_QP + (lt & 31) * 16, koff = W_KL + (lt >> 5) * W_KP + (lt & 31) * 16, voff = W_VL + (lt >> 3) * W_VP + (lt & 7) * 16;
    v4u ra[18], rb[18];
#define L_GLOAD(R, jj) do { _Pragma("unroll") for (int i_ = 0; i_ < 8; ++i_) { R[i_] = *(const v4u*)(qsrc + (size_t)(64 * (jj) + 8 * i_) * 1024); R[8 + i_] = *(const v4u*)(ksrc + (size_t)(64 * (jj) + 8 * i_) * 1024); } \
        R[16] = *(const v4u*)(vs2 + (size_t)(64 * (jj)) * vpitch); R[17] = *(const v4u*)(vs2 + (size_t)(64 * (jj) + 32) * vpitch); } while (0)
#define L_WRITE(R, bufo) do { LAS unsigned char* s_ = lds + (bufo); _Pragma("unroll") for (int i_ = 0; i_ < 8; ++i_) { *(LAS v4u*)(s_ + qoff + 8 * i_ * W_QP) = R[i_]; *(LAS v4u*)(s_ + koff + 8 * i_ * W_KP) = R[8 + i_]; } \
        *(LAS v4u*)(s_ + voff) = R[16]; *(LAS v4u*)(s_ + voff + 32 * W_VP) = R[17]; } while (0)
    if (loader) {
        L_GLOAD(ra, 0); L_WRITE(ra, 0); L_GLOAD(ra, 1); L_GLOAD(rb, 2);
        __syncthreads();
        for (int j = 0; j < 128; j += 2) {
            L_WRITE(ra, W2_STAGE); { const int jn = (j + 3 < 128) ? j + 3 : 127; L_GLOAD(ra, jn); }
            __syncthreads();
            L_WRITE(rb, 0); { const int jn = (j + 4 < 128) ? j + 4 : 127; L_GLOAD(rb, jn); }
            __syncthreads();
        }
    } else {
        f32x4_ Ct[16];
#pragma unroll
        for (int kt = 0; kt < 16; ++kt) Ct[kt] = (f32x4_){0.f, 0.f, 0.f, 0.f};
        uint2 iba[4], ibb[4]; float wia[4], wib[4];
        { const int fr = lane & 15, g = lane >> 4;
#pragma unroll
          for (int tt = 0; tt < 4; ++tt) { const size_t r0 = rowb + 16 * tt + fr; wia[tt] = B.winter[r0 * 4 + h];
              if (sl < 4) iba[tt] = *(const uint2*)(B.IB + r0 * 1024 + h * 256 + 64 * sl + 16 * wave + 4 * g); else { iba[tt].x = __float_as_uint(B.rowsum[r0 * 4 + h]); iba[tt].y = 0u; } } }
        __syncthreads();
        for (int j = 0; j < 128; j += 2) {
            w2_compute(Ct, lds, wcL[j], B, rowb + 64 * j, h, sl, wave, lane, iba, wia, ibb, wib, true);
            __syncthreads();
            w2_compute(Ct, lds + W2_STAGE, wcL[j + 1], B, rowb + 64 * (j + 1), h, sl, wave, lane, ibb, wib, iba, wia, j + 2 < 128);
            __syncthreads();
        }
    }
#undef L_GLOAD
#undef L_WRITE
}
__device__ __forceinline__ void mlstm_post_item(const MlBufs& B, const float* __restrict__ mh_norm_g, size_t row, int h, int lane) {
    const uint2 iw = *(const uint2*)(B.IB + row * 1024 + h * 256 + lane * 4);
    const float dinv = 1.f / fmaxf(fabsf(B.rowsum[row * 4 + h]), __expf(-B.mcomb[row * 4 + h]));
    float hv[4];
    hv[0] = bfw(iw.x, 0) * dinv; hv[1] = bfw(iw.x, 1) * dinv; hv[2] = bfw(iw.y, 0) * dinv; hv[3] = bfw(iw.y, 1) * dinv;
    const float ss = wave_sum(hv[0] * hv[0] + hv[1] * hv[1] + hv[2] * hv[2] + hv[3] * hv[3]);
    const float r = 1.0f / sqrtf(ss * (1.f / 256.f) + EPS);
    const int c = h * 256 + lane * 4;
    bf16* gp = B.proj + row * NP + C_GZ + c;
    const uint2 gz = *(const uint2*)gp;
    const f4 gn = *(const f4*)(mh_norm_g + c);
    uint2 w;
    w.x = cvtpk(hv[0] * r * gn[0] * bfw(gz.x, 0), hv[1] * r * gn[1] * bfw(gz.x, 1));
    w.y = cvtpk(hv[2] * r * gn[2] * bfw(gz.y, 0), hv[3] * r * gn[3] * bfw(gz.y, 1));
    *(uint2*)gp = w;
}
__global__ void __launch_bounds__(NWAVES * 64, 2) mega(MArgs a) {
    extern __shared__ __attribute__((aligned(16))) unsigned char lds_raw[];
    LAS unsigned char* lds = (LAS unsigned char*)lds_raw;
    cg::grid_group grid = cg::this_grid();
    const int tid = threadIdx.x, lane = tid & 63, wave = __builtin_amdgcn_readfirstlane(tid >> 6);
    const int G = gridDim.x, gw = blockIdx.x * NWAVES + wave, NGW = G * NWAVES;
    const float* x = a.in[0]; const float* cvec = a.in[1]; const float* w_ada = a.in[2]; const float* b_ada = a.in[3]; const float* norm_g = a.in[4]; const float* w_in = a.in[5];
    const float* b_if = a.in[6]; const float* final_g = a.in[14]; const float* w_proj_m = a.in[11]; const float* w_proj_a = a.in[12]; const float* w_out = a.in[13];
    unsigned char* ws = a.ws; unsigned char* ob = (unsigned char*)a.out;
    bf16* proj = (bf16*)(ws + WS_PROJ); bf16* Wpm_t = (bf16*)(ws + WS_WPM); bf16* Wpa_t = (bf16*)(ws + WS_WPA); bf16* Wout_t = (bf16*)(ws + WS_WOUT);
    float* modp = (float*)(ws + WS_MODP); float* mod = (float*)(ws + WS_MOD); float* gates = (float*)(ws + WS_GATES); float* rowss = (float*)(ws + WS_ROWSS);
    bf16* merged = proj;
    bf16* H = (bf16*)(ob + OB_H); bf16* Win_t = (bf16*)(ob + OB_WIN);
    const int lo = a.ph_lo, hi = a.ph_hi;
    unsigned long long* tsb = (unsigned long long*)(ws + WS_TS); int nst = 0;
#define STAMP() do { if (PROBE_SLOT >= 0 && blockIdx.x == 0 && tid == 0) tsb[nst] = __builtin_amdgcn_s_memrealtime(); ++nst; } while (0)
    STAMP();
#define IN(k) (lo <= (k) && (k) < hi)
#define BOTH(k) (IN(k) && IN((k) + 1))

    if (IN(0)) {
        LAS float* scr = (LAS float*)(lds + wave * 16384);
        constexpr int I_ADA = 16 * 24, I_IN = (D / 64) * (NPW / 32), I_PM = (1024 / 64) * (D / 32), I_OUT = (D / 64) * (D / 32);
        constexpr int NITEMS = I_ADA + I_IN + 2 * I_PM + I_OUT;
        for (int it = gw; it < NITEMS; it += NGW) {
            int r = it;
            if (r < I_ADA) {
                const int ks = r / 24, cb = r % 24, n0 = cb * 256 + lane * 4;
                float4 a0 = {0.f, 0.f, 0.f, 0.f}, a1 = {0.f, 0.f, 0.f, 0.f};
                if (ks == 0) { a0 = *(const float4*)(b_ada + n0); a1 = a0; }
#pragma unroll 8
                for (int kk = 0; kk < 128; ++kk) { const int k = ks * 128 + kk; const float4 w = *(const float4*)(w_ada + (size_t)k * (3 * D) + n0);
                    const float c0 = cvec[k], c1 = cvec[D + k]; const float s0 = c0 / (1.f + __expf(-c0)), s1 = c1 / (1.f + __expf(-c1));
                    a0.x += s0 * w.x; a0.y += s0 * w.y; a0.z += s0 * w.z; a0.w += s0 * w.w; a1.x += s1 * w.x; a1.y += s1 * w.y; a1.z += s1 * w.z; a1.w += s1 * w.w; }
                *(float4*)(modp + (size_t)(ks * 2 + 0) * (3 * D) + n0) = a0; *(float4*)(modp + (size_t)(ks * 2 + 1) * (3 * D) + n0) = a1;
                continue; }
            r -= I_ADA;
            if (r < I_IN) { const int nblk = NPW / 32, kb = r / nblk, nb = r % nblk, nd = 32 * nb;
                int ns = nd; if (nd >= 5120) ns = nd + 8; else if (nd >= 3072) { const int t = (nd - 3072) >> 8, rr = (nd - 3072) & 255; ns = (rr < 128) ? 3072 + 128 * t + rr : 4096 + 128 * t + (rr - 128); }
                transpose_item(w_in, INC, ns, Win_t, D, nd, 64 * kb, scr, lane); continue; }
            r -= I_IN;
            if (r < I_PM) { const int nblk = D / 32, kb = r / nblk, nb = r % nblk; transpose_item(w_proj_m, D, 32 * nb, Wpm_t, 1024, 32 * nb, 64 * kb, scr, lane); continue; }
            r -= I_PM;
            if (r < I_PM) { const int nblk = D / 32, kb = r / nblk, nb = r % nblk; transpose_item(w_proj_a, D, 32 * nb, Wpa_t, 1024, 32 * nb, 64 * kb, scr, lane); continue; }
            r -= I_PM;
            { const int nblk = D / 32, kb = r / nblk, nb = r % nblk; transpose_item(w_out, D, 32 * nb, Wout_t, D, 32 * nb, 64 * kb, scr, lane); }
        }
        if (BOTH(0)) grid.sync(); STAMP();
    }

    if (IN(1)) {
        LAS float* smod = (LAS float*)lds;
        LAS float* gwl = (LAS float*)(lds + 49152);
        for (int i = tid; i < 2 * 3 * D; i += NWAVES * 64) { float s = 0.f;
#pragma unroll
            for (int ks = 0; ks < 16; ++ks) s += modp[(size_t)ks * (2 * 3 * D) + i];
            smod[i] = s; if (blockIdx.x == 0) mod[i] = s; }
        if (blockIdx.x == 0 && tid == 0) *(unsigned*)(ws + WS_QCTR) = 0u;
        for (int k = tid; k < D; k += NWAVES * 64) { const float4 w0 = *(const float4*)(w_in + (size_t)k * INC + 5120), w1 = *(const float4*)(w_in + (size_t)k * INC + 5124);
            gwl[0 * D + k] = w0.x; gwl[1 * D + k] = w0.y; gwl[2 * D + k] = w0.z; gwl[3 * D + k] = w0.w; gwl[4 * D + k] = w1.x; gwl[5 * D + k] = w1.y; gwl[6 * D + k] = w1.z; gwl[7 * D + k] = w1.w; }
        __syncthreads();
        for (int row = gw; row < M; row += NGW) {
            const int b = row / S;
            const float4* xr = (const float4*)(x + (size_t)row * D);
            float4 v[8]; float ss = 0.f;
#pragma unroll
            for (int j = 0; j < 8; ++j) { v[j] = xr[lane + 64 * j]; ss += v[j].x * v[j].x + v[j].y * v[j].y + v[j].z * v[j].z + v[j].w * v[j].w; }
            ss = wave_sum(ss);
            const float rstd = 1.0f / sqrtf(ss * (1.f / D) + EPS);
            float acc[8];
#pragma unroll
            for (int i = 0; i < 8; ++i) acc[i] = 0.f;
            const LAS float* shift = smod + b * 3 * D; const LAS float* scale = shift + D;
#pragma unroll
            for (int j = 0; j < 8; ++j) {
                const int k0 = (lane + 64 * j) * 4;
                const f4 g4 = *(const f4*)(norm_g + k0); const f4 sc4 = *(const LAS f4*)(scale + k0); const f4 sh4 = *(const LAS f4*)(shift + k0);
                float4 h4; h4.x = v[j].x * rstd * g4.x * (1.f + sc4.x) + sh4.x; h4.y = v[j].y * rstd * g4.y * (1.f + sc4.y) + sh4.y; h4.z = v[j].z * rstd * g4.z * (1.f + sc4.z) + sh4.z; h4.w = v[j].w * rstd * g4.w * (1.f + sc4.w) + sh4.w;
#pragma unroll
                for (int i = 0; i < 8; ++i) { const f4 w4 = *(const LAS f4*)(gwl + i * D + k0); acc[i] += h4.x * w4.x + h4.y * w4.y + h4.z * w4.z + h4.w * w4.w; }
                uint2 o; o.x = pk2(h4.x, h4.y); o.y = pk2(h4.z, h4.w);
                *(uint2*)(H + (size_t)row * D + k0) = o;
                asm volatile("" ::: "memory");
            }
#pragma unroll
            for (int i = 0; i < 8; ++i) acc[i] = wave_sum(acc[i]);
            if (lane == 0) {
                rowss[row] = 0.f;
#pragma unroll
                for (int i = 0; i < 4; ++i) gates[(size_t)row * 8 + i] = acc[i] + b_if[i];
#pragma unroll
                for (int i = 4; i < 8; ++i) { const float z = acc[i] + b_if[i]; gates[(size_t)row * 8 + i] = fminf(z, 0.f) - log1pf(expf(-fabsf(z))); }
            }
        }
        __syncthreads();
        if (BOTH(1)) grid.sync(); STAMP();
    }

    constexpr int NWORK = 40, SKIP_ROUNDS = 6;
    if (IN(2)) {
        if (gw < 1024) mlstm_summary(gates, (float*)(ws + WS_SUMM), gw >> 7, gw & 127, lane);
        pg8::Gemm g{H, H, Win_t, Win_t, D, D}; pg8::StaticOrder So; So.init(M, 12 * 256, G, (int)blockIdx.x);
        pg8::EpiProj E{proj, NP};
        pg8::gemm_phase<pg8::EpiProj, pg8::StaticOrder, true, true>(lds, g, So, E);
        if (BOTH(2)) { grid.sync(); STAMP(); }
    }
    if (IN(3)) {
        MlBufs mb; mb.proj = proj; mb.gates = gates; mb.summ = (const float*)(ws + WS_SUMM); mb.conv_w = a.in[7]; mb.conv_b = a.in[8];
        mb.QC = (bf16*)(ws + WS_QC); mb.KC = (bf16*)(ws + WS_KC); mb.IB = (bf16*)(ws + WS_IB);
        mb.rowsum = (float*)(ws + WS_RSUM); mb.winter = (float*)(ws + WS_WINT); mb.mcomb = (float*)(ws + WS_MCOMB); mb.wc = (float*)(ws + WS_WC); mb.vones = (bf16*)(ws + WS_VONES);
        for (int u = blockIdx.x; u < 1024; u += G) mlstm_u1_unit(lds, mb, u >> 9, (u >> 7) & 3, u & 127, tid, lane, wave);
        grid.sync(); STAMP();
        if (blockIdx.x < NWORK) mlstm_worker2(lds, mb, (blockIdx.x & 7) >> 2, blockIdx.x & 3, blockIdx.x >> 3, tid, lane, wave);
        {
            pg8::Gemm g{H, H, Win_t, Win_t, D, D}; pg8::RestOrder So; So.base.init(M, 40 * 256, G, (int)blockIdx.x); So.nwork = NWORK; So.R = SKIP_ROUNDS; So.pn0 = 12;
            pg8::EpiProj E{proj, NP};
            pg8::gemm_phase<pg8::EpiProj, pg8::RestOrder, true, true>(lds, g, So, E);
        }
        grid.sync(); STAMP();
        for (int it = gw; it < M * 4; it += NGW) mlstm_post_item(mb, a.in[9], (size_t)(it >> 2), it & 3, lane);
        {
            unsigned* qctr = (unsigned*)(ws + WS_QCTR); volatile LAS unsigned* qslot = (volatile LAS unsigned*)(lds + 163000);
            for (;;) {
                __syncthreads();
                if (tid == 0) *qslot = atomicAdd(qctr, 1u);
                __syncthreads();
                const unsigned q = *qslot;
                if (q >= 512u) break;
                const int u = 511 - (int)q;
                attn_unit(lds, proj, a.in[10], (u & 15) >> 3, u & 7, u >> 4, tid, lane, wave);
            }
        }
        if (BOTH(3)) { grid.sync(); STAMP(); }
    }
    if (IN(4)) {
        pg8::Gemm g{proj + C_GZ, proj + C_AQ, Wpm_t, Wpa_t, NP, 1024}; pg8::SegOrder So; So.base.init(M, D, G, (int)blockIdx.x);
        pg8::EpiMerge E{proj, NP, C_GM, C_GA, merged, NP};
        pg8::gemm_phase<pg8::EpiMerge, pg8::SegOrder, true, true>(lds, g, So, E);
        if (BOTH(4)) grid.sync(); STAMP();
    }
    if (IN(5)) {
        pg8::Gemm g{merged, merged, Wout_t, Wout_t, NP, D}; pg8::StaticOrder So; So.init(M, D, G, (int)blockIdx.x);
        pg8::EpiOut E{x, mod + 2 * D, a.out, rowss, D, S, 3 * D};
        pg8::gemm_phase<pg8::EpiOut, pg8::StaticOrder, true, true>(lds, g, So, E);
        if (BOTH(5)) grid.sync(); STAMP();
    }
    if (IN(6)) {
        for (int row = gw; row < M; row += NGW) {
            const float r = 1.0f / sqrtf(rowss[row] * (1.f / D) + EPS);
            f4* xr = (f4*)(a.out + (size_t)row * D);
#pragma unroll
            for (int j = 0; j < 8; ++j) { const f4 g4 = *(const f4*)(final_g + (lane + 64 * j) * 4); xr[lane + 64 * j] = xr[lane + 64 * j] * r * g4; }
        }
    }
    if (PROBE_SLOT >= 0) {
        STAMP(); grid.sync();
        const float e = (float)(((tsb[PROBE_SLOT + 1] - tsb[PROBE_SLOT]) / PROBE_QUANT) * PROBE_QUANT) * 1e-6f;
        for (int row = gw; row < M; row += NGW) { f4* xr = (f4*)(a.out + (size_t)row * D);
#pragma unroll
            for (int j = 0; j < 8; ++j) xr[lane + 64 * j] = xr[lane + 64 * j] + e; }
    }
#undef IN
#undef BOTH
}

static int launch_mega(const MArgs& a, hipStream_t stream) {
    static int grid = 0;
    if (grid == 0) {
        int dev = 0, cus = 0, per_cu = 0;
        if (hipGetDevice(&dev) != hipSuccess || hipDeviceGetAttribute(&cus, hipDeviceAttributeMultiprocessorCount, dev) != hipSuccess) { fprintf(stderr, "kernel_launch: device query failed\n"); grid = -1; return -1; }
        if (hipFuncSetAttribute((const void*)mega, hipFuncAttributeMaxDynamicSharedMemorySize, LDS_BYTES) != hipSuccess) { fprintf(stderr, "kernel_launch: hipFuncSetAttribute failed\n"); grid = -1; return -1; }
        if (hipOccupancyMaxActiveBlocksPerMultiprocessor(&per_cu, (const void*)mega, NWAVES * 64, LDS_BYTES) != hipSuccess || per_cu < 1) { fprintf(stderr, "kernel_launch: occupancy query says %d blocks/CU\n", per_cu); (void)hipGetLastError(); grid = -1; return -1; }
        grid = cus * (per_cu > 1 ? 1 : per_cu);
        fprintf(stderr, "kernel_launch: %d CUs, occupancy %d blocks/CU, grid %d\n", cus, per_cu, grid);
    }
    if (grid < 0) return -1;
    MArgs arg = a; void* args[] = {(void*)&arg};
    const hipError_t e = hipLaunchCooperativeKernel((const void*)mega, dim3(grid), dim3(NWAVES * 64), args, LDS_BYTES, stream);
    if (e != hipSuccess) { fprintf(stderr, "kernel_launch: cooperative launch failed: %s (grid %d)\n", hipGetErrorString(e), grid); return -1; }
    return 0;
}

extern "C" void kernel_launch(void* const* d_in, const int* in_sizes, int n_in, void* d_out, int out_size, void* d_ws, size_t ws_size, hipStream_t stream) {
    if (n_in != 15 || in_sizes[0] != M * D || out_size != M * D || ws_size < WS_END) { fprintf(stderr, "kernel_launch: unexpected shapes / workspace (%zu < %zu)\n", ws_size, (size_t)WS_END); return; }
    MArgs a{}; for (int i = 0; i < 15; ++i) a.in[i] = (const float*)d_in[i]; a.out = (float*)d_out; a.ws = (unsigned char*)d_ws; a.ph_lo = 0; a.ph_hi = 7;
    launch_mega(a, stream);
}
```

```cpp
#include <hip/hip_runtime.h>
#include <cstdio>
#include <cstdint>
#include <hip/hip_cooperative_groups.h>
namespace cg = cooperative_groups;

typedef unsigned short bf16;
constexpr int D = 2048, NB = 2, S = 8192, M = NB * S;
constexpr int INC = 13320, NPW = 13312, NP = 12288 + 64;
constexpr int C_MQ = 0, C_MK = 1024, C_MV = 2048, C_GZ = 3072, C_AQ = 4096, C_AK = 5120, C_AV = 6144, C_AZ = 7168, C_GM = 8192, C_GA = 10240;
constexpr float EPS = 1e-6f;

__device__ __forceinline__ bf16 f2bf(float f) { unsigned u = __builtin_bit_cast(unsigned, f); return (bf16)((u + 0x7fffu + ((u >> 16) & 1u)) >> 16); }
__device__ __forceinline__ float bf2f(bf16 h) { return __builtin_bit_cast(float, (unsigned)h << 16); }
__device__ __forceinline__ float wave_sum(float v) {
#pragma unroll
    for (int o = 1; o < 64; o <<= 1) v += __shfl_xor(v, o);
    return v;
}
__device__ __forceinline__ float wave_max(float v) {
#pragma unroll
    for (int o = 1; o < 64; o <<= 1) v = fmaxf(v, __shfl_xor(v, o));
    return v;
}
__device__ __forceinline__ float sigmoidf_(float x) { return 1.f / (1.f + __expf(-x)); }
__device__ __forceinline__ float siluf_(float x) { return x / (1.f + __expf(-x)); }

namespace pg8 {
#define PG8_LAS __attribute__((address_space(3)))
typedef unsigned short bf16_t;
typedef short bf16x8 __attribute__((ext_vector_type(8)));
typedef float f32x4 __attribute__((ext_vector_type(4)));
typedef unsigned u32x4 __attribute__((ext_vector_type(4)));
constexpr int BM = 256, BK = 64, HALF = 128, HTB = HALF * BK * 2  , STAGE_BYTES = 8 * HTB, NXCD = 8, WGM = 8;

__host__ __device__ __forceinline__ int lds_byte(int r, int c) { const int st = (r >> 4) * 2 + (c >> 5), rr = r & 15, cc = c & 31, ob = rr * 64 + cc * 2; return st * 1024 + (ob ^ (((ob >> 9) & 1) << 5)); }
__host__ __device__ __forceinline__ void stage_rc(int b, int& R, int& C) { const int st = b / 1024, sb = b % 1024, swz = sb ^ (((sb >> 9) & 1) << 5); R = (st >> 1) * 16 + swz / 64; C = (st & 1) * 32 + (swz % 64) / 2; }
__host__ __device__ __forceinline__ int perm32(int rho) { const int n = rho >> 4, i = rho & 15; return 8 * (i >> 2) + 4 * n + (i & 3); }

struct Unit { int pm, pn, seg; };
struct Gemm { const bf16_t* A0; const bf16_t* A1; const bf16_t* B0; const bf16_t* B1; int lda, K; };

struct StaticOrder {
    int nM, nN, nwg, G, c;
    __host__ __device__ void init(int M, int N, int G_, int c_) { nM = M / BM; nN = N / BM; nwg = nM * nN; G = G_; c = c_; }
    __host__ __device__ bool next(int i, Unit& u) const { return map((long)i * G + c, u); }
    __host__ __device__ bool map(long L, Unit& u) const {
        if (L >= nwg) return false;
        int wgid = (int)L; { const int q = nwg / NXCD, r = nwg % NXCD, xcd = wgid % NXCD, off = wgid / NXCD; wgid = (xcd < r ? xcd * (q + 1) : r * (q + 1) + (xcd - r) * q) + off; }
        const int nig = WGM * nN, gid = wgid / nig, fm = gid * WGM, gsz = (nM - fm) < WGM ? (nM - fm) : WGM;
        u.pm = fm + ((wgid % nig) % gsz); u.pn = (wgid % nig) / gsz; u.seg = 0; return true;
    }
    __device__ __forceinline__ void a_ready(const Unit&) const {}
    __device__ __forceinline__ void done(const Unit&) const {}
};

__device__ __forceinline__ unsigned cvt_pk_bf16(float lo, float hi) { unsigned r; asm volatile("v_cvt_pk_bf16_f32 %0, %1, %2" : "=v"(r) : "v"(lo), "v"(hi)); return r; }
typedef float f32x2 __attribute__((ext_vector_type(2)));
template <class Epi, class Sched, bool ALIGN_EPI = false, bool SP2 = false>
__device__ __forceinline__ void gemm_phase(PG8_LAS unsigned char* lds, const Gemm g, const Sched& S, const Epi& E) {
    const int tid = threadIdx.x, wid = __builtin_amdgcn_readfirstlane(tid >> 6), lane = tid & 63, wr = wid >> 2, wc = wid & 3, fr = lane & 15, fq = lane >> 4;
    const int K = g.K, nt = K / BK;
    unsigned voffA[2], voffB[2];
#pragma unroll
    for (int i = 0; i < 2; ++i) { int R, C; stage_rc(tid * 16 + i * 8192, R, C); const int Rb = Epi::PERM ? ((R & ~31) + perm32(R & 31)) : R;
        voffA[i] = (unsigned)(R * g.lda + C) * 2u; voffB[i] = (unsigned)(Rb * K + C) * 2u; }
    const size_t kstep = (size_t)(BK * 2);
    const size_t hstepA = (size_t)HALF * g.lda * 2, hstepB = (size_t)HALF * K * 2;
    const size_t tstepA = 2 * hstepA, tstepB = 2 * hstepB;
    const unsigned ldsw = (unsigned)wid * 1024u;
    const int aoff = lds_byte(wr * 64 + fr, fq * 8), boff = lds_byte(wc * 32 + fr, fq * 8);
#define PG8_SA(b, h) (((b) * 2 + (h)) * HTB)
#define PG8_SB(b, h) ((4 + (b) * 2 + (h)) * HTB)
#define PG8_STAGE(bufoff, gbase, voff) do { _Pragma("unroll") for (int _i = 0; _i < 2; ++_i) \
        __builtin_amdgcn_global_load_lds((const unsigned*)((const char*)(gbase) + (voff)[_i]), (PG8_LAS unsigned*)(lds + (bufoff) + ldsw + _i * 8192), 16, 0, 0); } while (0)
#define PG8_LDA(dst, b, h) do { _Pragma("unroll") for (int m = 0; m < 4; ++m) _Pragma("unroll") for (int k = 0; k < 2; ++k) dst[m][k] = *(const PG8_LAS bf16x8*)(lds + PG8_SA(b, h) + aoff + m * 2048 + k * 1024); } while (0)
#define PG8_LDB(dst, b, h) do { _Pragma("unroll") for (int n = 0; n < 2; ++n) _Pragma("unroll") for (int k = 0; k < 2; ++k) dst[n][k] = *(const PG8_LAS bf16x8*)(lds + PG8_SB(b, h) + boff + n * 2048 + k * 1024); } while (0)
#define PG8_MMA(ai, bj, At, Bt) do { __builtin_amdgcn_s_setprio(1); _Pragma("unroll") for (int m = 0; m < 4; ++m) _Pragma("unroll") for (int n = 0; n < 2; ++n) _Pragma("unroll") for (int k = 0; k < 2; ++k) \
        acc[ai][bj][m][n] = __builtin_amdgcn_mfma_f32_16x16x32_bf16(Bt[n][k], At[m][k], acc[ai][bj][m][n], 0, 0, 0); __builtin_amdgcn_s_setprio(0); } while (0)
#define PG8_WAIT_V(n) asm volatile("s_waitcnt vmcnt(" #n ")" ::: "memory")
#define PG8_WAIT_L(n) asm volatile("s_waitcnt lgkmcnt(" #n ")" ::: "memory")
#define PG8_BAR __builtin_amdgcn_s_barrier()
#define PG8_SCHED __builtin_amdgcn_sched_barrier(0)
    Unit cur, nxt; int ui = 0;
    if (!S.next(0, cur)) return;
    f32x4 acc[2][2][4][2];
#pragma unroll
    for (int a = 0; a < 2; ++a)
#pragma unroll
        for (int b = 0; b < 2; ++b)
#pragma unroll
            for (int m = 0; m < 4; ++m)
#pragma unroll
                for (int n = 0; n < 2; ++n) acc[a][b][m][n] = (f32x4){0.f, 0.f, 0.f, 0.f};
    bf16x8 At[4][2], B0[2][2], B1[2][2];
    const char* cA = (const char*)(cur.seg ? g.A1 : g.A0) + (size_t)cur.pm * tstepA; const char* cB = (const char*)(cur.seg ? g.B1 : g.B0) + (size_t)cur.pn * tstepB;
    S.a_ready(cur);
    if constexpr (SP2) {
        PG8_STAGE(PG8_SB(0, 0), cB, voffB); PG8_STAGE(PG8_SB(0, 1), cB + hstepB, voffB); PG8_STAGE(PG8_SA(0, 0), cA, voffA); PG8_STAGE(PG8_SA(0, 1), cA + hstepA, voffA);
        if (wr == 1) PG8_BAR;
        PG8_WAIT_V(2); PG8_BAR;
        PG8_STAGE(PG8_SB(1, 0), cB + kstep, voffB); PG8_STAGE(PG8_SA(1, 0), cA + kstep, voffA); PG8_STAGE(PG8_SB(1, 1), cB + hstepB + kstep, voffB);
        PG8_WAIT_V(6); PG8_BAR;
    } else {
        PG8_STAGE(PG8_SB(0, 0), cB, voffB); PG8_STAGE(PG8_SA(0, 0), cA, voffA); PG8_STAGE(PG8_SB(0, 1), cB + hstepB, voffB); PG8_STAGE(PG8_SA(0, 1), cA + hstepA, voffA);
        if (wr == 1) PG8_BAR;
        PG8_WAIT_V(4); PG8_BAR;
        PG8_STAGE(PG8_SB(1, 0), cB + kstep, voffB); PG8_STAGE(PG8_SA(1, 0), cA + kstep, voffA); PG8_STAGE(PG8_SB(1, 1), cB + hstepB + kstep, voffB);
        PG8_WAIT_V(6); PG8_BAR;
    }
    for (;;) {
        const bool has_next = S.next(ui + 1, nxt);
        const char* nA = has_next ? (const char*)(nxt.seg ? g.A1 : g.A0) + (size_t)nxt.pm * tstepA : cA; const char* nB = has_next ? (const char*)(nxt.seg ? g.B1 : g.B0) + (size_t)nxt.pn * tstepB : cB;
        for (int t = 0; t < nt; t += 2) {
            const bool last = (t == nt - 2);
            const char* a1 = cA + (size_t)(t + 1) * kstep;
            const char* a2 = last ? nA : cA + (size_t)(t + 2) * kstep; const char* b2 = last ? nB : cB + (size_t)(t + 2) * kstep;
            const char* a3 = a2 + kstep; const char* b3 = b2 + kstep;
            if (last && has_next) S.a_ready(nxt);
            if constexpr (SP2) {
            PG8_LDB(B0, 0, 0); PG8_LDB(B1, 0, 1); PG8_SCHED; PG8_LDA(At, 0, 0); PG8_STAGE(PG8_SA(1, 1), a1 + hstepA, voffA);
            PG8_WAIT_V(8); PG8_WAIT_L(0); PG8_BAR; PG8_MMA(0, 0, At, B0); PG8_MMA(0, 1, At, B1); PG8_BAR; PG8_SCHED;
            PG8_LDA(At, 0, 1); PG8_STAGE(PG8_SB(0, 0), b2, voffB); PG8_STAGE(PG8_SB(0, 1), b2 + hstepB, voffB); PG8_STAGE(PG8_SA(0, 0), a2, voffA);
            PG8_WAIT_V(8); PG8_WAIT_L(0); PG8_BAR; PG8_MMA(1, 0, At, B0); PG8_MMA(1, 1, At, B1); PG8_BAR; PG8_SCHED;
            PG8_LDB(B0, 1, 0); PG8_LDB(B1, 1, 1); PG8_SCHED; PG8_LDA(At, 1, 0); PG8_STAGE(PG8_SA(0, 1), a2 + hstepA, voffA);
            PG8_WAIT_V(8); PG8_WAIT_L(0); PG8_BAR; PG8_MMA(0, 0, At, B0); PG8_MMA(0, 1, At, B1); PG8_BAR; PG8_SCHED;
            PG8_LDA(At, 1, 1); PG8_STAGE(PG8_SB(1, 0), b3, voffB); PG8_STAGE(PG8_SB(1, 1), b3 + hstepB, voffB); PG8_STAGE(PG8_SA(1, 0), a3, voffA);
            PG8_WAIT_V(8); PG8_WAIT_L(0); PG8_BAR; PG8_MMA(1, 0, At, B0); PG8_MMA(1, 1, At, B1); PG8_BAR; PG8_SCHED;
            } else {
            PG8_LDB(B0, 0, 0); PG8_SCHED; PG8_LDA(At, 0, 0); PG8_STAGE(PG8_SA(1, 1), a1 + hstepA, voffA);
            PG8_WAIT_L(8); PG8_BAR; PG8_WAIT_L(0); PG8_MMA(0, 0, At, B0); PG8_BAR; PG8_SCHED;
            PG8_LDB(B1, 0, 1); PG8_STAGE(PG8_SB(0, 0), b2, voffB);
            PG8_BAR; PG8_WAIT_L(0); PG8_MMA(0, 1, At, B1); PG8_BAR;
            PG8_LDA(At, 0, 1); PG8_STAGE(PG8_SA(0, 0), a2, voffA);
            PG8_BAR; PG8_WAIT_L(0); PG8_MMA(1, 0, At, B0); PG8_BAR; PG8_SCHED;
            PG8_STAGE(PG8_SB(0, 1), b2 + hstepB, voffB);
            PG8_WAIT_V(6); PG8_BAR; PG8_MMA(1, 1, At, B1); PG8_BAR;
            PG8_LDB(B0, 1, 0); PG8_SCHED; PG8_LDA(At, 1, 0); PG8_STAGE(PG8_SA(0, 1), a2 + hstepA, voffA);
            PG8_WAIT_L(8); PG8_BAR; PG8_WAIT_L(0); PG8_MMA(0, 0, At, B0); PG8_BAR; PG8_SCHED;
            PG8_LDB(B1, 1, 1); PG8_STAGE(PG8_SB(1, 0), b3, voffB);
            PG8_BAR; PG8_WAIT_L(0); PG8_MMA(0, 1, At, B1); PG8_BAR;
            PG8_LDA(At, 1, 1); PG8_STAGE(PG8_SA(1, 0), a3, voffA);
            PG8_BAR; PG8_WAIT_L(0); PG8_MMA(1, 0, At, B0); PG8_BAR; PG8_SCHED;
            PG8_STAGE(PG8_SB(1, 1), b3 + hstepB, voffB);
            PG8_WAIT_V(6); PG8_BAR; PG8_MMA(1, 1, At, B1); PG8_BAR;
            }
        }
        if constexpr (ALIGN_EPI) { if (wr == 0) PG8_BAR; }
        if constexpr (!Epi::AFTER_DRAIN) { E(acc, cur, wr, wc, fr, fq); S.done(cur); }
        if (!has_next) break;
        if (E.zero_after(cur)) {
#pragma unroll
        for (int a = 0; a < 2; ++a)
#pragma unroll
            for (int b = 0; b < 2; ++b)
#pragma unroll
                for (int m = 0; m < 4; ++m)
#pragma unroll
                    for (int n = 0; n < 2; ++n) acc[a][b][m][n] = (f32x4){0.f, 0.f, 0.f, 0.f};
        }
        cur = nxt; cA = nA; cB = nB; ++ui;
        if constexpr (ALIGN_EPI) { if (wr == 1) PG8_BAR; }
    }
    PG8_WAIT_V(0);
    if constexpr (!ALIGN_EPI) { if (wr == 0) PG8_BAR; }
    PG8_BAR;
    if constexpr (Epi::AFTER_DRAIN) { E.fused(acc, cur, wr, wc, fr, fq, lds, wid, lane); S.done(cur); }
#undef PG8_SA
#undef PG8_SB
#undef PG8_STAGE
#undef PG8_LDA
#undef PG8_LDB
#undef PG8_MMA
#undef PG8_WAIT_V
#undef PG8_WAIT_L
#undef PG8_BAR
#undef PG8_SCHED
}
}

namespace pg8 {
typedef unsigned u32x4_ __attribute__((ext_vector_type(4)));
struct EpiProj {
    static constexpr bool PERM = true, AFTER_DRAIN = false;
    bf16_t* O; int ldc;
    __device__ __forceinline__ bool zero_after(const Unit&) const { return true; }
    __device__ __forceinline__ void operator()(f32x4 (&acc)[2][2][4][2], const Unit& u, int wr, int wc, int fr, int fq) const {
        const int row0 = u.pm * BM + wr * 64 + fr;
        if (u.pn >= 12 && u.pn < 20) {
            const int col0 = 3072 + 128 * (u.pn - 12) + wc * 32 + 8 * fq;
#pragma unroll
            for (int ai = 0; ai < 2; ++ai)
#pragma unroll
                for (int m = 0; m < 4; ++m) { float o[8];
#pragma unroll
                    for (int e = 0; e < 8; ++e) { const float mo = acc[ai][0][m][e >> 2][e & 3], mz = acc[ai][1][m][e >> 2][e & 3];
                        o[e] = mz * __builtin_amdgcn_rcpf((1.f + __expf(-mo)) * (1.f + __expf(-mz))); }
                    u32x4 w; w.x = cvt_pk_bf16(o[0], o[1]); w.y = cvt_pk_bf16(o[2], o[3]); w.z = cvt_pk_bf16(o[4], o[5]); w.w = cvt_pk_bf16(o[6], o[7]);
                    *(u32x4*)(O + (size_t)(row0 + ai * HALF + m * 16) * ldc + col0) = w; }
        } else {
            const int col0 = (u.pn < 12 ? u.pn * BM : 4096 + (u.pn - 20) * BM) + wc * 32 + 8 * fq;
#pragma unroll
            for (int ai = 0; ai < 2; ++ai)
#pragma unroll
                for (int m = 0; m < 4; ++m) { bf16_t* rowp = O + (size_t)(row0 + ai * HALF + m * 16) * ldc + col0;
#pragma unroll
                    for (int bj = 0; bj < 2; ++bj) { const f32x4 v0 = acc[ai][bj][m][0], v1 = acc[ai][bj][m][1];
                        u32x4 w; w.x = cvt_pk_bf16(v0[0], v0[1]); w.y = cvt_pk_bf16(v0[2], v0[3]); w.z = cvt_pk_bf16(v1[0], v1[1]); w.w = cvt_pk_bf16(v1[2], v1[3]);
                        *(u32x4*)(rowp + bj * HALF) = w; } }
        }
    }
};
struct RestOrder {
    StaticOrder base; int nwork, R, pn0;
    __device__ __forceinline__ bool next(int i, Unit& u) const {
        const int G = base.G, c = base.c, nn = G - nwork; long L;
        if (c < nwork) L = (long)R * nn + (long)i * G + c;
        else L = (i < R) ? (long)i * nn + (c - nwork) : (long)R * nn + (long)(i - R) * G + c;
        if (!base.map(L, u)) return false;
        u.pn += pn0; return true;
    }
    __device__ __forceinline__ void a_ready(const Unit&) const {}
    __device__ __forceinline__ void done(const Unit&) const {}
};
struct SegOrder {
    StaticOrder base;
    __device__ __forceinline__ bool next(int i, Unit& u) const { if (!base.next(i >> 1, u)) return false; u.seg = i & 1; return true; }
    __device__ __forceinline__ void a_ready(const Unit&) const {}
    __device__ __forceinline__ void done(const Unit&) const {}
};
__device__ __forceinline__ float bfw(unsigned w, int half) { return __builtin_bit_cast(float, half ? (w & 0xffff0000u) : (w << 16)); }
struct EpiMerge {
    static constexpr bool PERM = true, AFTER_DRAIN = false;
    const bf16_t* proj; int ldp, cgm, cga; bf16_t* O; int ldo;
    __device__ __forceinline__ bool zero_after(const Unit& u) const { return u.seg != 0; }
    __device__ __forceinline__ void operator()(f32x4 (&acc)[2][2][4][2], const Unit& u, int wr, int wc, int fr, int fq) const {
        const int row0 = u.pm * BM + wr * 64 + fr, col0 = u.pn * BM + wc * 32 + 8 * fq;
#pragma unroll
        for (int ai = 0; ai < 2; ++ai)
#pragma unroll
            for (int m = 0; m < 4; ++m) { const size_t row = (size_t)(row0 + ai * HALF + m * 16);
#pragma unroll
                for (int bj = 0; bj < 2; ++bj) {
                    const u32x4 ga4 = *(const u32x4*)(proj + row * ldp + cga + col0 + bj * HALF);
                    if (u.seg == 0) {
                        const u32x4 gm4 = *(const u32x4*)(proj + row * ldp + cgm + col0 + bj * HALF);
#pragma unroll
                        for (int e = 0; e < 8; ++e) { const float gm = bfw(gm4[e >> 1], e & 1), ga = bfw(ga4[e >> 1], e & 1);
                            acc[ai][bj][m][e >> 2][e & 3] *= (1.f + __expf(-ga)) * __builtin_amdgcn_rcpf(1.f + __expf(-gm)); }
                    } else {
                        float o[8];
#pragma unroll
                        for (int e = 0; e < 8; ++e) { const float ga = bfw(ga4[e >> 1], e & 1); o[e] = acc[ai][bj][m][e >> 2][e & 3] * __builtin_amdgcn_rcpf(1.f + __expf(-ga)); }
                        u32x4 w; w.x = cvt_pk_bf16(o[0], o[1]); w.y = cvt_pk_bf16(o[2], o[3]); w.z = cvt_pk_bf16(o[4], o[5]); w.w = cvt_pk_bf16(o[6], o[7]);
                        *(u32x4*)(O + row * ldo + col0 + bj * HALF) = w;
                    }
                }
                if (m & 1) asm volatile("" ::: "memory"); }
    }
};
struct EpiOut {
    static constexpr bool PERM = false, AFTER_DRAIN = false;
    const float* x; const float* gate; float* out; float* rowss; int ldc, rows_per_batch, gate_stride;
    __device__ __forceinline__ bool zero_after(const Unit&) const { return true; }
    __device__ __forceinline__ void operator()(f32x4 (&acc)[2][2][4][2], const Unit& u, int wr, int wc, int fr, int fq) const {
        const int row0 = u.pm * BM + wr * 64 + fr, col0 = u.pn * BM + wc * 32 + 4 * fq;
        const float* gp = gate + (size_t)((u.pm * BM) / rows_per_batch) * gate_stride + col0;
        f32x4 gt[2][2];
#pragma unroll
        for (int bj = 0; bj < 2; ++bj)
#pragma unroll
            for (int n = 0; n < 2; ++n) gt[bj][n] = *(const f32x4*)(gp + bj * HALF + n * 16);
#pragma unroll
        for (int ai = 0; ai < 2; ++ai)
#pragma unroll
            for (int m = 0; m < 4; ++m) { const int row = row0 + ai * HALF + m * 16; const size_t off = (size_t)row * ldc + col0; float ssq = 0.f;
#pragma unroll
                for (int bj = 0; bj < 2; ++bj)
#pragma unroll
                    for (int n = 0; n < 2; ++n) { const f32x4 xv = *(const f32x4*)(x + off + bj * HALF + n * 16); const f32x4 o = xv + gt[bj][n] * acc[ai][bj][m][n];
                        ssq += (o[0] * o[0] + o[1] * o[1]) + (o[2] * o[2] + o[3] * o[3]); *(f32x4*)(out + off + bj * HALF + n * 16) = o; }
                ssq += __shfl_xor(ssq, 16); ssq += __shfl_xor(ssq, 32);
                if (fq == 0) atomicAdd(rowss + row, ssq);
                if (m & 1) asm volatile("" ::: "memory"); }
    }
};
}

#define PROBE_QUANT 1
#define PROBE_SLOT (-1)
#define LAS __attribute__((address_space(3)))
typedef unsigned v4u __attribute__((ext_vector_type(4)));
typedef float f4 __attribute__((ext_vector_type(4)));
constexpr size_t MiB = 1u << 20;
constexpr size_t WS_PROJ = 0;
constexpr size_t WS_QC = 386 * MiB;
constexpr size_t WS_KC = 418 * MiB;
constexpr size_t WS_IB = 450 * MiB;
constexpr size_t WS_WPM = 482 * MiB;
constexpr size_t WS_WPA = 486 * MiB;
constexpr size_t WS_WOUT = 490 * MiB;
constexpr size_t WS_MODP = 498 * MiB;
constexpr size_t WS_MOD = WS_MODP + 786432;
constexpr size_t WS_GATES = 499 * MiB;
constexpr size_t WS_ROWSS = WS_GATES + 524288;
constexpr size_t WS_SUMM = WS_ROWSS + 65536;
constexpr size_t WS_WC = WS_SUMM + 8192;
constexpr size_t WS_QCTR = WS_WC + 4096;
constexpr size_t WS_TS = WS_WC + 4096 + 256;
constexpr size_t WS_RSUM = 500 * MiB;
constexpr size_t WS_WINT = WS_RSUM + 262144;
constexpr size_t WS_MCOMB = WS_WINT + 262144;
constexpr size_t WS_VONES = 501 * MiB;
constexpr size_t WS_END = 509 * MiB;
static_assert(WS_MCOMB + 262144 <= WS_VONES && WS_VONES + (size_t)8 * 8192 * 64 * 2 <= WS_END && WS_PROJ + (size_t)M * NP * 2 <= WS_QC && WS_TS + 256 <= WS_RSUM && WS_MOD + 49152 <= WS_GATES, "d_ws map");
constexpr size_t OB_H = 0;
constexpr size_t OB_WIN = 64 * MiB;
constexpr int NWAVES = 8, LDS_BYTES = 163840;

struct MArgs { const float* in[15]; float* out; unsigned char* ws; int ph_lo, ph_hi; };

__device__ __forceinline__ unsigned pk2(float lo, float hi) { return (unsigned)f2bf(lo) | ((unsigned)f2bf(hi) << 16); }
#define LDS_WAIT() asm volatile("s_waitcnt lgkmcnt(0)" ::: "memory")

__device__ __forceinline__ void transpose_item(const float* __restrict__ W, int ldw, int ncol_src0, bf16* __restrict__ WT, int K, int nrow_dst0, int k0, LAS float* scr, int lane) {
#pragma unroll 8
    for (int i = 0; i < 32; ++i) { const int kk = 2 * i + (lane >> 5); scr[kk * 33 + (lane & 31)] = W[(size_t)(k0 + kk) * ldw + ncol_src0 + (lane & 31)]; }
    LDS_WAIT();
    const int c = lane & 7;
#pragma unroll
    for (int j = 0; j < 4; ++j) { const int n = (lane >> 3) + 8 * j; const LAS float* s = scr + (8 * c) * 33 + n;
        v4u o; o.x = pk2(s[0 * 33], s[1 * 33]); o.y = pk2(s[2 * 33], s[3 * 33]); o.z = pk2(s[4 * 33], s[5 * 33]); o.w = pk2(s[6 * 33], s[7 * 33]);
        *(v4u*)(WT + (size_t)(nrow_dst0 + n) * K + k0 + 8 * c) = o; }
    LDS_WAIT();
}

typedef short bf16x8 __attribute__((ext_vector_type(8)));
typedef short s16x4 __attribute__((ext_vector_type(4)));
typedef float f32x16 __attribute__((ext_vector_type(16)));
typedef float f32x2_t __attribute__((ext_vector_type(2)));
typedef __bf16 bf16x2_t __attribute__((ext_vector_type(2)));
__device__ __forceinline__ unsigned cvtpk(float lo, float hi) { f32x2_t v = {lo, hi}; bf16x2_t b = __builtin_convertvector(v, bf16x2_t); return __builtin_bit_cast(unsigned, b); }
__device__ __forceinline__ s16x4 tr_read(const LAS unsigned char* p) { return __builtin_bit_cast(s16x4, __builtin_amdgcn_ds_read_tr16_b64_v4i16((LAS s16x4*)p)); }
constexpr int AT_KP = 272, AT_VP = 320, AT_KBUF = 64 * AT_KP, AT_VBUF = 64 * AT_VP, AT_VOFF = 2 * AT_KBUF, AT_BIAS = AT_VOFF + 2 * AT_VBUF, AT_LDS = AT_BIAS + 768;
constexpr float LOG2E = 1.4426950408889634f;

__device__ __forceinline__ void attn_unit(LAS unsigned char* lds, bf16* proj, const float* __restrict__ rel_bias, int b, int h, int g4, int tid, int lane, int wave) {
    const int j0 = 4 * g4, half = wave & 1, jq = j0 + (wave >> 1);
    const int r32 = lane & 31, hb = lane >> 5;
    const int tq = 64 * jq + 32 * half + r32;
    const size_t rowq = (size_t)b * S + tq;
    LAS float* biasL = (LAS float*)(lds + AT_BIAS);
    if (tid < 192) biasL[tid] = rel_bias[h * 192 + tid] * LOG2E;
    bf16x8 qf[8];
#pragma unroll
    for (int ks = 0; ks < 8; ++ks) qf[ks] = *(const bf16x8*)(proj + rowq * NP + C_AQ + h * 128 + 16 * ks + 8 * hb);
    f32x16 o[4];
#pragma unroll
    for (int dt = 0; dt < 4; ++dt)
#pragma unroll
        for (int r = 0; r < 16; ++r) o[dt][r] = 0.f;
    float m_run = -1e30f, l_run = 0.f;
    const int t0 = j0 > 8 ? j0 - 8 : 0, nt = j0 + 3 - t0 + 1;
    const int srow = tid >> 4, sc16 = tid & 15;
    const bf16* gsrc = proj + ((size_t)b * S + srow) * NP + h * 128 + sc16 * 8;
    v4u kr0, kr1, vr0, vr1;
#define AT_GLOAD(tc) do { const bf16* g_ = gsrc + (size_t)(64 * (tc)) * NP; kr0 = *(const v4u*)(g_ + C_AK); vr0 = *(const v4u*)(g_ + C_AV); kr1 = *(const v4u*)(g_ + (size_t)32 * NP + C_AK); vr1 = *(const v4u*)(g_ + (size_t)32 * NP + C_AV); } while (0)
#define AT_LWRITE(buf) do { LAS unsigned char* k_ = lds + (buf) * AT_KBUF + srow * AT_KP + sc16 * 16; LAS unsigned char* v_ = lds + AT_VOFF + (buf) * AT_VBUF + srow * AT_VP + sc16 * 16; \
        *(LAS v4u*)k_ = kr0; *(LAS v4u*)(k_ + 32 * AT_KP) = kr1; *(LAS v4u*)v_ = vr0; *(LAS v4u*)(v_ + 32 * AT_VP) = vr1; } while (0)
    AT_GLOAD(t0); AT_LWRITE(0);
    __syncthreads();
    const float SC = 0.08838834764831845f * LOG2E;
    for (int i = 0; i < nt; ++i) {
        const int tc = t0 + i, buf = i & 1;
        if (i + 1 < nt) AT_GLOAD(tc + 1);
        const int cdiff = jq - tc;
        if (cdiff >= 0 && cdiff <= 8) {
            const LAS unsigned char* Kb = lds + buf * AT_KBUF + r32 * AT_KP + hb * 16;
            f32x16 s0, s1;
#pragma unroll
            for (int r = 0; r < 16; ++r) { s0[r] = 0.f; s1[r] = 0.f; }
#pragma unroll
            for (int ks = 0; ks < 8; ++ks) {
                const bf16x8 k0 = *(const LAS bf16x8*)(Kb + ks * 32), k1 = *(const LAS bf16x8*)(Kb + 32 * AT_KP + ks * 32);
                s0 = __builtin_amdgcn_mfma_f32_32x32x16_bf16(k0, qf[ks], s0, 0, 0, 0);
                s1 = __builtin_amdgcn_mfma_f32_32x32x16_bf16(k1, qf[ks], s1, 0, 0, 0);
            }
            if (cdiff >= 3) { const float bc = biasL[191];
#pragma unroll
                for (int r = 0; r < 16; ++r) { s0[r] = s0[r] * SC + bc; s1[r] = s1[r] * SC + bc; }
            } else { const int base = 64 * cdiff + 32 * half + r32 + 63 - 4 * hb;
#pragma unroll
                for (int r = 0; r < 16; ++r) { const int i0 = base - ((r & 3) + 8 * (r >> 2)), i1 = i0 - 32;
                    s0[r] = s0[r] * SC + biasL[i0 > 191 ? 191 : i0]; s1[r] = s1[r] * SC + biasL[i1 > 191 ? 191 : i1]; }
            }
            float mx = fmaxf(s0[0], s1[0]);
#pragma unroll
            for (int r = 1; r < 16; ++r) mx = fmaxf(mx, fmaxf(s0[r], s1[r]));
            mx = fmaxf(mx, __shfl_xor(mx, 32));
            const float m_new = fmaxf(m_run, mx), alpha = __builtin_amdgcn_exp2f(m_run - m_new); m_run = m_new;
            float ls = 0.f;
#pragma unroll
            for (int r = 0; r < 16; ++r) { s0[r] = __builtin_amdgcn_exp2f(s0[r] - m_new); s1[r] = __builtin_amdgcn_exp2f(s1[r] - m_new); ls += s0[r] + s1[r]; }
            l_run = l_run * alpha + ls;
#pragma unroll
            for (int dt = 0; dt < 4; ++dt)
#pragma unroll
                for (int r = 0; r < 16; ++r) o[dt][r] *= alpha;
            v4u pw[4];
            pw[0] = (v4u){cvtpk(s0[0], s0[1]), cvtpk(s0[2], s0[3]), cvtpk(s0[4], s0[5]), cvtpk(s0[6], s0[7])};
            pw[1] = (v4u){cvtpk(s0[8], s0[9]), cvtpk(s0[10], s0[11]), cvtpk(s0[12], s0[13]), cvtpk(s0[14], s0[15])};
            pw[2] = (v4u){cvtpk(s1[0], s1[1]), cvtpk(s1[2], s1[3]), cvtpk(s1[4], s1[5]), cvtpk(s1[6], s1[7])};
            pw[3] = (v4u){cvtpk(s1[8], s1[9]), cvtpk(s1[10], s1[11]), cvtpk(s1[12], s1[13]), cvtpk(s1[14], s1[15])};
            const LAS unsigned char* Vb = lds + AT_VOFF + buf * AT_VBUF + (4 * hb + ((lane & 15) >> 2)) * AT_VP + (16 * ((lane >> 4) & 1) + 4 * (lane & 3)) * 2;
#pragma unroll
            for (int q = 0; q < 4; ++q) {
#pragma unroll
                for (int dt = 0; dt < 4; ++dt) {
                    const s16x4 lo = tr_read(Vb + (16 * q) * AT_VP + dt * 64), hi = tr_read(Vb + (16 * q + 8) * AT_VP + dt * 64);
                    const bf16x8 vf = (bf16x8){lo[0], lo[1], lo[2], lo[3], hi[0], hi[1], hi[2], hi[3]};
                    o[dt] = __builtin_amdgcn_mfma_f32_32x32x16_bf16(vf, __builtin_bit_cast(bf16x8, pw[q]), o[dt], 0, 0, 0);
                }
            }
        }
        if (i + 1 < nt) AT_LWRITE(buf ^ 1);
        __syncthreads();
    }
#undef AT_GLOAD
#undef AT_LWRITE
    const float linv = 1.f / (l_run + __shfl_xor(l_run, 32));
#pragma unroll
    for (int dt = 0; dt < 4; ++dt)
#pragma unroll
        for (int rq = 0; rq < 4; ++rq) {
            const int d0 = 32 * dt + 8 * rq + 4 * hb;
            const uint2 zz = *(const uint2*)(proj + rowq * NP + C_AZ + h * 128 + d0);
            const float z0 = __builtin_bit_cast(float, zz.x << 16), z1 = __builtin_bit_cast(float, zz.x & 0xffff0000u), z2 = __builtin_bit_cast(float, zz.y << 16), z3 = __builtin_bit_cast(float, zz.y & 0xffff0000u);
            uint2 w; w.x = cvtpk(o[dt][4 * rq + 0] * linv * siluf_(z0), o[dt][4 * rq + 1] * linv * siluf_(z1)); w.y = cvtpk(o[dt][4 * rq + 2] * linv * siluf_(z2), o[dt][4 * rq + 3] * linv * siluf_(z3));
            *(uint2*)(proj + rowq * NP + C_AQ + h * 128 + d0) = w;
        }
}

using pg8::bfw;
typedef float f32x4_ __attribute__((ext_vector_type(4)));
typedef unsigned u2v __attribute__((ext_vector_type(2)));
#define MFMA16(a, b, c) __builtin_amdgcn_mfma_f32_16x16x32_bf16((a), (b), (c), 0, 0, 0)
__device__ __forceinline__ float wave_scan_add(float x, int lane) {
#pragma unroll
    for (int o = 1; o < 64; o <<= 1) { const float t = __shfl_up(x, o); if (lane >= o) x += t; }
    return x;
}
__device__ __forceinline__ float wave_scan_max(float x, int lane) {
#pragma unroll
    for (int o = 1; o < 64; o <<= 1) { const float t = __shfl_up(x, o); if (lane >= o) x = fmaxf(x, t); }
    return x;
}
__device__ __forceinline__ void mlstm_summary(const float* __restrict__ gates, float* __restrict__ summ, int bh, int j, int lane) {
    const size_t row = (size_t)(bh >> 2) * S + 64 * j + lane; const int h = bh & 3;
    const float ig = gates[row * 8 + h], lf = gates[row * 8 + 4 + h];
    const float bc = wave_scan_add(lf, lane); const float b_last = __shfl(bc, 63);
    const float gmax = wave_max(b_last - bc + ig);
    if (lane == 0) { summ[(bh * 128 + j) * 2] = b_last; summ[(bh * 128 + j) * 2 + 1] = gmax; }
}
constexpr int U1_QP = 528, U1_VP = 576, U1_SP = 144;
constexpr int U1_QCL = 0, U1_KCL = 64 * U1_QP, U1_VL = 2 * 64 * U1_QP, U1_SWL = U1_VL + 64 * U1_VP, U1_SCAL = U1_SWL + 64 * U1_SP, U1_LDS = U1_SCAL + 3 * 256;
struct MlBufs { bf16* proj; const float* gates; const float* summ; const float* conv_w; const float* conv_b; bf16* QC; bf16* KC; bf16* IB; float* rowsum; float* winter; float* mcomb; float* wc; bf16* vones; };

__device__ __forceinline__ void mlstm_u1_unit(LAS unsigned char* lds, const MlBufs& B, int b, int h, int j, int tid, int lane, int wave) {
    const int bh = b * 4 + h; const size_t rowb = (size_t)b * S + 64 * j;
    LAS float* sA = (LAS float*)(lds + U1_SCAL); LAS float* sC = sA + 64; LAS float* sWk = sA + 128;
    __syncthreads();
    if (wave == 0) {
        const size_t row = rowb + lane;
        const float ig = B.gates[row * 8 + h], lf = B.gates[row * 8 + 4 + h];
        const float bc = wave_scan_add(lf, lane); const float b_last = __shfl(bc, 63);
        const float a_s = ig - bc; const float pm = wave_scan_max(a_s, lane);
        const float gg = b_last - bc + ig; const float gmax = wave_max(gg);
        float m_prev = 0.f;
        if (j > 0) {
            const float bl0 = B.summ[(bh * 128 + lane) * 2], gm0 = B.summ[(bh * 128 + lane) * 2 + 1], bl1 = B.summ[(bh * 128 + 64 + lane) * 2], gm1 = B.summ[(bh * 128 + 64 + lane) * 2 + 1];
            const float P0 = wave_scan_add(bl0, lane); const float tot0 = __shfl(P0, 63); const float P1 = wave_scan_add(bl1, lane) + tot0;
            const int jm = j - 1;
            const float e0 = (lane <= jm) ? gm0 - P0 : -INFINITY, e1 = (lane + 64 <= jm) ? gm1 - P1 : -INFINITY;
            const float emax = wave_max(fmaxf(e0, e1));
            const float Bjm = (jm < 64) ? __shfl(P0, jm) : __shfl(P1, jm - 64);
            m_prev = Bjm + fmaxf(0.f, emax);
        }
        const float m_j = fmaxf(b_last + m_prev, gmax);
        const float c_t = fmaxf(pm, m_prev);
        sA[lane] = a_s; sC[lane] = c_t; sWk[lane] = __expf(gg - m_j);
        B.winter[row * 4 + h] = __expf(m_prev - c_t); B.mcomb[row * 4 + h] = bc + c_t;
        if (lane == 0) B.wc[bh * 128 + j] = __expf(b_last + m_prev - m_j);
    }
    {
        const int cg = tid & 63, tg = tid >> 6, isk = cg >> 5, c8 = (cg & 31) * 8, chan = isk * 1024 + h * 256 + c8;
        const bf16* src = B.proj + (rowb + 8 * tg - 3) * NP + (isk ? C_MK : C_MQ) + h * 256 + c8;
        float wv[4][8], bv[8];
#pragma unroll
        for (int tap = 0; tap < 4; ++tap) { const f4 w0 = *(const f4*)(B.conv_w + tap * 2048 + chan), w1 = *(const f4*)(B.conv_w + tap * 2048 + chan + 4);
            wv[tap][0] = w0[0]; wv[tap][1] = w0[1]; wv[tap][2] = w0[2]; wv[tap][3] = w0[3]; wv[tap][4] = w1[0]; wv[tap][5] = w1[1]; wv[tap][6] = w1[2]; wv[tap][7] = w1[3]; }
        { const f4 b0 = *(const f4*)(B.conv_b + chan), b1 = *(const f4*)(B.conv_b + chan + 4); bv[0] = b0[0]; bv[1] = b0[1]; bv[2] = b0[2]; bv[3] = b0[3]; bv[4] = b1[0]; bv[5] = b1[1]; bv[6] = b1[2]; bv[7] = b1[3]; }
        v4u raw[11];
#pragma unroll
        for (int i = 0; i < 11; ++i) { const int tt = 64 * j + 8 * tg - 3 + i; raw[i] = (tt >= 0) ? *(const v4u*)(src + (size_t)i * NP) : (v4u){0u, 0u, 0u, 0u}; }
        const float osc = isk ? 0.0625f : 1.f;
        LAS unsigned char* ldst = lds + (isk ? U1_KCL : U1_QCL) + (8 * tg) * U1_QP + c8 * 2;
        bf16* gdst = (isk ? B.KC : B.QC) + (rowb + 8 * tg) * 1024 + h * 256 + c8;
#pragma unroll
        for (int t8 = 0; t8 < 8; ++t8) {
            float o[8];
#pragma unroll
            for (int e = 0; e < 8; ++e) { float acc = bv[e];
#pragma unroll
                for (int tap = 0; tap < 4; ++tap) acc += wv[tap][e] * bfw(raw[t8 + tap][e >> 1], e & 1);
                o[e] = siluf_(acc) * osc; }
            const v4u w = (v4u){cvtpk(o[0], o[1]), cvtpk(o[2], o[3]), cvtpk(o[4], o[5]), cvtpk(o[6], o[7])};
            *(LAS v4u*)(ldst + t8 * U1_QP) = w; *(v4u*)(gdst + (size_t)t8 * 1024) = w;
        }
    }
    v4u vraw[4];
#pragma unroll
    for (int i = 0; i < 4; ++i) { const int ch = tid + 512 * i, row = ch >> 5, c16 = ch & 31; vraw[i] = *(const v4u*)(B.proj + (rowb + row) * NP + C_MV + h * 256 + c16 * 8);
        *(LAS v4u*)(lds + U1_VL + row * U1_VP + c16 * 16) = vraw[i]; }
    if (tid < 128) *(LAS v4u*)(lds + U1_VL + (tid >> 1) * U1_VP + 512 + (tid & 1) * 16) = (tid & 1) ? (v4u){0u, 0u, 0u, 0u} : (v4u){0x00003F80u, 0u, 0u, 0u};
    __syncthreads();
    const int fr = lane & 15, g = lane >> 4;
    {
        const int tt = wave & 3, st0 = 2 * (wave >> 2);
        f32x4_ sacc[2] = {{0.f, 0.f, 0.f, 0.f}, {0.f, 0.f, 0.f, 0.f}};
#pragma unroll
        for (int ks = 0; ks < 8; ++ks) {
            const bf16x8 bq = *(const LAS bf16x8*)(lds + U1_QCL + (16 * tt + fr) * U1_QP + (32 * ks + 8 * g) * 2);
#pragma unroll
            for (int i = 0; i < 2; ++i) { const bf16x8 ak = *(const LAS bf16x8*)(lds + U1_KCL + (16 * (st0 + i) + fr) * U1_QP + (32 * ks + 8 * g) * 2); sacc[i] = MFMA16(ak, bq, sacc[i]); }
        }
        const int t = 16 * tt + fr; const float c_t = sC[t];
#pragma unroll
        for (int i = 0; i < 2; ++i) { const int s0 = 16 * (st0 + i) + 4 * g; const f4 a4 = *(const LAS f4*)(sA + s0);
            float o[4];
#pragma unroll
            for (int r = 0; r < 4; ++r) o[r] = (s0 + r <= t) ? sacc[i][r] * __expf(a4[r] - c_t) : 0.f;
            u2v w; w.x = cvtpk(o[0], o[1]); w.y = cvtpk(o[2], o[3]);
            *(LAS u2v*)(lds + U1_SWL + t * U1_SP + s0 * 2) = w; }
    }
    __syncthreads();
    {
        const int nvt = (wave == 0) ? 3 : 2;
        for (int iv = 0; iv < nvt; ++iv) {
            const int vt = (iv == 2) ? 16 : 2 * wave + iv;
            f32x4_ ia[4] = {{0.f, 0.f, 0.f, 0.f}, {0.f, 0.f, 0.f, 0.f}, {0.f, 0.f, 0.f, 0.f}, {0.f, 0.f, 0.f, 0.f}};
#pragma unroll
            for (int ks = 0; ks < 2; ++ks) {
                const LAS unsigned char* va = lds + U1_VL + (32 * ks + 8 * g + ((lane & 15) >> 2)) * U1_VP + (16 * vt + 4 * (lane & 3)) * 2;
                const s16x4 lo = tr_read(va), hi = tr_read(va + 4 * U1_VP);
                const bf16x8 af = (bf16x8){lo[0], lo[1], lo[2], lo[3], hi[0], hi[1], hi[2], hi[3]};
#pragma unroll
                for (int tt = 0; tt < 4; ++tt) { const bf16x8 bs = *(const LAS bf16x8*)(lds + U1_SWL + (16 * tt + fr) * U1_SP + (32 * ks + 8 * g) * 2); ia[tt] = MFMA16(af, bs, ia[tt]); }
            }
#pragma unroll
            for (int tt = 0; tt < 4; ++tt) { const size_t row = rowb + 16 * tt + fr;
                if (vt < 16) { uint2 w; w.x = cvtpk(ia[tt][0], ia[tt][1]); w.y = cvtpk(ia[tt][2], ia[tt][3]); *(uint2*)(B.IB + row * 1024 + h * 256 + 16 * vt + 4 * g) = w; }
                else if (g == 0) B.rowsum[row * 4 + h] = ia[tt][0]; }
        }
    }
#pragma unroll
    for (int i = 0; i < 4; ++i) { const int ch = tid + 512 * i, row = ch >> 5, c16 = ch & 31; const float wk = sWk[row]; v4u w;
#pragma unroll
        for (int e = 0; e < 4; ++e) w[e] = cvtpk(bfw(vraw[i][e], 0) * wk, bfw(vraw[i][e], 1) * wk);
        *(v4u*)(B.proj + (rowb + row) * NP + C_MV + h * 256 + c16 * 8) = w; }
    { const int srow = tid >> 3, c = tid & 7; const unsigned w0 = (c == 0) ? (unsigned)f2bf(sWk[srow]) : 0u;
      *(v4u*)(B.vones + ((size_t)bh * S + 64 * j + srow) * 64 + c * 8) = (v4u){w0, 0u, 0u, 0u}; }
}

constexpr int W_QP = 528, W_KP = 544, W_VP = 144, W_QL = 0, W_KL = 64 * W_QP, W_VL = W_KL + 64 * W_KP, W_LDS = W_VL + 64 * W_VP;
constexpr int W2_STAGE = W_LDS, W2_WC = 2 * W2_STAGE, W2_LDS = W2_WC + 512;
__device__ __forceinline__ void w2_compute(f32x4_ (&Ct)[16], const LAS unsigned char* st, float w_c, const MlBufs& B, size_t row0, int h, int sl, int vq, int lane,
                                           const uint2 (&ibn)[4], const float (&win)[4], uint2 (&ibx)[4], float (&wix)[4], bool has_next) {
    const int fr = lane & 15, g = lane >> 4;
#pragma unroll
    for (int tt = 0; tt < 4; ++tt) { const size_t rown = row0 + (has_next ? 64 : 0) + 16 * tt + fr;
        wix[tt] = B.winter[rown * 4 + h];
        if (sl < 4) ibx[tt] = *(const uint2*)(B.IB + rown * 1024 + h * 256 + 64 * sl + 16 * vq + 4 * g); else { ibx[tt].x = __float_as_uint(B.rowsum[rown * 4 + h]); ibx[tt].y = 0u; } }
    f32x4_ ia[4] = {{0.f, 0.f, 0.f, 0.f}, {0.f, 0.f, 0.f, 0.f}, {0.f, 0.f, 0.f, 0.f}, {0.f, 0.f, 0.f, 0.f}};
    const LAS unsigned char* qbase = st + W_QL + fr * W_QP + (4 * g) * 2;
    u2v qlo[2][4], qhi[2][4];
#pragma unroll
    for (int tt = 0; tt < 4; ++tt) { qlo[0][tt] = *(const LAS u2v*)(qbase + 16 * tt * W_QP); qhi[0][tt] = *(const LAS u2v*)(qbase + 16 * tt * W_QP + 32); }
#pragma unroll
    for (int kk = 0; kk < 8; ++kk) {
        if (kk + 1 < 8) {
#pragma unroll
            for (int tt = 0; tt < 4; ++tt) { qlo[(kk + 1) & 1][tt] = *(const LAS u2v*)(qbase + 16 * tt * W_QP + 64 * (kk + 1)); qhi[(kk + 1) & 1][tt] = *(const LAS u2v*)(qbase + 16 * tt * W_QP + 64 * (kk + 1) + 32); }
        }
        const v4u cw = (v4u){cvtpk(Ct[2 * kk][0], Ct[2 * kk][1]), cvtpk(Ct[2 * kk][2], Ct[2 * kk][3]), cvtpk(Ct[2 * kk + 1][0], Ct[2 * kk + 1][1]), cvtpk(Ct[2 * kk + 1][2], Ct[2 * kk + 1][3])};
        __builtin_amdgcn_sched_barrier(0);
#pragma unroll
        for (int tt = 0; tt < 4; ++tt)
            ia[tt] = MFMA16(__builtin_bit_cast(bf16x8, cw), __builtin_bit_cast(bf16x8, ((v4u){qlo[kk & 1][tt].x, qlo[kk & 1][tt].y, qhi[kk & 1][tt].x, qhi[kk & 1][tt].y})), ia[tt]);
        __builtin_amdgcn_sched_barrier(0);
    }
#pragma unroll
    for (int tt = 0; tt < 4; ++tt) { const size_t row = row0 + 16 * tt + fr; const float wi = win[tt];
        if (sl < 4) { uint2 w; w.x = cvtpk(bfw(ibn[tt].x, 0) + wi * ia[tt][0], bfw(ibn[tt].x, 1) + wi * ia[tt][1]); w.y = cvtpk(bfw(ibn[tt].y, 0) + wi * ia[tt][2], bfw(ibn[tt].y, 1) + wi * ia[tt][3]);
            *(uint2*)(B.IB + row * 1024 + h * 256 + 64 * sl + 16 * vq + 4 * g) = w; }
        else if (vq == 0 && g == 0) B.rowsum[row * 4 + h] = __uint_as_float(ibn[tt].x) + wi * ia[tt][0]; }
#pragma unroll
    for (int kt = 0; kt < 16; ++kt) Ct[kt] *= w_c;
#pragma unroll
    for (int ks = 0; ks < 2; ++ks) {
        const LAS unsigned char* vb = st + W_VL + (32 * ks + 8 * g + ((lane & 15) >> 2)) * W_VP + (16 * vq + 4 * (lane & 3)) * 2;
        const s16x4 vlo = tr_read(vb), vhi = tr_read(vb + 4 * W_VP);
        const bf16x8 bvf = (bf16x8){vlo[0], vlo[1], vlo[2], vlo[3], vhi[0], vhi[1], vhi[2], vhi[3]};
        const LAS unsigned char* ka = st + W_KL + (32 * ks + 8 * g + ((lane & 15) >> 2)) * W_KP + (4 * (lane & 3)) * 2;
#pragma unroll
        for (int kt = 0; kt < 16; ++kt) { const s16x4 klo = tr_read(ka + kt * 32), khi = tr_read(ka + kt * 32 + 4 * W_KP);
            const bf16x8 akf = (bf16x8){klo[0], klo[1], klo[2], klo[3], khi[0], khi[1], khi[2], khi[3]};
            Ct[kt] = MFMA16(akf, bvf, Ct[kt]); }
    }
}
__device__ __forceinline__ void mlstm_worker2(LAS unsigned char* lds, const MlBufs& B, int b, int h, int sl, int tid, int lane, int wave) {
    const int bh = b * 4 + h; const size_t rowb = (size_t)b * S;
    const bf16* vsrc = (sl < 4) ? (B.proj + rowb * NP + C_MV + h * 256 + 64 * sl) : (B.vones + (size_t)bh * S * 64);
    const size_t vpitch = (sl < 4) ? (size_t)NP : (size_t)64;
    LAS float* wcL = (LAS float*)(lds + W2_WC);
    __syncthreads();
    if (tid < 128) wcL[tid] = B.wc[bh * 128 + tid];
    const bool loader = wave >= 4;
    const int lt = tid & 255;
    const bf16* qsrc = B.QC + (rowb + (lt >> 5)) * 1024 + h * 256 + (lt & 31) * 8;
    const bf16* ksrc = B.KC + (rowb + (lt >> 5)) * 1024 + h * 256 + (lt & 31) * 8;
    const bf16* vs2 = vsrc + (size_t)(lt >> 3) * vpitch + (lt & 7) * 8;
    const int qoff = W_QL + (lt >> 5) * W_QP + (lt & 31) * 16, koff = W_KL + (lt >> 5) * W_KP + (lt & 31) * 16, voff = W_VL + (lt >> 3) * W_VP + (lt & 7) * 16;
    v4u ra[18], rb[18];
#define L_GLOAD(R, jj) do { _Pragma("unroll") for (int i_ = 0; i_ < 8; ++i_) { R[i_] = *(const v4u*)(qsrc + (size_t)(64 * (jj) + 8 * i_) * 1024); R[8 + i_] = *(const v4u*)(ksrc + (size_t)(64 * (jj) + 8 * i_) * 1024); } \
        R[16] = *(const v4u*)(vs2 + (size_t)(64 * (jj)) * vpitch); R[17] = *(const v4u*)(vs2 + (size_t)(64 * (jj) + 32) * vpitch); } while (0)
#define L_WRITE(R, bufo) do { LAS unsigned char* s_ = lds + (bufo); _Pragma("unroll") for (int i_ = 0; i_ < 8; ++i_) { *(LAS v4u*)(s_ + qoff + 8 * i_ * W_QP) = R[i_]; *(LAS v4u*)(s_ + koff + 8 * i_ * W_KP) = R[8 + i_]; } \
        *(LAS v4u*)(s_ + voff) = R[16]; *(LAS v4u*)(s_ + voff + 32 * W_VP) = R[17]; } while (0)
    if (loader) {
        L_GLOAD(ra, 0); L_WRITE(ra, 0); L_GLOAD(ra, 1); L_GLOAD(rb, 2);
        __syncthreads();
        for (int j = 0; j < 128; j += 2) {
            L_WRITE(ra, W2_STAGE); { const int jn = (j + 3 < 128) ? j + 3 : 127; L_GLOAD(ra, jn); }
            __syncthreads();
            L_WRITE(rb, 0); { const int jn = (j + 4 < 128) ? j + 4 : 127; L_GLOAD(rb, jn); }
            __syncthreads();
        }
    } else {
        f32x4_ Ct[16];
#pragma unroll
        for (int kt = 0; kt < 16; ++kt) Ct[kt] = (f32x4_){0.f, 0.f, 0.f, 0.f};
        uint2 iba[4], ibb[4]; float wia[4], wib[4];
        { const int fr = lane & 15, g = lane >> 4;
#pragma unroll
          for (int tt = 0; tt < 4; ++tt) { const size_t r0 = rowb + 16 * tt + fr; wia[tt] = B.winter[r0 * 4 + h];
              if (sl < 4) iba[tt] = *(const uint2*)(B.IB + r0 * 1024 + h * 256 + 64 * sl + 16 * wave + 4 * g); else { iba[tt].x = __float_as_uint(B.rowsum[r0 * 4 + h]); iba[tt].y = 0u; } } }
        __syncthreads();
        for (int j = 0; j < 128; j += 2) {
            w2_compute(Ct, lds, wcL[j], B, rowb + 64 * j, h, sl, wave, lane, iba, wia, ibb, wib, true);
            __syncthreads();
            w2_compute(Ct, lds + W2_STAGE, wcL[j + 1], B, rowb + 64 * (j + 1), h, sl, wave, lane, ibb, wib, iba, wia, j + 2 < 128);
            __syncthreads();
        }
    }
#undef L_GLOAD
#undef L_WRITE
}
__device__ __forceinline__ void mlstm_post_item(const MlBufs& B, const float* __restrict__ mh_norm_g, size_t row, int h, int lane) {
    const uint2 iw = *(const uint2*)(B.IB + row * 1024 + h * 256 + lane * 4);
    const float dinv = 1.f / fmaxf(fabsf(B.rowsum[row * 4 + h]), __expf(-B.mcomb[row * 4 + h]));
    float hv[4];
    hv[0] = bfw(iw.x, 0) * dinv; hv[1] = bfw(iw.x, 1) * dinv; hv[2] = bfw(iw.y, 0) * dinv; hv[3] = bfw(iw.y, 1) * dinv;
    const float ss = wave_sum(hv[0] * hv[0] + hv[1] * hv[1] + hv[2] * hv[2] + hv[3] * hv[3]);
    const float r = 1.0f / sqrtf(ss * (1.f / 256.f) + EPS);
    const int c = h * 256 + lane * 4;
    bf16* gp = B.proj + row * NP + C_GZ + c;
    const uint2 gz = *(const uint2*)gp;
    const f4 gn = *(const f4*)(mh_norm_g + c);
    uint2 w;
    w.x = cvtpk(hv[0] * r * gn[0] * bfw(gz.x, 0), hv[1] * r * gn[1] * bfw(gz.x, 1));
    w.y = cvtpk(hv[2] * r * gn[2] * bfw(gz.y, 0), hv[3] * r * gn[3] * bfw(gz.y, 1));
    *(uint2*)gp = w;
}
__global__ void __launch_bounds__(NWAVES * 64, 2) mega(MArgs a) {
    extern __shared__ __attribute__((aligned(16))) unsigned char lds_raw[];
    LAS unsigned char* lds = (LAS unsigned char*)lds_raw;
    cg::grid_group grid = cg::this_grid();
    const int tid = threadIdx.x, lane = tid & 63, wave = __builtin_amdgcn_readfirstlane(tid >> 6);
    const int G = gridDim.x, gw = blockIdx.x * NWAVES + wave, NGW = G * NWAVES;
    const float* x = a.in[0]; const float* cvec = a.in[1]; const float* w_ada = a.in[2]; const float* b_ada = a.in[3]; const float* norm_g = a.in[4]; const float* w_in = a.in[5];
    const float* b_if = a.in[6]; const float* final_g = a.in[14]; const float* w_proj_m = a.in[11]; const float* w_proj_a = a.in[12]; const float* w_out = a.in[13];
    unsigned char* ws = a.ws; unsigned char* ob = (unsigned char*)a.out;
    bf16* proj = (bf16*)(ws + WS_PROJ); bf16* Wpm_t = (bf16*)(ws + WS_WPM); bf16* Wpa_t = (bf16*)(ws + WS_WPA); bf16* Wout_t = (bf16*)(ws + WS_WOUT);
    float* modp = (float*)(ws + WS_MODP); float* mod = (float*)(ws + WS_MOD); float* gates = (float*)(ws + WS_GATES); float* rowss = (float*)(ws + WS_ROWSS);
    bf16* merged = proj;
    bf16* H = (bf16*)(ob + OB_H); bf16* Win_t = (bf16*)(ob + OB_WIN);
    const int lo = a.ph_lo, hi = a.ph_hi;
    unsigned long long* tsb = (unsigned long long*)(ws + WS_TS); int nst = 0;
#define STAMP() do { if (PROBE_SLOT >= 0 && blockIdx.x == 0 && tid == 0) tsb[nst] = __builtin_amdgcn_s_memrealtime(); ++nst; } while (0)
    STAMP();
#define IN(k) (lo <= (k) && (k) < hi)
#define BOTH(k) (IN(k) && IN((k) + 1))

    if (IN(0)) {
        LAS float* scr = (LAS float*)(lds + wave * 16384);
        constexpr int I_ADA = 16 * 24, I_IN = (D / 64) * (NPW / 32), I_PM = (1024 / 64) * (D / 32), I_OUT = (D / 64) * (D / 32);
        constexpr int NITEMS = I_ADA + I_IN + 2 * I_PM + I_OUT;
        for (int it = gw; it < NITEMS; it += NGW) {
            int r = it;
            if (r < I_ADA) {
                const int ks = r / 24, cb = r % 24, n0 = cb * 256 + lane * 4;
                float4 a0 = {0.f, 0.f, 0.f, 0.f}, a1 = {0.f, 0.f, 0.f, 0.f};
                if (ks == 0) { a0 = *(const float4*)(b_ada + n0); a1 = a0; }
#pragma unroll 8
                for (int kk = 0; kk < 128; ++kk) { const int k = ks * 128 + kk; const float4 w = *(const float4*)(w_ada + (size_t)k * (3 * D) + n0);
                    const float c0 = cvec[k], c1 = cvec[D + k]; const float s0 = c0 / (1.f + __expf(-c0)), s1 = c1 / (1.f + __expf(-c1));
                    a0.x += s0 * w.x; a0.y += s0 * w.y; a0.z += s0 * w.z; a0.w += s0 * w.w; a1.x += s1 * w.x; a1.y += s1 * w.y; a1.z += s1 * w.z; a1.w += s1 * w.w; }
                *(float4*)(modp + (size_t)(ks * 2 + 0) * (3 * D) + n0) = a0; *(float4*)(modp + (size_t)(ks * 2 + 1) * (3 * D) + n0) = a1;
                continue; }
            r -= I_ADA;
            if (r < I_IN) { const int nblk = NPW / 32, kb = r / nblk, nb = r % nblk, nd = 32 * nb;
                int ns = nd; if (nd >= 5120) ns = nd + 8; else if (nd >= 3072) { const int t = (nd - 3072) >> 8, rr = (nd - 3072) & 255; ns = (rr < 128) ? 3072 + 128 * t + rr : 4096 + 128 * t + (rr - 128); }
                transpose_item(w_in, INC, ns, Win_t, D, nd, 64 * kb, scr, lane); continue; }
            r -= I_IN;
            if (r < I_PM) { const int nblk = D / 32, kb = r / nblk, nb = r % nblk; transpose_item(w_proj_m, D, 32 * nb, Wpm_t, 1024, 32 * nb, 64 * kb, scr, lane); continue; }
            r -= I_PM;
            if (r < I_PM) { const int nblk = D / 32, kb = r / nblk, nb = r % nblk; transpose_item(w_proj_a, D, 32 * nb, Wpa_t, 1024, 32 * nb, 64 * kb, scr, lane); continue; }
            r -= I_PM;
            { const int nblk = D / 32, kb = r / nblk, nb = r % nblk; transpose_item(w_out, D, 32 * nb, Wout_t, D, 32 * nb, 64 * kb, scr, lane); }
        }
        if (BOTH(0)) grid.sync(); STAMP();
    }

    if (IN(1)) {
        LAS float* smod = (LAS float*)lds;
        LAS float* gwl = (LAS float*)(lds + 49152);
        for (int i = tid; i < 2 * 3 * D; i += NWAVES * 64) { float s = 0.f;
#pragma unroll
            for (int ks = 0; ks < 16; ++ks) s += modp[(size_t)ks * (2 * 3 * D) + i];
            smod[i] = s; if (blockIdx.x == 0) mod[i] = s; }
        if (blockIdx.x == 0 && tid == 0) *(unsigned*)(ws + WS_QCTR) = 0u;
        for (int k = tid; k < D; k += NWAVES * 64) { const float4 w0 = *(const float4*)(w_in + (size_t)k * INC + 5120), w1 = *(const float4*)(w_in + (size_t)k * INC + 5124);
            gwl[0 * D + k] = w0.x; gwl[1 * D + k] = w0.y; gwl[2 * D + k] = w0.z; gwl[3 * D + k] = w0.w; gwl[4 * D + k] = w1.x; gwl[5 * D + k] = w1.y; gwl[6 * D + k] = w1.z; gwl[7 * D + k] = w1.w; }
        __syncthreads();
        for (int row = gw; row < M; row += NGW) {
            const int b = row / S;
            const float4* xr = (const float4*)(x + (size_t)row * D);
            float4 v[8]; float ss = 0.f;
#pragma unroll
            for (int j = 0; j < 8; ++j) { v[j] = xr[lane + 64 * j]; ss += v[j].x * v[j].x + v[j].y * v[j].y + v[j].z * v[j].z + v[j].w * v[j].w; }
            ss = wave_sum(ss);
            const float rstd = 1.0f / sqrtf(ss * (1.f / D) + EPS);
            float acc[8];
#pragma unroll
            for (int i = 0; i < 8; ++i) acc[i] = 0.f;
            const LAS float* shift = smod + b * 3 * D; const LAS float* scale = shift + D;
#pragma unroll
            for (int j = 0; j < 8; ++j) {
                const int k0 = (lane + 64 * j) * 4;
                const f4 g4 = *(const f4*)(norm_g + k0); const f4 sc4 = *(const LAS f4*)(scale + k0); const f4 sh4 = *(const LAS f4*)(shift + k0);
                float4 h4; h4.x = v[j].x * rstd * g4.x * (1.f + sc4.x) + sh4.x; h4.y = v[j].y * rstd * g4.y * (1.f + sc4.y) + sh4.y; h4.z = v[j].z * rstd * g4.z * (1.f + sc4.z) + sh4.z; h4.w = v[j].w * rstd * g4.w * (1.f + sc4.w) + sh4.w;
#pragma unroll
                for (int i = 0; i < 8; ++i) { const f4 w4 = *(const LAS f4*)(gwl + i * D + k0); acc[i] += h4.x * w4.x + h4.y * w4.y + h4.z * w4.z + h4.w * w4.w; }
                uint2 o; o.x = pk2(h4.x, h4.y); o.y = pk2(h4.z, h4.w);
                *(uint2*)(H + (size_t)row * D + k0) = o;
                asm volatile("" ::: "memory");
            }
#pragma unroll
            for (int i = 0; i < 8; ++i) acc[i] = wave_sum(acc[i]);
            if (lane == 0) {
                rowss[row] = 0.f;
#pragma unroll
                for (int i = 0; i < 4; ++i) gates[(size_t)row * 8 + i] = acc[i] + b_if[i];
#pragma unroll
                for (int i = 4; i < 8; ++i) { const float z = acc[i] + b_if[i]; gates[(size_t)row * 8 + i] = fminf(z, 0.f) - log1pf(expf(-fabsf(z))); }
            }
        }
        __syncthreads();
        if (BOTH(1)) grid.sync(); STAMP();
    }

    constexpr int NWORK = 40, SKIP_ROUNDS = 11;
    if (IN(2)) {
        if (gw < 1024) mlstm_summary(gates, (float*)(ws + WS_SUMM), gw >> 7, gw & 127, lane);
        pg8::Gemm g{H, H, Win_t, Win_t, D, D}; pg8::StaticOrder So; So.init(M, 12 * 256, G, (int)blockIdx.x);
        pg8::EpiProj E{proj, NP};
        pg8::gemm_phase<pg8::EpiProj, pg8::StaticOrder, true, true>(lds, g, So, E);
        if (BOTH(2)) { grid.sync(); STAMP(); }
    }
    if (IN(3)) {
        MlBufs mb; mb.proj = proj; mb.gates = gates; mb.summ = (const float*)(ws + WS_SUMM); mb.conv_w = a.in[7]; mb.conv_b = a.in[8];
        mb.QC = (bf16*)(ws + WS_QC); mb.KC = (bf16*)(ws + WS_KC); mb.IB = (bf16*)(ws + WS_IB);
        mb.rowsum = (float*)(ws + WS_RSUM); mb.winter = (float*)(ws + WS_WINT); mb.mcomb = (float*)(ws + WS_MCOMB); mb.wc = (float*)(ws + WS_WC); mb.vones = (bf16*)(ws + WS_VONES);
        for (int u = blockIdx.x; u < 1024; u += G) mlstm_u1_unit(lds, mb, u >> 9, (u >> 7) & 3, u & 127, tid, lane, wave);
        grid.sync(); STAMP();
        if (blockIdx.x < NWORK) mlstm_worker2(lds, mb, (blockIdx.x & 7) >> 2, blockIdx.x & 3, blockIdx.x >> 3, tid, lane, wave);
        {
            pg8::Gemm g{H, H, Win_t, Win_t, D, D}; pg8::RestOrder So; So.base.init(M, 40 * 256, G, (int)blockIdx.x); So.nwork = NWORK; So.R = SKIP_ROUNDS; So.pn0 = 12;
            pg8::EpiProj E{proj, NP};
            pg8::gemm_phase<pg8::EpiProj, pg8::RestOrder, true, true>(lds, g, So, E);
        }
        grid.sync(); STAMP();
        for (int it = gw; it < M * 4; it += NGW) mlstm_post_item(mb, a.in[9], (size_t)(it >> 2), it & 3, lane);
        {
            unsigned* qctr = (unsigned*)(ws + WS_QCTR); volatile LAS unsigned* qslot = (volatile LAS unsigned*)(lds + 163000);
            for (;;) {
                __syncthreads();
                if (tid == 0) *qslot = atomicAdd(qctr, 1u);
                __syncthreads();
                const unsigned q = *qslot;
                if (q >= 512u) break;
                const int u = 511 - (int)q;
                attn_unit(lds, proj, a.in[10], (u & 15) >> 3, u & 7, u >> 4, tid, lane, wave);
            }
        }
        if (BOTH(3)) { grid.sync(); STAMP(); }
    }
    if (IN(4)) {
        pg8::Gemm g{proj + C_GZ, proj + C_AQ, Wpm_t, Wpa_t, NP, 1024}; pg8::SegOrder So; So.base.init(M, D, G, (int)blockIdx.x);
        pg8::EpiMerge E{proj, NP, C_GM, C_GA, merged, NP};
        pg8::gemm_phase<pg8::EpiMerge, pg8::SegOrder, true, true>(lds, g, So, E);
        if (BOTH(4)) grid.sync(); STAMP();
    }
    if (IN(5)) {
        pg8::Gemm g{merged, merged, Wout_t, Wout_t, NP, D}; pg8::StaticOrder So; So.init(M, D, G, (int)blockIdx.x);
        pg8::EpiOut E{x, mod + 2 * D, a.out, rowss, D, S, 3 * D};
        pg8::gemm_phase<pg8::EpiOut, pg8::StaticOrder, true, true>(lds, g, So, E);
        if (BOTH(5)) grid.sync(); STAMP();
    }
    if (IN(6)) {
        for (int row = gw; row < M; row += NGW) {
            const float r = 1.0f / sqrtf(rowss[row] * (1.f / D) + EPS);
            f4* xr = (f4*)(a.out + (size_t)row * D);
#pragma unroll
            for (int j = 0; j < 8; ++j) { const f4 g4 = *(const f4*)(final_g + (lane + 64 * j) * 4); xr[lane + 64 * j] = xr[lane + 64 * j] * r * g4; }
        }
    }
    if (PROBE_SLOT >= 0) {
        STAMP(); grid.sync();
        const float e = (float)(((tsb[PROBE_SLOT + 1] - tsb[PROBE_SLOT]) / PROBE_QUANT) * PROBE_QUANT) * 1e-6f;
        for (int row = gw; row < M; row += NGW) { f4* xr = (f4*)(a.out + (size_t)row * D);
#pragma unroll
            for (int j = 0; j < 8; ++j) xr[lane + 64 * j] = xr[lane + 64 * j] + e; }
    }
#undef IN
#undef BOTH
}

static int launch_mega(const MArgs& a, hipStream_t stream) {
    static int grid = 0;
    if (grid == 0) {
        int dev = 0, cus = 0, per_cu = 0;
        if (hipGetDevice(&dev) != hipSuccess || hipDeviceGetAttribute(&cus, hipDeviceAttributeMultiprocessorCount, dev) != hipSuccess) { fprintf(stderr, "kernel_launch: device query failed\n"); grid = -1; return -1; }
        if (hipFuncSetAttribute((const void*)mega, hipFuncAttributeMaxDynamicSharedMemorySize, LDS_BYTES) != hipSuccess) { fprintf(stderr, "kernel_launch: hipFuncSetAttribute failed\n"); grid = -1; return -1; }
        if (hipOccupancyMaxActiveBlocksPerMultiprocessor(&per_cu, (const void*)mega, NWAVES * 64, LDS_BYTES) != hipSuccess || per_cu < 1) { fprintf(stderr, "kernel_launch: occupancy query says %d blocks/CU\n", per_cu); (void)hipGetLastError(); grid = -1; return -1; }
        grid = cus * (per_cu > 1 ? 1 : per_cu);
        fprintf(stderr, "kernel_launch: %d CUs, occupancy %d blocks/CU, grid %d\n", cus, per_cu, grid);
    }
    if (grid < 0) return -1;
    MArgs arg = a; void* args[] = {(void*)&arg};
    const hipError_t e = hipLaunchCooperativeKernel((const void*)mega, dim3(grid), dim3(NWAVES * 64), args, LDS_BYTES, stream);
    if (e != hipSuccess) { fprintf(stderr, "kernel_launch: cooperative launch failed: %s (grid %d)\n", hipGetErrorString(e), grid); return -1; }
    return 0;
}

extern "C" void kernel_launch(void* const* d_in, const int* in_sizes, int n_in, void* d_out, int out_size, void* d_ws, size_t ws_size, hipStream_t stream) {
    if (n_in != 15 || in_sizes[0] != M * D || out_size != M * D || ws_size < WS_END) { fprintf(stderr, "kernel_launch: unexpected shapes / workspace (%zu < %zu)\n", ws_size, (size_t)WS_END); return; }
    MArgs a{}; for (int i = 0; i < 15; ++i) a.in[i] = (const float*)d_in[i]; a.out = (float*)d_out; a.ws = (unsigned char*)d_ws; a.ph_lo = 0; a.ph_hi = 7;
    launch_mega(a, stream);
}
```

```cpp
#include <hip/hip_runtime.h>
#include <cstdio>
#include <cstdint>
#include <hip/hip_cooperative_groups.h>
namespace cg = cooperative_groups;

typedef unsigned short bf16;
constexpr int D = 2048, NB = 2, S = 8192, M = NB * S;
constexpr int INC = 13320, NPW = 13312, NP = 12288 + 64;
constexpr int C_MQ = 0, C_MK = 1024, C_MV = 2048, C_GZ = 3072, C_AQ = 4096, C_AK = 5120, C_AV = 6144, C_AZ = 7168, C_GM = 8192, C_GA = 10240;
constexpr float EPS = 1e-6f;

__device__ __forceinline__ bf16 f2bf(float f) { unsigned u = __builtin_bit_cast(unsigned, f); return (bf16)((u + 0x7fffu + ((u >> 16) & 1u)) >> 16); }
__device__ __forceinline__ float bf2f(bf16 h) { return __builtin_bit_cast(float, (unsigned)h << 16); }
__device__ __forceinline__ float wave_sum(float v) {
#pragma unroll
    for (int o = 1; o < 64; o <<= 1) v += __shfl_xor(v, o);
    return v;
}
__device__ __forceinline__ float wave_max(float v) {
#pragma unroll
    for (int o = 1; o < 64; o <<= 1) v = fmaxf(v, __shfl_xor(v, o));
    return v;
}
__device__ __forceinline__ float sigmoidf_(float x) { return 1.f / (1.f + __expf(-x)); }
__device__ __forceinline__ float siluf_(float x) { return x / (1.f + __expf(-x)); }

namespace pg8 {
#define PG8_LAS __attribute__((address_space(3)))
typedef unsigned short bf16_t;
typedef short bf16x8 __attribute__((ext_vector_type(8)));
typedef float f32x4 __attribute__((ext_vector_type(4)));
typedef unsigned u32x4 __attribute__((ext_vector_type(4)));
constexpr int BM = 256, BK = 64, HALF = 128, HTB = HALF * BK * 2  , STAGE_BYTES = 8 * HTB, NXCD = 8, WGM = 8;

__host__ __device__ __forceinline__ int lds_byte(int r, int c) { const int st = (r >> 4) * 2 + (c >> 5), rr = r & 15, cc = c & 31, ob = rr * 64 + cc * 2; return st * 1024 + (ob ^ (((ob >> 9) & 1) << 5)); }
__host__ __device__ __forceinline__ void stage_rc(int b, int& R, int& C) { const int st = b / 1024, sb = b % 1024, swz = sb ^ (((sb >> 9) & 1) << 5); R = (st >> 1) * 16 + swz / 64; C = (st & 1) * 32 + (swz % 64) / 2; }
__host__ __device__ __forceinline__ int perm32(int rho) { const int n = rho >> 4, i = rho & 15; return 8 * (i >> 2) + 4 * n + (i & 3); }

struct Unit { int pm, pn, seg; };
struct Gemm { const bf16_t* A0; const bf16_t* A1; const bf16_t* B0; const bf16_t* B1; int lda, K; };

struct StaticOrder {
    int nM, nN, nwg, G, c;
    __host__ __device__ void init(int M, int N, int G_, int c_) { nM = M / BM; nN = N / BM; nwg = nM * nN; G = G_; c = c_; }
    __host__ __device__ bool next(int i, Unit& u) const { return map((long)i * G + c, u); }
    __host__ __device__ bool map(long L, Unit& u) const {
        if (L >= nwg) return false;
        int wgid = (int)L; { const int q = nwg / NXCD, r = nwg % NXCD, xcd = wgid % NXCD, off = wgid / NXCD; wgid = (xcd < r ? xcd * (q + 1) : r * (q + 1) + (xcd - r) * q) + off; }
        const int nig = WGM * nN, gid = wgid / nig, fm = gid * WGM, gsz = (nM - fm) < WGM ? (nM - fm) : WGM;
        u.pm = fm + ((wgid % nig) % gsz); u.pn = (wgid % nig) / gsz; u.seg = 0; return true;
    }
    __device__ __forceinline__ void a_ready(const Unit&) const {}
    __device__ __forceinline__ void done(const Unit&) const {}
};

__device__ __forceinline__ unsigned cvt_pk_bf16(float lo, float hi) { unsigned r; asm volatile("v_cvt_pk_bf16_f32 %0, %1, %2" : "=v"(r) : "v"(lo), "v"(hi)); return r; }
typedef float f32x2 __attribute__((ext_vector_type(2)));
template <class Epi, class Sched, bool ALIGN_EPI = false, bool SP2 = false>
__device__ __forceinline__ void gemm_phase(PG8_LAS unsigned char* lds, const Gemm g, const Sched& S, const Epi& E) {
    const int tid = threadIdx.x, wid = __builtin_amdgcn_readfirstlane(tid >> 6), lane = tid & 63, wr = wid >> 2, wc = wid & 3, fr = lane & 15, fq = lane >> 4;
    const int K = g.K, nt = K / BK;
    unsigned voffA[2], voffB[2];
#pragma unroll
    for (int i = 0; i < 2; ++i) { int R, C; stage_rc(tid * 16 + i * 8192, R, C); const int Rb = Epi::PERM ? ((R & ~31) + perm32(R & 31)) : R;
        voffA[i] = (unsigned)(R * g.lda + C) * 2u; voffB[i] = (unsigned)(Rb * K + C) * 2u; }
    const size_t kstep = (size_t)(BK * 2);
    const size_t hstepA = (size_t)HALF * g.lda * 2, hstepB = (size_t)HALF * K * 2;
    const size_t tstepA = 2 * hstepA, tstepB = 2 * hstepB;
    const unsigned ldsw = (unsigned)wid * 1024u;
    const int aoff = lds_byte(wr * 64 + fr, fq * 8), boff = lds_byte(wc * 32 + fr, fq * 8);
#define PG8_SA(b, h) (((b) * 2 + (h)) * HTB)
#define PG8_SB(b, h) ((4 + (b) * 2 + (h)) * HTB)
#define PG8_STAGE(bufoff, gbase, voff) do { _Pragma("unroll") for (int _i = 0; _i < 2; ++_i) \
        __builtin_amdgcn_global_load_lds((const unsigned*)((const char*)(gbase) + (voff)[_i]), (PG8_LAS unsigned*)(lds + (bufoff) + ldsw + _i * 8192), 16, 0, 0); } while (0)
#define PG8_LDA(dst, b, h) do { _Pragma("unroll") for (int m = 0; m < 4; ++m) _Pragma("unroll") for (int k = 0; k < 2; ++k) dst[m][k] = *(const PG8_LAS bf16x8*)(lds + PG8_SA(b, h) + aoff + m * 2048 + k * 1024); } while (0)
#define PG8_LDB(dst, b, h) do { _Pragma("unroll") for (int n = 0; n < 2; ++n) _Pragma("unroll") for (int k = 0; k < 2; ++k) dst[n][k] = *(const PG8_LAS bf16x8*)(lds + PG8_SB(b, h) + boff + n * 2048 + k * 1024); } while (0)
#define PG8_MMA(ai, bj, At, Bt) do { __builtin_amdgcn_s_setprio(1); _Pragma("unroll") for (int m = 0; m < 4; ++m) _Pragma("unroll") for (int n = 0; n < 2; ++n) _Pragma("unroll") for (int k = 0; k < 2; ++k) \
        acc[ai][bj][m][n] = __builtin_amdgcn_mfma_f32_16x16x32_bf16(Bt[n][k], At[m][k], acc[ai][bj][m][n], 0, 0, 0); __builtin_amdgcn_s_setprio(0); } while (0)
#define PG8_WAIT_V(n) asm volatile("s_waitcnt vmcnt(" #n ")" ::: "memory")
#define PG8_WAIT_L(n) asm volatile("s_waitcnt lgkmcnt(" #n ")" ::: "memory")
#define PG8_BAR __builtin_amdgcn_s_barrier()
#define PG8_SCHED __builtin_amdgcn_sched_barrier(0)
    Unit cur, nxt; int ui = 0;
    if (!S.next(0, cur)) return;
    f32x4 acc[2][2][4][2];
#pragma unroll
    for (int a = 0; a < 2; ++a)
#pragma unroll
        for (int b = 0; b < 2; ++b)
#pragma unroll
            for (int m = 0; m < 4; ++m)
#pragma unroll
                for (int n = 0; n < 2; ++n) acc[a][b][m][n] = (f32x4){0.f, 0.f, 0.f, 0.f};
    bf16x8 At[4][2], B0[2][2], B1[2][2];
    const char* cA = (const char*)(cur.seg ? g.A1 : g.A0) + (size_t)cur.pm * tstepA; const char* cB = (const char*)(cur.seg ? g.B1 : g.B0) + (size_t)cur.pn * tstepB;
    S.a_ready(cur);
    if constexpr (SP2) {
        PG8_STAGE(PG8_SB(0, 0), cB, voffB); PG8_STAGE(PG8_SB(0, 1), cB + hstepB, voffB); PG8_STAGE(PG8_SA(0, 0), cA, voffA); PG8_STAGE(PG8_SA(0, 1), cA + hstepA, voffA);
        if (wr == 1) PG8_BAR;
        PG8_WAIT_V(2); PG8_BAR;
        PG8_STAGE(PG8_SB(1, 0), cB + kstep, voffB); PG8_STAGE(PG8_SA(1, 0), cA + kstep, voffA); PG8_STAGE(PG8_SB(1, 1), cB + hstepB + kstep, voffB);
        PG8_WAIT_V(6); PG8_BAR;
    } else {
        PG8_STAGE(PG8_SB(0, 0), cB, voffB); PG8_STAGE(PG8_SA(0, 0), cA, voffA); PG8_STAGE(PG8_SB(0, 1), cB + hstepB, voffB); PG8_STAGE(PG8_SA(0, 1), cA + hstepA, voffA);
        if (wr == 1) PG8_BAR;
        PG8_WAIT_V(4); PG8_BAR;
        PG8_STAGE(PG8_SB(1, 0), cB + kstep, voffB); PG8_STAGE(PG8_SA(1, 0), cA + kstep, voffA); PG8_STAGE(PG8_SB(1, 1), cB + hstepB + kstep, voffB);
        PG8_WAIT_V(6); PG8_BAR;
    }
    for (;;) {
        const bool has_next = S.next(ui + 1, nxt);
        const char* nA = has_next ? (const char*)(nxt.seg ? g.A1 : g.A0) + (size_t)nxt.pm * tstepA : cA; const char* nB = has_next ? (const char*)(nxt.seg ? g.B1 : g.B0) + (size_t)nxt.pn * tstepB : cB;
        for (int t = 0; t < nt; t += 2) {
            const bool last = (t == nt - 2);
            const char* a1 = cA + (size_t)(t + 1) * kstep;
            const char* a2 = last ? nA : cA + (size_t)(t + 2) * kstep; const char* b2 = last ? nB : cB + (size_t)(t + 2) * kstep;
            const char* a3 = a2 + kstep; const char* b3 = b2 + kstep;
            if (last && has_next) S.a_ready(nxt);
            if constexpr (SP2) {
            PG8_LDB(B0, 0, 0); PG8_LDB(B1, 0, 1); PG8_SCHED; PG8_LDA(At, 0, 0); PG8_STAGE(PG8_SA(1, 1), a1 + hstepA, voffA);
            PG8_WAIT_V(8); PG8_WAIT_L(0); PG8_BAR; PG8_MMA(0, 0, At, B0); PG8_MMA(0, 1, At, B1); PG8_BAR; PG8_SCHED;
            PG8_LDA(At, 0, 1); PG8_STAGE(PG8_SB(0, 0), b2, voffB); PG8_STAGE(PG8_SB(0, 1), b2 + hstepB, voffB); PG8_STAGE(PG8_SA(0, 0), a2, voffA);
            PG8_WAIT_V(8); PG8_WAIT_L(0); PG8_BAR; PG8_MMA(1, 0, At, B0); PG8_MMA(1, 1, At, B1); PG8_BAR; PG8_SCHED;
            PG8_LDB(B0, 1, 0); PG8_LDB(B1, 1, 1); PG8_SCHED; PG8_LDA(At, 1, 0); PG8_STAGE(PG8_SA(0, 1), a2 + hstepA, voffA);
            PG8_WAIT_V(8); PG8_WAIT_L(0); PG8_BAR; PG8_MMA(0, 0, At, B0); PG8_MMA(0, 1, At, B1); PG8_BAR; PG8_SCHED;
            PG8_LDA(At, 1, 1); PG8_STAGE(PG8_SB(1, 0), b3, voffB); PG8_STAGE(PG8_SB(1, 1), b3 + hstepB, voffB); PG8_STAGE(PG8_SA(1, 0), a3, voffA);
            PG8_WAIT_V(8); PG8_WAIT_L(0); PG8_BAR; PG8_MMA(1, 0, At, B0); PG8_MMA(1, 1, At, B1); PG8_BAR; PG8_SCHED;
            } else {
            PG8_LDB(B0, 0, 0); PG8_SCHED; PG8_LDA(At, 0, 0); PG8_STAGE(PG8_SA(1, 1), a1 + hstepA, voffA);
            PG8_WAIT_L(8); PG8_BAR; PG8_WAIT_L(0); PG8_MMA(0, 0, At, B0); PG8_BAR; PG8_SCHED;
            PG8_LDB(B1, 0, 1); PG8_STAGE(PG8_SB(0, 0), b2, voffB);
            PG8_BAR; PG8_WAIT_L(0); PG8_MMA(0, 1, At, B1); PG8_BAR;
            PG8_LDA(At, 0, 1); PG8_STAGE(PG8_SA(0, 0), a2, voffA);
            PG8_BAR; PG8_WAIT_L(0); PG8_MMA(1, 0, At, B0); PG8_BAR; PG8_SCHED;
            PG8_STAGE(PG8_SB(0, 1), b2 + hstepB, voffB);
            PG8_WAIT_V(6); PG8_BAR; PG8_MMA(1, 1, At, B1); PG8_BAR;
            PG8_LDB(B0, 1, 0); PG8_SCHED; PG8_LDA(At, 1, 0); PG8_STAGE(PG8_SA(0, 1), a2 + hstepA, voffA);
            PG8_WAIT_L(8); PG8_BAR; PG8_WAIT_L(0); PG8_MMA(0, 0, At, B0); PG8_BAR; PG8_SCHED;
            PG8_LDB(B1, 1, 1); PG8_STAGE(PG8_SB(1, 0), b3, voffB);
            PG8_BAR; PG8_WAIT_L(0); PG8_MMA(0, 1, At, B1); PG8_BAR;
            PG8_LDA(At, 1, 1); PG8_STAGE(PG8_SA(1, 0), a3, voffA);
            PG8_BAR; PG8_WAIT_L(0); PG8_MMA(1, 0, At, B0); PG8_BAR; PG8_SCHED;
            PG8_STAGE(PG8_SB(1, 1), b3 + hstepB, voffB);
            PG8_WAIT_V(6); PG8_BAR; PG8_MMA(1, 1, At, B1); PG8_BAR;
            }
        }
        if constexpr (ALIGN_EPI) { if (wr == 0) PG8_BAR; }
        if constexpr (!Epi::AFTER_DRAIN) { E(acc, cur, wr, wc, fr, fq); S.done(cur); }
        if (!has_next) break;
        if (E.zero_after(cur)) {
#pragma unroll
        for (int a = 0; a < 2; ++a)
#pragma unroll
            for (int b = 0; b < 2; ++b)
#pragma unroll
                for (int m = 0; m < 4; ++m)
#pragma unroll
                    for (int n = 0; n < 2; ++n) acc[a][b][m][n] = (f32x4){0.f, 0.f, 0.f, 0.f};
        }
        cur = nxt; cA = nA; cB = nB; ++ui;
        if constexpr (ALIGN_EPI) { if (wr == 1) PG8_BAR; }
    }
    PG8_WAIT_V(0);
    if constexpr (!ALIGN_EPI) { if (wr == 0) PG8_BAR; }
    PG8_BAR;
    if constexpr (Epi::AFTER_DRAIN) { E.fused(acc, cur, wr, wc, fr, fq, lds, wid, lane); S.done(cur); }
#undef PG8_SA
#undef PG8_SB
#undef PG8_STAGE
#undef PG8_LDA
#undef PG8_LDB
#undef PG8_MMA
#undef PG8_WAIT_V
#undef PG8_WAIT_L
#undef PG8_BAR
#undef PG8_SCHED
}
}

namespace pg8 {
typedef unsigned u32x4_ __attribute__((ext_vector_type(4)));
struct EpiProj {
    static constexpr bool PERM = true, AFTER_DRAIN = false;
    bf16_t* O; int ldc;
    __device__ __forceinline__ bool zero_after(const Unit&) const { return true; }
    __device__ __forceinline__ void operator()(f32x4 (&acc)[2][2][4][2], const Unit& u, int wr, int wc, int fr, int fq) const {
        const int row0 = u.pm * BM + wr * 64 + fr;
        if (u.pn >= 12 && u.pn < 20) {
            const int col0 = 3072 + 128 * (u.pn - 12) + wc * 32 + 8 * fq;
#pragma unroll
            for (int ai = 0; ai < 2; ++ai)
#pragma unroll
                for (int m = 0; m < 4; ++m) { float o[8];
#pragma unroll
                    for (int e = 0; e < 8; ++e) { const float mo = acc[ai][0][m][e >> 2][e & 3], mz = acc[ai][1][m][e >> 2][e & 3];
                        o[e] = mz * __builtin_amdgcn_rcpf((1.f + __expf(-mo)) * (1.f + __expf(-mz))); }
                    u32x4 w; w.x = cvt_pk_bf16(o[0], o[1]); w.y = cvt_pk_bf16(o[2], o[3]); w.z = cvt_pk_bf16(o[4], o[5]); w.w = cvt_pk_bf16(o[6], o[7]);
                    *(u32x4*)(O + (size_t)(row0 + ai * HALF + m * 16) * ldc + col0) = w; }
        } else if (u.pn >= 36) {
            const int col0 = 128 * (u.pn - 36) + wc * 32 + 8 * fq;
#pragma unroll
            for (int ai = 0; ai < 2; ++ai)
#pragma unroll
                for (int m = 0; m < 4; ++m) { float r[8], sa[8];
#pragma unroll
                    for (int e = 0; e < 8; ++e) { const float gm = acc[ai][0][m][e >> 2][e & 3], ga = acc[ai][1][m][e >> 2][e & 3]; const float ea = 1.f + __expf(-ga);
                        sa[e] = __builtin_amdgcn_rcpf(ea); r[e] = ea * __builtin_amdgcn_rcpf(1.f + __expf(-gm)); }
                    bf16_t* rowp = O + (size_t)(row0 + ai * HALF + m * 16) * ldc + col0;
                    u32x4 w; w.x = cvt_pk_bf16(r[0], r[1]); w.y = cvt_pk_bf16(r[2], r[3]); w.z = cvt_pk_bf16(r[4], r[5]); w.w = cvt_pk_bf16(r[6], r[7]);
                    *(u32x4*)(rowp + 8192) = w;
                    w.x = cvt_pk_bf16(sa[0], sa[1]); w.y = cvt_pk_bf16(sa[2], sa[3]); w.z = cvt_pk_bf16(sa[4], sa[5]); w.w = cvt_pk_bf16(sa[6], sa[7]);
                    *(u32x4*)(rowp + 10240) = w; }
        } else {
            const int col0 = (u.pn < 12 ? u.pn * BM : 4096 + (u.pn - 20) * BM) + wc * 32 + 8 * fq;
#pragma unroll
            for (int ai = 0; ai < 2; ++ai)
#pragma unroll
                for (int m = 0; m < 4; ++m) { bf16_t* rowp = O + (size_t)(row0 + ai * HALF + m * 16) * ldc + col0;
#pragma unroll
                    for (int bj = 0; bj < 2; ++bj) { const f32x4 v0 = acc[ai][bj][m][0], v1 = acc[ai][bj][m][1];
                        u32x4 w; w.x = cvt_pk_bf16(v0[0], v0[1]); w.y = cvt_pk_bf16(v0[2], v0[3]); w.z = cvt_pk_bf16(v1[0], v1[1]); w.w = cvt_pk_bf16(v1[2], v1[3]);
                        *(u32x4*)(rowp + bj * HALF) = w; } }
        }
    }
};
struct RestOrder {
    StaticOrder base; int nwork, R, pn0;
    __device__ __forceinline__ bool next(int i, Unit& u) const {
        const int G = base.G, c = base.c, nn = G - nwork; long L;
        if (c < nwork) L = (long)R * nn + (long)i * G + c;
        else L = (i < R) ? (long)i * nn + (c - nwork) : (long)R * nn + (long)(i - R) * G + c;
        if (!base.map(L, u)) return false;
        u.pn += pn0; return true;
    }
    __device__ __forceinline__ void a_ready(const Unit&) const {}
    __device__ __forceinline__ void done(const Unit&) const {}
};
struct SegOrder {
    StaticOrder base;
    __device__ __forceinline__ bool next(int i, Unit& u) const { if (!base.next(i >> 1, u)) return false; u.seg = i & 1; return true; }
    __device__ __forceinline__ void a_ready(const Unit&) const {}
    __device__ __forceinline__ void done(const Unit&) const {}
};
__device__ __forceinline__ float bfw(unsigned w, int half) { return __builtin_bit_cast(float, half ? (w & 0xffff0000u) : (w << 16)); }
struct EpiMerge {
    static constexpr bool PERM = true, AFTER_DRAIN = false;
    const bf16_t* proj; int ldp, cgm, cga; bf16_t* O; int ldo;
    __device__ __forceinline__ bool zero_after(const Unit& u) const { return u.seg != 0; }
    __device__ __forceinline__ void operator()(f32x4 (&acc)[2][2][4][2], const Unit& u, int wr, int wc, int fr, int fq) const {
        const int row0 = u.pm * BM + wr * 64 + fr, col0 = u.pn * BM + wc * 32 + 8 * fq;
        const bf16_t* gp = proj + (u.seg == 0 ? cgm : cga) + col0;
#pragma unroll
        for (int ai = 0; ai < 2; ++ai) {
            u32x4 gv[4][2];
#pragma unroll
            for (int m = 0; m < 4; ++m)
#pragma unroll
                for (int bj = 0; bj < 2; ++bj) gv[m][bj] = *(const u32x4*)(gp + (size_t)(row0 + ai * HALF + m * 16) * ldp + bj * HALF);
#pragma unroll
            for (int m = 0; m < 4; ++m) { const size_t row = (size_t)(row0 + ai * HALF + m * 16);
#pragma unroll
                for (int bj = 0; bj < 2; ++bj) {
                    if (u.seg == 0) {
#pragma unroll
                        for (int e = 0; e < 8; ++e) acc[ai][bj][m][e >> 2][e & 3] *= bfw(gv[m][bj][e >> 1], e & 1);
                    } else {
                        float o[8];
#pragma unroll
                        for (int e = 0; e < 8; ++e) o[e] = acc[ai][bj][m][e >> 2][e & 3] * bfw(gv[m][bj][e >> 1], e & 1);
                        u32x4 w; w.x = cvt_pk_bf16(o[0], o[1]); w.y = cvt_pk_bf16(o[2], o[3]); w.z = cvt_pk_bf16(o[4], o[5]); w.w = cvt_pk_bf16(o[6], o[7]);
                        *(u32x4*)(O + row * ldo + col0 + bj * HALF) = w;
                    }
                } }
            asm volatile("" ::: "memory");
        }
    }
};
struct EpiOut {
    static constexpr bool PERM = false, AFTER_DRAIN = false;
    const float* x; const float* gate; float* out; float* rowss; int ldc, rows_per_batch, gate_stride;
    __device__ __forceinline__ bool zero_after(const Unit&) const { return true; }
    __device__ __forceinline__ void operator()(f32x4 (&acc)[2][2][4][2], const Unit& u, int wr, int wc, int fr, int fq) const {
        const int row0 = u.pm * BM + wr * 64 + fr, col0 = u.pn * BM + wc * 32 + 4 * fq;
        const float* gp = gate + (size_t)((u.pm * BM) / rows_per_batch) * gate_stride + col0;
        f32x4 gt[2][2];
#pragma unroll
        for (int bj = 0; bj < 2; ++bj)
#pragma unroll
            for (int n = 0; n < 2; ++n) gt[bj][n] = *(const f32x4*)(gp + bj * HALF + n * 16);
#pragma unroll
        for (int ai = 0; ai < 2; ++ai)
#pragma unroll
            for (int m = 0; m < 4; ++m) { const int row = row0 + ai * HALF + m * 16; const size_t off = (size_t)row * ldc + col0; float ssq = 0.f;
#pragma unroll
                for (int bj = 0; bj < 2; ++bj)
#pragma unroll
                    for (int n = 0; n < 2; ++n) { const f32x4 xv = *(const f32x4*)(x + off + bj * HALF + n * 16); const f32x4 o = xv + gt[bj][n] * acc[ai][bj][m][n];
                        ssq += (o[0] * o[0] + o[1] * o[1]) + (o[2] * o[2] + o[3] * o[3]); *(f32x4*)(out + off + bj * HALF + n * 16) = o; }
                ssq += __shfl_xor(ssq, 16); ssq += __shfl_xor(ssq, 32);
                if (fq == 0) atomicAdd(rowss + row, ssq);
                if (m == 3) asm volatile("" ::: "memory"); }
    }
};
}

#define PROBE_QUANT 1
#define PROBE_SLOT (-1)
#define LAS __attribute__((address_space(3)))
typedef unsigned v4u __attribute__((ext_vector_type(4)));
typedef float f4 __attribute__((ext_vector_type(4)));
constexpr size_t MiB = 1u << 20;
constexpr size_t WS_PROJ = 0;
constexpr size_t WS_QC = 386 * MiB;
constexpr size_t WS_KC = 418 * MiB;
constexpr size_t WS_IB = 450 * MiB;
constexpr size_t WS_WPM = 482 * MiB;
constexpr size_t WS_WPA = 486 * MiB;
constexpr size_t WS_WOUT = 490 * MiB;
constexpr size_t WS_MODP = 498 * MiB;
constexpr size_t WS_MOD = WS_MODP + 786432;
constexpr size_t WS_GATES = 499 * MiB;
constexpr size_t WS_ROWSS = WS_GATES + 524288;
constexpr size_t WS_SUMM = WS_ROWSS + 65536;
constexpr size_t WS_WC = WS_SUMM + 8192;
constexpr size_t WS_QCTR = WS_WC + 4096;
constexpr size_t WS_TS = WS_WC + 4096 + 256;
constexpr size_t WS_RSUM = 500 * MiB;
constexpr size_t WS_WINT = WS_RSUM + 262144;
constexpr size_t WS_MCOMB = WS_WINT + 262144;
constexpr size_t WS_VONES = 501 * MiB;
constexpr size_t WS_END = 509 * MiB;
static_assert(WS_MCOMB + 262144 <= WS_VONES && WS_VONES + (size_t)8 * 8192 * 64 * 2 <= WS_END && WS_PROJ + (size_t)M * NP * 2 <= WS_QC && WS_TS + 256 <= WS_RSUM && WS_MOD + 49152 <= WS_GATES, "d_ws map");
constexpr size_t OB_H = 0;
constexpr size_t OB_WIN = 64 * MiB;
constexpr int NWAVES = 8, LDS_BYTES = 163840;

struct MArgs { const float* in[15]; float* out; unsigned char* ws; int ph_lo, ph_hi; };

__device__ __forceinline__ unsigned pk2(float lo, float hi) { return (unsigned)f2bf(lo) | ((unsigned)f2bf(hi) << 16); }
#define LDS_WAIT() asm volatile("s_waitcnt lgkmcnt(0)" ::: "memory")

__device__ __forceinline__ void transpose_item(const float* __restrict__ W, int ldw, int ncol_src0, bf16* __restrict__ WT, int K, int nrow_dst0, int k0, LAS float* scr, int lane) {
#pragma unroll 8
    for (int i = 0; i < 32; ++i) { const int kk = 2 * i + (lane >> 5); scr[kk * 33 + (lane & 31)] = W[(size_t)(k0 + kk) * ldw + ncol_src0 + (lane & 31)]; }
    LDS_WAIT();
    const int c = lane & 7;
#pragma unroll
    for (int j = 0; j < 4; ++j) { const int n = (lane >> 3) + 8 * j; const LAS float* s = scr + (8 * c) * 33 + n;
        v4u o; o.x = pk2(s[0 * 33], s[1 * 33]); o.y = pk2(s[2 * 33], s[3 * 33]); o.z = pk2(s[4 * 33], s[5 * 33]); o.w = pk2(s[6 * 33], s[7 * 33]);
        *(v4u*)(WT + (size_t)(nrow_dst0 + n) * K + k0 + 8 * c) = o; }
    LDS_WAIT();
}

typedef short bf16x8 __attribute__((ext_vector_type(8)));
typedef short s16x4 __attribute__((ext_vector_type(4)));
typedef float f32x16 __attribute__((ext_vector_type(16)));
typedef float f32x2_t __attribute__((ext_vector_type(2)));
typedef __bf16 bf16x2_t __attribute__((ext_vector_type(2)));
__device__ __forceinline__ unsigned cvtpk(float lo, float hi) { f32x2_t v = {lo, hi}; bf16x2_t b = __builtin_convertvector(v, bf16x2_t); return __builtin_bit_cast(unsigned, b); }
__device__ __forceinline__ s16x4 tr_read(const LAS unsigned char* p) { return __builtin_bit_cast(s16x4, __builtin_amdgcn_ds_read_tr16_b64_v4i16((LAS s16x4*)p)); }
constexpr int AT_KP = 272, AT_VP = 320, AT_KBUF = 64 * AT_KP, AT_VBUF = 64 * AT_VP, AT_VOFF = 2 * AT_KBUF, AT_BIAS = AT_VOFF + 2 * AT_VBUF, AT_LDS = AT_BIAS + 768;
constexpr float LOG2E = 1.4426950408889634f;

__device__ __forceinline__ void attn_unit(LAS unsigned char* lds, bf16* proj, const float* __restrict__ rel_bias, int b, int h, int g4, int tid, int lane, int wave) {
    const int j0 = 4 * g4, half = wave & 1, jq = j0 + (wave >> 1);
    const int r32 = lane & 31, hb = lane >> 5;
    const int tq = 64 * jq + 32 * half + r32;
    const size_t rowq = (size_t)b * S + tq;
    LAS float* biasL = (LAS float*)(lds + AT_BIAS);
    if (tid < 192) biasL[tid] = rel_bias[h * 192 + tid] * LOG2E;
    bf16x8 qf[8];
#pragma unroll
    for (int ks = 0; ks < 8; ++ks) qf[ks] = *(const bf16x8*)(proj + rowq * NP + C_AQ + h * 128 + 16 * ks + 8 * hb);
    f32x16 o[4];
#pragma unroll
    for (int dt = 0; dt < 4; ++dt)
#pragma unroll
        for (int r = 0; r < 16; ++r) o[dt][r] = 0.f;
    float m_run = -1e30f, l_run = 0.f;
    const int t0 = j0 > 8 ? j0 - 8 : 0, nt = j0 + 3 - t0 + 1;
    const int srow = tid >> 4, sc16 = tid & 15;
    const bf16* gsrc = proj + ((size_t)b * S + srow) * NP + h * 128 + sc16 * 8;
    v4u kr0, kr1, vr0, vr1;
#define AT_GLOAD(tc) do { const bf16* g_ = gsrc + (size_t)(64 * (tc)) * NP; kr0 = *(const v4u*)(g_ + C_AK); vr0 = *(const v4u*)(g_ + C_AV); kr1 = *(const v4u*)(g_ + (size_t)32 * NP + C_AK); vr1 = *(const v4u*)(g_ + (size_t)32 * NP + C_AV); } while (0)
#define AT_LWRITE(buf) do { LAS unsigned char* k_ = lds + (buf) * AT_KBUF + srow * AT_KP + sc16 * 16; LAS unsigned char* v_ = lds + AT_VOFF + (buf) * AT_VBUF + srow * AT_VP + sc16 * 16; \
        *(LAS v4u*)k_ = kr0; *(LAS v4u*)(k_ + 32 * AT_KP) = kr1; *(LAS v4u*)v_ = vr0; *(LAS v4u*)(v_ + 32 * AT_VP) = vr1; } while (0)
    AT_GLOAD(t0); AT_LWRITE(0);
    __syncthreads();
#pragma unroll
    for (int ks = 0; ks < 8; ++ks) asm volatile("" : "+v"(qf[ks]));
    const float SC = 0.08838834764831845f * LOG2E;
    for (int i = 0; i < nt; ++i) {
        const int tc = t0 + i, buf = i & 1;
        if (i + 1 < nt) AT_GLOAD(tc + 1);
        const int cdiff = jq - tc;
        if (cdiff >= 0 && cdiff <= 8) {
            const LAS unsigned char* Kb = lds + buf * AT_KBUF + r32 * AT_KP + hb * 16;
            f32x16 s0, s1;
#pragma unroll
            for (int r = 0; r < 16; ++r) { s0[r] = 0.f; s1[r] = 0.f; }
#pragma unroll
            for (int ks = 0; ks < 8; ++ks) {
                const bf16x8 k0 = *(const LAS bf16x8*)(Kb + ks * 32), k1 = *(const LAS bf16x8*)(Kb + 32 * AT_KP + ks * 32);
                s0 = __builtin_amdgcn_mfma_f32_32x32x16_bf16(k0, qf[ks], s0, 0, 0, 0);
                s1 = __builtin_amdgcn_mfma_f32_32x32x16_bf16(k1, qf[ks], s1, 0, 0, 0);
            }
            if (cdiff >= 3) { const float bc = biasL[191];
#pragma unroll
                for (int r = 0; r < 16; ++r) { s0[r] = s0[r] * SC + bc; s1[r] = s1[r] * SC + bc; }
            } else { const int base = 64 * cdiff + 32 * half + r32 + 63 - 4 * hb;
#pragma unroll
                for (int r = 0; r < 16; ++r) { const int i0 = base - ((r & 3) + 8 * (r >> 2)), i1 = i0 - 32;
                    s0[r] = s0[r] * SC + biasL[i0 > 191 ? 191 : i0]; s1[r] = s1[r] * SC + biasL[i1 > 191 ? 191 : i1]; }
            }
            float mx = fmaxf(s0[0], s1[0]);
#pragma unroll
            for (int r = 1; r < 16; ++r) mx = fmaxf(mx, fmaxf(s0[r], s1[r]));
            mx = fmaxf(mx, __shfl_xor(mx, 32));
            const float m_new = fmaxf(m_run, mx), alpha = __builtin_amdgcn_exp2f(m_run - m_new); m_run = m_new;
            float ls = 0.f;
#pragma unroll
            for (int r = 0; r < 16; ++r) { s0[r] = __builtin_amdgcn_exp2f(s0[r] - m_new); s1[r] = __builtin_amdgcn_exp2f(s1[r] - m_new); ls += s0[r] + s1[r]; }
            l_run = l_run * alpha + ls;
#pragma unroll
            for (int dt = 0; dt < 4; ++dt)
#pragma unroll
                for (int r = 0; r < 16; ++r) o[dt][r] *= alpha;
            v4u pw[4];
            pw[0] = (v4u){cvtpk(s0[0], s0[1]), cvtpk(s0[2], s0[3]), cvtpk(s0[4], s0[5]), cvtpk(s0[6], s0[7])};
            pw[1] = (v4u){cvtpk(s0[8], s0[9]), cvtpk(s0[10], s0[11]), cvtpk(s0[12], s0[13]), cvtpk(s0[14], s0[15])};
            pw[2] = (v4u){cvtpk(s1[0], s1[1]), cvtpk(s1[2], s1[3]), cvtpk(s1[4], s1[5]), cvtpk(s1[6], s1[7])};
            pw[3] = (v4u){cvtpk(s1[8], s1[9]), cvtpk(s1[10], s1[11]), cvtpk(s1[12], s1[13]), cvtpk(s1[14], s1[15])};
            const LAS unsigned char* Vb = lds + AT_VOFF + buf * AT_VBUF + (4 * hb + ((lane & 15) >> 2)) * AT_VP + (16 * ((lane >> 4) & 1) + 4 * (lane & 3)) * 2;
#pragma unroll
            for (int q = 0; q < 4; ++q) {
#pragma unroll
                for (int dt = 0; dt < 4; ++dt) {
                    const s16x4 lo = tr_read(Vb + (16 * q) * AT_VP + dt * 64), hi = tr_read(Vb + (16 * q + 8) * AT_VP + dt * 64);
                    const bf16x8 vf = (bf16x8){lo[0], lo[1], lo[2], lo[3], hi[0], hi[1], hi[2], hi[3]};
                    o[dt] = __builtin_amdgcn_mfma_f32_32x32x16_bf16(vf, __builtin_bit_cast(bf16x8, pw[q]), o[dt], 0, 0, 0);
                }
            }
        }
        if (i + 1 < nt) AT_LWRITE(buf ^ 1);
        __syncthreads();
    }
#undef AT_GLOAD
#undef AT_LWRITE
    const float linv = 1.f / (l_run + __shfl_xor(l_run, 32));
#pragma unroll
    for (int dt = 0; dt < 4; ++dt)
#pragma unroll
        for (int rq = 0; rq < 4; ++rq) {
            const int d0 = 32 * dt + 8 * rq + 4 * hb;
            const uint2 zz = *(const uint2*)(proj + rowq * NP + C_AZ + h * 128 + d0);
            const float z0 = __builtin_bit_cast(float, zz.x << 16), z1 = __builtin_bit_cast(float, zz.x & 0xffff0000u), z2 = __builtin_bit_cast(float, zz.y << 16), z3 = __builtin_bit_cast(float, zz.y & 0xffff0000u);
            uint2 w; w.x = cvtpk(o[dt][4 * rq + 0] * linv * siluf_(z0), o[dt][4 * rq + 1] * linv * siluf_(z1)); w.y = cvtpk(o[dt][4 * rq + 2] * linv * siluf_(z2), o[dt][4 * rq + 3] * linv * siluf_(z3));
            *(uint2*)(proj + rowq * NP + C_AQ + h * 128 + d0) = w;
        }
}

using pg8::bfw;
typedef float f32x4_ __attribute__((ext_vector_type(4)));
typedef unsigned u2v __attribute__((ext_vector_type(2)));
#define MFMA16(a, b, c) __builtin_amdgcn_mfma_f32_16x16x32_bf16((a), (b), (c), 0, 0, 0)
__device__ __forceinline__ float wave_scan_add(float x, int lane) {
#pragma unroll
    for (int o = 1; o < 64; o <<= 1) { const float t = __shfl_up(x, o); if (lane >= o) x += t; }
    return x;
}
__device__ __forceinline__ float wave_scan_max(float x, int lane) {
#pragma unroll
    for (int o = 1; o < 64; o <<= 1) { const float t = __shfl_up(x, o); if (lane >= o) x = fmaxf(x, t); }
    return x;
}
__device__ __forceinline__ void mlstm_summary(const float* __restrict__ gates, float* __restrict__ summ, int bh, int j, int lane) {
    const size_t row = (size_t)(bh >> 2) * S + 64 * j + lane; const int h = bh & 3;
    const float ig = gates[row * 8 + h], lf = gates[row * 8 + 4 + h];
    const float bc = wave_scan_add(lf, lane); const float b_last = __shfl(bc, 63);
    const float gmax = wave_max(b_last - bc + ig);
    if (lane == 0) { summ[(bh * 128 + j) * 2] = b_last; summ[(bh * 128 + j) * 2 + 1] = gmax; }
}
constexpr int U1_QP = 528, U1_VP = 576, U1_SP = 144;
constexpr int U1_QCL = 0, U1_KCL = 64 * U1_QP, U1_VL = 2 * 64 * U1_QP, U1_SWL = U1_VL + 64 * U1_VP, U1_SCAL = U1_SWL + 64 * U1_SP, U1_LDS = U1_SCAL + 3 * 256;
struct MlBufs { bf16* proj; const float* gates; const float* summ; const float* conv_w; const float* conv_b; bf16* QC; bf16* KC; bf16* IB; float* rowsum; float* winter; float* mcomb; float* wc; bf16* vones; };

__device__ __forceinline__ void mlstm_u1_unit(LAS unsigned char* lds, const MlBufs& B, int b, int h, int j, int tid, int lane, int wave) {
    const int bh = b * 4 + h; const size_t rowb = (size_t)b * S + 64 * j;
    LAS float* sA = (LAS float*)(lds + U1_SCAL); LAS float* sC = sA + 64; LAS float* sWk = sA + 128;
    __syncthreads();
    if (wave == 0) {
        const size_t row = rowb + lane;
        const float ig = B.gates[row * 8 + h], lf = B.gates[row * 8 + 4 + h];
        const float bc = wave_scan_add(lf, lane); const float b_last = __shfl(bc, 63);
        const float a_s = ig - bc; const float pm = wave_scan_max(a_s, lane);
        const float gg = b_last - bc + ig; const float gmax = wave_max(gg);
        float m_prev = 0.f;
        if (j > 0) {
            const float bl0 = B.summ[(bh * 128 + lane) * 2], gm0 = B.summ[(bh * 128 + lane) * 2 + 1], bl1 = B.summ[(bh * 128 + 64 + lane) * 2], gm1 = B.summ[(bh * 128 + 64 + lane) * 2 + 1];
            const float P0 = wave_scan_add(bl0, lane); const float tot0 = __shfl(P0, 63); const float P1 = wave_scan_add(bl1, lane) + tot0;
            const int jm = j - 1;
            const float e0 = (lane <= jm) ? gm0 - P0 : -INFINITY, e1 = (lane + 64 <= jm) ? gm1 - P1 : -INFINITY;
            const float emax = wave_max(fmaxf(e0, e1));
            const float Bjm = (jm < 64) ? __shfl(P0, jm) : __shfl(P1, jm - 64);
            m_prev = Bjm + fmaxf(0.f, emax);
        }
        const float m_j = fmaxf(b_last + m_prev, gmax);
        const float c_t = fmaxf(pm, m_prev);
        sA[lane] = a_s; sC[lane] = c_t; sWk[lane] = __expf(gg - m_j);
        B.winter[row * 4 + h] = __expf(m_prev - c_t); B.mcomb[row * 4 + h] = bc + c_t;
        if (lane == 0) B.wc[bh * 128 + j] = __expf(b_last + m_prev - m_j);
    }
    {
        const int cg = tid & 63, tg = tid >> 6, isk = cg >> 5, c8 = (cg & 31) * 8, chan = isk * 1024 + h * 256 + c8;
        const bf16* src = B.proj + (rowb + 8 * tg - 3) * NP + (isk ? C_MK : C_MQ) + h * 256 + c8;
        float wv[4][8], bv[8];
#pragma unroll
        for (int tap = 0; tap < 4; ++tap) { const f4 w0 = *(const f4*)(B.conv_w + tap * 2048 + chan), w1 = *(const f4*)(B.conv_w + tap * 2048 + chan + 4);
            wv[tap][0] = w0[0]; wv[tap][1] = w0[1]; wv[tap][2] = w0[2]; wv[tap][3] = w0[3]; wv[tap][4] = w1[0]; wv[tap][5] = w1[1]; wv[tap][6] = w1[2]; wv[tap][7] = w1[3]; }
        { const f4 b0 = *(const f4*)(B.conv_b + chan), b1 = *(const f4*)(B.conv_b + chan + 4); bv[0] = b0[0]; bv[1] = b0[1]; bv[2] = b0[2]; bv[3] = b0[3]; bv[4] = b1[0]; bv[5] = b1[1]; bv[6] = b1[2]; bv[7] = b1[3]; }
        v4u raw[11];
#pragma unroll
        for (int i = 0; i < 11; ++i) { const int tt = 64 * j + 8 * tg - 3 + i; raw[i] = (tt >= 0) ? *(const v4u*)(src + (size_t)i * NP) : (v4u){0u, 0u, 0u, 0u}; }
        const float osc = isk ? 0.0625f : 1.f;
        LAS unsigned char* ldst = lds + (isk ? U1_KCL : U1_QCL) + (8 * tg) * U1_QP + c8 * 2;
        bf16* gdst = (isk ? B.KC : B.QC) + (rowb + 8 * tg) * 1024 + h * 256 + c8;
#pragma unroll
        for (int t8 = 0; t8 < 8; ++t8) {
            float o[8];
#pragma unroll
            for (int e = 0; e < 8; ++e) { float acc = bv[e];
#pragma unroll
                for (int tap = 0; tap < 4; ++tap) acc += wv[tap][e] * bfw(raw[t8 + tap][e >> 1], e & 1);
                o[e] = siluf_(acc) * osc; }
            const v4u w = (v4u){cvtpk(o[0], o[1]), cvtpk(o[2], o[3]), cvtpk(o[4], o[5]), cvtpk(o[6], o[7])};
            *(LAS v4u*)(ldst + t8 * U1_QP) = w; *(v4u*)(gdst + (size_t)t8 * 1024) = w;
        }
    }
    v4u vraw[4];
#pragma unroll
    for (int i = 0; i < 4; ++i) { const int ch = tid + 512 * i, row = ch >> 5, c16 = ch & 31; vraw[i] = *(const v4u*)(B.proj + (rowb + row) * NP + C_MV + h * 256 + c16 * 8);
        *(LAS v4u*)(lds + U1_VL + row * U1_VP + c16 * 16) = vraw[i]; }
    if (tid < 128) *(LAS v4u*)(lds + U1_VL + (tid >> 1) * U1_VP + 512 + (tid & 1) * 16) = (tid & 1) ? (v4u){0u, 0u, 0u, 0u} : (v4u){0x00003F80u, 0u, 0u, 0u};
    __syncthreads();
    const int fr = lane & 15, g = lane >> 4;
    {
        const int tt = wave & 3, st0 = 2 * (wave >> 2);
        f32x4_ sacc[2] = {{0.f, 0.f, 0.f, 0.f}, {0.f, 0.f, 0.f, 0.f}};
#pragma unroll
        for (int ks = 0; ks < 8; ++ks) {
            const bf16x8 bq = *(const LAS bf16x8*)(lds + U1_QCL + (16 * tt + fr) * U1_QP + (32 * ks + 8 * g) * 2);
#pragma unroll
            for (int i = 0; i < 2; ++i) { const bf16x8 ak = *(const LAS bf16x8*)(lds + U1_KCL + (16 * (st0 + i) + fr) * U1_QP + (32 * ks + 8 * g) * 2); sacc[i] = MFMA16(ak, bq, sacc[i]); }
        }
        const int t = 16 * tt + fr; const float c_t = sC[t];
#pragma unroll
        for (int i = 0; i < 2; ++i) { const int s0 = 16 * (st0 + i) + 4 * g; const f4 a4 = *(const LAS f4*)(sA + s0);
            float o[4];
#pragma unroll
            for (int r = 0; r < 4; ++r) o[r] = (s0 + r <= t) ? sacc[i][r] * __expf(a4[r] - c_t) : 0.f;
            u2v w; w.x = cvtpk(o[0], o[1]); w.y = cvtpk(o[2], o[3]);
            *(LAS u2v*)(lds + U1_SWL + t * U1_SP + s0 * 2) = w; }
    }
    __syncthreads();
    {
        const int nvt = (wave == 0) ? 3 : 2;
        for (int iv = 0; iv < nvt; ++iv) {
            const int vt = (iv == 2) ? 16 : 2 * wave + iv;
            f32x4_ ia[4] = {{0.f, 0.f, 0.f, 0.f}, {0.f, 0.f, 0.f, 0.f}, {0.f, 0.f, 0.f, 0.f}, {0.f, 0.f, 0.f, 0.f}};
#pragma unroll
            for (int ks = 0; ks < 2; ++ks) {
                const LAS unsigned char* va = lds + U1_VL + (32 * ks + 8 * g + ((lane & 15) >> 2)) * U1_VP + (16 * vt + 4 * (lane & 3)) * 2;
                const s16x4 lo = tr_read(va), hi = tr_read(va + 4 * U1_VP);
                const bf16x8 af = (bf16x8){lo[0], lo[1], lo[2], lo[3], hi[0], hi[1], hi[2], hi[3]};
#pragma unroll
                for (int tt = 0; tt < 4; ++tt) { const bf16x8 bs = *(const LAS bf16x8*)(lds + U1_SWL + (16 * tt + fr) * U1_SP + (32 * ks + 8 * g) * 2); ia[tt] = MFMA16(af, bs, ia[tt]); }
            }
#pragma unroll
            for (int tt = 0; tt < 4; ++tt) { const size_t row = rowb + 16 * tt + fr;
                if (vt < 16) { uint2 w; w.x = cvtpk(ia[tt][0], ia[tt][1]); w.y = cvtpk(ia[tt][2], ia[tt][3]); *(uint2*)(B.IB + row * 1024 + h * 256 + 16 * vt + 4 * g) = w; }
                else if (g == 0) B.rowsum[row * 4 + h] = ia[tt][0]; }
        }
    }
#pragma unroll
    for (int i = 0; i < 4; ++i) { const int ch = tid + 512 * i, row = ch >> 5, c16 = ch & 31; const float wk = sWk[row]; v4u w;
#pragma unroll
        for (int e = 0; e < 4; ++e) w[e] = cvtpk(bfw(vraw[i][e], 0) * wk, bfw(vraw[i][e], 1) * wk);
        *(v4u*)(B.proj + (rowb + row) * NP + C_MV + h * 256 + c16 * 8) = w; }
    { const int srow = tid >> 3, c = tid & 7; const unsigned w0 = (c == 0) ? (unsigned)f2bf(sWk[srow]) : 0u;
      *(v4u*)(B.vones + ((size_t)bh * S + 64 * j + srow) * 64 + c * 8) = (v4u){w0, 0u, 0u, 0u}; }
}

constexpr int W_QP = 528, W_KP = 544, W_VP = 144, W_QL = 0, W_KL = 64 * W_QP, W_VL = W_KL + 64 * W_KP, W_LDS = W_VL + 64 * W_VP;
constexpr int W2_STAGE = W_LDS, W2_WC = 2 * W2_STAGE, W2_LDS = W2_WC + 512;
__device__ __forceinline__ void w2_compute(f32x4_ (&Ct)[16], const LAS unsigned char* st, float w_c, const MlBufs& B, size_t row0, int h, int sl, int vq, int lane,
                                           const uint2 (&ibn)[4], const float (&win)[4], uint2 (&ibx)[4], float (&wix)[4], bool has_next) {
    const int fr = lane & 15, g = lane >> 4;
#pragma unroll
    for (int tt = 0; tt < 4; ++tt) { const size_t rown = row0 + (has_next ? 64 : 0) + 16 * tt + fr;
        wix[tt] = B.winter[rown * 4 + h];
        if (sl < 4) ibx[tt] = *(const uint2*)(B.IB + rown * 1024 + h * 256 + 64 * sl + 16 * vq + 4 * g); else { ibx[tt].x = __float_as_uint(B.rowsum[rown * 4 + h]); ibx[tt].y = 0u; } }
    f32x4_ ia[4] = {{0.f, 0.f, 0.f, 0.f}, {0.f, 0.f, 0.f, 0.f}, {0.f, 0.f, 0.f, 0.f}, {0.f, 0.f, 0.f, 0.f}};
    const LAS unsigned char* qbase = st + W_QL + fr * W_QP + (4 * g) * 2;
    u2v qlo[2][4], qhi[2][4];
#pragma unroll
    for (int tt = 0; tt < 4; ++tt) { qlo[0][tt] = *(const LAS u2v*)(qbase + 16 * tt * W_QP); qhi[0][tt] = *(const LAS u2v*)(qbase + 16 * tt * W_QP + 32); }
#pragma unroll
    for (int kk = 0; kk < 8; ++kk) {
        if (kk + 1 < 8) {
#pragma unroll
            for (int tt = 0; tt < 4; ++tt) { qlo[(kk + 1) & 1][tt] = *(const LAS u2v*)(qbase + 16 * tt * W_QP + 64 * (kk + 1)); qhi[(kk + 1) & 1][tt] = *(const LAS u2v*)(qbase + 16 * tt * W_QP + 64 * (kk + 1) + 32); }
        }
        const v4u cw = (v4u){cvtpk(Ct[2 * kk][0], Ct[2 * kk][1]), cvtpk(Ct[2 * kk][2], Ct[2 * kk][3]), cvtpk(Ct[2 * kk + 1][0], Ct[2 * kk + 1][1]), cvtpk(Ct[2 * kk + 1][2], Ct[2 * kk + 1][3])};
        __builtin_amdgcn_sched_barrier(0);
#pragma unroll
        for (int tt = 0; tt < 4; ++tt)
            ia[tt] = MFMA16(__builtin_bit_cast(bf16x8, cw), __builtin_bit_cast(bf16x8, ((v4u){qlo[kk & 1][tt].x, qlo[kk & 1][tt].y, qhi[kk & 1][tt].x, qhi[kk & 1][tt].y})), ia[tt]);
        __builtin_amdgcn_sched_barrier(0);
    }
#pragma unroll
    for (int tt = 0; tt < 4; ++tt) { const size_t row = row0 + 16 * tt + fr; const float wi = win[tt];
        if (sl < 4) { uint2 w; w.x = cvtpk(bfw(ibn[tt].x, 0) + wi * ia[tt][0], bfw(ibn[tt].x, 1) + wi * ia[tt][1]); w.y = cvtpk(bfw(ibn[tt].y, 0) + wi * ia[tt][2], bfw(ibn[tt].y, 1) + wi * ia[tt][3]);
            *(uint2*)(B.IB + row * 1024 + h * 256 + 64 * sl + 16 * vq + 4 * g) = w; }
        else if (vq == 0 && g == 0) B.rowsum[row * 4 + h] = __uint_as_float(ibn[tt].x) + wi * ia[tt][0]; }
#pragma unroll
    for (int kt = 0; kt < 16; ++kt) Ct[kt] *= w_c;
#pragma unroll
    for (int ks = 0; ks < 2; ++ks) {
        const LAS unsigned char* vb = st + W_VL + (32 * ks + 8 * g + ((lane & 15) >> 2)) * W_VP + (16 * vq + 4 * (lane & 3)) * 2;
        const s16x4 vlo = tr_read(vb), vhi = tr_read(vb + 4 * W_VP);
        const bf16x8 bvf = (bf16x8){vlo[0], vlo[1], vlo[2], vlo[3], vhi[0], vhi[1], vhi[2], vhi[3]};
        const LAS unsigned char* ka = st + W_KL + (32 * ks + 8 * g + ((lane & 15) >> 2)) * W_KP + (4 * (lane & 3)) * 2;
#pragma unroll
        for (int kt = 0; kt < 16; ++kt) { const s16x4 klo = tr_read(ka + kt * 32), khi = tr_read(ka + kt * 32 + 4 * W_KP);
            const bf16x8 akf = (bf16x8){klo[0], klo[1], klo[2], klo[3], khi[0], khi[1], khi[2], khi[3]};
            Ct[kt] = MFMA16(akf, bvf, Ct[kt]); }
    }
}
__device__ __forceinline__ void mlstm_worker2(LAS unsigned char* lds, const MlBufs& B, int b, int h, int sl, int tid, int lane, int wave) {
    const int bh = b * 4 + h; const size_t rowb = (size_t)b * S;
    const bf16* vsrc = (sl < 4) ? (B.proj + rowb * NP + C_MV + h * 256 + 64 * sl) : (B.vones + (size_t)bh * S * 64);
    const size_t vpitch = (sl < 4) ? (size_t)NP : (size_t)64;
    LAS float* wcL = (LAS float*)(lds + W2_WC);
    __syncthreads();
    if (tid < 128) wcL[tid] = B.wc[bh * 128 + tid];
    const bool loader = wave >= 4;
    const int lt = tid & 255;
    const bf16* qsrc = B.QC + (rowb + (lt >> 5)) * 1024 + h * 256 + (lt & 31) * 8;
    const bf16* ksrc = B.KC + (rowb + (lt >> 5)) * 1024 + h * 256 + (lt & 31) * 8;
    const bf16* vs2 = vsrc + (size_t)(lt >> 3) * vpitch + (lt & 7) * 8;
    const int qoff = W_QL + (lt >> 5) * W_QP + (lt & 31) * 16, koff = W_KL + (lt >> 5) * W_KP + (lt & 31) * 16, voff = W_VL + (lt >> 3) * W_VP + (lt & 7) * 16;
    v4u ra[18], rb[18];
#define L_GLOAD(R, jj) do { _Pragma("unroll") for (int i_ = 0; i_ < 8; ++i_) { R[i_] = *(const v4u*)(qsrc + (size_t)(64 * (jj) + 8 * i_) * 1024); R[8 + i_] = *(const v4u*)(ksrc + (size_t)(64 * (jj) + 8 * i_) * 1024); } \
        R[16] = *(const v4u*)(vs2 + (size_t)(64 * (jj)) * vpitch); R[17] = *(const v4u*)(vs2 + (size_t)(64 * (jj) + 32) * vpitch); } while (0)
#define L_WRITE(R, bufo) do { LAS unsigned char* s_ = lds + (bufo); _Pragma("unroll") for (int i_ = 0; i_ < 8; ++i_) { *(LAS v4u*)(s_ + qoff + 8 * i_ * W_QP) = R[i_]; *(LAS v4u*)(s_ + koff + 8 * i_ * W_KP) = R[8 + i_]; } \
        *(LAS v4u*)(s_ + voff) = R[16]; *(LAS v4u*)(s_ + voff + 32 * W_VP) = R[17]; } while (0)
    if (loader) {
        L_GLOAD(ra, 0); L_WRITE(ra, 0); L_GLOAD(ra, 1); L_GLOAD(rb, 2);
        __syncthreads();
        for (int j = 0; j < 128; j += 2) {
            L_WRITE(ra, W2_STAGE); { const int jn = (j + 3 < 128) ? j + 3 : 127; L_GLOAD(ra, jn); }
            __syncthreads();
            L_WRITE(rb, 0); { const int jn = (j + 4 < 128) ? j + 4 : 127; L_GLOAD(rb, jn); }
            __syncthreads();
        }
    } else {
        f32x4_ Ct[16];
#pragma unroll
        for (int kt = 0; kt < 16; ++kt) Ct[kt] = (f32x4_){0.f, 0.f, 0.f, 0.f};
        uint2 iba[4], ibb[4]; float wia[4], wib[4];
        { const int fr = lane & 15, g = lane >> 4;
#pragma unroll
          for (int tt = 0; tt < 4; ++tt) { const size_t r0 = rowb + 16 * tt + fr; wia[tt] = B.winter[r0 * 4 + h];
              if (sl < 4) iba[tt] = *(const uint2*)(B.IB + r0 * 1024 + h * 256 + 64 * sl + 16 * wave + 4 * g); else { iba[tt].x = __float_as_uint(B.rowsum[r0 * 4 + h]); iba[tt].y = 0u; } } }
        __syncthreads();
        for (int j = 0; j < 128; j += 2) {
            w2_compute(Ct, lds, wcL[j], B, rowb + 64 * j, h, sl, wave, lane, iba, wia, ibb, wib, true);
            __syncthreads();
            w2_compute(Ct, lds + W2_STAGE, wcL[j + 1], B, rowb + 64 * (j + 1), h, sl, wave, lane, ibb, wib, iba, wia, j + 2 < 128);
            __syncthreads();
        }
    }
#undef L_GLOAD
#undef L_WRITE
}
template <int NI> __device__ __forceinline__ void mlstm_post_items(const MlBufs& B, const float* __restrict__ mh_norm_g, int it0, int stride, int lane) {
    uint2 iw[NI], gz[NI]; float den[NI], mc[NI]; bf16* gp[NI]; f4 gn[NI];
#pragma unroll
    for (int i = 0; i < NI; ++i) { const int it = it0 + i * stride; const size_t row = (size_t)(it >> 2); const int h = it & 3, c = h * 256 + lane * 4;
        iw[i] = *(const uint2*)(B.IB + row * 1024 + c); gp[i] = B.proj + row * NP + C_GZ + c; gz[i] = *(const uint2*)gp[i];
        den[i] = B.rowsum[row * 4 + h]; mc[i] = B.mcomb[row * 4 + h]; gn[i] = *(const f4*)(mh_norm_g + c); }
#pragma unroll
    for (int i = 0; i < NI; ++i) {
        const float dinv = 1.f / fmaxf(fabsf(den[i]), __expf(-mc[i]));
        float hv[4];
        hv[0] = bfw(iw[i].x, 0) * dinv; hv[1] = bfw(iw[i].x, 1) * dinv; hv[2] = bfw(iw[i].y, 0) * dinv; hv[3] = bfw(iw[i].y, 1) * dinv;
        const float ss = wave_sum(hv[0] * hv[0] + hv[1] * hv[1] + hv[2] * hv[2] + hv[3] * hv[3]);
        const float r = 1.0f / sqrtf(ss * (1.f / 256.f) + EPS);
        uint2 w;
        w.x = cvtpk(hv[0] * r * gn[i][0] * bfw(gz[i].x, 0), hv[1] * r * gn[i][1] * bfw(gz[i].x, 1));
        w.y = cvtpk(hv[2] * r * gn[i][2] * bfw(gz[i].y, 0), hv[3] * r * gn[i][3] * bfw(gz[i].y, 1));
        *(uint2*)gp[i] = w;
    }
}
__global__ void __launch_bounds__(NWAVES * 64, 2) mega(MArgs a) {
    extern __shared__ __attribute__((aligned(16))) unsigned char lds_raw[];
    LAS unsigned char* lds = (LAS unsigned char*)lds_raw;
    cg::grid_group grid = cg::this_grid();
    const int tid = threadIdx.x, lane = tid & 63, wave = __builtin_amdgcn_readfirstlane(tid >> 6);
    const int G = gridDim.x, gw = blockIdx.x * NWAVES + wave, NGW = G * NWAVES;
    const float* x = a.in[0]; const float* cvec = a.in[1]; const float* w_ada = a.in[2]; const float* b_ada = a.in[3]; const float* norm_g = a.in[4]; const float* w_in = a.in[5];
    const float* b_if = a.in[6]; const float* final_g = a.in[14]; const float* w_proj_m = a.in[11]; const float* w_proj_a = a.in[12]; const float* w_out = a.in[13];
    unsigned char* ws = a.ws; unsigned char* ob = (unsigned char*)a.out;
    bf16* proj = (bf16*)(ws + WS_PROJ); bf16* Wpm_t = (bf16*)(ws + WS_WPM); bf16* Wpa_t = (bf16*)(ws + WS_WPA); bf16* Wout_t = (bf16*)(ws + WS_WOUT);
    float* modp = (float*)(ws + WS_MODP); float* mod = (float*)(ws + WS_MOD); float* gates = (float*)(ws + WS_GATES); float* rowss = (float*)(ws + WS_ROWSS);
    bf16* merged = proj;
    bf16* H = (bf16*)(ob + OB_H); bf16* Win_t = (bf16*)(ob + OB_WIN);
    const int lo = a.ph_lo, hi = a.ph_hi;
    unsigned long long* tsb = (unsigned long long*)(ws + WS_TS); int nst = 0;
#define STAMP() do { if (PROBE_SLOT >= 0 && blockIdx.x == 0 && tid == 0) tsb[nst] = __builtin_amdgcn_s_memrealtime(); ++nst; } while (0)
    STAMP();
#define IN(k) (lo <= (k) && (k) < hi)
#define BOTH(k) (IN(k) && IN((k) + 1))

    if (IN(0)) {
        for (int it = gw; it < 64 * 24; it += NGW) {
            const int ks = it / 24, cb = it % 24, n0 = cb * 256 + lane * 4;
            f4 a0 = {0.f, 0.f, 0.f, 0.f}, a1 = {0.f, 0.f, 0.f, 0.f};
            if (ks == 0) { a0 = *(const f4*)(b_ada + n0); a1 = a0; }
#pragma unroll 8
            for (int kk = 0; kk < 32; ++kk) { const int k = ks * 32 + kk; const f4 w = *(const f4*)(w_ada + (size_t)k * (3 * D) + n0);
                const float c0 = cvec[k], c1 = cvec[D + k]; const float s0 = c0 / (1.f + __expf(-c0)), s1 = c1 / (1.f + __expf(-c1));
                a0 += w * s0; a1 += w * s1; }
#pragma unroll
            for (int e = 0; e < 4; ++e) { atomicAdd(mod + n0 + e, a0[e]); atomicAdd(mod + 3 * D + n0 + e, a1[e]); }
        }
        if (blockIdx.x == 0 && tid == 0) *(unsigned*)(ws + WS_QCTR) = 0u;
        if (BOTH(0)) { grid.sync(); STAMP(); }
    }

    if (IN(1)) {
        LAS float* smod = (LAS float*)lds;
        LAS float* gwl = (LAS float*)(lds + 49152);
        for (int i = tid; i < 2 * 3 * D; i += NWAVES * 64) { const float sv = mod[i]; const int c6 = i % (3 * D); smod[i] = (c6 >= D && c6 < 2 * D) ? norm_g[c6 - D] * (1.f + sv) : sv; }
        for (int k = tid; k < D; k += NWAVES * 64) { const float4 w0 = *(const float4*)(w_in + (size_t)k * INC + 5120), w1 = *(const float4*)(w_in + (size_t)k * INC + 5124);
            gwl[0 * D + k] = w0.x; gwl[1 * D + k] = w0.y; gwl[2 * D + k] = w0.z; gwl[3 * D + k] = w0.w; gwl[4 * D + k] = w1.x; gwl[5 * D + k] = w1.y; gwl[6 * D + k] = w1.z; gwl[7 * D + k] = w1.w; }
        __syncthreads();
        if (wave >= 4) {
            LAS float* scr = (LAS float*)(lds + 114688 + (wave - 4) * 8448);
            constexpr int I_IN = (D / 64) * (NPW / 32), I_PM = (1024 / 64) * (D / 32), I_OUT = (D / 64) * (D / 32);
            constexpr int NITEMS = I_IN + 2 * I_PM + I_OUT;
            for (int it = blockIdx.x * 4 + (wave - 4); it < NITEMS; it += G * 4) {
                int r = it;
                if (r < I_IN) { const int nblk = NPW / 32, kb = r / nblk, nb = r % nblk, nd = 32 * nb;
                    int ns = nd; if (nd >= 9216) { const int t = (nd - 9216) >> 8, rr = (nd - 9216) & 255; ns = (rr < 128) ? 9224 + 128 * t + rr : 11272 + 128 * t + (rr - 128); } else if (nd >= 5120) ns = nd + 8; else if (nd >= 3072) { const int t = (nd - 3072) >> 8, rr = (nd - 3072) & 255; ns = (rr < 128) ? 3072 + 128 * t + rr : 4096 + 128 * t + (rr - 128); }
                    transpose_item(w_in, INC, ns, Win_t, D, nd, 64 * kb, scr, lane); continue; }
                r -= I_IN;
                if (r < I_PM) { const int nblk = D / 32, kb = r / nblk, nb = r % nblk; transpose_item(w_proj_m, D, 32 * nb, Wpm_t, 1024, 32 * nb, 64 * kb, scr, lane); continue; }
                r -= I_PM;
                if (r < I_PM) { const int nblk = D / 32, kb = r / nblk, nb = r % nblk; transpose_item(w_proj_a, D, 32 * nb, Wpa_t, 1024, 32 * nb, 64 * kb, scr, lane); continue; }
                r -= I_PM;
                { const int nblk = D / 32, kb = r / nblk, nb = r % nblk; transpose_item(w_out, D, 32 * nb, Wout_t, D, 32 * nb, 64 * kb, scr, lane); }
            }
        } else {
        const int rw = blockIdx.x * 4 + wave, RST = G * 4;
        f4 vn[8], vm[8];
        { const f4* xr = (const f4*)(x + (size_t)rw * D); const f4* xr2 = (const f4*)(x + (size_t)((rw + RST < M) ? rw + RST : rw) * D);
#pragma unroll
          for (int j = 0; j < 8; ++j) { vn[j] = xr[lane + 64 * j]; vm[j] = xr2[lane + 64 * j]; } }
        for (int row = rw; row < M; row += RST) {
            const int b = row / S;
            f4 v[8]; float ss = 0.f;
#pragma unroll
            for (int j = 0; j < 8; ++j) { v[j] = vn[j]; vn[j] = vm[j]; ss += (v[j][0] * v[j][0] + v[j][1] * v[j][1]) + (v[j][2] * v[j][2] + v[j][3] * v[j][3]); }
            { const int rn = (row + 2 * RST < M) ? row + 2 * RST : row; const f4* xr = (const f4*)(x + (size_t)rn * D);
#pragma unroll
              for (int j = 0; j < 8; ++j) vm[j] = xr[lane + 64 * j]; }
            ss = wave_sum(ss);
            const float rstd = 1.0f / sqrtf(ss * (1.f / D) + EPS);
            float a0[8];
#pragma unroll
            for (int i = 0; i < 8; ++i) a0[i] = 0.f;
            const LAS float* shift = smod + b * 3 * D; const LAS float* scale = shift + D;
#pragma unroll
            for (int j = 0; j < 8; ++j) {
                const int k0 = (lane + 64 * j) * 4;
                const f4 gs = *(const LAS f4*)(scale + k0); const f4 sh4 = *(const LAS f4*)(shift + k0);
                const f4 h0 = v[j] * rstd * gs + sh4;
#pragma unroll
                for (int i = 0; i < 8; ++i) { const f4 w4 = *(const LAS f4*)(gwl + i * D + k0); a0[i] += (h0[0] * w4[0] + h0[1] * w4[1]) + (h0[2] * w4[2] + h0[3] * w4[3]); }
                uint2 o0; o0.x = pk2(h0[0], h0[1]); o0.y = pk2(h0[2], h0[3]);
                *(uint2*)(H + (size_t)row * D + k0) = o0;
                asm volatile("" ::: "memory"); __builtin_amdgcn_sched_barrier(0);
            }
            float d0;
            { float b0[4], c0[2];
#pragma unroll
              for (int i = 0; i < 4; ++i) { const bool hi = lane & 32; const float s0 = hi ? a0[i] : a0[4 + i]; b0[i] = (hi ? a0[4 + i] : a0[i]) + __shfl_xor(s0, 32); }
#pragma unroll
              for (int i = 0; i < 2; ++i) { const bool hi = lane & 16; const float s0 = hi ? b0[i] : b0[2 + i]; c0[i] = (hi ? b0[2 + i] : b0[i]) + __shfl_xor(s0, 16); }
              { const bool hi = lane & 8; const float s0 = hi ? c0[0] : c0[1]; d0 = (hi ? c0[1] : c0[0]) + __shfl_xor(s0, 8); }
              d0 += __shfl_xor(d0, 4); d0 += __shfl_xor(d0, 2); d0 += __shfl_xor(d0, 1); }
            if ((lane & 7) == 0) {
                const int vi = ((lane >> 5) & 1) * 4 + ((lane >> 4) & 1) * 2 + ((lane >> 3) & 1);
                float z0 = d0 + b_if[vi];
                if (vi >= 4) z0 = fminf(z0, 0.f) - log1pf(expf(-fabsf(z0)));
                gates[(size_t)row * 8 + vi] = z0;
                if (vi == 0) rowss[row] = 0.f;
            }
        }
        }
        __syncthreads();
        if (BOTH(1)) { grid.sync(); STAMP(); }
    }

    constexpr int NWORK = 40, SKIP_ROUNDS = 11;
    if (IN(2)) {
        if (gw < 1024) mlstm_summary(gates, (float*)(ws + WS_SUMM), gw >> 7, gw & 127, lane);
        pg8::Gemm g{H, H, Win_t, Win_t, D, D}; pg8::StaticOrder So; So.init(M, 12 * 256, G, (int)blockIdx.x);
        pg8::EpiProj E{proj, NP};
        pg8::gemm_phase<pg8::EpiProj, pg8::StaticOrder, true, true>(lds, g, So, E);
        if (BOTH(2)) { grid.sync(); STAMP(); }
    }
    if (IN(3)) {
        MlBufs mb; mb.proj = proj; mb.gates = gates; mb.summ = (const float*)(ws + WS_SUMM); mb.conv_w = a.in[7]; mb.conv_b = a.in[8];
        mb.QC = (bf16*)(ws + WS_QC); mb.KC = (bf16*)(ws + WS_KC); mb.IB = (bf16*)(ws + WS_IB);
        mb.rowsum = (float*)(ws + WS_RSUM); mb.winter = (float*)(ws + WS_WINT); mb.mcomb = (float*)(ws + WS_MCOMB); mb.wc = (float*)(ws + WS_WC); mb.vones = (bf16*)(ws + WS_VONES);
        for (int u = blockIdx.x; u < 1024; u += G) mlstm_u1_unit(lds, mb, u >> 9, (u >> 7) & 3, u & 127, tid, lane, wave);
        grid.sync(); STAMP();
        if (blockIdx.x < NWORK) mlstm_worker2(lds, mb, (blockIdx.x & 7) >> 2, blockIdx.x & 3, blockIdx.x >> 3, tid, lane, wave);
        {
            pg8::Gemm g{H, H, Win_t, Win_t, D, D}; pg8::RestOrder So; So.base.init(M, 40 * 256, G, (int)blockIdx.x); So.nwork = NWORK; So.R = SKIP_ROUNDS; So.pn0 = 12;
            pg8::EpiProj E{proj, NP};
            pg8::gemm_phase<pg8::EpiProj, pg8::RestOrder, true, true>(lds, g, So, E);
        }
        grid.sync(); STAMP();
        for (int it = gw; it < M * 4; it += 8 * NGW) mlstm_post_items<8>(mb, a.in[9], it, NGW, lane);
        {
            unsigned* qctr = (unsigned*)(ws + WS_QCTR); volatile LAS unsigned* qslot = (volatile LAS unsigned*)(lds + 163000);
            for (;;) {
                __syncthreads();
                if (tid == 0) *qslot = atomicAdd(qctr, 1u);
                __syncthreads();
                const unsigned q = *qslot;
                if (q >= 512u) break;
                const int u = 511 - (int)q;
                attn_unit(lds, proj, a.in[10], (u & 15) >> 3, u & 7, u >> 4, tid, lane, wave);
            }
        }
        if (BOTH(3)) { grid.sync(); STAMP(); }
    }
    if (IN(4)) {
        pg8::Gemm g{proj + C_GZ, proj + C_AQ, Wpm_t, Wpa_t, NP, 1024}; pg8::SegOrder So; So.base.init(M, D, G, (int)blockIdx.x);
        pg8::EpiMerge E{proj, NP, C_GM, C_GA, merged, NP};
        pg8::gemm_phase<pg8::EpiMerge, pg8::SegOrder, true, true>(lds, g, So, E);
        if (BOTH(4)) grid.sync(); STAMP();
    }
    if (IN(5)) {
        pg8::Gemm g{merged, merged, Wout_t, Wout_t, NP, D}; pg8::StaticOrder So; So.init(M, D, G, (int)blockIdx.x);
        pg8::EpiOut E{x, mod + 2 * D, a.out, rowss, D, S, 3 * D};
        pg8::gemm_phase<pg8::EpiOut, pg8::StaticOrder, true, true>(lds, g, So, E);
        if (BOTH(5)) grid.sync(); STAMP();
    }
    if (IN(6)) {
        for (int row = gw; row < M; row += NGW) {
            const float r = 1.0f / sqrtf(rowss[row] * (1.f / D) + EPS);
            f4* xr = (f4*)(a.out + (size_t)row * D);
#pragma unroll
            for (int j = 0; j < 8; ++j) { const f4 g4 = *(const f4*)(final_g + (lane + 64 * j) * 4); xr[lane + 64 * j] = xr[lane + 64 * j] * r * g4; }
        }
    }
    if (PROBE_SLOT >= 0) {
        STAMP(); grid.sync();
        const float e = (float)(((tsb[PROBE_SLOT + 1] - tsb[PROBE_SLOT]) / PROBE_QUANT) * PROBE_QUANT) * 1e-6f;
        for (int row = gw; row < M; row += NGW) { f4* xr = (f4*)(a.out + (size_t)row * D);
#pragma unroll
            for (int j = 0; j < 8; ++j) xr[lane + 64 * j] = xr[lane + 64 * j] + e; }
    }
#undef IN
#undef BOTH
}

static int launch_mega(const MArgs& a, hipStream_t stream) {
    static int grid = 0;
    if (grid == 0) {
        int dev = 0, cus = 0, per_cu = 0;
        if (hipGetDevice(&dev) != hipSuccess || hipDeviceGetAttribute(&cus, hipDeviceAttributeMultiprocessorCount, dev) != hipSuccess) { fprintf(stderr, "kernel_launch: device query failed\n"); grid = -1; return -1; }
        if (hipFuncSetAttribute((const void*)mega, hipFuncAttributeMaxDynamicSharedMemorySize, LDS_BYTES) != hipSuccess) { fprintf(stderr, "kernel_launch: hipFuncSetAttribute failed\n"); grid = -1; return -1; }
        if (hipOccupancyMaxActiveBlocksPerMultiprocessor(&per_cu, (const void*)mega, NWAVES * 64, LDS_BYTES) != hipSuccess || per_cu < 1) { fprintf(stderr, "kernel_launch: occupancy query says %d blocks/CU\n", per_cu); (void)hipGetLastError(); grid = -1; return -1; }
        grid = cus * (per_cu > 1 ? 1 : per_cu);
        fprintf(stderr, "kernel_launch: %d CUs, occupancy %d blocks/CU, grid %d\n", cus, per_cu, grid);
    }
    if (grid < 0) return -1;
    MArgs arg = a; void* args[] = {(void*)&arg};
    const hipError_t e = hipLaunchCooperativeKernel((const void*)mega, dim3(grid), dim3(NWAVES * 64), args, LDS_BYTES, stream);
    if (e != hipSuccess) { fprintf(stderr, "kernel_launch: cooperative launch failed: %s (grid %d)\n", hipGetErrorString(e), grid); return -1; }
    return 0;
}

extern "C" void kernel_launch(void* const* d_in, const int* in_sizes, int n_in, void* d_out, int out_size, void* d_ws, size_t ws_size, hipStream_t stream) {
    if (n_in != 15 || in_sizes[0] != M * D || out_size != M * D || ws_size < WS_END) { fprintf(stderr, "kernel_launch: unexpected shapes / workspace (%zu < %zu)\n", ws_size, (size_t)WS_END); return; }
    if (hipMemsetAsync((unsigned char*)d_ws + WS_MOD, 0, 2 * 3 * D * sizeof(float), stream) != hipSuccess) { fprintf(stderr, "kernel_launch: hipMemsetAsync failed\n"); return; }
    MArgs a{}; for (int i = 0; i < 15; ++i) a.in[i] = (const float*)d_in[i]; a.out = (float*)d_out; a.ws = (unsigned char*)d_ws; a.ph_lo = 0; a.ph_hi = 7;
    launch_mega(a, stream);
}
```
